# Optimizing an MI355X kernel written in HIP

```python
import math
import jax, jax.numpy as jnp
from jax import lax
import numpy as np

D_MODEL = 1024
BATCH = 8
SEQ = 4096
DEPTH = 2
DEC_BATCH = 2
DEC_SEQ = 8192
PAST_LEN = 128

GRID_W = 64
HEAD_DIM = 64
RW_HEADS = D_MODEL // 256
AT_HEADS = D_MODEL // 128
AT_KV_HEADS = AT_HEADS // 4
AT_GROUP = AT_HEADS // AT_KV_HEADS
ML_HEADS = D_MODEL // 256
RW_W = RW_HEADS * HEAD_DIM
AT_W = AT_HEADS * HEAD_DIM
AT_KV_W = AT_KV_HEADS * HEAD_DIM
ML_W = ML_HEADS * HEAD_DIM
MIX_W = RW_W + AT_W + ML_W
DECAY_LORA = 64
AAA_LORA = 64
GATE_LORA = 128
D_FF = 4 * D_MODEL
Q_BLOCK = 128
ML_CHUNK = 64
ROPE_THETA = 10000.0
NORM_EPS = 1e-6
RW_LN_EPS = 64e-5
RW_COLS = 3 * RW_W + 2 * DECAY_LORA + 2 * AAA_LORA + GATE_LORA
AT_COLS = AT_W + 2 * AT_KV_W
ML_COLS = 4 * ML_W + 4 * ML_HEADS
N_IN = RW_COLS + AT_COLS + ML_COLS

kernel_name = "hybrid_rwkv7_gqa_mlstm_encoder"


def split_cols(t, sizes):
    idx = np.cumsum(sizes)[:-1].tolist()
    return jnp.split(t, idx, axis=-1)


def rmsnorm(x, g):
    xf = x.astype(jnp.float32)
    y = xf * lax.rsqrt(jnp.mean(xf * xf, axis=-1, keepdims=True) + NORM_EPS)
    return (y * g.astype(jnp.float32)).astype(x.dtype)


def neighbours(y):
    prev = jnp.pad(y[:, :-1], ((0, 0), (1, 0), (0, 0)))
    nxt = jnp.pad(y[:, 1:], ((0, 0), (0, 1), (0, 0)))
    return prev, nxt


def flip_t(t):
    return jnp.flip(t, axis=1)


def rwkv_scan(r, w, k, v, kk, a):
    B, S, H, N = r.shape
    xs = tuple(jnp.moveaxis(t, 1, 0) for t in (r, w, k, v, kk, a))

    def step(st, inp):
        rt, wt, kt, vt, kkt, at = inp
        sa = jnp.einsum('bhij,bhj->bhi', st, -kkt)
        st = st * wt[:, :, None, :] + sa[..., None] * (kkt * at)[:, :, None, :] + vt[..., None] * kt[:, :, None, :]
        yt = jnp.einsum('bhij,bhj->bhi', st, rt)
        return st, yt

    s0 = jnp.zeros((B, H, N, N), jnp.float32)
    _, ys = lax.scan(step, s0, xs)
    return jnp.moveaxis(ys, 0, 1)


def rwkv_mixer(cols, w0, w2, a0, a2, g2, k_k, k_a, r_k, ln_w, ln_b):
    B, S, _ = cols.shape
    r, k, v, wd, ad, gd = split_cols(cols, [RW_W, RW_W, RW_W, 2 * DECAY_LORA, 2 * AAA_LORA, GATE_LORA])
    heads = lambda t: t.reshape(B, S, RW_HEADS, HEAD_DIM)
    kk = heads(k * k_k)
    kk = kk / jnp.maximum(jnp.sqrt(jnp.sum(kk * kk, axis=-1, keepdims=True)), 1e-12)
    g = jax.nn.sigmoid(gd) @ g2
    rh, vh = heads(r), heads(v)
    wkv = 0.0
    bonus = 0.0
    for d in range(2):
        wl = jnp.tanh(wd[..., d * DECAY_LORA:(d + 1) * DECAY_LORA]) @ w2[d]
        decay = jnp.exp(-jnp.exp(-jax.nn.softplus(-(w0[d] + wl)) - 0.5))
        a = jax.nn.sigmoid(a0[d] + ad[..., d * AAA_LORA:(d + 1) * AAA_LORA] @ a2[d])
        kd = heads(k * (1.0 + (a - 1.0) * k_a))
        seq_in = (rh, heads(decay), kd, vh, kk, heads(a))
        if d == 0:
            y_d = rwkv_scan(*seq_in)
        else:
            y_d = flip_t(rwkv_scan(*[flip_t(t) for t in seq_in]))
        wkv = wkv + y_d
        bonus = bonus + jnp.sum(rh * kd * r_k, axis=-1, keepdims=True) * vh
    mu = jnp.mean(wkv, axis=-1, keepdims=True)
    var = jnp.mean(jnp.square(wkv - mu), axis=-1, keepdims=True)
    y = ((wkv - mu) * lax.rsqrt(var + RW_LN_EPS)).reshape(B, S, RW_W) * ln_w + ln_b
    return (y + bonus.reshape(B, S, RW_W)) * g


def rope_tables(seq_len):
    rows = seq_len // GRID_W
    row_idx, col_idx = jnp.meshgrid(jnp.arange(rows), jnp.arange(GRID_W), indexing='ij')
    row = row_idx.reshape(-1).astype(jnp.float32)
    col = col_idx.reshape(-1).astype(jnp.float32)
    n_freq = HEAD_DIM // 4
    inv = ROPE_THETA ** (-jnp.arange(n_freq, dtype=jnp.float32) / n_freq)
    ang_r = row[:, None] * inv
    ang_c = col[:, None] * inv
    ang = jnp.concatenate([ang_r, ang_r, ang_c, ang_c], axis=-1)
    return jnp.cos(ang), jnp.sin(ang)


def rotate_halves(x):
    n_freq = HEAD_DIM // 4
    xs = x.reshape(x.shape[:-1] + (2, 2, n_freq))
    rot = jnp.stack([-xs[..., 1, :], xs[..., 0, :]], axis=-2)
    return rot.reshape(x.shape)


def attention_mixer(cols, q_norm, k_norm, cos, sin):
    B, S, _ = cols.shape
    q, k, v = split_cols(cols, [AT_W, AT_KV_W, AT_KV_W])
    q = rmsnorm(q.reshape(B, S, AT_KV_HEADS, AT_GROUP, HEAD_DIM), q_norm)
    k = rmsnorm(k.reshape(B, S, AT_KV_HEADS, HEAD_DIM), k_norm)
    v = v.reshape(B, S, AT_KV_HEADS, HEAD_DIM)
    q = q * cos[None, :, None, None, :] + rotate_halves(q) * sin[None, :, None, None, :]
    k = k * cos[None, :, None, :] + rotate_halves(k) * sin[None, :, None, :]
    q = q * (HEAD_DIM ** -0.5)
    nq = S // Q_BLOCK
    qb = q.reshape(B, nq, Q_BLOCK, AT_KV_HEADS, AT_GROUP, HEAD_DIM).transpose(1, 0, 2, 3, 4, 5)

    def one_block(q_blk):
        s = jnp.einsum('bqhgd,bkhd->bhgqk', q_blk, k)
        p = jax.nn.softmax(s.astype(jnp.float32), axis=-1)
        return jnp.einsum('bhgqk,bkhd->bqhgd', p, v)

    o = lax.map(one_block, qb)
    return o.transpose(1, 0, 2, 3, 4, 5).reshape(B, S, AT_W)


def mlstm_chunked(q, k, v, ig, lf):
    B, S, H, Dh = q.shape
    L = ML_CHUNK
    nc = S // L
    to_c = lambda t: t.reshape(B, nc, L, H, Dh).transpose(0, 3, 1, 2, 4)
    to_g = lambda t: t.reshape(B, nc, L, H).transpose(0, 3, 1, 2)
    q, k, v = to_c(q), to_c(k), to_c(v)
    ig, lf = to_g(ig), to_g(lf)
    b = jnp.cumsum(lf, axis=-1)
    bL = b[..., -1]
    g = bL[..., None] - b + ig
    mg = jnp.max(g, axis=-1)
    wgt = jnp.exp(g - mg[..., None])
    Kc = jnp.einsum('bhcl,bhcld,bhcle->bhcde', wgt, v, k)
    Nc = jnp.einsum('bhcl,bhcle->bhce', wgt, k)

    def step(carry, inp):
        C, n, m = carry
        bl, mgc, kc, ncc = inp
        m_new = jnp.maximum(bl + m, mgc)
        a1 = jnp.exp(bl + m - m_new)
        a2 = jnp.exp(mgc - m_new)
        C_new = a1[..., None, None] * C + a2[..., None, None] * kc
        n_new = a1[..., None] * n + a2[..., None] * ncc
        return (C_new, n_new, m_new), (C, n, m)

    xs = (jnp.moveaxis(bL, 2, 0), jnp.moveaxis(mg, 2, 0), jnp.moveaxis(Kc, 2, 0), jnp.moveaxis(Nc, 2, 0))
    init = (jnp.zeros((B, H, Dh, Dh), jnp.float32), jnp.zeros((B, H, Dh), jnp.float32), jnp.zeros((B, H), jnp.float32))
    _, (Cp, Np, Mp) = lax.scan(step, init, xs)
    Cp = jnp.moveaxis(Cp, 0, 2)
    Np = jnp.moveaxis(Np, 0, 2)
    Mp = jnp.moveaxis(Mp, 0, 2)
    lower = jnp.tril(jnp.ones((L, L), dtype=bool))
    Dm = jnp.where(lower, b[..., :, None] - b[..., None, :] + ig[..., None, :], -jnp.inf)
    inter = b + Mp[..., None]
    m_t = jnp.maximum(jnp.max(Dm, axis=-1), inter)
    P = jnp.exp(Dm - m_t[..., None]) * jnp.einsum('bhctd,bhcsd->bhcts', q, k)
    sc = jnp.exp(inter - m_t)
    num = jnp.einsum('bhcts,bhcsd->bhctd', P, v) + sc[..., None] * jnp.einsum('bhcde,bhcte->bhctd', Cp, q)
    den = jnp.sum(P, axis=-1) + sc * jnp.einsum('bhce,bhcte->bhct', Np, q)
    h = num / jnp.maximum(jnp.abs(den), jnp.exp(-m_t))[..., None]
    return h.transpose(0, 2, 3, 1, 4).reshape(B, S, H, Dh)


def mlstm_mixer(cols, conv_w, i_bias, f_bias, norm_w):
    B, S, _ = cols.shape
    qk, v, o, ig, fg = split_cols(cols, [2 * ML_W, ML_W, ML_W, 2 * ML_HEADS, 2 * ML_HEADS])
    prev, nxt = neighbours(qk)
    qk = jax.nn.silu(conv_w[0] * prev + conv_w[1] * qk + conv_w[2] * nxt)
    q, k = split_cols(qk, [ML_W, ML_W])
    heads = lambda t: t.reshape(B, S, ML_HEADS, HEAD_DIM)
    q, k, v = heads(q), heads(k) * (HEAD_DIM ** -0.5), heads(v)
    h = 0.0
    for d in range(2):
        ig_d = ig[..., d * ML_HEADS:(d + 1) * ML_HEADS] + i_bias[d]
        lf_d = jax.nn.log_sigmoid(fg[..., d * ML_HEADS:(d + 1) * ML_HEADS] + f_bias[d])
        if d == 0:
            h = h + mlstm_chunked(q, k, v, ig_d, lf_d)
        else:
            h = h + flip_t(mlstm_chunked(flip_t(q), flip_t(k), flip_t(v), flip_t(ig_d), flip_t(lf_d)))
    h = rmsnorm(h, norm_w.reshape(ML_HEADS, HEAD_DIM)).reshape(B, S, ML_W)
    return jax.nn.sigmoid(o) * h


def trunk(x, P):
    S = x.shape[1]
    cos, sin = rope_tables(S)
    for l in range(DEPTH):
        xin = rmsnorm(x, P['norm1_g'][l])
        proj = (xin @ P['w_in'][l]).astype(jnp.float32)
        rw, at, ml = split_cols(proj, [RW_COLS, AT_COLS, ML_COLS])
        prev, nxt = neighbours(rw)
        rw = rw + (0.5 * (prev + nxt) - rw) * P['rw_mu'][l]
        y_rw = rwkv_mixer(rw, P['rw_w0'][l], P['rw_w2'][l], P['rw_a0'][l], P['rw_a2'][l], P['rw_g2'][l],
                          P['rw_kk'][l], P['rw_ka'][l], P['rw_rk'][l], P['rw_lnw'][l], P['rw_lnb'][l])
        y_at = attention_mixer(at, P['at_qn'][l], P['at_kn'][l], cos, sin)
        y_ml = mlstm_mixer(ml, P['ml_conv'][l], P['ml_ib'][l], P['ml_fb'][l], P['ml_nw'][l])
        mix = jnp.concatenate([y_rw, y_at, y_ml], axis=-1).astype(x.dtype)
        h = x + mix @ P['w_out'][l]
        hn = rmsnorm(h, P['norm2_g'][l])
        x = h + jnp.square(jax.nn.relu(hn @ P['mlp_w1'][l])) @ P['mlp_w2'][l]
    return rmsnorm(x, P['final_g'])


def setup_inputs(seed: int = 0) -> dict:
    key = jax.random.key(seed)
    ks = jax.random.split(key, 32)
    f32 = jnp.float32
    nrm = lambda k, shape, s: jax.random.normal(k, shape, f32) * s
    gain = lambda k, shape: 1.0 + 0.02 * jax.random.normal(k, shape, f32)
    f_bias = jnp.broadcast_to(jnp.linspace(3.0, 6.0, ML_HEADS, dtype=f32), (DEPTH, 2, ML_HEADS))
    return {
        "x_prompt": jax.random.normal(ks[0], (BATCH, SEQ, D_MODEL), f32),
        "x_sample": jax.random.normal(ks[1], (DEC_BATCH, DEC_SEQ, D_MODEL), f32),
        "norm1_g": gain(ks[2], (DEPTH, D_MODEL)),
        "w_in": nrm(ks[3], (DEPTH, D_MODEL, N_IN), D_MODEL ** -0.5),
        "rw_mu": jax.random.uniform(ks[4], (DEPTH, RW_COLS), f32),
        "rw_w0": nrm(ks[5], (DEPTH, 2, RW_W), 1.0) + 0.5,
        "rw_w2": nrm(ks[6], (DEPTH, 2, DECAY_LORA, RW_W), 0.3 * DECAY_LORA ** -0.5),
        "rw_a0": nrm(ks[7], (DEPTH, 2, RW_W), 0.1),
        "rw_a2": nrm(ks[8], (DEPTH, 2, AAA_LORA, RW_W), 0.3 * AAA_LORA ** -0.5),
        "rw_g2": nrm(ks[9], (DEPTH, GATE_LORA, RW_W), GATE_LORA ** -0.5),
        "rw_kk": 0.85 + nrm(ks[10], (DEPTH, RW_W), 0.02),
        "rw_ka": 1.0 + nrm(ks[11], (DEPTH, RW_W), 0.02),
        "rw_rk": nrm(ks[12], (DEPTH, RW_HEADS, HEAD_DIM), 0.1),
        "rw_lnw": gain(ks[13], (DEPTH, RW_W)),
        "rw_lnb": nrm(ks[14], (DEPTH, RW_W), 0.02),
        "at_qn": gain(ks[15], (DEPTH, HEAD_DIM)),
        "at_kn": gain(ks[16], (DEPTH, HEAD_DIM)),
        "ml_conv": nrm(ks[17], (DEPTH, 3, 2 * ML_W), 3 ** -0.5),
        "ml_ib": nrm(ks[18], (DEPTH, 2, ML_HEADS), 0.1),
        "ml_fb": f_bias + nrm(ks[19], (DEPTH, 2, ML_HEADS), 0.1),
        "ml_nw": gain(ks[20], (DEPTH, ML_W)),
        "w_out": nrm(ks[21], (DEPTH, MIX_W, D_MODEL), MIX_W ** -0.5),
        "norm2_g": gain(ks[22], (DEPTH, D_MODEL)),
        "mlp_w1": nrm(ks[23], (DEPTH, D_MODEL, D_FF), D_MODEL ** -0.5),
        "mlp_w2": nrm(ks[24], (DEPTH, D_FF, D_MODEL), D_FF ** -0.5),
        "final_g": gain(ks[25], (D_MODEL,)),
    }


def reference(x_prompt, x_sample, norm1_g, w_in, rw_mu, rw_w0, rw_w2, rw_a0, rw_a2, rw_g2, rw_kk, rw_ka,
              rw_rk, rw_lnw, rw_lnb, at_qn, at_kn, ml_conv, ml_ib, ml_fb, ml_nw, w_out, norm2_g,
              mlp_w1, mlp_w2, final_g):
    P = dict(norm1_g=norm1_g, w_in=w_in, rw_mu=rw_mu, rw_w0=rw_w0, rw_w2=rw_w2, rw_a0=rw_a0, rw_a2=rw_a2,
             rw_g2=rw_g2, rw_kk=rw_kk, rw_ka=rw_ka, rw_rk=rw_rk, rw_lnw=rw_lnw, rw_lnb=rw_lnb,
             at_qn=at_qn, at_kn=at_kn, ml_conv=ml_conv, ml_ib=ml_ib, ml_fb=ml_fb, ml_nw=ml_nw,
             w_out=w_out, norm2_g=norm2_g, mlp_w1=mlp_w1, mlp_w2=mlp_w2, final_g=final_g)
    y_prompt = trunk(x_prompt, P)
    y_sample = trunk(x_sample, P)
    return (y_prompt, y_sample)
```

```cpp
#include <hip/hip_runtime.h>
#include <hip/hip_cooperative_groups.h>
#include <cstdio>
#include <cstdint>
namespace cg = cooperative_groups;
namespace pg8 {
#define PG8_LAS __attribute__((address_space(3)))
typedef unsigned short bf16_t;
typedef short bf16x8 __attribute__((ext_vector_type(8)));
typedef float f32x4 __attribute__((ext_vector_type(4)));
typedef unsigned u32x4 __attribute__((ext_vector_type(4)));
constexpr int BM = 256, BK = 64, HALF = 128, HTB = HALF * BK * 2  , STAGE_BYTES = 8 * HTB, NXCD = 8, WGM = 8;

__host__ __device__ __forceinline__ int lds_byte(int r, int c) { const int st = (r >> 4) * 2 + (c >> 5), rr = r & 15, cc = c & 31, ob = rr * 64 + cc * 2; return st * 1024 + (ob ^ (((ob >> 9) & 1) << 5)); }
__host__ __device__ __forceinline__ void stage_rc(int b, int& R, int& C) { const int st = b / 1024, sb = b % 1024, swz = sb ^ (((sb >> 9) & 1) << 5); R = (st >> 1) * 16 + swz / 64; C = (st & 1) * 32 + (swz % 64) / 2; }
__host__ __device__ __forceinline__ int perm32(int rho) { const int n = rho >> 4, i = rho & 15; return 8 * (i >> 2) + 4 * n + (i & 3); }

struct Unit { int pm, pn; };
struct Gemm { const bf16_t* A; const bf16_t* Bt; int M, N, K; };

struct StaticOrder {
    int nM, nN, nwg, G, c;
    __host__ __device__ void init(int M, int N, int G_, int c_) { nM = M / BM; nN = N / BM; nwg = nM * nN; G = G_; c = c_; }
    __host__ __device__ bool next(int i, Unit& u) const {
        const long L = (long)i * G + c; if (L >= nwg) return false;
        int wgid = (int)L; { const int q = nwg / NXCD, r = nwg % NXCD, xcd = wgid % NXCD, off = wgid / NXCD; wgid = (xcd < r ? xcd * (q + 1) : r * (q + 1) + (xcd - r) * q) + off; }
        const int nig = WGM * nN, gid = wgid / nig, fm = gid * WGM, gsz = (nM - fm) < WGM ? (nM - fm) : WGM;
        u.pm = fm + ((wgid % nig) % gsz); u.pn = (wgid % nig) / gsz; return true;
    }
    __device__ __forceinline__ void a_ready(const Unit&) const {}
    __device__ __forceinline__ void done(const Unit&) const {}
};

template <class Epi, class Sched, bool ALIGN_EPI = false, bool SP2 = false>
__device__ __forceinline__ void gemm_phase(PG8_LAS unsigned char* lds, const Gemm g, const Sched& S, const Epi& E) {
    int tid_l = threadIdx.x; asm volatile("" : "+v"(tid_l));
    const int tid = tid_l, wid = __builtin_amdgcn_readfirstlane(tid >> 6), lane = tid & 63, wr = wid >> 2, wc = wid & 3, fr = lane & 15, fq = lane >> 4;
    const int K = g.K, nt = K / BK;
    unsigned voffA[2], voffB[2];
#pragma unroll
    for (int i = 0; i < 2; ++i) { int R, C; stage_rc(tid * 16 + i * 8192, R, C); const int Rb = Epi::PERM ? ((R & ~31) + perm32(R & 31)) : R;
        voffA[i] = (unsigned)(R * K + C) * 2u; voffB[i] = (unsigned)(Rb * K + C) * 2u; }
    const size_t kstep = (size_t)(BK * 2);
    const size_t hstep = (size_t)HALF * K * 2;
    const size_t tstep = 2 * hstep;
    const unsigned ldsw = (unsigned)wid * 1024u;
    const int aoff = lds_byte(wr * 64 + fr, fq * 8), boff = lds_byte(wc * 32 + fr, fq * 8);
#define PG8_SA(b, h) (((b) * 2 + (h)) * HTB)
#define PG8_SB(b, h) ((4 + (b) * 2 + (h)) * HTB)
#define PG8_STAGE(bufoff, gbase, voff) do { _Pragma("unroll") for (int _i = 0; _i < 2; ++_i) \
        __builtin_amdgcn_global_load_lds((const unsigned*)((const char*)(gbase) + (voff)[_i]), (PG8_LAS unsigned*)(lds + (bufoff) + ldsw + _i * 8192), 16, 0, 0); } while (0)
#define PG8_LDA(dst, b, h) do { _Pragma("unroll") for (int m = 0; m < 4; ++m) _Pragma("unroll") for (int k = 0; k < 2; ++k) dst[m][k] = *(const PG8_LAS bf16x8*)(lds + PG8_SA(b, h) + aoff + m * 2048 + k * 1024); } while (0)
#define PG8_LDB(dst, b, h) do { _Pragma("unroll") for (int n = 0; n < 2; ++n) _Pragma("unroll") for (int k = 0; k < 2; ++k) dst[n][k] = *(const PG8_LAS bf16x8*)(lds + PG8_SB(b, h) + boff + n * 2048 + k * 1024); } while (0)
#define PG8_MMA(ai, bj, At, Bt) do { __builtin_amdgcn_s_setprio(1); _Pragma("unroll") for (int m = 0; m < 4; ++m) _Pragma("unroll") for (int n = 0; n < 2; ++n) _Pragma("unroll") for (int k = 0; k < 2; ++k) \
        acc[ai][bj][m][n] = __builtin_amdgcn_mfma_f32_16x16x32_bf16(Bt[n][k], At[m][k], acc[ai][bj][m][n], 0, 0, 0); __builtin_amdgcn_s_setprio(0); } while (0)
#define PG8_WAIT_V(n) asm volatile("s_waitcnt vmcnt(" #n ")" ::: "memory")
#define PG8_WAIT_L(n) asm volatile("s_waitcnt lgkmcnt(" #n ")" ::: "memory")
#define PG8_BAR __builtin_amdgcn_s_barrier()
#define PG8_SCHED __builtin_amdgcn_sched_barrier(0)
    Unit cur, nxt; int ui = 0;
    if (!S.next(0, cur)) return;
    f32x4 acc[2][2][4][2];
#pragma unroll
    for (int a = 0; a < 2; ++a)
#pragma unroll
        for (int b = 0; b < 2; ++b)
#pragma unroll
            for (int m = 0; m < 4; ++m)
#pragma unroll
                for (int n = 0; n < 2; ++n) acc[a][b][m][n] = (f32x4){0.f, 0.f, 0.f, 0.f};
    bf16x8 At[4][2], B0[2][2], B1[2][2];
    const char* cA = (const char*)g.A + (size_t)cur.pm * tstep; const char* cB = (const char*)g.Bt + (size_t)cur.pn * tstep;
    S.a_ready(cur);
    if constexpr (SP2) {
        PG8_STAGE(PG8_SB(0, 0), cB, voffB); PG8_STAGE(PG8_SB(0, 1), cB + hstep, voffB); PG8_STAGE(PG8_SA(0, 0), cA, voffA); PG8_STAGE(PG8_SA(0, 1), cA + hstep, voffA);
        if (wr == 1) PG8_BAR;
        PG8_WAIT_V(2); PG8_BAR;
        PG8_STAGE(PG8_SB(1, 0), cB + kstep, voffB); PG8_STAGE(PG8_SA(1, 0), cA + kstep, voffA); PG8_STAGE(PG8_SB(1, 1), cB + hstep + kstep, voffB);
        PG8_WAIT_V(6); PG8_BAR;
    } else {
        PG8_STAGE(PG8_SB(0, 0), cB, voffB); PG8_STAGE(PG8_SA(0, 0), cA, voffA); PG8_STAGE(PG8_SB(0, 1), cB + hstep, voffB); PG8_STAGE(PG8_SA(0, 1), cA + hstep, voffA);
        if (wr == 1) PG8_BAR;
        PG8_WAIT_V(4); PG8_BAR;
        PG8_STAGE(PG8_SB(1, 0), cB + kstep, voffB); PG8_STAGE(PG8_SA(1, 0), cA + kstep, voffA); PG8_STAGE(PG8_SB(1, 1), cB + hstep + kstep, voffB);
        PG8_WAIT_V(6); PG8_BAR;
    }
    for (;;) {
        const bool has_next = S.next(ui + 1, nxt);
        const char* nA = has_next ? (const char*)g.A + (size_t)nxt.pm * tstep : cA; const char* nB = has_next ? (const char*)g.Bt + (size_t)nxt.pn * tstep : cB;
        for (int t = 0; t < nt; t += 2) {
            const bool last = (t == nt - 2);
            const char* a1 = cA + (size_t)(t + 1) * kstep;
            const char* a2 = last ? nA : cA + (size_t)(t + 2) * kstep; const char* b2 = last ? nB : cB + (size_t)(t + 2) * kstep;
            const char* a3 = a2 + kstep; const char* b3 = b2 + kstep;
            if (last && has_next) S.a_ready(nxt);
            if constexpr (SP2) {
            PG8_LDB(B0, 0, 0); PG8_LDB(B1, 0, 1); PG8_SCHED; PG8_LDA(At, 0, 0); PG8_STAGE(PG8_SA(1, 1), a1 + hstep, voffA);
            PG8_WAIT_V(8); PG8_WAIT_L(0); PG8_BAR; PG8_MMA(0, 0, At, B0); PG8_MMA(0, 1, At, B1); PG8_BAR; PG8_SCHED;
            PG8_LDA(At, 0, 1); PG8_STAGE(PG8_SB(0, 0), b2, voffB); PG8_STAGE(PG8_SB(0, 1), b2 + hstep, voffB); PG8_STAGE(PG8_SA(0, 0), a2, voffA);
            PG8_WAIT_V(8); PG8_WAIT_L(0); PG8_BAR; PG8_MMA(1, 0, At, B0); PG8_MMA(1, 1, At, B1); PG8_BAR; PG8_SCHED;
            PG8_LDB(B0, 1, 0); PG8_LDB(B1, 1, 1); PG8_SCHED; PG8_LDA(At, 1, 0); PG8_STAGE(PG8_SA(0, 1), a2 + hstep, voffA);
            PG8_WAIT_V(8); PG8_WAIT_L(0); PG8_BAR; PG8_MMA(0, 0, At, B0); PG8_MMA(0, 1, At, B1); PG8_BAR; PG8_SCHED;
            PG8_LDA(At, 1, 1); PG8_STAGE(PG8_SB(1, 0), b3, voffB); PG8_STAGE(PG8_SB(1, 1), b3 + hstep, voffB); PG8_STAGE(PG8_SA(1, 0), a3, voffA);
            PG8_WAIT_V(8); PG8_WAIT_L(0); PG8_BAR; PG8_MMA(1, 0, At, B0); PG8_MMA(1, 1, At, B1); PG8_BAR; PG8_SCHED;
            } else {
            PG8_LDB(B0, 0, 0); PG8_SCHED; PG8_LDA(At, 0, 0); PG8_STAGE(PG8_SA(1, 1), a1 + hstep, voffA);
            PG8_WAIT_L(8); PG8_BAR; PG8_WAIT_L(0); PG8_MMA(0, 0, At, B0); PG8_BAR; PG8_SCHED;
            PG8_LDB(B1, 0, 1); PG8_STAGE(PG8_SB(0, 0), b2, voffB);
            PG8_BAR; PG8_WAIT_L(0); PG8_MMA(0, 1, At, B1); PG8_BAR;
            PG8_LDA(At, 0, 1); PG8_STAGE(PG8_SA(0, 0), a2, voffA);
            PG8_BAR; PG8_WAIT_L(0); PG8_MMA(1, 0, At, B0); PG8_BAR; PG8_SCHED;
            PG8_STAGE(PG8_SB(0, 1), b2 + hstep, voffB);
            PG8_WAIT_V(6); PG8_BAR; PG8_MMA(1, 1, At, B1); PG8_BAR;
            PG8_LDB(B0, 1, 0); PG8_SCHED; PG8_LDA(At, 1, 0); PG8_STAGE(PG8_SA(0, 1), a2 + hstep, voffA);
            PG8_WAIT_L(8); PG8_BAR; PG8_WAIT_L(0); PG8_MMA(0, 0, At, B0); PG8_BAR; PG8_SCHED;
            PG8_LDB(B1, 1, 1); PG8_STAGE(PG8_SB(1, 0), b3, voffB);
            PG8_BAR; PG8_WAIT_L(0); PG8_MMA(0, 1, At, B1); PG8_BAR;
            PG8_LDA(At, 1, 1); PG8_STAGE(PG8_SA(1, 0), a3, voffA);
            PG8_BAR; PG8_WAIT_L(0); PG8_MMA(1, 0, At, B0); PG8_BAR; PG8_SCHED;
            PG8_STAGE(PG8_SB(1, 1), b3 + hstep, voffB);
            PG8_WAIT_V(6); PG8_BAR; PG8_MMA(1, 1, At, B1); PG8_BAR;
            }
        }
        if constexpr (ALIGN_EPI) { if (wr == 0) PG8_BAR; }
        if constexpr (!Epi::AFTER_DRAIN) { E(acc, cur, wr, wc, fr, fq); S.done(cur); }
        if (!has_next) break;
#pragma unroll
        for (int a = 0; a < 2; ++a)
#pragma unroll
            for (int b = 0; b < 2; ++b)
#pragma unroll
                for (int m = 0; m < 4; ++m)
#pragma unroll
                    for (int n = 0; n < 2; ++n) acc[a][b][m][n] = (f32x4){0.f, 0.f, 0.f, 0.f};
        cur = nxt; cA = nA; cB = nB; ++ui;
        if constexpr (ALIGN_EPI) { if (wr == 1) PG8_BAR; }
    }
    PG8_WAIT_V(0);
    if constexpr (!ALIGN_EPI) { if (wr == 0) PG8_BAR; }
    PG8_BAR;
    if constexpr (Epi::AFTER_DRAIN) { E.fused(acc, cur, wr, wc, fr, fq, lds, wid, lane); S.done(cur); }
#undef PG8_SA
#undef PG8_SB
#undef PG8_STAGE
#undef PG8_LDA
#undef PG8_LDB
#undef PG8_MMA
#undef PG8_WAIT_V
#undef PG8_WAIT_L
#undef PG8_BAR
#undef PG8_SCHED
}
}

#define DI __device__ __forceinline__
#define LAS __attribute__((address_space(3)))
typedef unsigned short bf16_t;
typedef short bf16x8 __attribute__((ext_vector_type(8)));
typedef short s16x4 __attribute__((ext_vector_type(4)));
typedef float f32x4 __attribute__((ext_vector_type(4)));
typedef float f32x2 __attribute__((ext_vector_type(2)));
typedef float f32x16 __attribute__((ext_vector_type(16)));
typedef unsigned u32x4 __attribute__((ext_vector_type(4)));
typedef unsigned u32x2 __attribute__((ext_vector_type(2)));
typedef __bf16 bf16x2_t __attribute__((ext_vector_type(2)));
#define MFMA32(a, b, c) __builtin_amdgcn_mfma_f32_32x32x16_bf16((a), (b), (c), 0, 0, 0)

constexpr int T = 49152, DM = 1024, NPROJ = 3072, NIN = 2960, DFF = 4096, HFF = 2048;
constexpr int C_R = 0, C_K = 256, C_V = 512, C_WD = 768, C_AD = 896, C_GD = 1024;
constexpr int C_AQ = 1152, C_AK = 1664, C_AV = 1792;
constexpr int C_MQ = 1920, C_MK = 2176, C_MV = 2432, C_MO = 2688, C_IG = 2944, C_FG = 2952;
constexpr size_t MiB = 1u << 20;
constexpr size_t WS_SS = 0, WS_CNT = MiB - 4096, WS_CDOT = 1 * MiB, WS_TAB = 2 * MiB + 512 * 1024, WS_WIN = 3 * MiB, WS_WOUT = 15 * MiB,
                 WS_W1 = 19 * MiB, WS_W2 = 35 * MiB, WS_VT = 51 * MiB, WS_YB = 63 * MiB, WS_HBP = 87 * MiB, WS_X1 = 111 * MiB, WS_R = 207 * MiB,
                 WS_HID = WS_R + 96 * MiB, WS_END = 495 * MiB;
constexpr int LDS_BYTES = 131072 + 256;
constexpr int NTHR = 512;

struct KP { const float* in[26]; float* out; unsigned char* ws; };

DI unsigned cvtpk(float lo, float hi) { f32x2 v = {lo, hi}; bf16x2_t b = __builtin_convertvector(v, bf16x2_t); return __builtin_bit_cast(unsigned, b); }
DI unsigned short f2bf(float f) { return (unsigned short)(cvtpk(f, 0.f) & 0xffffu); }
DI float bf2f(unsigned h) { return __builtin_bit_cast(float, h << 16); }
DI float bflo(unsigned w) { return __builtin_bit_cast(float, w << 16); }
DI float bfhi(unsigned w) { return __builtin_bit_cast(float, w & 0xffff0000u); }
DI int crow(int reg, int h) { return (reg & 3) + 8 * (reg >> 2) + 4 * h; }
template <int CTRL> DI float dppf(float v) { return __builtin_bit_cast(float, __builtin_amdgcn_update_dpp(0, __builtin_bit_cast(int, v), CTRL, 0xf, 0xf, true)); }
DI float red8(float v) { v += dppf<0xB1>(v); v += dppf<0x4E>(v); v += dppf<0x141>(v); return v; }
DI float red16(float v) { v = red8(v); v += dppf<0x128>(v); return v; }
DI float sigmoidf_(float x) { return 1.f / (1.f + __expf(-x)); }
DI f32x16 zero16() { f32x16 z; for (int i = 0; i < 16; ++i) z[i] = 0.f; return z; }
DI void seq_of_job(int j, int& seq, int& h, int& dir) { if (j < 16) { seq = 8 + (j >> 3); } else { j -= 16; seq = j >> 3; } h = (j >> 1) & 3; dir = j & 1; }
DI void seq_info(int s, int& start, int& len) { if (s < 8) { start = s * 4096; len = 4096; } else { start = 32768 + (s - 8) * 8192; len = 8192; } }
DI int tok_seq_start(int tok, int& len) { if (tok < 32768) { len = 4096; return tok & ~4095; } len = 8192; return 32768 + ((tok - 32768) & ~8191); }

struct EpiProj {
    static constexpr bool PERM = true, AFTER_DRAIN = false;
    bf16_t* O; const float* ss;
    DI void operator()(const pg8::f32x4 (&acc)[2][2][4][2], const pg8::Unit& u, int wr, int wc, int fr, int fq) const {
        const int row0 = u.pm * 256 + wr * 64 + fr, col0 = u.pn * 256 + wc * 32 + 8 * fq;
#pragma unroll
        for (int ai = 0; ai < 2; ++ai)
#pragma unroll
            for (int m = 0; m < 4; ++m) {
                const int row = row0 + ai * 128 + m * 16;
                const float rs = rsqrtf(ss[row] * (1.f / 1024.f) + 1e-6f);
                bf16_t* rp = O + (size_t)row * NPROJ + col0;
#pragma unroll
                for (int bj = 0; bj < 2; ++bj) {
                    pg8::f32x4 v0 = acc[ai][bj][m][0] * rs, v1 = acc[ai][bj][m][1] * rs;
                    u32x4 w; w.x = cvtpk(v0[0], v0[1]); w.y = cvtpk(v0[2], v0[3]); w.z = cvtpk(v1[0], v1[1]); w.w = cvtpk(v1[2], v1[3]);
                    *(u32x4*)(rp + bj * 128) = w;
                }
            }
    }
};
struct EpiRelu2 {
    static constexpr bool PERM = true, AFTER_DRAIN = false;
    bf16_t* O; const float* ss;
    DI void operator()(const pg8::f32x4 (&acc)[2][2][4][2], const pg8::Unit& u, int wr, int wc, int fr, int fq) const {
        const int row0 = u.pm * 256 + wr * 64 + fr, col0 = u.pn * 256 + wc * 32 + 8 * fq;
#pragma unroll
        for (int ai = 0; ai < 2; ++ai)
#pragma unroll
            for (int m = 0; m < 4; ++m) {
                const int row = row0 + ai * 128 + m * 16;
                const float rs = rsqrtf(ss[row] * (1.f / 1024.f) + 1e-6f);
                bf16_t* rp = O + (size_t)row * HFF + col0;
#pragma unroll
                for (int bj = 0; bj < 2; ++bj) {
                    pg8::f32x4 v0 = acc[ai][bj][m][0] * rs, v1 = acc[ai][bj][m][1] * rs;
#pragma unroll
                    for (int j = 0; j < 4; ++j) { float a = fmaxf(v0[j], 0.f); v0[j] = a * a; float b = fmaxf(v1[j], 0.f); v1[j] = b * b; }
                    u32x4 w; w.x = cvtpk(v0[0], v0[1]); w.y = cvtpk(v0[2], v0[3]); w.z = cvtpk(v1[0], v1[1]); w.w = cvtpk(v1[2], v1[3]);
                    *(u32x4*)(rp + bj * 128) = w;
                }
            }
    }
};
template <bool WRITE_HB, bool DO_SS> struct EpiRes {
    static constexpr bool PERM = true, AFTER_DRAIN = false;
    float* X; bf16_t* HB; float* ss;
    DI void operator()(const pg8::f32x4 (&acc)[2][2][4][2], const pg8::Unit& u, int wr, int wc, int fr, int fq) const {
        const int row0 = u.pm * 256 + wr * 64 + fr, col0 = u.pn * 256 + wc * 32 + 8 * fq;
#pragma unroll
        for (int ai = 0; ai < 2; ++ai)
#pragma unroll
            for (int m = 0; m < 4; ++m) {
                const int row = row0 + ai * 128 + m * 16;
                float* xp = X + (size_t)row * DM + col0;
                float sq = 0.f;
#pragma unroll
                for (int bj = 0; bj < 2; ++bj) {
                    pg8::f32x4 a0 = *(const pg8::f32x4*)(xp + bj * 128), a1 = *(const pg8::f32x4*)(xp + bj * 128 + 4);
                    a0 += acc[ai][bj][m][0]; a1 += acc[ai][bj][m][1];
                    *(pg8::f32x4*)(xp + bj * 128) = a0; *(pg8::f32x4*)(xp + bj * 128 + 4) = a1;
                    if (WRITE_HB) { u32x4 w; w.x = cvtpk(a0[0], a0[1]); w.y = cvtpk(a0[2], a0[3]); w.z = cvtpk(a1[0], a1[1]); w.w = cvtpk(a1[2], a1[3]);
                        *(u32x4*)(HB + (size_t)row * DM + col0 + bj * 128) = w; }
                    if (DO_SS) sq += a0[0] * a0[0] + a0[1] * a0[1] + a0[2] * a0[2] + a0[3] * a0[3] + a1[0] * a1[0] + a1[1] * a1[1] + a1[2] * a1[2] + a1[3] * a1[3];
                }
                if (DO_SS) { sq += __shfl_xor(sq, 16); sq += __shfl_xor(sq, 32); if (fq == 0) atomicAdd(ss + row, sq); }
            }
    }
};

DI void transpose_tile(const float* src, int N, int nvalid, const float* gain, bf16_t* dst, int K, int kt, int nt, LAS float* tile, int tid) {
    const int a = tid & 63, b8 = tid >> 6;
#pragma unroll
    for (int i = 0; i < 8; ++i) { const int k = b8 + 8 * i, n = nt * 64 + a; float v = (n < nvalid) ? src[(size_t)(kt * 64 + k) * N + n] : 0.f; if (gain) v *= gain[kt * 64 + k]; tile[k * 65 + a] = v; }
    __syncthreads();
#pragma unroll
    for (int i = 0; i < 8; ++i) { const int n = b8 + 8 * i; dst[(size_t)(nt * 64 + n) * K + kt * 64 + a] = f2bf(tile[a * 65 + n]); }
    __syncthreads();
}
DI void p0_phase(const KP& p, LAS unsigned char* lds, int tid, int G, int bid) {
    LAS float* tile = (LAS float*)lds;
    for (int it = bid; it < 6144; it += G) {
        const int l = it / 3072; int r = it % 3072;
        const float* src; const float* gain; bf16_t* dst; int N, nvalid, K, kt, nt;
        if (r < 768) { src = p.in[3] + (size_t)l * 1024 * NIN; N = NIN; nvalid = NIN; K = 1024; gain = p.in[2] + l * 1024; dst = (bf16_t*)(p.ws + WS_WIN) + (size_t)l * NPROJ * 1024; kt = r / 48; nt = r % 48; }
        else if (r < 1024) { r -= 768; src = p.in[21] + (size_t)l * 1024 * 1024; N = 1024; nvalid = 1024; K = 1024; gain = nullptr; dst = (bf16_t*)(p.ws + WS_WOUT) + (size_t)l * 1024 * 1024; kt = r / 16; nt = r % 16; }
        else if (r < 2048) { r -= 1024; src = p.in[23] + (size_t)l * 1024 * 4096; N = 4096; nvalid = 4096; K = 1024; gain = p.in[22] + l * 1024; dst = (bf16_t*)(p.ws + WS_W1) + (size_t)l * 4096 * 1024; kt = r / 64; nt = r % 64; }
        else { r -= 2048; const int h = r / 512; r %= 512; src = p.in[24] + (size_t)l * 4096 * 1024 + (size_t)h * 2048 * 1024; N = 1024; nvalid = 1024; K = 2048; gain = nullptr;
               dst = (bf16_t*)(p.ws + WS_W2) + (size_t)l * 2 * 1024 * 2048 + (size_t)h * 1024 * 2048; kt = r / 16; nt = r % 16; }
        transpose_tile(src, N, nvalid, gain, dst, K, kt, nt, tile, tid);
    }
    const int wave = tid >> 6, lane = tid & 63;
    float* ss = (float*)(p.ws + WS_SS);
    bf16_t* xb = (bf16_t*)(p.ws + WS_X1);
    for (int row = bid * 8 + wave; row < T; row += G * 8) {
        const float* xs = (row < 32768) ? p.in[0] + (size_t)row * DM : p.in[1] + (size_t)(row - 32768) * DM;
        float sq = 0.f;
#pragma unroll
        for (int j = 0; j < 4; ++j) {
            const int c = (j * 64 + lane) * 4;
            const f32x4 v = *(const f32x4*)(xs + c);
            *(f32x4*)(p.out + (size_t)row * DM + c) = v;
            u32x2 w; w.x = cvtpk(v[0], v[1]); w.y = cvtpk(v[2], v[3]);
            *(u32x2*)(xb + (size_t)row * DM + c) = w;
            sq += v[0] * v[0] + v[1] * v[1] + v[2] * v[2] + v[3] * v[3];
        }
#pragma unroll
        for (int o = 32; o >= 1; o >>= 1) sq += __shfl_xor(sq, o);
        if (lane == 0) ss[row] = sq;
    }
    for (int i = bid * NTHR + tid; i < 4 * T; i += G * NTHR) ss[T + i] = 0.f;
    if (bid == 0) {
        if (tid < 64) ((unsigned*)(p.ws + WS_CNT))[tid] = 0u;
        float2* tab = (float2*)(p.ws + WS_TAB);
        for (int idx = tid; idx < 2048; idx += NTHR) { const int pos = idx >> 4, f = idx & 15; const float inv = powf(10000.f, -(float)f / 16.f); const float ang = (float)pos * inv; tab[idx] = make_float2(cosf(ang), sinf(ang)); }
    }
}

DI void prep_phase(const KP& p, int l, LAS unsigned char* lds, int tid, int G, int bid) {
    bf16_t* proj = (bf16_t*)(p.ws + WS_R);
    bf16_t* vT = (bf16_t*)(p.ws + WS_VT);
    const float2* tab = (const float2*)(p.ws + WS_TAB);
    const float* qn = p.in[15] + l * 64; const float* kn = p.in[16] + l * 64;
    const int wave = tid >> 6, lane = tid & 63, g = lane >> 4, li = lane & 15;
    LAS bf16_t* vts = (LAS bf16_t*)lds;
    for (int unit = bid; unit < T / 64; unit += G) {
        const int tok0 = unit * 64;
        for (int i = 0; i < 8; ++i) {
            const int tok = tok0 + wave * 8 + i; int len; const int st = tok_seq_start(tok, len); const int pos = tok - st; const int prow = pos >> 6, pcol = pos & 63;
#pragma unroll
            for (int it = 0; it < 3; ++it) {
                const bool act = (it < 2) || (g < 2);
                const int colbase = (it < 2) ? C_AQ + (it * 4 + g) * 64 : C_AK + (g & 1) * 64;
                const float* wn = (it < 2) ? qn : kn;
                bf16_t* ptr = proj + (size_t)tok * NPROJ + colbase + li * 4;
                const u32x2 raw = *(const u32x2*)ptr;
                float x[4] = {bflo(raw.x), bfhi(raw.x), bflo(raw.y), bfhi(raw.y)};
                float sq = x[0] * x[0] + x[1] * x[1] + x[2] * x[2] + x[3] * x[3];
                sq = red16(sq);
                const float rinv = rsqrtf(sq * (1.f / 64.f) + 1e-6f);
                const f32x4 w4 = *(const f32x4*)(wn + li * 4);
                const int idx = (li >> 3) ? pcol : prow; const bool second = (li >> 2) & 1;
                const float scale = (it < 2) ? 0.125f * 1.4426950408889634f : 1.f;
                float o[4];
#pragma unroll
                for (int j = 0; j < 4; ++j) {
                    const float y = x[j] * rinv * w4[j];
                    const float pr = __shfl_xor(y, 4);
                    const int f = (li * 4 + j) & 15;
                    const float2 cs = tab[idx * 16 + f];
                    o[j] = (second ? (y * cs.x + pr * cs.y) : (y * cs.x - pr * cs.y)) * scale;
                }
                if (act) { u32x2 w; w.x = cvtpk(o[0], o[1]); w.y = cvtpk(o[2], o[3]); *(u32x2*)ptr = w; }
            }
        }
#pragma unroll
        for (int i = 0; i < 2; ++i) { const int idx = tid + NTHR * i; const int tl = idx >> 4, c8 = (idx & 15) * 8;
            const u32x4 v = *(const u32x4*)(proj + (size_t)(tok0 + tl) * NPROJ + C_AV + c8); *(LAS u32x4*)(vts + tl * 136 + c8) = v; }
        __syncthreads();
        { const int c = tid >> 2, tq = tid & 3; unsigned w[8];
#pragma unroll
          for (int j = 0; j < 8; ++j) { const unsigned lo = vts[(tq * 16 + 2 * j) * 136 + c], hi = vts[(tq * 16 + 2 * j + 1) * 136 + c]; w[j] = lo | (hi << 16); }
          u32x4 a = {w[0], w[1], w[2], w[3]}, b = {w[4], w[5], w[6], w[7]};
          bf16_t* dp = vT + (size_t)c * T + tok0 + tq * 16; *(u32x4*)dp = a; *(u32x4*)(dp + 8) = b; }
        __syncthreads();
    }
}

DI void attn_unit(const KP& p, int unit, LAS unsigned char* lds, int tid) {
    const bf16_t* proj = (const bf16_t*)(p.ws + WS_R);
    const bf16_t* vT = (const bf16_t*)(p.ws + WS_VT);
    bf16_t* mix = (bf16_t*)(p.ws + WS_X1);
    int seq, kvh, qt;
    if (unit < 512) { seq = 8 + (unit >> 8); const int r = unit & 255; kvh = r >> 7; qt = r & 127; }
    else { const int u2 = unit - 512; seq = u2 >> 7; const int r = u2 & 127; kvh = r >> 6; qt = r & 63; }
    int start, len; seq_info(seq, start, len);
    const int nk = len >> 6;
    const int wave = tid >> 6, lane = tid & 63, r32 = lane & 31, hh = lane >> 5;
    const int head = kvh * 4 + (wave >> 1);
    const int q0 = start + qt * 64 + (wave & 1) * 32;
    bf16x8 qf[4];
    { const bf16_t* qp = proj + (size_t)(q0 + r32) * NPROJ + C_AQ + head * 64 + hh * 8;
#pragma unroll
      for (int ks = 0; ks < 4; ++ks) qf[ks] = *(const bf16x8*)(qp + ks * 16); }
    f32x16 o0 = zero16(), o1 = zero16();
    float m = -1e30f, lsum = 0.f;
    const int lrow = tid >> 3, lseg = tid & 7;
    const bf16_t* kptr = proj + (size_t)(start + lrow) * NPROJ + C_AK + kvh * 64 + lseg * 8;
    const bf16_t* vptr = vT + (size_t)(kvh * 64 + lrow) * T + start + lseg * 8;
    const int lds_off = lrow * 144 + lseg * 16;
    u32x4 kreg = *(const u32x4*)kptr, vreg = *(const u32x4*)vptr;
    *(LAS u32x4*)(lds + lds_off) = kreg; *(LAS u32x4*)(lds + 9216 + lds_off) = vreg;
    __syncthreads();
    for (int j = 0; j < nk; ++j) {
        const bool more = (j + 1 < nk);
        if (more) { kreg = *(const u32x4*)(kptr + (size_t)(j + 1) * 64 * NPROJ); vreg = *(const u32x4*)(vptr + (j + 1) * 64); }
        LAS unsigned char* Ks = lds + (j & 1) * 18432; LAS unsigned char* Vs = Ks + 9216;
        f32x16 s0 = zero16(), s1 = zero16();
#pragma unroll
        for (int ks = 0; ks < 4; ++ks) {
            const bf16x8 a0 = *(const LAS bf16x8*)(Ks + r32 * 144 + (ks * 16 + hh * 8) * 2);
            const bf16x8 a1 = *(const LAS bf16x8*)(Ks + (32 + r32) * 144 + (ks * 16 + hh * 8) * 2);
            s0 = MFMA32(a0, qf[ks], s0); s1 = MFMA32(a1, qf[ks], s1);
        }
        float mx = s0[0];
#pragma unroll
        for (int i = 1; i < 16; ++i) mx = fmaxf(mx, s0[i]);
#pragma unroll
        for (int i = 0; i < 16; ++i) mx = fmaxf(mx, s1[i]);
        mx = fmaxf(mx, __shfl_xor(mx, 32));
        const float mnew = fmaxf(m, mx);
        const float alpha = __builtin_amdgcn_exp2f(m - mnew);
        m = mnew;
        float rs = 0.f;
#pragma unroll
        for (int i = 0; i < 16; ++i) { s0[i] = __builtin_amdgcn_exp2f(s0[i] - mnew); rs += s0[i]; }
#pragma unroll
        for (int i = 0; i < 16; ++i) { s1[i] = __builtin_amdgcn_exp2f(s1[i] - mnew); rs += s1[i]; }
        lsum = lsum * alpha + rs;
#pragma unroll
        for (int i = 0; i < 16; ++i) { o0[i] *= alpha; o1[i] *= alpha; }
#pragma unroll
        for (int mb = 0; mb < 2; ++mb)
#pragma unroll
            for (int s = 0; s < 2; ++s) {
                u32x4 pk;
                if (mb == 0) { pk.x = cvtpk(s0[8 * s], s0[8 * s + 1]); pk.y = cvtpk(s0[8 * s + 2], s0[8 * s + 3]); pk.z = cvtpk(s0[8 * s + 4], s0[8 * s + 5]); pk.w = cvtpk(s0[8 * s + 6], s0[8 * s + 7]); }
                else         { pk.x = cvtpk(s1[8 * s], s1[8 * s + 1]); pk.y = cvtpk(s1[8 * s + 2], s1[8 * s + 3]); pk.z = cvtpk(s1[8 * s + 4], s1[8 * s + 5]); pk.w = cvtpk(s1[8 * s + 6], s1[8 * s + 7]); }
                const bf16x8 pb = __builtin_bit_cast(bf16x8, pk);
                const int keyoff = 32 * mb + 16 * s + 4 * hh;
                { const s16x4 lo = *(const LAS s16x4*)(Vs + r32 * 144 + keyoff * 2), hi = *(const LAS s16x4*)(Vs + r32 * 144 + (keyoff + 8) * 2);
                  const bf16x8 va = __builtin_shufflevector(lo, hi, 0, 1, 2, 3, 4, 5, 6, 7); o0 = MFMA32(va, pb, o0); }
                { const s16x4 lo = *(const LAS s16x4*)(Vs + (32 + r32) * 144 + keyoff * 2), hi = *(const LAS s16x4*)(Vs + (32 + r32) * 144 + (keyoff + 8) * 2);
                  const bf16x8 va = __builtin_shufflevector(lo, hi, 0, 1, 2, 3, 4, 5, 6, 7); o1 = MFMA32(va, pb, o1); }
            }
        if (more) { LAS unsigned char* Kn = lds + ((j + 1) & 1) * 18432; *(LAS u32x4*)(Kn + lds_off) = kreg; *(LAS u32x4*)(Kn + 9216 + lds_off) = vreg; }
        __syncthreads();
    }
    lsum += __shfl_xor(lsum, 32);
    const float inv = 1.f / lsum;
    bf16_t* op = mix + (size_t)(q0 + r32) * DM + 256 + head * 64;
#pragma unroll
    for (int g4 = 0; g4 < 4; ++g4) {
        u32x2 w0; w0.x = cvtpk(o0[4 * g4] * inv, o0[4 * g4 + 1] * inv); w0.y = cvtpk(o0[4 * g4 + 2] * inv, o0[4 * g4 + 3] * inv);
        *(u32x2*)(op + 8 * g4 + 4 * hh) = w0;
        u32x2 w1; w1.x = cvtpk(o1[4 * g4] * inv, o1[4 * g4 + 1] * inv); w1.y = cvtpk(o1[4 * g4 + 2] * inv, o1[4 * g4 + 3] * inv);
        *(u32x2*)(op + 32 + 8 * g4 + 4 * hh) = w1;
    }
}

constexpr int RW_XR = 0, RW_XKD = 8192, RW_XV = 16384, RW_WLW = 24576, RW_ALB = 32768, RW_KKN = 40960, RW_YO = 49152, RW_XWD = 57344, RW_XAD = 61952,
              RW_W2T = 66560, RW_A2T = 75776, RW_CD = 84992;
DI void rwkv_job(const KP& p, int l, int job, LAS unsigned char* lds, int tid) {
    int seq, h, dir; seq_of_job(job, seq, h, dir);
    int start, len; seq_info(seq, start, len);
    const bf16_t* proj = (const bf16_t*)(p.ws + WS_R);
    bf16_t* mix = (bf16_t*)(p.ws + WS_X1);
    bf16_t* yb = (bf16_t*)(p.ws + WS_YB);
    float* cdot = (float*)(p.ws + WS_CDOT);
    const float* mu = p.in[4] + l * 1152;
    const int wave = tid >> 6, lane = tid & 63, r32 = lane & 31, hh = lane >> 5;
    LAS float* XR = (LAS float*)(lds + RW_XR); LAS float* XKD = (LAS float*)(lds + RW_XKD); LAS float* XV = (LAS float*)(lds + RW_XV);
    LAS float* WLW = (LAS float*)(lds + RW_WLW); LAS float* ALB = (LAS float*)(lds + RW_ALB); LAS float* KKN = (LAS float*)(lds + RW_KKN);
    LAS float* YO = (LAS float*)(lds + RW_YO); LAS float* CD = (LAS float*)(lds + RW_CD);
    LAS bf16_t* XWD = (LAS bf16_t*)(lds + RW_XWD); LAS bf16_t* XAD = (LAS bf16_t*)(lds + RW_XAD);
    LAS bf16_t* W2T = (LAS bf16_t*)(lds + RW_W2T); LAS bf16_t* A2T = (LAS bf16_t*)(lds + RW_A2T);
    { const float* w2 = p.in[6] + (size_t)((l * 2 + dir) * 64) * 256 + h * 64; const float* a2 = p.in[8] + (size_t)((l * 2 + dir) * 64) * 256 + h * 64;
#pragma unroll
      for (int i = 0; i < 8; ++i) { const int idx = tid + NTHR * i; const int mm = idx >> 6, c = idx & 63; W2T[c * 72 + mm] = f2bf(w2[mm * 256 + c]); A2T[c * 72 + mm] = f2bf(a2[mm * 256 + c]); } }
    const int ct = tid >> 4, cli = tid & 15, cc4 = cli * 4;
    const f32x4 w0v = *(const f32x4*)(p.in[5] + (l * 2 + dir) * 256 + h * 64 + cc4);
    const f32x4 a0v = *(const f32x4*)(p.in[7] + (l * 2 + dir) * 256 + h * 64 + cc4);
    const f32x4 kkw = *(const f32x4*)(p.in[10] + l * 256 + h * 64 + cc4);
    const f32x4 kaw = *(const f32x4*)(p.in[11] + l * 256 + h * 64 + cc4);
    const f32x4 rkw = *(const f32x4*)(p.in[12] + l * 256 + h * 64 + cc4);
    const int si = tid >> 3, sj = (tid & 7) * 8;
    float S[8];
#pragma unroll
    for (int j = 0; j < 8; ++j) S[j] = 0.f;
    __syncthreads();
    const int nch = len >> 5;
    for (int ch = 0; ch < nch; ++ch) {
        const int n0 = ch * 32;
#pragma unroll
        for (int i = 0; i < 5; ++i) {
            const int q = tid + NTHR * i; const int t = q / 80, cq = q % 80; const int gi = cq >> 4, c4 = (cq & 15) * 4;
            const int n = n0 + t; const int pos = dir ? (len - 1 - n) : n;
            const int col = (gi == 0) ? C_R + h * 64 + c4 : (gi == 1) ? C_K + h * 64 + c4 : (gi == 2) ? C_V + h * 64 + c4 : (gi == 3) ? C_WD + dir * 64 + c4 : C_AD + dir * 64 + c4;
            const bf16_t* bp = proj + (size_t)(start + pos) * NPROJ + col;
            const u32x2 cu = *(const u32x2*)bp;
            u32x2 pv = {0u, 0u}, nv = {0u, 0u};
            if (pos > 0) pv = *(const u32x2*)(bp - NPROJ);
            if (pos < len - 1) nv = *(const u32x2*)(bp + NPROJ);
            const f32x4 m4 = *(const f32x4*)(mu + col);
            float x[4];
            x[0] = bflo(cu.x); x[1] = bfhi(cu.x); x[2] = bflo(cu.y); x[3] = bfhi(cu.y);
            const float pn[4] = {bflo(pv.x) + bflo(nv.x), bfhi(pv.x) + bfhi(nv.x), bflo(pv.y) + bflo(nv.y), bfhi(pv.y) + bfhi(nv.y)};
#pragma unroll
            for (int j = 0; j < 4; ++j) x[j] = x[j] + (0.5f * pn[j] - x[j]) * m4[j];
            if (gi < 3) { LAS float* dst = (gi == 0) ? XR : (gi == 1) ? XKD : XV; f32x4 v = {x[0], x[1], x[2], x[3]}; *(LAS f32x4*)(dst + t * 64 + c4) = v; }
            else if (gi == 3) {
#pragma unroll
                for (int j = 0; j < 4; ++j) { const float e = __expf(2.f * x[j]); x[j] = 1.f - 2.f / (e + 1.f); }
                u32x2 w; w.x = cvtpk(x[0], x[1]); w.y = cvtpk(x[2], x[3]); *(LAS u32x2*)(XWD + t * 72 + c4) = w; }
            else { u32x2 w; w.x = cvtpk(x[0], x[1]); w.y = cvtpk(x[2], x[3]); *(LAS u32x2*)(XAD + t * 72 + c4) = w; }
        }
        __syncthreads();
        if (wave < 4) {
            const int mat = wave >> 1, nb = wave & 1;
            LAS bf16_t* Xs = mat ? XAD : XWD; LAS bf16_t* Ws = mat ? A2T : W2T;
            f32x16 acc = zero16();
#pragma unroll
            for (int ks = 0; ks < 4; ++ks) {
                const bf16x8 a = *(const LAS bf16x8*)(Xs + r32 * 72 + ks * 16 + hh * 8);
                const bf16x8 b = *(const LAS bf16x8*)(Ws + (nb * 32 + r32) * 72 + ks * 16 + hh * 8);
                acc = MFMA32(a, b, acc);
            }
            LAS float* dst = mat ? ALB : WLW;
#pragma unroll
            for (int i = 0; i < 16; ++i) dst[crow(i, hh) * 64 + nb * 32 + r32] = acc[i];
        }
        __syncthreads();
        {
            const f32x4 wl = *(const LAS f32x4*)(WLW + ct * 64 + cc4), al = *(const LAS f32x4*)(ALB + ct * 64 + cc4);
            const f32x4 k4 = *(const LAS f32x4*)(XKD + ct * 64 + cc4), r4 = *(const LAS f32x4*)(XR + ct * 64 + cc4);
            f32x4 w, a, kkr, kd;
            float ssq = 0.f, cd = 0.f;
#pragma unroll
            for (int j = 0; j < 4; ++j) {
                const float sg = sigmoidf_(w0v[j] + wl[j]);
                w[j] = __expf(-0.6065306597126334f * sg);
                a[j] = sigmoidf_(a0v[j] + al[j]);
                kkr[j] = k4[j] * kkw[j]; ssq += kkr[j] * kkr[j];
                kd[j] = k4[j] * (1.f + (a[j] - 1.f) * kaw[j]);
                cd += r4[j] * kd[j] * rkw[j];
            }
            ssq = red16(ssq); cd = red16(cd);
            const float inv = 1.f / fmaxf(sqrtf(ssq), 1e-12f);
            f32x4 kkn, b;
#pragma unroll
            for (int j = 0; j < 4; ++j) { kkn[j] = kkr[j] * inv; b[j] = kkn[j] * a[j]; }
            *(LAS f32x4*)(WLW + ct * 64 + cc4) = w; *(LAS f32x4*)(ALB + ct * 64 + cc4) = b; *(LAS f32x4*)(KKN + ct * 64 + cc4) = kkn; *(LAS f32x4*)(XKD + ct * 64 + cc4) = kd;
            if (cli == 0) CD[ct] = cd;
        }
        __syncthreads();
        for (int t = 0; t < 32; ++t) {
            const f32x4 wa = *(const LAS f32x4*)(WLW + t * 64 + sj), wb = *(const LAS f32x4*)(WLW + t * 64 + sj + 4);
            const f32x4 ka = *(const LAS f32x4*)(KKN + t * 64 + sj), kb = *(const LAS f32x4*)(KKN + t * 64 + sj + 4);
            const f32x4 ba = *(const LAS f32x4*)(ALB + t * 64 + sj), bb = *(const LAS f32x4*)(ALB + t * 64 + sj + 4);
            const f32x4 da = *(const LAS f32x4*)(XKD + t * 64 + sj), db = *(const LAS f32x4*)(XKD + t * 64 + sj + 4);
            const f32x4 ra = *(const LAS f32x4*)(XR + t * 64 + sj), rb = *(const LAS f32x4*)(XR + t * 64 + sj + 4);
            const float v = XV[t * 64 + si];
            float sa = 0.f;
#pragma unroll
            for (int j = 0; j < 4; ++j) { sa += S[j] * ka[j]; sa += S[4 + j] * kb[j]; }
            sa = -red8(sa);
            float y = 0.f;
#pragma unroll
            for (int j = 0; j < 4; ++j) {
                S[j] = S[j] * wa[j] + sa * ba[j] + v * da[j];
                S[4 + j] = S[4 + j] * wb[j] + sa * bb[j] + v * db[j];
                y += S[j] * ra[j]; y += S[4 + j] * rb[j];
            }
            y = red8(y);
            if ((tid & 7) == 0) YO[t * 64 + si] = y;
        }
        __syncthreads();
        {
            const int n = n0 + ct; const int pos = dir ? (len - 1 - n) : n; const int tok = start + pos;
            const f32x4 yv = *(const LAS f32x4*)(YO + ct * 64 + cc4);
            u32x2 w; w.x = cvtpk(yv[0], yv[1]); w.y = cvtpk(yv[2], yv[3]);
            if (dir) *(u32x2*)(yb + (size_t)tok * 256 + h * 64 + cc4) = w; else *(u32x2*)(mix + (size_t)tok * DM + h * 64 + cc4) = w;
            if (tid < 32) { const int n2 = n0 + tid; const int pos2 = dir ? (len - 1 - n2) : n2; cdot[((size_t)(start + pos2) * 4 + h) * 2 + dir] = CD[tid]; }
        }
    }
    __syncthreads();
}

constexpr int ML_QS = 0, ML_KS = 9216, ML_KT = 18432, ML_VT = 27648, ML_VWT = 36864, ML_PS = 46080, ML_CB = 55296, ML_WGT = 64512, ML_RR = 64768, ML_MROW = 65024,
              ML_SC = 65280, ML_EMT = 65536, ML_DENI = 65792, ML_NS = 66048, ML_A12 = 66304;
DI void mlstm_job(const KP& p, int l, int job, LAS unsigned char* lds, int tid) {
    int seq, hm, dir; seq_of_job(job, seq, hm, dir);
    int start, len; seq_info(seq, start, len);
    const bf16_t* proj = (const bf16_t*)(p.ws + WS_R);
    bf16_t* mix = (bf16_t*)(p.ws + WS_X1);
    bf16_t* hbp = (bf16_t*)(p.ws + WS_HBP);
    const float* cw = p.in[17] + l * 3 * 512;
    const float ibv = p.in[18][(l * 2 + dir) * 4 + hm], fbv = p.in[19][(l * 2 + dir) * 4 + hm];
    const int wave = tid >> 6, lane = tid & 63, r32 = lane & 31, hh = lane >> 5;
    LAS bf16_t* Qs = (LAS bf16_t*)(lds + ML_QS); LAS bf16_t* Ks = (LAS bf16_t*)(lds + ML_KS); LAS bf16_t* KT = (LAS bf16_t*)(lds + ML_KT);
    LAS bf16_t* VT = (LAS bf16_t*)(lds + ML_VT); LAS bf16_t* VWT = (LAS bf16_t*)(lds + ML_VWT); LAS bf16_t* Ps = (LAS bf16_t*)(lds + ML_PS); LAS bf16_t* CB = (LAS bf16_t*)(lds + ML_CB);
    LAS float* WGT = (LAS float*)(lds + ML_WGT); LAS float* RR = (LAS float*)(lds + ML_RR); LAS float* MROW = (LAS float*)(lds + ML_MROW); LAS float* SC = (LAS float*)(lds + ML_SC);
    LAS float* EMT = (LAS float*)(lds + ML_EMT); LAS float* DENI = (LAS float*)(lds + ML_DENI); LAS float* NS = (LAS float*)(lds + ML_NS); LAS float* A12 = (LAS float*)(lds + ML_A12);
    for (int i = tid; i < 64 * 72; i += NTHR) CB[i] = 0;
    if (tid < 64) NS[tid] = 0.f;
    f32x16 Creg = zero16();
    float Mst = 0.f;
    __syncthreads();
    const int nch = len >> 6;
    const int ll = tid >> 3, e8 = (tid & 7) * 8;
    for (int ch = 0; ch < nch; ++ch) {
        {
            const int n = ch * 64 + ll; const int pos = dir ? (len - 1 - n) : n; const int tok = start + pos;
#pragma unroll
            for (int which = 0; which < 2; ++which) {
                const int col = (which ? C_MK : C_MQ) + hm * 64 + e8; const int cwc = (which ? 256 : 0) + hm * 64 + e8;
                const bf16_t* bp = proj + (size_t)tok * NPROJ + col;
                const u32x4 cu = *(const u32x4*)bp; u32x4 pv = {0u, 0u, 0u, 0u}, nv = {0u, 0u, 0u, 0u};
                if (pos > 0) pv = *(const u32x4*)(bp - NPROJ);
                if (pos < len - 1) nv = *(const u32x4*)(bp + NPROJ);
                float o[8];
#pragma unroll
                for (int j = 0; j < 4; ++j) {
                    const f32x2 c0 = *(const f32x2*)(cw + cwc + 2 * j), c1 = *(const f32x2*)(cw + 512 + cwc + 2 * j), c2 = *(const f32x2*)(cw + 1024 + cwc + 2 * j);
                    const float v0 = c0.x * bflo(pv[j]) + c1.x * bflo(cu[j]) + c2.x * bflo(nv[j]);
                    const float v1 = c0.y * bfhi(pv[j]) + c1.y * bfhi(cu[j]) + c2.y * bfhi(nv[j]);
                    o[2 * j] = v0 * sigmoidf_(v0); o[2 * j + 1] = v1 * sigmoidf_(v1);
                }
                if (which) {
#pragma unroll
                    for (int j = 0; j < 8; ++j) o[j] *= 0.125f;
                }
                u32x4 w; w.x = cvtpk(o[0], o[1]); w.y = cvtpk(o[2], o[3]); w.z = cvtpk(o[4], o[5]); w.w = cvtpk(o[6], o[7]);
                if (!which) *(LAS u32x4*)(Qs + ll * 72 + e8) = w;
                else { *(LAS u32x4*)(Ks + ll * 72 + e8) = w;
#pragma unroll
                    for (int j = 0; j < 4; ++j) { KT[(e8 + 2 * j) * 72 + ll] = (bf16_t)(w[j] & 0xffffu); KT[(e8 + 2 * j + 1) * 72 + ll] = (bf16_t)(w[j] >> 16); } }
            }
        }
        if (wave == 0) {
            const int n = ch * 64 + lane; const int pos = dir ? (len - 1 - n) : n; const int tok = start + pos;
            const float igv = bf2f(proj[(size_t)tok * NPROJ + C_IG + dir * 4 + hm]) + ibv;
            const float fgv = bf2f(proj[(size_t)tok * NPROJ + C_FG + dir * 4 + hm]) + fbv;
            const float lf = (fgv > 0.f) ? -log1pf(__expf(-fgv)) : (fgv - log1pf(__expf(fgv)));
            float b = lf;
#pragma unroll
            for (int o = 1; o < 64; o <<= 1) { const float t2 = __shfl_up(b, o); if (lane >= o) b += t2; }
            const float bL = __shfl(b, 63);
            const float g = bL - b + igv;
            float mg = g;
#pragma unroll
            for (int o = 32; o >= 1; o >>= 1) mg = fmaxf(mg, __shfl_xor(mg, o));
            const float wgt = __expf(g - mg);
            const float r = igv - b;
            float cm = r;
#pragma unroll
            for (int o = 1; o < 64; o <<= 1) { const float t2 = __shfl_up(cm, o); if (lane >= o) cm = fmaxf(cm, t2); }
            const float mrow = fmaxf(cm, Mst);
            WGT[lane] = wgt; RR[lane] = r; MROW[lane] = mrow; SC[lane] = __expf(Mst - mrow); EMT[lane] = __expf(-(b + mrow));
            const float Mnew = fmaxf(bL + Mst, mg);
            if (lane == 0) { A12[0] = __expf(bL + Mst - Mnew); A12[1] = __expf(mg - Mnew); }
            Mst = Mnew;
        }
        __syncthreads();
        {
            const int n = ch * 64 + ll; const int pos = dir ? (len - 1 - n) : n; const int tok = start + pos;
            const u32x4 vv = *(const u32x4*)(proj + (size_t)tok * NPROJ + C_MV + hm * 64 + e8);
            const float wg = WGT[ll];
#pragma unroll
            for (int j = 0; j < 4; ++j) {
                VT[(e8 + 2 * j) * 72 + ll] = (bf16_t)(vv[j] & 0xffffu); VT[(e8 + 2 * j + 1) * 72 + ll] = (bf16_t)(vv[j] >> 16);
                const unsigned pw = cvtpk(bflo(vv[j]) * wg, bfhi(vv[j]) * wg);
                VWT[(e8 + 2 * j) * 72 + ll] = (bf16_t)(pw & 0xffffu); VWT[(e8 + 2 * j + 1) * 72 + ll] = (bf16_t)(pw >> 16);
            }
        }
        __syncthreads();
        if (wave < 4) {
            const int tb = wave >> 1, sb = wave & 1;
            f32x16 acc = zero16();
#pragma unroll
            for (int ks = 0; ks < 4; ++ks) {
                const bf16x8 a = *(const LAS bf16x8*)(Qs + (tb * 32 + r32) * 72 + ks * 16 + hh * 8);
                const bf16x8 b = *(const LAS bf16x8*)(Ks + (sb * 32 + r32) * 72 + ks * 16 + hh * 8);
                acc = MFMA32(a, b, acc);
            }
            const int s = sb * 32 + r32; const float rs_ = RR[s];
#pragma unroll
            for (int i = 0; i < 16; ++i) { const int t = tb * 32 + crow(i, hh); const float pvv = (s <= t) ? __expf(rs_ - MROW[t]) * acc[i] : 0.f; Ps[t * 72 + s] = f2bf(pvv); }
        } else {
            const int db = (wave - 4) >> 1, eb = (wave - 4) & 1;
            f32x16 kc = zero16();
#pragma unroll
            for (int ks = 0; ks < 4; ++ks) {
                const bf16x8 a = *(const LAS bf16x8*)(VWT + (db * 32 + r32) * 72 + ks * 16 + hh * 8);
                const bf16x8 b = *(const LAS bf16x8*)(KT + (eb * 32 + r32) * 72 + ks * 16 + hh * 8);
                kc = MFMA32(a, b, kc);
            }
            const float a1 = A12[0], a2 = A12[1];
#pragma unroll
            for (int i = 0; i < 16; ++i) Creg[i] = a1 * Creg[i] + a2 * kc[i];
        }
        __syncthreads();
        f32x16 acc = zero16();
        float ncv = 0.f;
        if (wave < 4) {
            const int tb = wave >> 1, db = wave & 1;
#pragma unroll
            for (int ks = 0; ks < 4; ++ks) {
                const bf16x8 a = *(const LAS bf16x8*)(Qs + (tb * 32 + r32) * 72 + ks * 16 + hh * 8);
                const bf16x8 b = *(const LAS bf16x8*)(CB + (db * 32 + r32) * 72 + ks * 16 + hh * 8);
                acc = MFMA32(a, b, acc);
            }
#pragma unroll
            for (int i = 0; i < 16; ++i) acc[i] *= SC[tb * 32 + crow(i, hh)];
#pragma unroll
            for (int ks = 0; ks < 4; ++ks) {
                const bf16x8 a = *(const LAS bf16x8*)(Ps + (tb * 32 + r32) * 72 + ks * 16 + hh * 8);
                const bf16x8 b = *(const LAS bf16x8*)(VT + (db * 32 + r32) * 72 + ks * 16 + hh * 8);
                acc = MFMA32(a, b, acc);
            }
        } else if (wave == 4) {
            float rsum = 0.f, qn = 0.f;
            for (int e = 0; e < 64; ++e) { rsum += bf2f(Ps[lane * 72 + e]); qn += bf2f(Qs[lane * 72 + e]) * NS[e]; }
            const float den = rsum + SC[lane] * qn;
            DENI[lane] = 1.f / fmaxf(fabsf(den), EMT[lane]);
        } else if (wave == 5) {
            for (int s = 0; s < 64; ++s) ncv += WGT[s] * bf2f(KT[lane * 72 + s]);
        }
        __syncthreads();
        if (wave < 4) {
            const int tb = wave >> 1, db = wave & 1;
#pragma unroll
            for (int i = 0; i < 16; ++i) {
                const int t = tb * 32 + crow(i, hh); const int n = ch * 64 + t; const int pos = dir ? (len - 1 - n) : n; const int tok = start + pos;
                const bf16_t o = f2bf(acc[i] * DENI[t]);
                if (dir) hbp[(size_t)tok * 256 + hm * 64 + db * 32 + r32] = o; else mix[(size_t)tok * DM + 768 + hm * 64 + db * 32 + r32] = o;
            }
        } else {
            const int db = (wave - 4) >> 1, eb = (wave - 4) & 1;
#pragma unroll
            for (int i = 0; i < 16; ++i) CB[(db * 32 + crow(i, hh)) * 72 + eb * 32 + r32] = f2bf(Creg[i]);
            if (wave == 5) NS[lane] = A12[0] * NS[lane] + A12[1] * ncv;
        }
        __syncthreads();
    }
}

DI void mixers_phase(const KP& p, int l, LAS unsigned char* lds, int tid, int G, int bid) {
    for (int j = bid; j < 160; j += G) {
        if (j < 80) rwkv_job(p, l, j, lds, tid); else mlstm_job(p, l, j - 80, lds, tid);
        __syncthreads();
    }
    unsigned* cnt = (unsigned*)(p.ws + WS_CNT) + l;
    LAS int* slot = (LAS int*)(lds + 131072);
    for (;;) {
        if (tid == 0) *slot = (int)atomicAdd(cnt, 1u);
        __syncthreads();
        const int unit = *slot;
        __syncthreads();
        if (unit >= 1536) break;
        attn_unit(p, unit, lds, tid);
    }
}

constexpr int PO_G2T = 0, PO_AS = 69632, PO_GO = 87040;
DI void post_phase(const KP& p, int l, LAS unsigned char* lds, int tid, int G, int bid) {
    const bf16_t* proj = (const bf16_t*)(p.ws + WS_R);
    bf16_t* mix = (bf16_t*)(p.ws + WS_X1);
    const bf16_t* yb = (const bf16_t*)(p.ws + WS_YB);
    const bf16_t* hbp = (const bf16_t*)(p.ws + WS_HBP);
    const float* cdot = (const float*)(p.ws + WS_CDOT);
    const float* mu = p.in[4] + l * 1152;
    const float* lnw = p.in[13] + l * 256; const float* lnb = p.in[14] + l * 256; const float* nw = p.in[20] + l * 256;
    LAS bf16_t* G2T = (LAS bf16_t*)(lds + PO_G2T); LAS bf16_t* AS = (LAS bf16_t*)(lds + PO_AS); LAS bf16_t* GO = (LAS bf16_t*)(lds + PO_GO);
    const int wave = tid >> 6, lane = tid & 63, r32 = lane & 31, hh = lane >> 5;
    { const float* g2 = p.in[9] + (size_t)l * 128 * 256;
      for (int i = 0; i < 64; ++i) { const int idx = tid + NTHR * i; const int mm = idx >> 8, c = idx & 255; G2T[c * 136 + mm] = f2bf(g2[idx]); } }
    __syncthreads();
    for (int unit = bid; unit < T / 64; unit += G) {
        const int tok0 = unit * 64;
        int len; const int st = tok_seq_start(tok0, len);
#pragma unroll
        for (int i = 0; i < 4; ++i) {
            const int q = tid + NTHR * i; const int t = q >> 5, c4 = (q & 31) * 4; const int tok = tok0 + t; const int pos = tok - st;
            const bf16_t* bp = proj + (size_t)tok * NPROJ + C_GD + c4;
            const u32x2 cu = *(const u32x2*)bp; u32x2 pv = {0u, 0u}, nv = {0u, 0u};
            if (pos > 0) pv = *(const u32x2*)(bp - NPROJ);
            if (pos < len - 1) nv = *(const u32x2*)(bp + NPROJ);
            const f32x4 m4 = *(const f32x4*)(mu + C_GD + c4);
            float x[4] = {bflo(cu.x), bfhi(cu.x), bflo(cu.y), bfhi(cu.y)};
            const float pn[4] = {bflo(pv.x) + bflo(nv.x), bfhi(pv.x) + bfhi(nv.x), bflo(pv.y) + bflo(nv.y), bfhi(pv.y) + bfhi(nv.y)};
#pragma unroll
            for (int j = 0; j < 4; ++j) x[j] = sigmoidf_(x[j] + (0.5f * pn[j] - x[j]) * m4[j]);
            u32x2 w; w.x = cvtpk(x[0], x[1]); w.y = cvtpk(x[2], x[3]); *(LAS u32x2*)(AS + t * 136 + c4) = w;
        }
        __syncthreads();
        {
            const int hd = wave & 3, tb = wave >> 2;
            f32x16 a0 = zero16(), a1 = zero16();
#pragma unroll
            for (int ks = 0; ks < 8; ++ks) {
                const bf16x8 a = *(const LAS bf16x8*)(AS + (tb * 32 + r32) * 136 + ks * 16 + hh * 8);
                const bf16x8 b0 = *(const LAS bf16x8*)(G2T + (hd * 64 + r32) * 136 + ks * 16 + hh * 8);
                const bf16x8 b1 = *(const LAS bf16x8*)(G2T + (hd * 64 + 32 + r32) * 136 + ks * 16 + hh * 8);
                a0 = MFMA32(a, b0, a0); a1 = MFMA32(a, b1, a1);
            }
#pragma unroll
            for (int i = 0; i < 16; ++i) { const int t = tb * 32 + crow(i, hh); GO[t * 264 + hd * 64 + r32] = f2bf(a0[i]); GO[t * 264 + hd * 64 + 32 + r32] = f2bf(a1[i]); }
        }
        __syncthreads();
#pragma unroll 1
        for (int it = 0; it < 8; ++it) {
            const int task = tid + NTHR * it; const int grp = task >> 4, li = task & 15; const int t = grp >> 2, hd = grp & 3; const int c4 = li * 4;
            const int tok = tok0 + t; const int pos = tok - st;
            {
                const u32x2 yf = *(const u32x2*)(mix + (size_t)tok * DM + hd * 64 + c4), ybv = *(const u32x2*)(yb + (size_t)tok * 256 + hd * 64 + c4);
                float x[4] = {bflo(yf.x) + bflo(ybv.x), bfhi(yf.x) + bfhi(ybv.x), bflo(yf.y) + bflo(ybv.y), bfhi(yf.y) + bfhi(ybv.y)};
                const float mean = red16(x[0] + x[1] + x[2] + x[3]) * (1.f / 64.f);
                float vs = 0.f;
#pragma unroll
                for (int j = 0; j < 4; ++j) { x[j] -= mean; vs += x[j] * x[j]; }
                const float rstd = rsqrtf(red16(vs) * (1.f / 64.f) + 64e-5f);
                const bf16_t* bp = proj + (size_t)tok * NPROJ + C_V + hd * 64 + c4;
                const u32x2 cu = *(const u32x2*)bp; u32x2 pv = {0u, 0u}, nv = {0u, 0u};
                if (pos > 0) pv = *(const u32x2*)(bp - NPROJ);
                if (pos < len - 1) nv = *(const u32x2*)(bp + NPROJ);
                const f32x4 m4 = *(const f32x4*)(mu + C_V + hd * 64 + c4);
                float v[4] = {bflo(cu.x), bfhi(cu.x), bflo(cu.y), bfhi(cu.y)};
                const float pn[4] = {bflo(pv.x) + bflo(nv.x), bfhi(pv.x) + bfhi(nv.x), bflo(pv.y) + bflo(nv.y), bfhi(pv.y) + bfhi(nv.y)};
                const f32x2 cdv = *(const f32x2*)(cdot + ((size_t)tok * 4 + hd) * 2);
                const float cds = cdv.x + cdv.y;
                const f32x4 lw = *(const f32x4*)(lnw + hd * 64 + c4), lb = *(const f32x4*)(lnb + hd * 64 + c4);
                const u32x2 gv = *(const LAS u32x2*)(GO + t * 264 + hd * 64 + c4);
                const float g[4] = {bflo(gv.x), bfhi(gv.x), bflo(gv.y), bfhi(gv.y)};
                float o[4];
#pragma unroll
                for (int j = 0; j < 4; ++j) { const float vsft = v[j] + (0.5f * pn[j] - v[j]) * m4[j]; o[j] = (x[j] * rstd * lw[j] + lb[j] + cds * vsft) * g[j]; }
                u32x2 w; w.x = cvtpk(o[0], o[1]); w.y = cvtpk(o[2], o[3]); *(u32x2*)(mix + (size_t)tok * DM + hd * 64 + c4) = w;
            }
            {
                const u32x2 hf = *(const u32x2*)(mix + (size_t)tok * DM + 768 + hd * 64 + c4), hb = *(const u32x2*)(hbp + (size_t)tok * 256 + hd * 64 + c4);
                const float x[4] = {bflo(hf.x) + bflo(hb.x), bfhi(hf.x) + bfhi(hb.x), bflo(hf.y) + bflo(hb.y), bfhi(hf.y) + bfhi(hb.y)};
                const float ms = red16(x[0] * x[0] + x[1] * x[1] + x[2] * x[2] + x[3] * x[3]) * (1.f / 64.f);
                const float rinv = rsqrtf(ms + 1e-6f);
                const u32x2 ov = *(const u32x2*)(proj + (size_t)tok * NPROJ + C_MO + hd * 64 + c4);
                const float og[4] = {bflo(ov.x), bfhi(ov.x), bflo(ov.y), bfhi(ov.y)};
                const f32x4 nwv = *(const f32x4*)(nw + hd * 64 + c4);
                float o[4];
#pragma unroll
                for (int j = 0; j < 4; ++j) o[j] = sigmoidf_(og[j]) * x[j] * rinv * nwv[j];
                u32x2 w; w.x = cvtpk(o[0], o[1]); w.y = cvtpk(o[2], o[3]); *(u32x2*)(mix + (size_t)tok * DM + 768 + hd * 64 + c4) = w;
            }
        }
        __syncthreads();
    }
}

DI void final_phase(const KP& p, int tid, int G, int bid) {
    const float* ss = (const float*)(p.ws + WS_SS) + 4 * T;
    const float* g = p.in[25];
    for (size_t i = (size_t)bid * NTHR + tid; i < (size_t)T * 256; i += (size_t)G * NTHR) {
        const int row = (int)(i >> 8), c = (int)(i & 255) * 4;
        const float rs = rsqrtf(ss[row] * (1.f / 1024.f) + 1e-6f);
        f32x4 v = *(const f32x4*)(p.out + i * 4); const f32x4 gv = *(const f32x4*)(g + c);
        v[0] *= rs * gv[0]; v[1] *= rs * gv[1]; v[2] *= rs * gv[2]; v[3] *= rs * gv[3];
        *(f32x4*)(p.out + i * 4) = v;
    }
}

__global__ void __launch_bounds__(NTHR, 2) fwd_kernel(KP p) {
    extern __shared__ __attribute__((aligned(16))) unsigned char lds_raw[];
    LAS unsigned char* lds = (LAS unsigned char*)lds_raw;
    cg::grid_group grid = cg::this_grid();
    int tid = threadIdx.x; const int G = gridDim.x, bid = blockIdx.x;
#define LAUNDER() asm volatile("" : "+v"(tid))
    float* ss = (float*)(p.ws + WS_SS);
    bf16_t* X1 = (bf16_t*)(p.ws + WS_X1);
    bf16_t* PROJ = (bf16_t*)(p.ws + WS_R);
    bf16_t* HB = (bf16_t*)(p.ws + WS_R);
    bf16_t* HID = (bf16_t*)(p.ws + WS_HID);

        LAUNDER();
    p0_phase(p, lds, tid, G, bid);
    grid.sync();
    for (int l = 0; l < 2; ++l) {
        {
            pg8::Gemm g{X1, (const bf16_t*)(p.ws + WS_WIN) + (size_t)l * NPROJ * 1024, T, NPROJ, 1024}; pg8::StaticOrder S; S.init(T, NPROJ, G, bid);
            EpiProj E{PROJ, ss + (2 * l) * T};
            pg8::gemm_phase<EpiProj, pg8::StaticOrder, true, true>(lds, g, S, E);
        }
        grid.sync();
        LAUNDER();
        prep_phase(p, l, lds, tid, G, bid);
        grid.sync();
        LAUNDER();
        mixers_phase(p, l, lds, tid, G, bid);
        grid.sync();
        LAUNDER();
        post_phase(p, l, lds, tid, G, bid);
        grid.sync();
        {
            pg8::Gemm g{X1, (const bf16_t*)(p.ws + WS_WOUT) + (size_t)l * 1024 * 1024, T, DM, 1024}; pg8::StaticOrder S; S.init(T, DM, G, bid);
            EpiRes<true, true> E{p.out, HB, ss + (2 * l + 1) * T};
            pg8::gemm_phase<EpiRes<true, true>, pg8::StaticOrder, true, true>(lds, g, S, E);
        }
        grid.sync();
        for (int hf = 0; hf < 2; ++hf) {
            {
                pg8::Gemm g{HB, (const bf16_t*)(p.ws + WS_W1) + (size_t)l * 4096 * 1024 + (size_t)hf * HFF * 1024, T, HFF, 1024}; pg8::StaticOrder S; S.init(T, HFF, G, bid);
                EpiRelu2 E{HID, ss + (2 * l + 1) * T};
                pg8::gemm_phase<EpiRelu2, pg8::StaticOrder, true, true>(lds, g, S, E);
            }
            grid.sync();
            {
                pg8::Gemm g{HID, (const bf16_t*)(p.ws + WS_W2) + (size_t)l * 2 * 1024 * 2048 + (size_t)hf * 1024 * 2048, T, DM, HFF}; pg8::StaticOrder S; S.init(T, DM, G, bid);
                if (hf == 0) { EpiRes<false, false> E{p.out, nullptr, nullptr}; pg8::gemm_phase<EpiRes<false, false>, pg8::StaticOrder, true, true>(lds, g, S, E); }
                else { EpiRes<true, true> E{p.out, X1, ss + (2 * l + 2) * T}; pg8::gemm_phase<EpiRes<true, true>, pg8::StaticOrder, true, true>(lds, g, S, E); }
            }
            grid.sync();
        }
    }
        LAUNDER();
    final_phase(p, tid, G, bid);
}

extern "C" void kernel_launch(void* const* d_in, const int* in_sizes, int n_in, void* d_out, int out_size, void* d_ws, size_t ws_size, hipStream_t stream) {
    static int grid_blocks = 0;
    if (grid_blocks == 0) {
        if (n_in != 26 || out_size != T * DM || ws_size < WS_END) { fprintf(stderr, "kernel_launch: unexpected shapes (n_in %d out %d ws %zu)\n", n_in, out_size, ws_size); grid_blocks = -1; return; }
        int dev = 0, cus = 0, per_cu = 0;
        hipGetDevice(&dev);
        hipDeviceGetAttribute(&cus, hipDeviceAttributeMultiprocessorCount, dev);
        hipFuncSetAttribute((const void*)fwd_kernel, hipFuncAttributeMaxDynamicSharedMemorySize, LDS_BYTES);
        hipOccupancyMaxActiveBlocksPerMultiprocessor(&per_cu, (const void*)fwd_kernel, NTHR, LDS_BYTES);
        if (per_cu < 1) per_cu = 1;
        grid_blocks = cus * per_cu;
        (void)hipGetLastError();
    }
    if (grid_blocks < 0) return;
    KP p{};
    for (int i = 0; i < 26; ++i) p.in[i] = (const float*)d_in[i];
    p.out = (float*)d_out; p.ws = (unsigned char*)d_ws;
    void* args[] = {&p};
    hipError_t e = hipLaunchCooperativeKernel((const void*)fwd_kernel, dim3(grid_blocks), dim3(NTHR), args, LDS_BYTES, stream);
    if (e != hipSuccess) fprintf(stderr, "cooperative launch failed: %s (grid %d)\n", hipGetErrorString(e), grid_blocks);
}
```

```cpp
#include <hip/hip_runtime.h>
#include <hip/hip_cooperative_groups.h>
#include <cstdio>
#include <cstdint>
namespace cg = cooperative_groups;
namespace pg8 {
#define PG8_LAS __attribute__((address_space(3)))
typedef unsigned short bf16_t;
typedef short bf16x8 __attribute__((ext_vector_type(8)));
typedef float f32x4 __attribute__((ext_vector_type(4)));
typedef unsigned u32x4 __attribute__((ext_vector_type(4)));
constexpr int BM = 256, BK = 64, HALF = 128, HTB = HALF * BK * 2  , STAGE_BYTES = 8 * HTB, NXCD = 8, WGM = 8;

__host__ __device__ __forceinline__ int lds_byte(int r, int c) { const int st = (r >> 4) * 2 + (c >> 5), rr = r & 15, cc = c & 31, ob = rr * 64 + cc * 2; return st * 1024 + (ob ^ (((ob >> 9) & 1) << 5)); }
__host__ __device__ __forceinline__ void stage_rc(int b, int& R, int& C) { const int st = b / 1024, sb = b % 1024, swz = sb ^ (((sb >> 9) & 1) << 5); R = (st >> 1) * 16 + swz / 64; C = (st & 1) * 32 + (swz % 64) / 2; }
__host__ __device__ __forceinline__ int perm32(int rho) { const int n = rho >> 4, i = rho & 15; return 8 * (i >> 2) + 4 * n + (i & 3); }

struct Unit { int pm, pn; };
struct Gemm { const bf16_t* A; const bf16_t* Bt; int M, N, K; };

struct StaticOrder {
    int nM, nN, nwg, G, c;
    __host__ __device__ void init(int M, int N, int G_, int c_) { nM = M / BM; nN = N / BM; nwg = nM * nN; G = G_; c = c_; }
    __host__ __device__ bool next(int i, Unit& u) const {
        const long L = (long)i * G + c; if (L >= nwg) return false;
        int wgid = (int)L; { const int q = nwg / NXCD, r = nwg % NXCD, xcd = wgid % NXCD, off = wgid / NXCD; wgid = (xcd < r ? xcd * (q + 1) : r * (q + 1) + (xcd - r) * q) + off; }
        const int nig = WGM * nN, gid = wgid / nig, fm = gid * WGM, gsz = (nM - fm) < WGM ? (nM - fm) : WGM;
        u.pm = fm + ((wgid % nig) % gsz); u.pn = (wgid % nig) / gsz; return true;
    }
    __device__ __forceinline__ void a_ready(const Unit&) const {}
    __device__ __forceinline__ void done(const Unit&) const {}
};

template <class Epi, class Sched, bool ALIGN_EPI = false, bool SP2 = false>
__device__ __forceinline__ void gemm_phase(PG8_LAS unsigned char* lds, const Gemm g, const Sched& S, const Epi& E) {
    int tid_l = threadIdx.x; asm volatile("" : "+v"(tid_l));
    const int tid = tid_l, wid = __builtin_amdgcn_readfirstlane(tid >> 6), lane = tid & 63, wr = wid >> 2, wc = wid & 3, fr = lane & 15, fq = lane >> 4;
    const int K = g.K, nt = K / BK;
    unsigned voffA[2], voffB[2];
#pragma unroll
    for (int i = 0; i < 2; ++i) { int R, C; stage_rc(tid * 16 + i * 8192, R, C); const int Rb = Epi::PERM ? ((R & ~31) + perm32(R & 31)) : R;
        voffA[i] = (unsigned)(R * K + C) * 2u; voffB[i] = (unsigned)(Rb * K + C) * 2u; }
    const size_t kstep = (size_t)(BK * 2);
    const size_t hstep = (size_t)HALF * K * 2;
    const size_t tstep = 2 * hstep;
    const unsigned ldsw = (unsigned)wid * 1024u;
    const int aoff = lds_byte(wr * 64 + fr, fq * 8), boff = lds_byte(wc * 32 + fr, fq * 8);
#define PG8_SA(b, h) (((b) * 2 + (h)) * HTB)
#define PG8_SB(b, h) ((4 + (b) * 2 + (h)) * HTB)
#define PG8_STAGE(bufoff, gbase, voff) do { _Pragma("unroll") for (int _i = 0; _i < 2; ++_i) \
        __builtin_amdgcn_global_load_lds((const unsigned*)((const char*)(gbase) + (voff)[_i]), (PG8_LAS unsigned*)(lds + (bufoff) + ldsw + _i * 8192), 16, 0, 0); } while (0)
#define PG8_LDA(dst, b, h) do { _Pragma("unroll") for (int m = 0; m < 4; ++m) _Pragma("unroll") for (int k = 0; k < 2; ++k) dst[m][k] = *(const PG8_LAS bf16x8*)(lds + PG8_SA(b, h) + aoff + m * 2048 + k * 1024); } while (0)
#define PG8_LDB(dst, b, h) do { _Pragma("unroll") for (int n = 0; n < 2; ++n) _Pragma("unroll") for (int k = 0; k < 2; ++k) dst[n][k] = *(const PG8_LAS bf16x8*)(lds + PG8_SB(b, h) + boff + n * 2048 + k * 1024); } while (0)
#define PG8_MMA(ai, bj, At, Bt) do { __builtin_amdgcn_s_setprio(1); _Pragma("unroll") for (int m = 0; m < 4; ++m) _Pragma("unroll") for (int n = 0; n < 2; ++n) _Pragma("unroll") for (int k = 0; k < 2; ++k) \
        acc[ai][bj][m][n] = __builtin_amdgcn_mfma_f32_16x16x32_bf16(Bt[n][k], At[m][k], acc[ai][bj][m][n], 0, 0, 0); __builtin_amdgcn_s_setprio(0); } while (0)
#define PG8_WAIT_V(n) asm volatile("s_waitcnt vmcnt(" #n ")" ::: "memory")
#define PG8_WAIT_L(n) asm volatile("s_waitcnt lgkmcnt(" #n ")" ::: "memory")
#define PG8_BAR __builtin_amdgcn_s_barrier()
#define PG8_SCHED __builtin_amdgcn_sched_barrier(0)
    Unit cur, nxt; int ui = 0;
    if (!S.next(0, cur)) return;
    f32x4 acc[2][2][4][2];
#pragma unroll
    for (int a = 0; a < 2; ++a)
#pragma unroll
        for (int b = 0; b < 2; ++b)
#pragma unroll
            for (int m = 0; m < 4; ++m)
#pragma unroll
                for (int n = 0; n < 2; ++n) acc[a][b][m][n] = (f32x4){0.f, 0.f, 0.f, 0.f};
    bf16x8 At[4][2], B0[2][2], B1[2][2];
    const char* cA = (const char*)g.A + (size_t)cur.pm * tstep; const char* cB = (const char*)g.Bt + (size_t)cur.pn * tstep;
    S.a_ready(cur);
    if constexpr (SP2) {
        PG8_STAGE(PG8_SB(0, 0), cB, voffB); PG8_STAGE(PG8_SB(0, 1), cB + hstep, voffB); PG8_STAGE(PG8_SA(0, 0), cA, voffA); PG8_STAGE(PG8_SA(0, 1), cA + hstep, voffA);
        if (wr == 1) PG8_BAR;
        PG8_WAIT_V(2); PG8_BAR;
        PG8_STAGE(PG8_SB(1, 0), cB + kstep, voffB); PG8_STAGE(PG8_SA(1, 0), cA + kstep, voffA); PG8_STAGE(PG8_SB(1, 1), cB + hstep + kstep, voffB);
        PG8_WAIT_V(6); PG8_BAR;
    } else {
        PG8_STAGE(PG8_SB(0, 0), cB, voffB); PG8_STAGE(PG8_SA(0, 0), cA, voffA); PG8_STAGE(PG8_SB(0, 1), cB + hstep, voffB); PG8_STAGE(PG8_SA(0, 1), cA + hstep, voffA);
        if (wr == 1) PG8_BAR;
        PG8_WAIT_V(4); PG8_BAR;
        PG8_STAGE(PG8_SB(1, 0), cB + kstep, voffB); PG8_STAGE(PG8_SA(1, 0), cA + kstep, voffA); PG8_STAGE(PG8_SB(1, 1), cB + hstep + kstep, voffB);
        PG8_WAIT_V(6); PG8_BAR;
    }
    for (;;) {
        const bool has_next = S.next(ui + 1, nxt);
        const char* nA = has_next ? (const char*)g.A + (size_t)nxt.pm * tstep : cA; const char* nB = has_next ? (const char*)g.Bt + (size_t)nxt.pn * tstep : cB;
        for (int t = 0; t < nt; t += 2) {
            const bool last = (t == nt - 2);
            const char* a1 = cA + (size_t)(t + 1) * kstep;
            const char* a2 = last ? nA : cA + (size_t)(t + 2) * kstep; const char* b2 = last ? nB : cB + (size_t)(t + 2) * kstep;
            const char* a3 = a2 + kstep; const char* b3 = b2 + kstep;
            if (last && has_next) S.a_ready(nxt);
            if constexpr (SP2) {
            PG8_LDB(B0, 0, 0); PG8_LDB(B1, 0, 1); PG8_SCHED; PG8_LDA(At, 0, 0); PG8_STAGE(PG8_SA(1, 1), a1 + hstep, voffA);
            PG8_WAIT_V(8); PG8_WAIT_L(0); PG8_BAR; PG8_MMA(0, 0, At, B0); PG8_MMA(0, 1, At, B1); PG8_BAR; PG8_SCHED;
            PG8_LDA(At, 0, 1); PG8_STAGE(PG8_SB(0, 0), b2, voffB); PG8_STAGE(PG8_SB(0, 1), b2 + hstep, voffB); PG8_STAGE(PG8_SA(0, 0), a2, voffA);
            PG8_WAIT_V(8); PG8_WAIT_L(0); PG8_BAR; PG8_MMA(1, 0, At, B0); PG8_MMA(1, 1, At, B1); PG8_BAR; PG8_SCHED;
            PG8_LDB(B0, 1, 0); PG8_LDB(B1, 1, 1); PG8_SCHED; PG8_LDA(At, 1, 0); PG8_STAGE(PG8_SA(0, 1), a2 + hstep, voffA);
            PG8_WAIT_V(8); PG8_WAIT_L(0); PG8_BAR; PG8_MMA(0, 0, At, B0); PG8_MMA(0, 1, At, B1); PG8_BAR; PG8_SCHED;
            PG8_LDA(At, 1, 1); PG8_STAGE(PG8_SB(1, 0), b3, voffB); PG8_STAGE(PG8_SB(1, 1), b3 + hstep, voffB); PG8_STAGE(PG8_SA(1, 0), a3, voffA);
            PG8_WAIT_V(8); PG8_WAIT_L(0); PG8_BAR; PG8_MMA(1, 0, At, B0); PG8_MMA(1, 1, At, B1); PG8_BAR; PG8_SCHED;
            } else {
            PG8_LDB(B0, 0, 0); PG8_SCHED; PG8_LDA(At, 0, 0); PG8_STAGE(PG8_SA(1, 1), a1 + hstep, voffA);
            PG8_WAIT_L(8); PG8_BAR; PG8_WAIT_L(0); PG8_MMA(0, 0, At, B0); PG8_BAR; PG8_SCHED;
            PG8_LDB(B1, 0, 1); PG8_STAGE(PG8_SB(0, 0), b2, voffB);
            PG8_BAR; PG8_WAIT_L(0); PG8_MMA(0, 1, At, B1); PG8_BAR;
            PG8_LDA(At, 0, 1); PG8_STAGE(PG8_SA(0, 0), a2, voffA);
            PG8_BAR; PG8_WAIT_L(0); PG8_MMA(1, 0, At, B0); PG8_BAR; PG8_SCHED;
            PG8_STAGE(PG8_SB(0, 1), b2 + hstep, voffB);
            PG8_WAIT_V(6); PG8_BAR; PG8_MMA(1, 1, At, B1); PG8_BAR;
            PG8_LDB(B0, 1, 0); PG8_SCHED; PG8_LDA(At, 1, 0); PG8_STAGE(PG8_SA(0, 1), a2 + hstep, voffA);
            PG8_WAIT_L(8); PG8_BAR; PG8_WAIT_L(0); PG8_MMA(0, 0, At, B0); PG8_BAR; PG8_SCHED;
            PG8_LDB(B1, 1, 1); PG8_STAGE(PG8_SB(1, 0), b3, voffB);
            PG8_BAR; PG8_WAIT_L(0); PG8_MMA(0, 1, At, B1); PG8_BAR;
            PG8_LDA(At, 1, 1); PG8_STAGE(PG8_SA(1, 0), a3, voffA);
            PG8_BAR; PG8_WAIT_L(0); PG8_MMA(1, 0, At, B0); PG8_BAR; PG8_SCHED;
            PG8_STAGE(PG8_SB(1, 1), b3 + hstep, voffB);
            PG8_WAIT_V(6); PG8_BAR; PG8_MMA(1, 1, At, B1); PG8_BAR;
            }
        }
        if constexpr (ALIGN_EPI) { if (wr == 0) PG8_BAR; }
        if constexpr (!Epi::AFTER_DRAIN) { E(acc, cur, wr, wc, fr, fq); S.done(cur); }
        if (!has_next) break;
#pragma unroll
        for (int a = 0; a < 2; ++a)
#pragma unroll
            for (int b = 0; b < 2; ++b)
#pragma unroll
                for (int m = 0; m < 4; ++m)
#pragma unroll
                    for (int n = 0; n < 2; ++n) acc[a][b][m][n] = (f32x4){0.f, 0.f, 0.f, 0.f};
        cur = nxt; cA = nA; cB = nB; ++ui;
        if constexpr (ALIGN_EPI) { if (wr == 1) PG8_BAR; }
    }
    PG8_WAIT_V(0);
    if constexpr (!ALIGN_EPI) { if (wr == 0) PG8_BAR; }
    PG8_BAR;
    if constexpr (Epi::AFTER_DRAIN) { E.fused(acc, cur, wr, wc, fr, fq, lds, wid, lane); S.done(cur); }
#undef PG8_SA
#undef PG8_SB
#undef PG8_STAGE
#undef PG8_LDA
#undef PG8_LDB
#undef PG8_MMA
#undef PG8_WAIT_V
#undef PG8_WAIT_L
#undef PG8_BAR
#undef PG8_SCHED
}
}

#define DI __device__ __forceinline__
#define LAS __attribute__((address_space(3)))
typedef unsigned short bf16_t;
typedef short bf16x8 __attribute__((ext_vector_type(8)));
typedef short s16x4 __attribute__((ext_vector_type(4)));
typedef float f32x4 __attribute__((ext_vector_type(4)));
typedef float f32x2 __attribute__((ext_vector_type(2)));
typedef float f32x16 __attribute__((ext_vector_type(16)));
typedef unsigned u32x4 __attribute__((ext_vector_type(4)));
typedef unsigned u32x2 __attribute__((ext_vector_type(2)));
typedef __bf16 bf16x2_t __attribute__((ext_vector_type(2)));
#define MFMA32(a, b, c) __builtin_amdgcn_mfma_f32_32x32x16_bf16((a), (b), (c), 0, 0, 0)

constexpr int T = 49152, DM = 1024, NPROJ = 3072, NIN = 2960, DFF = 4096, HFF = 2048;
constexpr int C_R = 0, C_K = 256, C_V = 512, C_WD = 768, C_AD = 896, C_GD = 1024;
constexpr int C_AQ = 1152, C_AK = 1664, C_AV = 1792;
constexpr int C_MQ = 1920, C_MK = 2176, C_MV = 2432, C_MO = 2688, C_IG = 2944, C_FG = 2952;
constexpr size_t MiB = 1u << 20;
constexpr size_t WS_SS = 0, WS_CNT = MiB - 4096, WS_CDOT = 1 * MiB, WS_TAB = 2 * MiB + 512 * 1024, WS_WIN = 3 * MiB, WS_WOUT = 15 * MiB,
                 WS_W1 = 19 * MiB, WS_W2 = 35 * MiB, WS_VT = 51 * MiB, WS_YB = 63 * MiB, WS_HBP = 87 * MiB, WS_X1 = 111 * MiB, WS_R = 207 * MiB,
                 WS_HID = WS_R + 96 * MiB, WS_END = 495 * MiB;
constexpr int LDS_BYTES = 131072 + 256;
constexpr int NTHR = 512;

struct KP { const float* in[26]; float* out; unsigned char* ws; };

DI unsigned cvtpk(float lo, float hi) { f32x2 v = {lo, hi}; bf16x2_t b = __builtin_convertvector(v, bf16x2_t); return __builtin_bit_cast(unsigned, b); }
DI unsigned short f2bf(float f) { return (unsigned short)(cvtpk(f, 0.f) & 0xffffu); }
DI float bf2f(unsigned h) { return __builtin_bit_cast(float, h << 16); }
DI float bflo(unsigned w) { return __builtin_bit_cast(float, w << 16); }
DI float bfhi(unsigned w) { return __builtin_bit_cast(float, w & 0xffff0000u); }
DI int crow(int reg, int h) { return (reg & 3) + 8 * (reg >> 2) + 4 * h; }
template <int CTRL> DI float dppf(float v) { return __builtin_bit_cast(float, __builtin_amdgcn_update_dpp(0, __builtin_bit_cast(int, v), CTRL, 0xf, 0xf, true)); }
DI float red8(float v) { v += dppf<0xB1>(v); v += dppf<0x4E>(v); v += dppf<0x141>(v); return v; }
DI float red16(float v) { v = red8(v); v += dppf<0x128>(v); return v; }
DI float sigmoidf_(float x) { return 1.f / (1.f + __expf(-x)); }
DI f32x16 zero16() { f32x16 z; for (int i = 0; i < 16; ++i) z[i] = 0.f; return z; }
DI void seq_of_job(int j, int& seq, int& h, int& dir) { if (j < 16) { seq = 8 + (j >> 3); } else { j -= 16; seq = j >> 3; } h = (j >> 1) & 3; dir = j & 1; }
DI void seq_info(int s, int& start, int& len) { if (s < 8) { start = s * 4096; len = 4096; } else { start = 32768 + (s - 8) * 8192; len = 8192; } }
DI int tok_seq_start(int tok, int& len) { if (tok < 32768) { len = 4096; return tok & ~4095; } len = 8192; return 32768 + ((tok - 32768) & ~8191); }

struct EpiProj {
    static constexpr bool PERM = true, AFTER_DRAIN = false;
    bf16_t* O; const float* ss;
    DI void operator()(const pg8::f32x4 (&acc)[2][2][4][2], const pg8::Unit& u, int wr, int wc, int fr, int fq) const {
        const int row0 = u.pm * 256 + wr * 64 + fr, col0 = u.pn * 256 + wc * 32 + 8 * fq;
#pragma unroll
        for (int ai = 0; ai < 2; ++ai)
#pragma unroll
            for (int m = 0; m < 4; ++m) {
                const int row = row0 + ai * 128 + m * 16;
                const float rs = rsqrtf(ss[row] * (1.f / 1024.f) + 1e-6f);
                bf16_t* rp = O + (size_t)row * NPROJ + col0;
#pragma unroll
                for (int bj = 0; bj < 2; ++bj) {
                    pg8::f32x4 v0 = acc[ai][bj][m][0] * rs, v1 = acc[ai][bj][m][1] * rs;
                    u32x4 w; w.x = cvtpk(v0[0], v0[1]); w.y = cvtpk(v0[2], v0[3]); w.z = cvtpk(v1[0], v1[1]); w.w = cvtpk(v1[2], v1[3]);
                    *(u32x4*)(rp + bj * 128) = w;
                }
            }
    }
};
struct EpiRelu2 {
    static constexpr bool PERM = true, AFTER_DRAIN = false;
    bf16_t* O; const float* ss;
    DI void operator()(const pg8::f32x4 (&acc)[2][2][4][2], const pg8::Unit& u, int wr, int wc, int fr, int fq) const {
        const int row0 = u.pm * 256 + wr * 64 + fr, col0 = u.pn * 256 + wc * 32 + 8 * fq;
#pragma unroll
        for (int ai = 0; ai < 2; ++ai)
#pragma unroll
            for (int m = 0; m < 4; ++m) {
                const int row = row0 + ai * 128 + m * 16;
                const float rs = rsqrtf(ss[row] * (1.f / 1024.f) + 1e-6f);
                bf16_t* rp = O + (size_t)row * HFF + col0;
#pragma unroll
                for (int bj = 0; bj < 2; ++bj) {
                    pg8::f32x4 v0 = acc[ai][bj][m][0] * rs, v1 = acc[ai][bj][m][1] * rs;
#pragma unroll
                    for (int j = 0; j < 4; ++j) { float a = fmaxf(v0[j], 0.f); v0[j] = a * a; float b = fmaxf(v1[j], 0.f); v1[j] = b * b; }
                    u32x4 w; w.x = cvtpk(v0[0], v0[1]); w.y = cvtpk(v0[2], v0[3]); w.z = cvtpk(v1[0], v1[1]); w.w = cvtpk(v1[2], v1[3]);
                    *(u32x4*)(rp + bj * 128) = w;
                }
            }
    }
};
template <bool WRITE_HB, bool DO_SS> struct EpiRes {
    static constexpr bool PERM = true, AFTER_DRAIN = false;
    float* X; bf16_t* HB; float* ss;
    DI void operator()(const pg8::f32x4 (&acc)[2][2][4][2], const pg8::Unit& u, int wr, int wc, int fr, int fq) const {
        const int row0 = u.pm * 256 + wr * 64 + fr, col0 = u.pn * 256 + wc * 32 + 8 * fq;
#pragma unroll
        for (int ai = 0; ai < 2; ++ai)
#pragma unroll
            for (int m = 0; m < 4; ++m) {
                const int row = row0 + ai * 128 + m * 16;
                float* xp = X + (size_t)row * DM + col0;
                float sq = 0.f;
#pragma unroll
                for (int bj = 0; bj < 2; ++bj) {
                    pg8::f32x4 a0 = *(const pg8::f32x4*)(xp + bj * 128), a1 = *(const pg8::f32x4*)(xp + bj * 128 + 4);
                    a0 += acc[ai][bj][m][0]; a1 += acc[ai][bj][m][1];
                    *(pg8::f32x4*)(xp + bj * 128) = a0; *(pg8::f32x4*)(xp + bj * 128 + 4) = a1;
                    if (WRITE_HB) { u32x4 w; w.x = cvtpk(a0[0], a0[1]); w.y = cvtpk(a0[2], a0[3]); w.z = cvtpk(a1[0], a1[1]); w.w = cvtpk(a1[2], a1[3]);
                        *(u32x4*)(HB + (size_t)row * DM + col0 + bj * 128) = w; }
                    if (DO_SS) sq += a0[0] * a0[0] + a0[1] * a0[1] + a0[2] * a0[2] + a0[3] * a0[3] + a1[0] * a1[0] + a1[1] * a1[1] + a1[2] * a1[2] + a1[3] * a1[3];
                }
                if (DO_SS) { sq += __shfl_xor(sq, 16); sq += __shfl_xor(sq, 32); if (fq == 0) atomicAdd(ss + row, sq); }
            }
    }
};

DI void transpose_tile(const float* src, int N, int nvalid, const float* gain, bf16_t* dst, int K, int kt, int nt, LAS float* tile, int tid) {
    const int a = tid & 63, b8 = tid >> 6;
#pragma unroll
    for (int i = 0; i < 8; ++i) { const int k = b8 + 8 * i, n = nt * 64 + a; float v = (n < nvalid) ? src[(size_t)(kt * 64 + k) * N + n] : 0.f; if (gain) v *= gain[kt * 64 + k]; tile[k * 65 + a] = v; }
    __syncthreads();
#pragma unroll
    for (int i = 0; i < 8; ++i) { const int n = b8 + 8 * i; dst[(size_t)(nt * 64 + n) * K + kt * 64 + a] = f2bf(tile[a * 65 + n]); }
    __syncthreads();
}
DI void p0_phase(const KP& p, LAS unsigned char* lds, int tid, int G, int bid) {
    LAS float* tile = (LAS float*)lds;
    for (int it = bid; it < 6144; it += G) {
        const int l = it / 3072; int r = it % 3072;
        const float* src; const float* gain; bf16_t* dst; int N, nvalid, K, kt, nt;
        if (r < 768) { src = p.in[3] + (size_t)l * 1024 * NIN; N = NIN; nvalid = NIN; K = 1024; gain = p.in[2] + l * 1024; dst = (bf16_t*)(p.ws + WS_WIN) + (size_t)l * NPROJ * 1024; kt = r / 48; nt = r % 48; }
        else if (r < 1024) { r -= 768; src = p.in[21] + (size_t)l * 1024 * 1024; N = 1024; nvalid = 1024; K = 1024; gain = nullptr; dst = (bf16_t*)(p.ws + WS_WOUT) + (size_t)l * 1024 * 1024; kt = r / 16; nt = r % 16; }
        else if (r < 2048) { r -= 1024; src = p.in[23] + (size_t)l * 1024 * 4096; N = 4096; nvalid = 4096; K = 1024; gain = p.in[22] + l * 1024; dst = (bf16_t*)(p.ws + WS_W1) + (size_t)l * 4096 * 1024; kt = r / 64; nt = r % 64; }
        else { r -= 2048; const int h = r / 512; r %= 512; src = p.in[24] + (size_t)l * 4096 * 1024 + (size_t)h * 2048 * 1024; N = 1024; nvalid = 1024; K = 2048; gain = nullptr;
               dst = (bf16_t*)(p.ws + WS_W2) + (size_t)l * 2 * 1024 * 2048 + (size_t)h * 1024 * 2048; kt = r / 16; nt = r % 16; }
        transpose_tile(src, N, nvalid, gain, dst, K, kt, nt, tile, tid);
    }
    const int wave = tid >> 6, lane = tid & 63;
    float* ss = (float*)(p.ws + WS_SS);
    bf16_t* xb = (bf16_t*)(p.ws + WS_X1);
    for (int row = bid * 8 + wave; row < T; row += G * 8) {
        const float* xs = (row < 32768) ? p.in[0] + (size_t)row * DM : p.in[1] + (size_t)(row - 32768) * DM;
        float sq = 0.f;
#pragma unroll
        for (int j = 0; j < 4; ++j) {
            const int c = (j * 64 + lane) * 4;
            const f32x4 v = *(const f32x4*)(xs + c);
            *(f32x4*)(p.out + (size_t)row * DM + c) = v;
            u32x2 w; w.x = cvtpk(v[0], v[1]); w.y = cvtpk(v[2], v[3]);
            *(u32x2*)(xb + (size_t)row * DM + c) = w;
            sq += v[0] * v[0] + v[1] * v[1] + v[2] * v[2] + v[3] * v[3];
        }
#pragma unroll
        for (int o = 32; o >= 1; o >>= 1) sq += __shfl_xor(sq, o);
        if (lane == 0) ss[row] = sq;
    }
    for (int i = bid * NTHR + tid; i < 4 * T; i += G * NTHR) ss[T + i] = 0.f;
    if (bid == 0) {
        if (tid < 64) ((unsigned*)(p.ws + WS_CNT))[tid] = 0u;
        float2* tab = (float2*)(p.ws + WS_TAB);
        for (int idx = tid; idx < 2048; idx += NTHR) { const int pos = idx >> 4, f = idx & 15; const float inv = powf(10000.f, -(float)f / 16.f); const float ang = (float)pos * inv; tab[idx] = make_float2(cosf(ang), sinf(ang)); }
    }
}

DI void prep_phase(const KP& p, int l, LAS unsigned char* lds, int tid, int G, int bid) {
    bf16_t* proj = (bf16_t*)(p.ws + WS_R);
    bf16_t* vT = (bf16_t*)(p.ws + WS_VT);
    const float2* tab = (const float2*)(p.ws + WS_TAB);
    const float* qn = p.in[15] + l * 64; const float* kn = p.in[16] + l * 64;
    const int wave = tid >> 6, lane = tid & 63, g = lane >> 4, li = lane & 15;
    LAS bf16_t* vts = (LAS bf16_t*)lds;
    for (int unit = bid; unit < T / 64; unit += G) {
        const int tok0 = unit * 64;
        for (int i = 0; i < 8; ++i) {
            const int tok = tok0 + wave * 8 + i; int len; const int st = tok_seq_start(tok, len); const int pos = tok - st; const int prow = pos >> 6, pcol = pos & 63;
#pragma unroll
            for (int it = 0; it < 3; ++it) {
                const bool act = (it < 2) || (g < 2);
                const int colbase = (it < 2) ? C_AQ + (it * 4 + g) * 64 : C_AK + (g & 1) * 64;
                const float* wn = (it < 2) ? qn : kn;
                bf16_t* ptr = proj + (size_t)tok * NPROJ + colbase + li * 4;
                const u32x2 raw = *(const u32x2*)ptr;
                float x[4] = {bflo(raw.x), bfhi(raw.x), bflo(raw.y), bfhi(raw.y)};
                float sq = x[0] * x[0] + x[1] * x[1] + x[2] * x[2] + x[3] * x[3];
                sq = red16(sq);
                const float rinv = rsqrtf(sq * (1.f / 64.f) + 1e-6f);
                const f32x4 w4 = *(const f32x4*)(wn + li * 4);
                const int idx = (li >> 3) ? pcol : prow; const bool second = (li >> 2) & 1;
                const float scale = (it < 2) ? 0.125f * 1.4426950408889634f : 1.f;
                float o[4];
#pragma unroll
                for (int j = 0; j < 4; ++j) {
                    const float y = x[j] * rinv * w4[j];
                    const float pr = __shfl_xor(y, 4);
                    const int f = (li * 4 + j) & 15;
                    const float2 cs = tab[idx * 16 + f];
                    o[j] = (second ? (y * cs.x + pr * cs.y) : (y * cs.x - pr * cs.y)) * scale;
                }
                if (act) { u32x2 w; w.x = cvtpk(o[0], o[1]); w.y = cvtpk(o[2], o[3]); *(u32x2*)ptr = w; }
            }
        }
#pragma unroll
        for (int i = 0; i < 2; ++i) { const int idx = tid + NTHR * i; const int tl = idx >> 4, c8 = (idx & 15) * 8;
            const u32x4 v = *(const u32x4*)(proj + (size_t)(tok0 + tl) * NPROJ + C_AV + c8); *(LAS u32x4*)(vts + tl * 136 + c8) = v; }
        __syncthreads();
        { const int c = tid >> 2, tq = tid & 3; unsigned w[8];
#pragma unroll
          for (int j = 0; j < 8; ++j) { const unsigned lo = vts[(tq * 16 + 2 * j) * 136 + c], hi = vts[(tq * 16 + 2 * j + 1) * 136 + c]; w[j] = lo | (hi << 16); }
          u32x4 a = {w[0], w[1], w[2], w[3]}, b = {w[4], w[5], w[6], w[7]};
          bf16_t* dp = vT + (size_t)c * T + tok0 + tq * 16; *(u32x4*)dp = a; *(u32x4*)(dp + 8) = b; }
        __syncthreads();
    }
}

DI void attn_unit(const KP& p, int unit, LAS unsigned char* lds, int tid) {
    const bf16_t* proj = (const bf16_t*)(p.ws + WS_R);
    const bf16_t* vT = (const bf16_t*)(p.ws + WS_VT);
    bf16_t* mix = (bf16_t*)(p.ws + WS_X1);
    int seq, kvh, qt;
    if (unit < 512) { seq = 8 + (unit >> 8); const int r = unit & 255; kvh = r >> 7; qt = r & 127; }
    else { const int u2 = unit - 512; seq = u2 >> 7; const int r = u2 & 127; kvh = r >> 6; qt = r & 63; }
    int start, len; seq_info(seq, start, len);
    const int nk = len >> 6;
    const int wave = tid >> 6, lane = tid & 63, r32 = lane & 31, hh = lane >> 5;
    const int head = kvh * 4 + (wave >> 1);
    const int q0 = start + qt * 64 + (wave & 1) * 32;
    bf16x8 qf[4];
    { const bf16_t* qp = proj + (size_t)(q0 + r32) * NPROJ + C_AQ + head * 64 + hh * 8;
#pragma unroll
      for (int ks = 0; ks < 4; ++ks) qf[ks] = *(const bf16x8*)(qp + ks * 16); }
    f32x16 o0 = zero16(), o1 = zero16();
    float m = -1e30f, lsum = 0.f;
    const int lrow = tid >> 3, lseg = tid & 7;
    const bf16_t* kptr = proj + (size_t)(start + lrow) * NPROJ + C_AK + kvh * 64 + lseg * 8;
    const bf16_t* vptr = vT + (size_t)(kvh * 64 + lrow) * T + start + lseg * 8;
    const int lds_off = lrow * 144 + lseg * 16;
    u32x4 kreg = *(const u32x4*)kptr, vreg = *(const u32x4*)vptr;
    *(LAS u32x4*)(lds + lds_off) = kreg; *(LAS u32x4*)(lds + 9216 + lds_off) = vreg;
    __syncthreads();
    for (int j = 0; j < nk; ++j) {
        const bool more = (j + 1 < nk);
        if (more) { kreg = *(const u32x4*)(kptr + (size_t)(j + 1) * 64 * NPROJ); vreg = *(const u32x4*)(vptr + (j + 1) * 64); }
        LAS unsigned char* Ks = lds + (j & 1) * 18432; LAS unsigned char* Vs = Ks + 9216;
        f32x16 s0 = zero16(), s1 = zero16();
#pragma unroll
        for (int ks = 0; ks < 4; ++ks) {
            const bf16x8 a0 = *(const LAS bf16x8*)(Ks + r32 * 144 + (ks * 16 + hh * 8) * 2);
            const bf16x8 a1 = *(const LAS bf16x8*)(Ks + (32 + r32) * 144 + (ks * 16 + hh * 8) * 2);
            s0 = MFMA32(a0, qf[ks], s0); s1 = MFMA32(a1, qf[ks], s1);
        }
        float mx = s0[0];
#pragma unroll
        for (int i = 1; i < 16; ++i) mx = fmaxf(mx, s0[i]);
#pragma unroll
        for (int i = 0; i < 16; ++i) mx = fmaxf(mx, s1[i]);
        mx = fmaxf(mx, __shfl_xor(mx, 32));
        const float mnew = fmaxf(m, mx);
        const float alpha = __builtin_amdgcn_exp2f(m - mnew);
        m = mnew;
        float rs = 0.f;
#pragma unroll
        for (int i = 0; i < 16; ++i) { s0[i] = __builtin_amdgcn_exp2f(s0[i] - mnew); rs += s0[i]; }
#pragma unroll
        for (int i = 0; i < 16; ++i) { s1[i] = __builtin_amdgcn_exp2f(s1[i] - mnew); rs += s1[i]; }
        lsum = lsum * alpha + rs;
#pragma unroll
        for (int i = 0; i < 16; ++i) { o0[i] *= alpha; o1[i] *= alpha; }
#pragma unroll
        for (int mb = 0; mb < 2; ++mb)
#pragma unroll
            for (int s = 0; s < 2; ++s) {
                u32x4 pk;
                if (mb == 0) { pk.x = cvtpk(s0[8 * s], s0[8 * s + 1]); pk.y = cvtpk(s0[8 * s + 2], s0[8 * s + 3]); pk.z = cvtpk(s0[8 * s + 4], s0[8 * s + 5]); pk.w = cvtpk(s0[8 * s + 6], s0[8 * s + 7]); }
                else         { pk.x = cvtpk(s1[8 * s], s1[8 * s + 1]); pk.y = cvtpk(s1[8 * s + 2], s1[8 * s + 3]); pk.z = cvtpk(s1[8 * s + 4], s1[8 * s + 5]); pk.w = cvtpk(s1[8 * s + 6], s1[8 * s + 7]); }
                const bf16x8 pb = __builtin_bit_cast(bf16x8, pk);
                const int keyoff = 32 * mb + 16 * s + 4 * hh;
                { const s16x4 lo = *(const LAS s16x4*)(Vs + r32 * 144 + keyoff * 2), hi = *(const LAS s16x4*)(Vs + r32 * 144 + (keyoff + 8) * 2);
                  const bf16x8 va = __builtin_shufflevector(lo, hi, 0, 1, 2, 3, 4, 5, 6, 7); o0 = MFMA32(va, pb, o0); }
                { const s16x4 lo = *(const LAS s16x4*)(Vs + (32 + r32) * 144 + keyoff * 2), hi = *(const LAS s16x4*)(Vs + (32 + r32) * 144 + (keyoff + 8) * 2);
                  const bf16x8 va = __builtin_shufflevector(lo, hi, 0, 1, 2, 3, 4, 5, 6, 7); o1 = MFMA32(va, pb, o1); }
            }
        if (more) { LAS unsigned char* Kn = lds + ((j + 1) & 1) * 18432; *(LAS u32x4*)(Kn + lds_off) = kreg; *(LAS u32x4*)(Kn + 9216 + lds_off) = vreg; }
        __syncthreads();
    }
    lsum += __shfl_xor(lsum, 32);
    const float inv = 1.f / lsum;
    bf16_t* op = mix + (size_t)(q0 + r32) * DM + 256 + head * 64;
#pragma unroll
    for (int g4 = 0; g4 < 4; ++g4) {
        u32x2 w0; w0.x = cvtpk(o0[4 * g4] * inv, o0[4 * g4 + 1] * inv); w0.y = cvtpk(o0[4 * g4 + 2] * inv, o0[4 * g4 + 3] * inv);
        *(u32x2*)(op + 8 * g4 + 4 * hh) = w0;
        u32x2 w1; w1.x = cvtpk(o1[4 * g4] * inv, o1[4 * g4 + 1] * inv); w1.y = cvtpk(o1[4 * g4 + 2] * inv, o1[4 * g4 + 3] * inv);
        *(u32x2*)(op + 32 + 8 * g4 + 4 * hh) = w1;
    }
}

constexpr int RW_XR = 0, RW_XKD = 8192, RW_XV = 16384, RW_WLW = 24576, RW_ALB = 32768, RW_KKN = 40960, RW_YO = 49152, RW_XWD = 57344, RW_XAD = 61952,
              RW_W2T = 66560, RW_A2T = 75776, RW_CD = 84992;
#define RW_DECODE(i_) const int q = tid + NTHR * (i_); const int t = q / 80, cq = q % 80; const int gi = cq >> 4, c4 = (cq & 15) * 4; \
            const int col = (gi == 0) ? C_R + h * 64 + c4 : (gi == 1) ? C_K + h * 64 + c4 : (gi == 2) ? C_V + h * 64 + c4 : (gi == 3) ? C_WD + dir * 64 + c4 : C_AD + dir * 64 + c4;
#define RW_ISSUE(chx) do { _Pragma("unroll") for (int i = 0; i < 5; ++i) { RW_DECODE(i) \
            const int n = (chx) * 32 + t; const int pos = dir ? (len - 1 - n) : n; \
            const bf16_t* bp = proj + (size_t)(start + pos) * NPROJ + col; \
            rc[i] = *(const u32x2*)bp; rp_[i] = (u32x2){0u, 0u}; rn[i] = (u32x2){0u, 0u}; \
            if (pos > 0) rp_[i] = *(const u32x2*)(bp - NPROJ); \
            if (pos < len - 1) rn[i] = *(const u32x2*)(bp + NPROJ); } } while (0)
DI void rwkv_job(const KP& p, int l, int job, LAS unsigned char* lds, int tid) {
    int seq, h, dir, rpart;
    { int j = job; if (j < 32) { seq = 8 + (j >> 4); } else { j -= 32; seq = j >> 4; } h = (j >> 2) & 3; dir = (j >> 1) & 1; rpart = j & 1; }
    int start, len; seq_info(seq, start, len);
    const bf16_t* proj = (const bf16_t*)(p.ws + WS_R);
    bf16_t* mix = (bf16_t*)(p.ws + WS_X1);
    bf16_t* yb = (bf16_t*)(p.ws + WS_YB);
    float* cdot = (float*)(p.ws + WS_CDOT);
    const float* mu = p.in[4] + l * 1152;
    const int wave = tid >> 6, lane = tid & 63, r32 = lane & 31, hh = lane >> 5;
    LAS float* XR = (LAS float*)(lds + RW_XR); LAS float* XKD = (LAS float*)(lds + RW_XKD); LAS float* XV = (LAS float*)(lds + RW_XV);
    LAS float* WLW = (LAS float*)(lds + RW_WLW); LAS float* ALB = (LAS float*)(lds + RW_ALB); LAS float* KKN = (LAS float*)(lds + RW_KKN);
    LAS float* YO = (LAS float*)(lds + RW_YO); LAS float* CD = (LAS float*)(lds + RW_CD);
    LAS bf16_t* XWD = (LAS bf16_t*)(lds + RW_XWD); LAS bf16_t* XAD = (LAS bf16_t*)(lds + RW_XAD);
    LAS bf16_t* W2T = (LAS bf16_t*)(lds + RW_W2T); LAS bf16_t* A2T = (LAS bf16_t*)(lds + RW_A2T);
    { const float* w2 = p.in[6] + (size_t)((l * 2 + dir) * 64) * 256 + h * 64; const float* a2 = p.in[8] + (size_t)((l * 2 + dir) * 64) * 256 + h * 64;
#pragma unroll
      for (int i = 0; i < 8; ++i) { const int idx = tid + NTHR * i; const int mm = idx >> 6, c = idx & 63; W2T[c * 72 + mm] = f2bf(w2[mm * 256 + c]); A2T[c * 72 + mm] = f2bf(a2[mm * 256 + c]); } }
    const int ct = tid >> 4, cli = tid & 15, cc4 = cli * 4;
    const f32x4 w0v = *(const f32x4*)(p.in[5] + (l * 2 + dir) * 256 + h * 64 + cc4);
    const f32x4 a0v = *(const f32x4*)(p.in[7] + (l * 2 + dir) * 256 + h * 64 + cc4);
    const f32x4 kkw = *(const f32x4*)(p.in[10] + l * 256 + h * 64 + cc4);
    const f32x4 kaw = *(const f32x4*)(p.in[11] + l * 256 + h * 64 + cc4);
    const f32x4 rkw = *(const f32x4*)(p.in[12] + l * 256 + h * 64 + cc4);
    const int sil = tid >> 4, si = rpart * 32 + sil, sj = (tid & 15) * 4;
    f32x4 S = {0.f, 0.f, 0.f, 0.f};
    u32x2 rc[5], rp_[5], rn[5];
    const int nch = len >> 5;
    RW_ISSUE(0);
    __syncthreads();
    for (int ch = 0; ch < nch; ++ch) {
        const int n0 = ch * 32;
#pragma unroll
        for (int i = 0; i < 5; ++i) {
            RW_DECODE(i)
            const f32x4 m4 = *(const f32x4*)(mu + col);
            float x[4];
            x[0] = bflo(rc[i].x); x[1] = bfhi(rc[i].x); x[2] = bflo(rc[i].y); x[3] = bfhi(rc[i].y);
            const float pn[4] = {bflo(rp_[i].x) + bflo(rn[i].x), bfhi(rp_[i].x) + bfhi(rn[i].x), bflo(rp_[i].y) + bflo(rn[i].y), bfhi(rp_[i].y) + bfhi(rn[i].y)};
#pragma unroll
            for (int j = 0; j < 4; ++j) x[j] = x[j] + (0.5f * pn[j] - x[j]) * m4[j];
            if (gi < 3) { LAS float* dst = (gi == 0) ? XR : (gi == 1) ? XKD : XV; f32x4 v = {x[0], x[1], x[2], x[3]}; *(LAS f32x4*)(dst + t * 64 + c4) = v; }
            else if (gi == 3) {
#pragma unroll
                for (int j = 0; j < 4; ++j) { const float e = __expf(2.f * x[j]); x[j] = 1.f - 2.f / (e + 1.f); }
                u32x2 w; w.x = cvtpk(x[0], x[1]); w.y = cvtpk(x[2], x[3]); *(LAS u32x2*)(XWD + t * 72 + c4) = w; }
            else { u32x2 w; w.x = cvtpk(x[0], x[1]); w.y = cvtpk(x[2], x[3]); *(LAS u32x2*)(XAD + t * 72 + c4) = w; }
        }
        __syncthreads();
        if (wave < 4) {
            const int mat = wave >> 1, nb = wave & 1;
            LAS bf16_t* Xs = mat ? XAD : XWD; LAS bf16_t* Ws = mat ? A2T : W2T;
            f32x16 acc = zero16();
#pragma unroll
            for (int ks = 0; ks < 4; ++ks) {
                const bf16x8 a = *(const LAS bf16x8*)(Xs + r32 * 72 + ks * 16 + hh * 8);
                const bf16x8 b = *(const LAS bf16x8*)(Ws + (nb * 32 + r32) * 72 + ks * 16 + hh * 8);
                acc = MFMA32(a, b, acc);
            }
            LAS float* dst = mat ? ALB : WLW;
#pragma unroll
            for (int i = 0; i < 16; ++i) dst[crow(i, hh) * 64 + nb * 32 + r32] = acc[i];
        }
        __syncthreads();
        {
            const f32x4 wl = *(const LAS f32x4*)(WLW + ct * 64 + cc4), al = *(const LAS f32x4*)(ALB + ct * 64 + cc4);
            const f32x4 k4 = *(const LAS f32x4*)(XKD + ct * 64 + cc4), r4 = *(const LAS f32x4*)(XR + ct * 64 + cc4);
            f32x4 w, a, kkr, kd;
            float ssq = 0.f, cd = 0.f;
#pragma unroll
            for (int j = 0; j < 4; ++j) {
                const float sg = sigmoidf_(w0v[j] + wl[j]);
                w[j] = __expf(-0.6065306597126334f * sg);
                a[j] = sigmoidf_(a0v[j] + al[j]);
                kkr[j] = k4[j] * kkw[j]; ssq += kkr[j] * kkr[j];
                kd[j] = k4[j] * (1.f + (a[j] - 1.f) * kaw[j]);
                cd += r4[j] * kd[j] * rkw[j];
            }
            ssq = red16(ssq); cd = red16(cd);
            const float inv = 1.f / fmaxf(sqrtf(ssq), 1e-12f);
            f32x4 kkn, b;
#pragma unroll
            for (int j = 0; j < 4; ++j) { kkn[j] = kkr[j] * inv; b[j] = kkn[j] * a[j]; }
            *(LAS f32x4*)(WLW + ct * 64 + cc4) = w; *(LAS f32x4*)(ALB + ct * 64 + cc4) = b; *(LAS f32x4*)(KKN + ct * 64 + cc4) = kkn; *(LAS f32x4*)(XKD + ct * 64 + cc4) = kd;
            if (cli == 0) CD[ct] = cd;
        }
        __syncthreads();
        if (ch + 1 < nch) RW_ISSUE(ch + 1);
#pragma unroll 4
        for (int t = 0; t < 32; ++t) {
            const f32x4 w4 = *(const LAS f32x4*)(WLW + t * 64 + sj);
            const f32x4 k4 = *(const LAS f32x4*)(KKN + t * 64 + sj);
            const f32x4 b4 = *(const LAS f32x4*)(ALB + t * 64 + sj);
            const f32x4 d4 = *(const LAS f32x4*)(XKD + t * 64 + sj);
            const f32x4 r4 = *(const LAS f32x4*)(XR + t * 64 + sj);
            const float v = XV[t * 64 + si];
            float sa = S[0] * k4[0] + S[1] * k4[1] + S[2] * k4[2] + S[3] * k4[3];
            sa = -red16(sa);
            S = S * w4 + sa * b4 + v * d4;
            float y = S[0] * r4[0] + S[1] * r4[1] + S[2] * r4[2] + S[3] * r4[3];
            y = red16(y);
            if ((tid & 15) == 0) YO[t * 32 + sil] = y;
        }
        __syncthreads();
        {
            const int c2 = cli * 2;
            const int n = n0 + ct; const int pos = dir ? (len - 1 - n) : n; const int tok = start + pos;
            const f32x2 yv = *(const LAS f32x2*)(YO + ct * 32 + c2);
            const unsigned w = cvtpk(yv[0], yv[1]);
            if (dir) *(unsigned*)(yb + (size_t)tok * 256 + h * 64 + rpart * 32 + c2) = w; else *(unsigned*)(mix + (size_t)tok * DM + h * 64 + rpart * 32 + c2) = w;
            if (rpart == 0 && tid < 32) { const int n2 = n0 + tid; const int pos2 = dir ? (len - 1 - n2) : n2; cdot[((size_t)(start + pos2) * 4 + h) * 2 + dir] = CD[tid]; }
        }
    }
    __syncthreads();
}

constexpr int ML_QS = 0, ML_KS = 9216, ML_KT = 18432, ML_VT = 27648, ML_VWT = 36864, ML_PS = 46080, ML_CB = 55296, ML_WGT = 64512, ML_RR = 64768, ML_MROW = 65024,
              ML_SC = 65280, ML_EMT = 65536, ML_DENI = 65792, ML_NS = 66048, ML_A12 = 66304;
DI void mlstm_job(const KP& p, int l, int job, LAS unsigned char* lds, int tid) {
    int seq, hm, dir; seq_of_job(job, seq, hm, dir);
    int start, len; seq_info(seq, start, len);
    const bf16_t* proj = (const bf16_t*)(p.ws + WS_R);
    bf16_t* mix = (bf16_t*)(p.ws + WS_X1);
    bf16_t* hbp = (bf16_t*)(p.ws + WS_HBP);
    const float* cw = p.in[17] + l * 3 * 512;
    const float ibv = p.in[18][(l * 2 + dir) * 4 + hm], fbv = p.in[19][(l * 2 + dir) * 4 + hm];
    const int wave = tid >> 6, lane = tid & 63, r32 = lane & 31, hh = lane >> 5;
    LAS bf16_t* Qs = (LAS bf16_t*)(lds + ML_QS); LAS bf16_t* Ks = (LAS bf16_t*)(lds + ML_KS); LAS bf16_t* KT = (LAS bf16_t*)(lds + ML_KT);
    LAS bf16_t* VT = (LAS bf16_t*)(lds + ML_VT); LAS bf16_t* VWT = (LAS bf16_t*)(lds + ML_VWT); LAS bf16_t* Ps = (LAS bf16_t*)(lds + ML_PS); LAS bf16_t* CB = (LAS bf16_t*)(lds + ML_CB);
    LAS float* WGT = (LAS float*)(lds + ML_WGT); LAS float* RR = (LAS float*)(lds + ML_RR); LAS float* MROW = (LAS float*)(lds + ML_MROW); LAS float* SC = (LAS float*)(lds + ML_SC);
    LAS float* EMT = (LAS float*)(lds + ML_EMT); LAS float* DENI = (LAS float*)(lds + ML_DENI); LAS float* NS = (LAS float*)(lds + ML_NS); LAS float* A12 = (LAS float*)(lds + ML_A12);
    for (int i = tid; i < 64 * 72; i += NTHR) CB[i] = 0;
    if (tid < 64) NS[tid] = 0.f;
    f32x16 Creg = zero16();
    float Mst = 0.f;
    __syncthreads();
    const int nch = len >> 6;
    const int ll = tid >> 3, e8 = (tid & 7) * 8;
    for (int ch = 0; ch < nch; ++ch) {
        {
            const int n = ch * 64 + ll; const int pos = dir ? (len - 1 - n) : n; const int tok = start + pos;
#pragma unroll
            for (int which = 0; which < 2; ++which) {
                const int col = (which ? C_MK : C_MQ) + hm * 64 + e8; const int cwc = (which ? 256 : 0) + hm * 64 + e8;
                const bf16_t* bp = proj + (size_t)tok * NPROJ + col;
                const u32x4 cu = *(const u32x4*)bp; u32x4 pv = {0u, 0u, 0u, 0u}, nv = {0u, 0u, 0u, 0u};
                if (pos > 0) pv = *(const u32x4*)(bp - NPROJ);
                if (pos < len - 1) nv = *(const u32x4*)(bp + NPROJ);
                float o[8];
#pragma unroll
                for (int j = 0; j < 4; ++j) {
                    const f32x2 c0 = *(const f32x2*)(cw + cwc + 2 * j), c1 = *(const f32x2*)(cw + 512 + cwc + 2 * j), c2 = *(const f32x2*)(cw + 1024 + cwc + 2 * j);
                    const float v0 = c0.x * bflo(pv[j]) + c1.x * bflo(cu[j]) + c2.x * bflo(nv[j]);
                    const float v1 = c0.y * bfhi(pv[j]) + c1.y * bfhi(cu[j]) + c2.y * bfhi(nv[j]);
                    o[2 * j] = v0 * sigmoidf_(v0); o[2 * j + 1] = v1 * sigmoidf_(v1);
                }
                if (which) {
#pragma unroll
                    for (int j = 0; j < 8; ++j) o[j] *= 0.125f;
                }
                u32x4 w; w.x = cvtpk(o[0], o[1]); w.y = cvtpk(o[2], o[3]); w.z = cvtpk(o[4], o[5]); w.w = cvtpk(o[6], o[7]);
                if (!which) *(LAS u32x4*)(Qs + ll * 72 + e8) = w;
                else { *(LAS u32x4*)(Ks + ll * 72 + e8) = w;
#pragma unroll
                    for (int j = 0; j < 4; ++j) { KT[(e8 + 2 * j) * 72 + ll] = (bf16_t)(w[j] & 0xffffu); KT[(e8 + 2 * j + 1) * 72 + ll] = (bf16_t)(w[j] >> 16); } }
            }
        }
        if (wave == 0) {
            const int n = ch * 64 + lane; const int pos = dir ? (len - 1 - n) : n; const int tok = start + pos;
            const float igv = bf2f(proj[(size_t)tok * NPROJ + C_IG + dir * 4 + hm]) + ibv;
            const float fgv = bf2f(proj[(size_t)tok * NPROJ + C_FG + dir * 4 + hm]) + fbv;
            const float lf = (fgv > 0.f) ? -log1pf(__expf(-fgv)) : (fgv - log1pf(__expf(fgv)));
            float b = lf;
#pragma unroll
            for (int o = 1; o < 64; o <<= 1) { const float t2 = __shfl_up(b, o); if (lane >= o) b += t2; }
            const float bL = __shfl(b, 63);
            const float g = bL - b + igv;
            float mg = g;
#pragma unroll
            for (int o = 32; o >= 1; o >>= 1) mg = fmaxf(mg, __shfl_xor(mg, o));
            const float wgt = __expf(g - mg);
            const float r = igv - b;
            float cm = r;
#pragma unroll
            for (int o = 1; o < 64; o <<= 1) { const float t2 = __shfl_up(cm, o); if (lane >= o) cm = fmaxf(cm, t2); }
            const float mrow = fmaxf(cm, Mst);
            WGT[lane] = wgt; RR[lane] = r; MROW[lane] = mrow; SC[lane] = __expf(Mst - mrow); EMT[lane] = __expf(-(b + mrow));
            const float Mnew = fmaxf(bL + Mst, mg);
            if (lane == 0) { A12[0] = __expf(bL + Mst - Mnew); A12[1] = __expf(mg - Mnew); }
            Mst = Mnew;
        }
        __syncthreads();
        {
            const int n = ch * 64 + ll; const int pos = dir ? (len - 1 - n) : n; const int tok = start + pos;
            const u32x4 vv = *(const u32x4*)(proj + (size_t)tok * NPROJ + C_MV + hm * 64 + e8);
            const float wg = WGT[ll];
#pragma unroll
            for (int j = 0; j < 4; ++j) {
                VT[(e8 + 2 * j) * 72 + ll] = (bf16_t)(vv[j] & 0xffffu); VT[(e8 + 2 * j + 1) * 72 + ll] = (bf16_t)(vv[j] >> 16);
                const unsigned pw = cvtpk(bflo(vv[j]) * wg, bfhi(vv[j]) * wg);
                VWT[(e8 + 2 * j) * 72 + ll] = (bf16_t)(pw & 0xffffu); VWT[(e8 + 2 * j + 1) * 72 + ll] = (bf16_t)(pw >> 16);
            }
        }
        __syncthreads();
        if (wave < 4) {
            const int tb = wave >> 1, sb = wave & 1;
            f32x16 acc = zero16();
#pragma unroll
            for (int ks = 0; ks < 4; ++ks) {
                const bf16x8 a = *(const LAS bf16x8*)(Qs + (tb * 32 + r32) * 72 + ks * 16 + hh * 8);
                const bf16x8 b = *(const LAS bf16x8*)(Ks + (sb * 32 + r32) * 72 + ks * 16 + hh * 8);
                acc = MFMA32(a, b, acc);
            }
            const int s = sb * 32 + r32; const float rs_ = RR[s];
#pragma unroll
            for (int i = 0; i < 16; ++i) { const int t = tb * 32 + crow(i, hh); const float pvv = (s <= t) ? __expf(rs_ - MROW[t]) * acc[i] : 0.f; Ps[t * 72 + s] = f2bf(pvv); }
        } else {
            const int db = (wave - 4) >> 1, eb = (wave - 4) & 1;
            f32x16 kc = zero16();
#pragma unroll
            for (int ks = 0; ks < 4; ++ks) {
                const bf16x8 a = *(const LAS bf16x8*)(VWT + (db * 32 + r32) * 72 + ks * 16 + hh * 8);
                const bf16x8 b = *(const LAS bf16x8*)(KT + (eb * 32 + r32) * 72 + ks * 16 + hh * 8);
                kc = MFMA32(a, b, kc);
            }
            const float a1 = A12[0], a2 = A12[1];
#pragma unroll
            for (int i = 0; i < 16; ++i) Creg[i] = a1 * Creg[i] + a2 * kc[i];
        }
        __syncthreads();
        f32x16 acc = zero16();
        float ncv = 0.f;
        if (wave < 4) {
            const int tb = wave >> 1, db = wave & 1;
#pragma unroll
            for (int ks = 0; ks < 4; ++ks) {
                const bf16x8 a = *(const LAS bf16x8*)(Qs + (tb * 32 + r32) * 72 + ks * 16 + hh * 8);
                const bf16x8 b = *(const LAS bf16x8*)(CB + (db * 32 + r32) * 72 + ks * 16 + hh * 8);
                acc = MFMA32(a, b, acc);
            }
#pragma unroll
            for (int i = 0; i < 16; ++i) acc[i] *= SC[tb * 32 + crow(i, hh)];
#pragma unroll
            for (int ks = 0; ks < 4; ++ks) {
                const bf16x8 a = *(const LAS bf16x8*)(Ps + (tb * 32 + r32) * 72 + ks * 16 + hh * 8);
                const bf16x8 b = *(const LAS bf16x8*)(VT + (db * 32 + r32) * 72 + ks * 16 + hh * 8);
                acc = MFMA32(a, b, acc);
            }
        } else if (wave == 4) {
            float rsum = 0.f, qn = 0.f;
            for (int e = 0; e < 64; ++e) { rsum += bf2f(Ps[lane * 72 + e]); qn += bf2f(Qs[lane * 72 + e]) * NS[e]; }
            const float den = rsum + SC[lane] * qn;
            DENI[lane] = 1.f / fmaxf(fabsf(den), EMT[lane]);
        } else if (wave == 5) {
            for (int s = 0; s < 64; ++s) ncv += WGT[s] * bf2f(KT[lane * 72 + s]);
        }
        __syncthreads();
        if (wave < 4) {
            const int tb = wave >> 1, db = wave & 1;
#pragma unroll
            for (int i = 0; i < 16; ++i) {
                const int t = tb * 32 + crow(i, hh); const int n = ch * 64 + t; const int pos = dir ? (len - 1 - n) : n; const int tok = start + pos;
                const bf16_t o = f2bf(acc[i] * DENI[t]);
                if (dir) hbp[(size_t)tok * 256 + hm * 64 + db * 32 + r32] = o; else mix[(size_t)tok * DM + 768 + hm * 64 + db * 32 + r32] = o;
            }
        } else {
            const int db = (wave - 4) >> 1, eb = (wave - 4) & 1;
#pragma unroll
            for (int i = 0; i < 16; ++i) CB[(db * 32 + crow(i, hh)) * 72 + eb * 32 + r32] = f2bf(Creg[i]);
            if (wave == 5) NS[lane] = A12[0] * NS[lane] + A12[1] * ncv;
        }
        __syncthreads();
    }
}

DI void mixers_phase(const KP& p, int l, LAS unsigned char* lds, int tid, int G, int bid) {
    unsigned* cnt = (unsigned*)(p.ws + WS_CNT) + l;
    LAS int* slot = (LAS int*)(lds + 131072);
    for (;;) {
        if (tid == 0) *slot = (int)atomicAdd(cnt, 1u);
        __syncthreads();
        const int item = *slot;
        __syncthreads();
        if (item >= 240 + 1536) break;
        int kind, jb;
        if (item < 32) { kind = 0; jb = item; } else if (item < 48) { kind = 1; jb = item - 32; } else if (item < 176) { kind = 0; jb = item - 48 + 32; }
        else if (item < 240) { kind = 1; jb = item - 176 + 16; } else { kind = 2; jb = item - 240; }
        int t2 = tid; asm volatile("" : "+v"(t2));
        if (kind == 0) rwkv_job(p, l, jb, lds, t2);
        else if (kind == 1) mlstm_job(p, l, jb, lds, t2);
        else attn_unit(p, jb, lds, t2);
        __syncthreads();
    }
}

constexpr int PO_G2T = 0, PO_AS = 69632, PO_GO = 87040;
DI void post_phase(const KP& p, int l, LAS unsigned char* lds, int tid, int G, int bid) {
    const bf16_t* proj = (const bf16_t*)(p.ws + WS_R);
    bf16_t* mix = (bf16_t*)(p.ws + WS_X1);
    const bf16_t* yb = (const bf16_t*)(p.ws + WS_YB);
    const bf16_t* hbp = (const bf16_t*)(p.ws + WS_HBP);
    const float* cdot = (const float*)(p.ws + WS_CDOT);
    const float* mu = p.in[4] + l * 1152;
    const float* lnw = p.in[13] + l * 256; const float* lnb = p.in[14] + l * 256; const float* nw = p.in[20] + l * 256;
    LAS bf16_t* G2T = (LAS bf16_t*)(lds + PO_G2T); LAS bf16_t* AS = (LAS bf16_t*)(lds + PO_AS); LAS bf16_t* GO = (LAS bf16_t*)(lds + PO_GO);
    const int wave = tid >> 6, lane = tid & 63, r32 = lane & 31, hh = lane >> 5;
    { const float* g2 = p.in[9] + (size_t)l * 128 * 256;
      for (int i = 0; i < 64; ++i) { const int idx = tid + NTHR * i; const int mm = idx >> 8, c = idx & 255; G2T[c * 136 + mm] = f2bf(g2[idx]); } }
    __syncthreads();
    for (int unit = bid; unit < T / 64; unit += G) {
        const int tok0 = unit * 64;
        int len; const int st = tok_seq_start(tok0, len);
#pragma unroll
        for (int i = 0; i < 4; ++i) {
            const int q = tid + NTHR * i; const int t = q >> 5, c4 = (q & 31) * 4; const int tok = tok0 + t; const int pos = tok - st;
            const bf16_t* bp = proj + (size_t)tok * NPROJ + C_GD + c4;
            const u32x2 cu = *(const u32x2*)bp; u32x2 pv = {0u, 0u}, nv = {0u, 0u};
            if (pos > 0) pv = *(const u32x2*)(bp - NPROJ);
            if (pos < len - 1) nv = *(const u32x2*)(bp + NPROJ);
            const f32x4 m4 = *(const f32x4*)(mu + C_GD + c4);
            float x[4] = {bflo(cu.x), bfhi(cu.x), bflo(cu.y), bfhi(cu.y)};
            const float pn[4] = {bflo(pv.x) + bflo(nv.x), bfhi(pv.x) + bfhi(nv.x), bflo(pv.y) + bflo(nv.y), bfhi(pv.y) + bfhi(nv.y)};
#pragma unroll
            for (int j = 0; j < 4; ++j) x[j] = sigmoidf_(x[j] + (0.5f * pn[j] - x[j]) * m4[j]);
            u32x2 w; w.x = cvtpk(x[0], x[1]); w.y = cvtpk(x[2], x[3]); *(LAS u32x2*)(AS + t * 136 + c4) = w;
        }
        __syncthreads();
        {
            const int hd = wave & 3, tb = wave >> 2;
            f32x16 a0 = zero16(), a1 = zero16();
#pragma unroll
            for (int ks = 0; ks < 8; ++ks) {
                const bf16x8 a = *(const LAS bf16x8*)(AS + (tb * 32 + r32) * 136 + ks * 16 + hh * 8);
                const bf16x8 b0 = *(const LAS bf16x8*)(G2T + (hd * 64 + r32) * 136 + ks * 16 + hh * 8);
                const bf16x8 b1 = *(const LAS bf16x8*)(G2T + (hd * 64 + 32 + r32) * 136 + ks * 16 + hh * 8);
                a0 = MFMA32(a, b0, a0); a1 = MFMA32(a, b1, a1);
            }
#pragma unroll
            for (int i = 0; i < 16; ++i) { const int t = tb * 32 + crow(i, hh); GO[t * 264 + hd * 64 + r32] = f2bf(a0[i]); GO[t * 264 + hd * 64 + 32 + r32] = f2bf(a1[i]); }
        }
        __syncthreads();
#pragma unroll 1
        for (int it = 0; it < 8; ++it) {
            const int task = tid + NTHR * it; const int grp = task >> 4, li = task & 15; const int t = grp >> 2, hd = grp & 3; const int c4 = li * 4;
            const int tok = tok0 + t; const int pos = tok - st;
            {
                const u32x2 yf = *(const u32x2*)(mix + (size_t)tok * DM + hd * 64 + c4), ybv = *(const u32x2*)(yb + (size_t)tok * 256 + hd * 64 + c4);
                float x[4] = {bflo(yf.x) + bflo(ybv.x), bfhi(yf.x) + bfhi(ybv.x), bflo(yf.y) + bflo(ybv.y), bfhi(yf.y) + bfhi(ybv.y)};
                const float mean = red16(x[0] + x[1] + x[2] + x[3]) * (1.f / 64.f);
                float vs = 0.f;
#pragma unroll
                for (int j = 0; j < 4; ++j) { x[j] -= mean; vs += x[j] * x[j]; }
                const float rstd = rsqrtf(red16(vs) * (1.f / 64.f) + 64e-5f);
                const bf16_t* bp = proj + (size_t)tok * NPROJ + C_V + hd * 64 + c4;
                const u32x2 cu = *(const u32x2*)bp; u32x2 pv = {0u, 0u}, nv = {0u, 0u};
                if (pos > 0) pv = *(const u32x2*)(bp - NPROJ);
                if (pos < len - 1) nv = *(const u32x2*)(bp + NPROJ);
                const f32x4 m4 = *(const f32x4*)(mu + C_V + hd * 64 + c4);
                float v[4] = {bflo(cu.x), bfhi(cu.x), bflo(cu.y), bfhi(cu.y)};
                const float pn[4] = {bflo(pv.x) + bflo(nv.x), bfhi(pv.x) + bfhi(nv.x), bflo(pv.y) + bflo(nv.y), bfhi(pv.y) + bfhi(nv.y)};
                const f32x2 cdv = *(const f32x2*)(cdot + ((size_t)tok * 4 + hd) * 2);
                const float cds = cdv.x + cdv.y;
                const f32x4 lw = *(const f32x4*)(lnw + hd * 64 + c4), lb = *(const f32x4*)(lnb + hd * 64 + c4);
                const u32x2 gv = *(const LAS u32x2*)(GO + t * 264 + hd * 64 + c4);
                const float g[4] = {bflo(gv.x), bfhi(gv.x), bflo(gv.y), bfhi(gv.y)};
                float o[4];
#pragma unroll
                for (int j = 0; j < 4; ++j) { const float vsft = v[j] + (0.5f * pn[j] - v[j]) * m4[j]; o[j] = (x[j] * rstd * lw[j] + lb[j] + cds * vsft) * g[j]; }
                u32x2 w; w.x = cvtpk(o[0], o[1]); w.y = cvtpk(o[2], o[3]); *(u32x2*)(mix + (size_t)tok * DM + hd * 64 + c4) = w;
            }
            {
                const u32x2 hf = *(const u32x2*)(mix + (size_t)tok * DM + 768 + hd * 64 + c4), hb = *(const u32x2*)(hbp + (size_t)tok * 256 + hd * 64 + c4);
                const float x[4] = {bflo(hf.x) + bflo(hb.x), bfhi(hf.x) + bfhi(hb.x), bflo(hf.y) + bflo(hb.y), bfhi(hf.y) + bfhi(hb.y)};
                const float ms = red16(x[0] * x[0] + x[1] * x[1] + x[2] * x[2] + x[3] * x[3]) * (1.f / 64.f);
                const float rinv = rsqrtf(ms + 1e-6f);
                const u32x2 ov = *(const u32x2*)(proj + (size_t)tok * NPROJ + C_MO + hd * 64 + c4);
                const float og[4] = {bflo(ov.x), bfhi(ov.x), bflo(ov.y), bfhi(ov.y)};
                const f32x4 nwv = *(const f32x4*)(nw + hd * 64 + c4);
                float o[4];
#pragma unroll
                for (int j = 0; j < 4; ++j) o[j] = sigmoidf_(og[j]) * x[j] * rinv * nwv[j];
                u32x2 w; w.x = cvtpk(o[0], o[1]); w.y = cvtpk(o[2], o[3]); *(u32x2*)(mix + (size_t)tok * DM + 768 + hd * 64 + c4) = w;
            }
        }
        __syncthreads();
    }
}

DI void final_phase(const KP& p, int tid, int G, int bid) {
    const float* ss = (const float*)(p.ws + WS_SS) + 4 * T;
    const float* g = p.in[25];
    for (size_t i = (size_t)bid * NTHR + tid; i < (size_t)T * 256; i += (size_t)G * NTHR) {
        const int row = (int)(i >> 8), c = (int)(i & 255) * 4;
        const float rs = rsqrtf(ss[row] * (1.f / 1024.f) + 1e-6f);
        f32x4 v = *(const f32x4*)(p.out + i * 4); const f32x4 gv = *(const f32x4*)(g + c);
        v[0] *= rs * gv[0]; v[1] *= rs * gv[1]; v[2] *= rs * gv[2]; v[3] *= rs * gv[3];
        *(f32x4*)(p.out + i * 4) = v;
    }
}

__global__ void __launch_bounds__(NTHR, 2) fwd_kernel(KP p) {
    extern __shared__ __attribute__((aligned(16))) unsigned char lds_raw[];
    LAS unsigned char* lds = (LAS unsigned char*)lds_raw;
    cg::grid_group grid = cg::this_grid();
    int tid = threadIdx.x; const int G = gridDim.x, bid = blockIdx.x;
#define LAUNDER() asm volatile("" : "+v"(tid))
    float* ss = (float*)(p.ws + WS_SS);
    bf16_t* X1 = (bf16_t*)(p.ws + WS_X1);
    bf16_t* PROJ = (bf16_t*)(p.ws + WS_R);
    bf16_t* HB = (bf16_t*)(p.ws + WS_R);
    bf16_t* HID = (bf16_t*)(p.ws + WS_HID);

        LAUNDER();
    p0_phase(p, lds, tid, G, bid);
    grid.sync();
    for (int l = 0; l < 2; ++l) {
        {
            pg8::Gemm g{X1, (const bf16_t*)(p.ws + WS_WIN) + (size_t)l * NPROJ * 1024, T, NPROJ, 1024}; pg8::StaticOrder S; S.init(T, NPROJ, G, bid);
            EpiProj E{PROJ, ss + (2 * l) * T};
            pg8::gemm_phase<EpiProj, pg8::StaticOrder, true, true>(lds, g, S, E);
        }
        grid.sync();
        LAUNDER();
        prep_phase(p, l, lds, tid, G, bid);
        grid.sync();
        LAUNDER();
        mixers_phase(p, l, lds, tid, G, bid);
        grid.sync();
        LAUNDER();
        post_phase(p, l, lds, tid, G, bid);
        grid.sync();
        {
            pg8::Gemm g{X1, (const bf16_t*)(p.ws + WS_WOUT) + (size_t)l * 1024 * 1024, T, DM, 1024}; pg8::StaticOrder S; S.init(T, DM, G, bid);
            EpiRes<true, true> E{p.out, HB, ss + (2 * l + 1) * T};
            pg8::gemm_phase<EpiRes<true, true>, pg8::StaticOrder, true, true>(lds, g, S, E);
        }
        grid.sync();
        for (int hf = 0; hf < 2; ++hf) {
            {
                pg8::Gemm g{HB, (const bf16_t*)(p.ws + WS_W1) + (size_t)l * 4096 * 1024 + (size_t)hf * HFF * 1024, T, HFF, 1024}; pg8::StaticOrder S; S.init(T, HFF, G, bid);
                EpiRelu2 E{HID, ss + (2 * l + 1) * T};
                pg8::gemm_phase<EpiRelu2, pg8::StaticOrder, true, true>(lds, g, S, E);
            }
            grid.sync();
            {
                pg8::Gemm g{HID, (const bf16_t*)(p.ws + WS_W2) + (size_t)l * 2 * 1024 * 2048 + (size_t)hf * 1024 * 2048, T, DM, HFF}; pg8::StaticOrder S; S.init(T, DM, G, bid);
                if (hf == 0) { EpiRes<false, false> E{p.out, nullptr, nullptr}; pg8::gemm_phase<EpiRes<false, false>, pg8::StaticOrder, true, true>(lds, g, S, E); }
                else { EpiRes<true, true> E{p.out, X1, ss + (2 * l + 2) * T}; pg8::gemm_phase<EpiRes<true, true>, pg8::StaticOrder, true, true>(lds, g, S, E); }
            }
            grid.sync();
        }
    }
        LAUNDER();
    final_phase(p, tid, G, bid);
}

extern "C" void kernel_launch(void* const* d_in, const int* in_sizes, int n_in, void* d_out, int out_size, void* d_ws, size_t ws_size, hipStream_t stream) {
    static int grid_blocks = 0;
    if (grid_blocks == 0) {
        if (n_in != 26 || out_size != T * DM || ws_size < WS_END) { fprintf(stderr, "kernel_launch: unexpected shapes (n_in %d out %d ws %zu)\n", n_in, out_size, ws_size); grid_blocks = -1; return; }
        int dev = 0, cus = 0, per_cu = 0;
        hipGetDevice(&dev);
        hipDeviceGetAttribute(&cus, hipDeviceAttributeMultiprocessorCount, dev);
        hipFuncSetAttribute((const void*)fwd_kernel, hipFuncAttributeMaxDynamicSharedMemorySize, LDS_BYTES);
        hipOccupancyMaxActiveBlocksPerMultiprocessor(&per_cu, (const void*)fwd_kernel, NTHR, LDS_BYTES);
        if (per_cu < 1) per_cu = 1;
        grid_blocks = cus * per_cu;
        (void)hipGetLastError();
    }
    if (grid_blocks < 0) return;
    KP p{};
    for (int i = 0; i < 26; ++i) p.in[i] = (const float*)d_in[i];
    p.out = (float*)d_out; p.ws = (unsigned char*)d_ws;
    void* args[] = {&p};
    hipError_t e = hipLaunchCooperativeKernel((const void*)fwd_kernel, dim3(grid_blocks), dim3(NTHR), args, LDS_BYTES, stream);
    if (e != hipSuccess) fprintf(stderr, "cooperative launch failed: %s (grid %d)\n", hipGetErrorString(e), grid_blocks);
}
```

```cpp
#include <hip/hip_runtime.h>
#include <hip/hip_cooperative_groups.h>
#include <cstdio>
#include <cstdint>
namespace cg = cooperative_groups;
namespace pg8 {
#define PG8_LAS __attribute__((address_space(3)))
typedef unsigned short bf16_t;
typedef short bf16x8 __attribute__((ext_vector_type(8)));
typedef float f32x4 __attribute__((ext_vector_type(4)));
typedef unsigned u32x4 __attribute__((ext_vector_type(4)));
constexpr int BM = 256, BK = 64, HALF = 128, HTB = HALF * BK * 2  , STAGE_BYTES = 8 * HTB, NXCD = 8, WGM = 8;

__host__ __device__ __forceinline__ int lds_byte(int r, int c) { const int st = (r >> 4) * 2 + (c >> 5), rr = r & 15, cc = c & 31, ob = rr * 64 + cc * 2; return st * 1024 + (ob ^ (((ob >> 9) & 1) << 5)); }
__host__ __device__ __forceinline__ void stage_rc(int b, int& R, int& C) { const int st = b / 1024, sb = b % 1024, swz = sb ^ (((sb >> 9) & 1) << 5); R = (st >> 1) * 16 + swz / 64; C = (st & 1) * 32 + (swz % 64) / 2; }
__host__ __device__ __forceinline__ int perm32(int rho) { const int n = rho >> 4, i = rho & 15; return 8 * (i >> 2) + 4 * n + (i & 3); }

struct Unit { int pm, pn; };
struct Gemm { const bf16_t* A; const bf16_t* Bt; int M, N, K; };

struct StaticOrder {
    int nM, nN, nwg, G, c;
    __host__ __device__ void init(int M, int N, int G_, int c_) { nM = M / BM; nN = N / BM; nwg = nM * nN; G = G_; c = c_; }
    __host__ __device__ bool next(int i, Unit& u) const {
        const long L = (long)i * G + c; if (L >= nwg) return false;
        int wgid = (int)L; { const int q = nwg / NXCD, r = nwg % NXCD, xcd = wgid % NXCD, off = wgid / NXCD; wgid = (xcd < r ? xcd * (q + 1) : r * (q + 1) + (xcd - r) * q) + off; }
        const int nig = WGM * nN, gid = wgid / nig, fm = gid * WGM, gsz = (nM - fm) < WGM ? (nM - fm) : WGM;
        u.pm = fm + ((wgid % nig) % gsz); u.pn = (wgid % nig) / gsz; return true;
    }
    __device__ __forceinline__ void a_ready(const Unit&) const {}
    __device__ __forceinline__ void done(const Unit&) const {}
};

template <class Epi, class Sched, bool ALIGN_EPI = false, bool SP2 = false>
__device__ __forceinline__ void gemm_phase(PG8_LAS unsigned char* lds, const Gemm g, const Sched& S, const Epi& E) {
    int tid_l = threadIdx.x; asm volatile("" : "+v"(tid_l));
    const int tid = tid_l, wid = __builtin_amdgcn_readfirstlane(tid >> 6), lane = tid & 63, wr = wid >> 2, wc = wid & 3, fr = lane & 15, fq = lane >> 4;
    const int K = g.K, nt = K / BK;
    unsigned voffA[2], voffB[2];
#pragma unroll
    for (int i = 0; i < 2; ++i) { int R, C; stage_rc(tid * 16 + i * 8192, R, C); const int Rb = Epi::PERM ? ((R & ~31) + perm32(R & 31)) : R;
        voffA[i] = (unsigned)(R * K + C) * 2u; voffB[i] = (unsigned)(Rb * K + C) * 2u; }
    const size_t kstep = (size_t)(BK * 2);
    const size_t hstep = (size_t)HALF * K * 2;
    const size_t tstep = 2 * hstep;
    const unsigned ldsw = (unsigned)wid * 1024u;
    const int aoff = lds_byte(wr * 64 + fr, fq * 8), boff = lds_byte(wc * 32 + fr, fq * 8);
#define PG8_SA(b, h) (((b) * 2 + (h)) * HTB)
#define PG8_SB(b, h) ((4 + (b) * 2 + (h)) * HTB)
#define PG8_STAGE(bufoff, gbase, voff) do { _Pragma("unroll") for (int _i = 0; _i < 2; ++_i) \
        __builtin_amdgcn_global_load_lds((const unsigned*)((const char*)(gbase) + (voff)[_i]), (PG8_LAS unsigned*)(lds + (bufoff) + ldsw + _i * 8192), 16, 0, 0); } while (0)
#define PG8_LDA(dst, b, h) do { _Pragma("unroll") for (int m = 0; m < 4; ++m) _Pragma("unroll") for (int k = 0; k < 2; ++k) dst[m][k] = *(const PG8_LAS bf16x8*)(lds + PG8_SA(b, h) + aoff + m * 2048 + k * 1024); } while (0)
#define PG8_LDB(dst, b, h) do { _Pragma("unroll") for (int n = 0; n < 2; ++n) _Pragma("unroll") for (int k = 0; k < 2; ++k) dst[n][k] = *(const PG8_LAS bf16x8*)(lds + PG8_SB(b, h) + boff + n * 2048 + k * 1024); } while (0)
#define PG8_MMA(ai, bj, At, Bt) do { __builtin_amdgcn_s_setprio(1); _Pragma("unroll") for (int m = 0; m < 4; ++m) _Pragma("unroll") for (int n = 0; n < 2; ++n) _Pragma("unroll") for (int k = 0; k < 2; ++k) \
        acc[ai][bj][m][n] = __builtin_amdgcn_mfma_f32_16x16x32_bf16(Bt[n][k], At[m][k], acc[ai][bj][m][n], 0, 0, 0); __builtin_amdgcn_s_setprio(0); } while (0)
#define PG8_WAIT_V(n) asm volatile("s_waitcnt vmcnt(" #n ")" ::: "memory")
#define PG8_WAIT_L(n) asm volatile("s_waitcnt lgkmcnt(" #n ")" ::: "memory")
#define PG8_BAR __builtin_amdgcn_s_barrier()
#define PG8_SCHED __builtin_amdgcn_sched_barrier(0)
    Unit cur, nxt; int ui = 0;
    if (!S.next(0, cur)) return;
    f32x4 acc[2][2][4][2];
#pragma unroll
    for (int a = 0; a < 2; ++a)
#pragma unroll
        for (int b = 0; b < 2; ++b)
#pragma unroll
            for (int m = 0; m < 4; ++m)
#pragma unroll
                for (int n = 0; n < 2; ++n) acc[a][b][m][n] = (f32x4){0.f, 0.f, 0.f, 0.f};
    bf16x8 At[4][2], B0[2][2], B1[2][2];
    const char* cA = (const char*)g.A + (size_t)cur.pm * tstep; const char* cB = (const char*)g.Bt + (size_t)cur.pn * tstep;
    S.a_ready(cur);
    if constexpr (SP2) {
        PG8_STAGE(PG8_SB(0, 0), cB, voffB); PG8_STAGE(PG8_SB(0, 1), cB + hstep, voffB); PG8_STAGE(PG8_SA(0, 0), cA, voffA); PG8_STAGE(PG8_SA(0, 1), cA + hstep, voffA);
        if (wr == 1) PG8_BAR;
        PG8_WAIT_V(2); PG8_BAR;
        PG8_STAGE(PG8_SB(1, 0), cB + kstep, voffB); PG8_STAGE(PG8_SA(1, 0), cA + kstep, voffA); PG8_STAGE(PG8_SB(1, 1), cB + hstep + kstep, voffB);
        PG8_WAIT_V(6); PG8_BAR;
    } else {
        PG8_STAGE(PG8_SB(0, 0), cB, voffB); PG8_STAGE(PG8_SA(0, 0), cA, voffA); PG8_STAGE(PG8_SB(0, 1), cB + hstep, voffB); PG8_STAGE(PG8_SA(0, 1), cA + hstep, voffA);
        if (wr == 1) PG8_BAR;
        PG8_WAIT_V(4); PG8_BAR;
        PG8_STAGE(PG8_SB(1, 0), cB + kstep, voffB); PG8_STAGE(PG8_SA(1, 0), cA + kstep, voffA); PG8_STAGE(PG8_SB(1, 1), cB + hstep + kstep, voffB);
        PG8_WAIT_V(6); PG8_BAR;
    }
    for (;;) {
        const bool has_next = S.next(ui + 1, nxt);
        const char* nA = has_next ? (const char*)g.A + (size_t)nxt.pm * tstep : cA; const char* nB = has_next ? (const char*)g.Bt + (size_t)nxt.pn * tstep : cB;
        for (int t = 0; t < nt; t += 2) {
            const bool last = (t == nt - 2);
            const char* a1 = cA + (size_t)(t + 1) * kstep;
            const char* a2 = last ? nA : cA + (size_t)(t + 2) * kstep; const char* b2 = last ? nB : cB + (size_t)(t + 2) * kstep;
            const char* a3 = a2 + kstep; const char* b3 = b2 + kstep;
            if (last && has_next) S.a_ready(nxt);
            if constexpr (SP2) {
            PG8_LDB(B0, 0, 0); PG8_LDB(B1, 0, 1); PG8_SCHED; PG8_LDA(At, 0, 0); PG8_STAGE(PG8_SA(1, 1), a1 + hstep, voffA);
            PG8_WAIT_V(8); PG8_WAIT_L(0); PG8_BAR; PG8_MMA(0, 0, At, B0); PG8_MMA(0, 1, At, B1); PG8_BAR; PG8_SCHED;
            PG8_LDA(At, 0, 1); PG8_STAGE(PG8_SB(0, 0), b2, voffB); PG8_STAGE(PG8_SB(0, 1), b2 + hstep, voffB); PG8_STAGE(PG8_SA(0, 0), a2, voffA);
            PG8_WAIT_V(8); PG8_WAIT_L(0); PG8_BAR; PG8_MMA(1, 0, At, B0); PG8_MMA(1, 1, At, B1); PG8_BAR; PG8_SCHED;
            PG8_LDB(B0, 1, 0); PG8_LDB(B1, 1, 1); PG8_SCHED; PG8_LDA(At, 1, 0); PG8_STAGE(PG8_SA(0, 1), a2 + hstep, voffA);
            PG8_WAIT_V(8); PG8_WAIT_L(0); PG8_BAR; PG8_MMA(0, 0, At, B0); PG8_MMA(0, 1, At, B1); PG8_BAR; PG8_SCHED;
            PG8_LDA(At, 1, 1); PG8_STAGE(PG8_SB(1, 0), b3, voffB); PG8_STAGE(PG8_SB(1, 1), b3 + hstep, voffB); PG8_STAGE(PG8_SA(1, 0), a3, voffA);
            PG8_WAIT_V(8); PG8_WAIT_L(0); PG8_BAR; PG8_MMA(1, 0, At, B0); PG8_MMA(1, 1, At, B1); PG8_BAR; PG8_SCHED;
            } else {
            PG8_LDB(B0, 0, 0); PG8_SCHED; PG8_LDA(At, 0, 0); PG8_STAGE(PG8_SA(1, 1), a1 + hstep, voffA);
            PG8_WAIT_L(8); PG8_BAR; PG8_WAIT_L(0); PG8_MMA(0, 0, At, B0); PG8_BAR; PG8_SCHED;
            PG8_LDB(B1, 0, 1); PG8_STAGE(PG8_SB(0, 0), b2, voffB);
            PG8_BAR; PG8_WAIT_L(0); PG8_MMA(0, 1, At, B1); PG8_BAR;
            PG8_LDA(At, 0, 1); PG8_STAGE(PG8_SA(0, 0), a2, voffA);
            PG8_BAR; PG8_WAIT_L(0); PG8_MMA(1, 0, At, B0); PG8_BAR; PG8_SCHED;
            PG8_STAGE(PG8_SB(0, 1), b2 + hstep, voffB);
            PG8_WAIT_V(6); PG8_BAR; PG8_MMA(1, 1, At, B1); PG8_BAR;
            PG8_LDB(B0, 1, 0); PG8_SCHED; PG8_LDA(At, 1, 0); PG8_STAGE(PG8_SA(0, 1), a2 + hstep, voffA);
            PG8_WAIT_L(8); PG8_BAR; PG8_WAIT_L(0); PG8_MMA(0, 0, At, B0); PG8_BAR; PG8_SCHED;
            PG8_LDB(B1, 1, 1); PG8_STAGE(PG8_SB(1, 0), b3, voffB);
            PG8_BAR; PG8_WAIT_L(0); PG8_MMA(0, 1, At, B1); PG8_BAR;
            PG8_LDA(At, 1, 1); PG8_STAGE(PG8_SA(1, 0), a3, voffA);
            PG8_BAR; PG8_WAIT_L(0); PG8_MMA(1, 0, At, B0); PG8_BAR; PG8_SCHED;
            PG8_STAGE(PG8_SB(1, 1), b3 + hstep, voffB);
            PG8_WAIT_V(6); PG8_BAR; PG8_MMA(1, 1, At, B1); PG8_BAR;
            }
        }
        if constexpr (ALIGN_EPI) { if (wr == 0) PG8_BAR; }
        if constexpr (!Epi::AFTER_DRAIN) { E(acc, cur, wr, wc, fr, fq); S.done(cur); }
        if (!has_next) break;
#pragma unroll
        for (int a = 0; a < 2; ++a)
#pragma unroll
            for (int b = 0; b < 2; ++b)
#pragma unroll
                for (int m = 0; m < 4; ++m)
#pragma unroll
                    for (int n = 0; n < 2; ++n) acc[a][b][m][n] = (f32x4){0.f, 0.f, 0.f, 0.f};
        cur = nxt; cA = nA; cB = nB; ++ui;
        if constexpr (ALIGN_EPI) { if (wr == 1) PG8_BAR; }
    }
    PG8_WAIT_V(0);
    if constexpr (!ALIGN_EPI) { if (wr == 0) PG8_BAR; }
    PG8_BAR;
    if constexpr (Epi::AFTER_DRAIN) { E.fused(acc, cur, wr, wc, fr, fq, lds, wid, lane); S.done(cur); }
#undef PG8_SA
#undef PG8_SB
#undef PG8_STAGE
#undef PG8_LDA
#undef PG8_LDB
#undef PG8_MMA
#undef PG8_WAIT_V
#undef PG8_WAIT_L
#undef PG8_BAR
#undef PG8_SCHED
}
}

#define DI __device__ __forceinline__
#define LAS __attribute__((address_space(3)))
typedef unsigned short bf16_t;
typedef short bf16x8 __attribute__((ext_vector_type(8)));
typedef short s16x4 __attribute__((ext_vector_type(4)));
typedef float f32x4 __attribute__((ext_vector_type(4)));
typedef float f32x2 __attribute__((ext_vector_type(2)));
typedef float f32x16 __attribute__((ext_vector_type(16)));
typedef unsigned u32x4 __attribute__((ext_vector_type(4)));
typedef unsigned u32x2 __attribute__((ext_vector_type(2)));
typedef __bf16 bf16x2_t __attribute__((ext_vector_type(2)));
#define MFMA32(a, b, c) __builtin_amdgcn_mfma_f32_32x32x16_bf16((a), (b), (c), 0, 0, 0)

constexpr int T = 49152, DM = 1024, NPROJ = 3072, NIN = 2960, DFF = 4096, HFF = 2048;
constexpr int C_R = 0, C_K = 256, C_V = 512, C_WD = 768, C_AD = 896, C_GD = 1024;
constexpr int C_AQ = 1152, C_AK = 1664, C_AV = 1792;
constexpr int C_MQ = 1920, C_MK = 2176, C_MV = 2432, C_MO = 2688, C_IG = 2944, C_FG = 2952;
constexpr size_t MiB = 1u << 20;
constexpr size_t WS_SS = 0, WS_CNT = MiB - 4096, WS_CDOT = 1 * MiB, WS_TAB = 2 * MiB + 512 * 1024, WS_WIN = 3 * MiB, WS_WOUT = 15 * MiB,
                 WS_W1 = 19 * MiB, WS_W2 = 35 * MiB, WS_VT = 51 * MiB, WS_YB = 63 * MiB, WS_HBP = 87 * MiB, WS_X1 = 111 * MiB, WS_R = 207 * MiB,
                 WS_HID = WS_R + 96 * MiB, WS_END = 495 * MiB;
constexpr int LDS_BYTES = 131072 + 256;
constexpr int NTHR = 512;

struct KP { const float* in[26]; float* out; unsigned char* ws; };

DI unsigned cvtpk(float lo, float hi) { f32x2 v = {lo, hi}; bf16x2_t b = __builtin_convertvector(v, bf16x2_t); return __builtin_bit_cast(unsigned, b); }
DI unsigned short f2bf(float f) { return (unsigned short)(cvtpk(f, 0.f) & 0xffffu); }
DI float bf2f(unsigned h) { return __builtin_bit_cast(float, h << 16); }
DI float bflo(unsigned w) { return __builtin_bit_cast(float, w << 16); }
DI float bfhi(unsigned w) { return __builtin_bit_cast(float, w & 0xffff0000u); }
DI int crow(int reg, int h) { return (reg & 3) + 8 * (reg >> 2) + 4 * h; }
template <int CTRL> DI float dppf(float v) { return __builtin_bit_cast(float, __builtin_amdgcn_update_dpp(0, __builtin_bit_cast(int, v), CTRL, 0xf, 0xf, true)); }
DI float red8(float v) { v += dppf<0xB1>(v); v += dppf<0x4E>(v); v += dppf<0x141>(v); return v; }
DI float red16(float v) { v = red8(v); v += dppf<0x128>(v); return v; }
DI float frcp(float x) { return __builtin_amdgcn_rcpf(x); }
DI float sigmoidf_(float x) { return frcp(1.f + __expf(-x)); }
DI f32x16 zero16() { f32x16 z; for (int i = 0; i < 16; ++i) z[i] = 0.f; return z; }
DI void seq_of_job(int j, int& seq, int& h, int& dir) { if (j < 16) { seq = 8 + (j >> 3); } else { j -= 16; seq = j >> 3; } h = (j >> 1) & 3; dir = j & 1; }
DI void seq_info(int s, int& start, int& len) { if (s < 8) { start = s * 4096; len = 4096; } else { start = 32768 + (s - 8) * 8192; len = 8192; } }
DI int tok_seq_start(int tok, int& len) { if (tok < 32768) { len = 4096; return tok & ~4095; } len = 8192; return 32768 + ((tok - 32768) & ~8191); }

struct EpiProj {
    static constexpr bool PERM = true, AFTER_DRAIN = false;
    bf16_t* O; const float* ss;
    DI void operator()(const pg8::f32x4 (&acc)[2][2][4][2], const pg8::Unit& u, int wr, int wc, int fr, int fq) const {
        const int row0 = u.pm * 256 + wr * 64 + fr, col0 = u.pn * 256 + wc * 32 + 8 * fq;
#pragma unroll
        for (int ai = 0; ai < 2; ++ai)
#pragma unroll
            for (int m = 0; m < 4; ++m) {
                const int row = row0 + ai * 128 + m * 16;
                const float rs = rsqrtf(ss[row] * (1.f / 1024.f) + 1e-6f);
                bf16_t* rp = O + (size_t)row * NPROJ + col0;
#pragma unroll
                for (int bj = 0; bj < 2; ++bj) {
                    pg8::f32x4 v0 = acc[ai][bj][m][0] * rs, v1 = acc[ai][bj][m][1] * rs;
                    u32x4 w; w.x = cvtpk(v0[0], v0[1]); w.y = cvtpk(v0[2], v0[3]); w.z = cvtpk(v1[0], v1[1]); w.w = cvtpk(v1[2], v1[3]);
                    *(u32x4*)(rp + bj * 128) = w;
                }
            }
    }
};
struct EpiRelu2 {
    static constexpr bool PERM = true, AFTER_DRAIN = false;
    bf16_t* O; const float* ss;
    DI void operator()(const pg8::f32x4 (&acc)[2][2][4][2], const pg8::Unit& u, int wr, int wc, int fr, int fq) const {
        const int row0 = u.pm * 256 + wr * 64 + fr, col0 = u.pn * 256 + wc * 32 + 8 * fq;
#pragma unroll
        for (int ai = 0; ai < 2; ++ai)
#pragma unroll
            for (int m = 0; m < 4; ++m) {
                const int row = row0 + ai * 128 + m * 16;
                const float rs = rsqrtf(ss[row] * (1.f / 1024.f) + 1e-6f);
                bf16_t* rp = O + (size_t)row * HFF + col0;
#pragma unroll
                for (int bj = 0; bj < 2; ++bj) {
                    pg8::f32x4 v0 = acc[ai][bj][m][0] * rs, v1 = acc[ai][bj][m][1] * rs;
#pragma unroll
                    for (int j = 0; j < 4; ++j) { float a = fmaxf(v0[j], 0.f); v0[j] = a * a; float b = fmaxf(v1[j], 0.f); v1[j] = b * b; }
                    u32x4 w; w.x = cvtpk(v0[0], v0[1]); w.y = cvtpk(v0[2], v0[3]); w.z = cvtpk(v1[0], v1[1]); w.w = cvtpk(v1[2], v1[3]);
                    *(u32x4*)(rp + bj * 128) = w;
                }
            }
    }
};
template <bool WRITE_HB, bool DO_SS> struct EpiRes {
    static constexpr bool PERM = true, AFTER_DRAIN = false;
    float* X; bf16_t* HB; float* ss;
    DI void operator()(const pg8::f32x4 (&acc)[2][2][4][2], const pg8::Unit& u, int wr, int wc, int fr, int fq) const {
        const int row0 = u.pm * 256 + wr * 64 + fr, col0 = u.pn * 256 + wc * 32 + 8 * fq;
#pragma unroll
        for (int ai = 0; ai < 2; ++ai)
#pragma unroll
            for (int m = 0; m < 4; ++m) {
                const int row = row0 + ai * 128 + m * 16;
                float* xp = X + (size_t)row * DM + col0;
                float sq = 0.f;
#pragma unroll
                for (int bj = 0; bj < 2; ++bj) {
                    pg8::f32x4 a0 = *(const pg8::f32x4*)(xp + bj * 128), a1 = *(const pg8::f32x4*)(xp + bj * 128 + 4);
                    a0 += acc[ai][bj][m][0]; a1 += acc[ai][bj][m][1];
                    *(pg8::f32x4*)(xp + bj * 128) = a0; *(pg8::f32x4*)(xp + bj * 128 + 4) = a1;
                    if (WRITE_HB) { u32x4 w; w.x = cvtpk(a0[0], a0[1]); w.y = cvtpk(a0[2], a0[3]); w.z = cvtpk(a1[0], a1[1]); w.w = cvtpk(a1[2], a1[3]);
                        *(u32x4*)(HB + (size_t)row * DM + col0 + bj * 128) = w; }
                    if (DO_SS) sq += a0[0] * a0[0] + a0[1] * a0[1] + a0[2] * a0[2] + a0[3] * a0[3] + a1[0] * a1[0] + a1[1] * a1[1] + a1[2] * a1[2] + a1[3] * a1[3];
                }
                if (DO_SS) { sq += __shfl_xor(sq, 16); sq += __shfl_xor(sq, 32); if (fq == 0) atomicAdd(ss + row, sq); }
            }
    }
};

DI void transpose_tile(const float* src, int N, int nvalid, const float* gain, bf16_t* dst, int K, int kt, int nt, LAS float* tile, int tid) {
    const int a = tid & 63, b8 = tid >> 6;
#pragma unroll
    for (int i = 0; i < 8; ++i) { const int k = b8 + 8 * i, n = nt * 64 + a; float v = (n < nvalid) ? src[(size_t)(kt * 64 + k) * N + n] : 0.f; if (gain) v *= gain[kt * 64 + k]; tile[k * 65 + a] = v; }
    __syncthreads();
#pragma unroll
    for (int i = 0; i < 8; ++i) { const int n = b8 + 8 * i; dst[(size_t)(nt * 64 + n) * K + kt * 64 + a] = f2bf(tile[a * 65 + n]); }
    __syncthreads();
}
DI void p0_phase(const KP& p, LAS unsigned char* lds, int tid, int G, int bid) {
    LAS float* tile = (LAS float*)lds;
    for (int it = bid; it < 6144; it += G) {
        const int l = it / 3072; int r = it % 3072;
        const float* src; const float* gain; bf16_t* dst; int N, nvalid, K, kt, nt;
        if (r < 768) { src = p.in[3] + (size_t)l * 1024 * NIN; N = NIN; nvalid = NIN; K = 1024; gain = p.in[2] + l * 1024; dst = (bf16_t*)(p.ws + WS_WIN) + (size_t)l * NPROJ * 1024; kt = r / 48; nt = r % 48; }
        else if (r < 1024) { r -= 768; src = p.in[21] + (size_t)l * 1024 * 1024; N = 1024; nvalid = 1024; K = 1024; gain = nullptr; dst = (bf16_t*)(p.ws + WS_WOUT) + (size_t)l * 1024 * 1024; kt = r / 16; nt = r % 16; }
        else if (r < 2048) { r -= 1024; src = p.in[23] + (size_t)l * 1024 * 4096; N = 4096; nvalid = 4096; K = 1024; gain = p.in[22] + l * 1024; dst = (bf16_t*)(p.ws + WS_W1) + (size_t)l * 4096 * 1024; kt = r / 64; nt = r % 64; }
        else { r -= 2048; const int h = r / 512; r %= 512; src = p.in[24] + (size_t)l * 4096 * 1024 + (size_t)h * 2048 * 1024; N = 1024; nvalid = 1024; K = 2048; gain = nullptr;
               dst = (bf16_t*)(p.ws + WS_W2) + (size_t)l * 2 * 1024 * 2048 + (size_t)h * 1024 * 2048; kt = r / 16; nt = r % 16; }
        transpose_tile(src, N, nvalid, gain, dst, K, kt, nt, tile, tid);
    }
    const int wave = tid >> 6, lane = tid & 63;
    float* ss = (float*)(p.ws + WS_SS);
    bf16_t* xb = (bf16_t*)(p.ws + WS_X1);
    for (int row = bid * 8 + wave; row < T; row += G * 8) {
        const float* xs = (row < 32768) ? p.in[0] + (size_t)row * DM : p.in[1] + (size_t)(row - 32768) * DM;
        float sq = 0.f;
#pragma unroll
        for (int j = 0; j < 4; ++j) {
            const int c = (j * 64 + lane) * 4;
            const f32x4 v = *(const f32x4*)(xs + c);
            *(f32x4*)(p.out + (size_t)row * DM + c) = v;
            u32x2 w; w.x = cvtpk(v[0], v[1]); w.y = cvtpk(v[2], v[3]);
            *(u32x2*)(xb + (size_t)row * DM + c) = w;
            sq += v[0] * v[0] + v[1] * v[1] + v[2] * v[2] + v[3] * v[3];
        }
#pragma unroll
        for (int o = 32; o >= 1; o >>= 1) sq += __shfl_xor(sq, o);
        if (lane == 0) ss[row] = sq;
    }
    for (int i = bid * NTHR + tid; i < 4 * T; i += G * NTHR) ss[T + i] = 0.f;
    if (bid == 0) {
        if (tid < 64) ((unsigned*)(p.ws + WS_CNT))[tid] = 0u;
        float2* tab = (float2*)(p.ws + WS_TAB);
        for (int idx = tid; idx < 2048; idx += NTHR) { const int pos = idx >> 4, f = idx & 15; const float inv = powf(10000.f, -(float)f / 16.f); const float ang = (float)pos * inv; tab[idx] = make_float2(cosf(ang), sinf(ang)); }
    }
}

DI void prep_phase(const KP& p, int l, LAS unsigned char* lds, int tid, int G, int bid) {
    bf16_t* proj = (bf16_t*)(p.ws + WS_R);
    bf16_t* vT = (bf16_t*)(p.ws + WS_VT);
    const float2* tab = (const float2*)(p.ws + WS_TAB);
    const float* qn = p.in[15] + l * 64; const float* kn = p.in[16] + l * 64;
    const int wave = tid >> 6, lane = tid & 63, g = lane >> 4, li = lane & 15;
    LAS bf16_t* vts = (LAS bf16_t*)lds;
    for (int unit = bid; unit < T / 64; unit += G) {
        const int tok0 = unit * 64;
        for (int i = 0; i < 8; ++i) {
            const int tok = tok0 + wave * 8 + i; int len; const int st = tok_seq_start(tok, len); const int pos = tok - st; const int prow = pos >> 6, pcol = pos & 63;
#pragma unroll
            for (int it = 0; it < 3; ++it) {
                const bool act = (it < 2) || (g < 2);
                const int colbase = (it < 2) ? C_AQ + (it * 4 + g) * 64 : C_AK + (g & 1) * 64;
                const float* wn = (it < 2) ? qn : kn;
                bf16_t* ptr = proj + (size_t)tok * NPROJ + colbase + li * 4;
                const u32x2 raw = *(const u32x2*)ptr;
                float x[4] = {bflo(raw.x), bfhi(raw.x), bflo(raw.y), bfhi(raw.y)};
                float sq = x[0] * x[0] + x[1] * x[1] + x[2] * x[2] + x[3] * x[3];
                sq = red16(sq);
                const float rinv = rsqrtf(sq * (1.f / 64.f) + 1e-6f);
                const f32x4 w4 = *(const f32x4*)(wn + li * 4);
                const int idx = (li >> 3) ? pcol : prow; const bool second = (li >> 2) & 1;
                const float scale = (it < 2) ? 0.125f * 1.4426950408889634f : 1.f;
                float o[4];
#pragma unroll
                for (int j = 0; j < 4; ++j) {
                    const float y = x[j] * rinv * w4[j];
                    const float pr = __shfl_xor(y, 4);
                    const int f = (li * 4 + j) & 15;
                    const float2 cs = tab[idx * 16 + f];
                    o[j] = (second ? (y * cs.x + pr * cs.y) : (y * cs.x - pr * cs.y)) * scale;
                }
                if (act) { u32x2 w; w.x = cvtpk(o[0], o[1]); w.y = cvtpk(o[2], o[3]); *(u32x2*)ptr = w; }
            }
        }
#pragma unroll
        for (int i = 0; i < 2; ++i) { const int idx = tid + NTHR * i; const int tl = idx >> 4, c8 = (idx & 15) * 8;
            const u32x4 v = *(const u32x4*)(proj + (size_t)(tok0 + tl) * NPROJ + C_AV + c8); *(LAS u32x4*)(vts + tl * 136 + c8) = v; }
        __syncthreads();
        { const int c = tid >> 2, tq = tid & 3; unsigned w[8];
#pragma unroll
          for (int j = 0; j < 8; ++j) { const unsigned lo = vts[(tq * 16 + 2 * j) * 136 + c], hi = vts[(tq * 16 + 2 * j + 1) * 136 + c]; w[j] = lo | (hi << 16); }
          u32x4 a = {w[0], w[1], w[2], w[3]}, b = {w[4], w[5], w[6], w[7]};
          bf16_t* dp = vT + (size_t)c * T + tok0 + tq * 16; *(u32x4*)dp = a; *(u32x4*)(dp + 8) = b; }
        __syncthreads();
    }
}

DI void attn_unit(const KP& p, int unit, LAS unsigned char* lds, int tid) {
    const bf16_t* proj = (const bf16_t*)(p.ws + WS_R);
    const bf16_t* vT = (const bf16_t*)(p.ws + WS_VT);
    bf16_t* mix = (bf16_t*)(p.ws + WS_X1);
    int seq, kvh, qt;
    if (unit < 512) { seq = 8 + (unit >> 8); const int r = unit & 255; kvh = r >> 7; qt = r & 127; }
    else { const int u2 = unit - 512; seq = u2 >> 7; const int r = u2 & 127; kvh = r >> 6; qt = r & 63; }
    int start, len; seq_info(seq, start, len);
    const int nk = len >> 6;
    const int wave = tid >> 6, lane = tid & 63, r32 = lane & 31, hh = lane >> 5;
    const int head = kvh * 4 + (wave >> 1);
    const int q0 = start + qt * 64 + (wave & 1) * 32;
    bf16x8 qf[4];
    { const bf16_t* qp = proj + (size_t)(q0 + r32) * NPROJ + C_AQ + head * 64 + hh * 8;
#pragma unroll
      for (int ks = 0; ks < 4; ++ks) qf[ks] = *(const bf16x8*)(qp + ks * 16); }
    f32x16 o0 = zero16(), o1 = zero16();
    float m = -1e30f, lsum = 0.f;
    const int lrow = tid >> 3, lseg = tid & 7;
    const bf16_t* kptr = proj + (size_t)(start + lrow) * NPROJ + C_AK + kvh * 64 + lseg * 8;
    const bf16_t* vptr = vT + (size_t)(kvh * 64 + lrow) * T + start + lseg * 8;
    const int lds_off = lrow * 144 + lseg * 16;
    u32x4 kreg = *(const u32x4*)kptr, vreg = *(const u32x4*)vptr;
    *(LAS u32x4*)(lds + lds_off) = kreg; *(LAS u32x4*)(lds + 9216 + lds_off) = vreg;
    __syncthreads();
    for (int j = 0; j < nk; ++j) {
        const bool more = (j + 1 < nk);
        if (more) { kreg = *(const u32x4*)(kptr + (size_t)(j + 1) * 64 * NPROJ); vreg = *(const u32x4*)(vptr + (j + 1) * 64); }
        LAS unsigned char* Ks = lds + (j & 1) * 18432; LAS unsigned char* Vs = Ks + 9216;
        f32x16 s0 = zero16(), s1 = zero16();
#pragma unroll
        for (int ks = 0; ks < 4; ++ks) {
            const bf16x8 a0 = *(const LAS bf16x8*)(Ks + r32 * 144 + (ks * 16 + hh * 8) * 2);
            const bf16x8 a1 = *(const LAS bf16x8*)(Ks + (32 + r32) * 144 + (ks * 16 + hh * 8) * 2);
            s0 = MFMA32(a0, qf[ks], s0); s1 = MFMA32(a1, qf[ks], s1);
        }
        float mx = s0[0];
#pragma unroll
        for (int i = 1; i < 16; ++i) mx = fmaxf(mx, s0[i]);
#pragma unroll
        for (int i = 0; i < 16; ++i) mx = fmaxf(mx, s1[i]);
        mx = fmaxf(mx, __shfl_xor(mx, 32));
        const float mnew = fmaxf(m, mx);
        const float alpha = __builtin_amdgcn_exp2f(m - mnew);
        m = mnew;
        float rs = 0.f;
#pragma unroll
        for (int i = 0; i < 16; ++i) { s0[i] = __builtin_amdgcn_exp2f(s0[i] - mnew); rs += s0[i]; }
#pragma unroll
        for (int i = 0; i < 16; ++i) { s1[i] = __builtin_amdgcn_exp2f(s1[i] - mnew); rs += s1[i]; }
        lsum = lsum * alpha + rs;
#pragma unroll
        for (int i = 0; i < 16; ++i) { o0[i] *= alpha; o1[i] *= alpha; }
#pragma unroll
        for (int mb = 0; mb < 2; ++mb)
#pragma unroll
            for (int s = 0; s < 2; ++s) {
                u32x4 pk;
                if (mb == 0) { pk.x = cvtpk(s0[8 * s], s0[8 * s + 1]); pk.y = cvtpk(s0[8 * s + 2], s0[8 * s + 3]); pk.z = cvtpk(s0[8 * s + 4], s0[8 * s + 5]); pk.w = cvtpk(s0[8 * s + 6], s0[8 * s + 7]); }
                else         { pk.x = cvtpk(s1[8 * s], s1[8 * s + 1]); pk.y = cvtpk(s1[8 * s + 2], s1[8 * s + 3]); pk.z = cvtpk(s1[8 * s + 4], s1[8 * s + 5]); pk.w = cvtpk(s1[8 * s + 6], s1[8 * s + 7]); }
                const bf16x8 pb = __builtin_bit_cast(bf16x8, pk);
                const int keyoff = 32 * mb + 16 * s + 4 * hh;
                { const s16x4 lo = *(const LAS s16x4*)(Vs + r32 * 144 + keyoff * 2), hi = *(const LAS s16x4*)(Vs + r32 * 144 + (keyoff + 8) * 2);
                  const bf16x8 va = __builtin_shufflevector(lo, hi, 0, 1, 2, 3, 4, 5, 6, 7); o0 = MFMA32(va, pb, o0); }
                { const s16x4 lo = *(const LAS s16x4*)(Vs + (32 + r32) * 144 + keyoff * 2), hi = *(const LAS s16x4*)(Vs + (32 + r32) * 144 + (keyoff + 8) * 2);
                  const bf16x8 va = __builtin_shufflevector(lo, hi, 0, 1, 2, 3, 4, 5, 6, 7); o1 = MFMA32(va, pb, o1); }
            }
        if (more) { LAS unsigned char* Kn = lds + ((j + 1) & 1) * 18432; *(LAS u32x4*)(Kn + lds_off) = kreg; *(LAS u32x4*)(Kn + 9216 + lds_off) = vreg; }
        __syncthreads();
    }
    lsum += __shfl_xor(lsum, 32);
    const float inv = 1.f / lsum;
    bf16_t* op = mix + (size_t)(q0 + r32) * DM + 256 + head * 64;
#pragma unroll
    for (int g4 = 0; g4 < 4; ++g4) {
        u32x2 w0; w0.x = cvtpk(o0[4 * g4] * inv, o0[4 * g4 + 1] * inv); w0.y = cvtpk(o0[4 * g4 + 2] * inv, o0[4 * g4 + 3] * inv);
        *(u32x2*)(op + 8 * g4 + 4 * hh) = w0;
        u32x2 w1; w1.x = cvtpk(o1[4 * g4] * inv, o1[4 * g4 + 1] * inv); w1.y = cvtpk(o1[4 * g4 + 2] * inv, o1[4 * g4 + 3] * inv);
        *(u32x2*)(op + 32 + 8 * g4 + 4 * hh) = w1;
    }
}

constexpr int RW_XR = 0, RW_XKD = 8192, RW_XV = 16384, RW_WLW = 24576, RW_ALB = 32768, RW_KKN = 40960, RW_YO = 49152, RW_XWD = 57344, RW_XAD = 61952,
              RW_W2T = 66560, RW_A2T = 75776, RW_CD = 84992;
#define RW_DECODE(i_) const int t = tid >> 4, c4 = (tid & 15) * 4; constexpr int gi = (i_); \
            const int col = (gi == 0) ? C_R + h * 64 + c4 : (gi == 1) ? C_K + h * 64 + c4 : (gi == 2) ? C_V + h * 64 + c4 : (gi == 3) ? C_WD + dir * 64 + c4 : C_AD + dir * 64 + c4;
#define RW_ISSUE1(chx, i_) { RW_DECODE(i_) \
            const int n = (chx) * 32 + t; const int pos = dir ? (len - 1 - n) : n; \
            const bf16_t* bp = proj + (size_t)(start + pos) * NPROJ + col; \
            rc[i_] = *(const u32x2*)bp; rp_[i_] = (u32x2){0u, 0u}; rn[i_] = (u32x2){0u, 0u}; \
            if (pos > 0) rp_[i_] = *(const u32x2*)(bp - NPROJ); \
            if (pos < len - 1) rn[i_] = *(const u32x2*)(bp + NPROJ); }
#define RW_ISSUE(chx) do { RW_ISSUE1(chx, 0) RW_ISSUE1(chx, 1) RW_ISSUE1(chx, 2) RW_ISSUE1(chx, 3) RW_ISSUE1(chx, 4) } while (0)
#define RW_CONV1(i_) { RW_DECODE(i_) \
            const f32x4 m4 = *(const f32x4*)(mu + col); \
            f32x4 x = {bflo(rc[i_].x), bfhi(rc[i_].x), bflo(rc[i_].y), bfhi(rc[i_].y)}; \
            const f32x4 pn = {bflo(rp_[i_].x) + bflo(rn[i_].x), bfhi(rp_[i_].x) + bfhi(rn[i_].x), bflo(rp_[i_].y) + bflo(rn[i_].y), bfhi(rp_[i_].y) + bfhi(rn[i_].y)}; \
            x = x + (0.5f * pn - x) * m4; \
            if (gi < 3) { LAS float* dst = (gi == 0) ? XR : (gi == 1) ? XKD : XV; *(LAS f32x4*)(dst + t * 64 + c4) = x; } \
            else if (gi == 3) { \
                _Pragma("unroll") for (int j = 0; j < 4; ++j) { const float e = __expf(2.f * x[j]); x[j] = 1.f - 2.f * frcp(e + 1.f); } \
                u32x2 w; w.x = cvtpk(x[0], x[1]); w.y = cvtpk(x[2], x[3]); *(LAS u32x2*)(XWD + t * 72 + c4) = w; } \
            else { u32x2 w; w.x = cvtpk(x[0], x[1]); w.y = cvtpk(x[2], x[3]); *(LAS u32x2*)(XAD + t * 72 + c4) = w; } }
#define RW_BAR() asm volatile("s_waitcnt lgkmcnt(0)\n\ts_barrier" ::: "memory")
DI void rwkv_job(const KP& p, int l, int job, LAS unsigned char* lds, int tid) {
    int seq, h, dir, rpart;
    int nrows;
    if (job < 64) { seq = 8 + (job >> 5); h = (job >> 3) & 3; dir = (job >> 2) & 1; rpart = job & 3; nrows = 16; }
    else { const int j = job - 64; seq = j >> 4; h = (j >> 2) & 3; dir = (j >> 1) & 1; rpart = j & 1; nrows = 32; }
    int start, len; seq_info(seq, start, len);
    const bf16_t* proj = (const bf16_t*)(p.ws + WS_R);
    bf16_t* mix = (bf16_t*)(p.ws + WS_X1);
    bf16_t* yb = (bf16_t*)(p.ws + WS_YB);
    float* cdot = (float*)(p.ws + WS_CDOT);
    const float* mu = p.in[4] + l * 1152;
    const int wave = tid >> 6, lane = tid & 63, r32 = lane & 31, hh = lane >> 5;
    LAS float* XR = (LAS float*)(lds + RW_XR); LAS float* XKD = (LAS float*)(lds + RW_XKD); LAS float* XV = (LAS float*)(lds + RW_XV);
    LAS float* WLW = (LAS float*)(lds + RW_WLW); LAS float* ALB = (LAS float*)(lds + RW_ALB); LAS float* KKN = (LAS float*)(lds + RW_KKN);
    LAS float* YO = (LAS float*)(lds + RW_YO); LAS float* CD = (LAS float*)(lds + RW_CD);
    LAS bf16_t* XWD = (LAS bf16_t*)(lds + RW_XWD); LAS bf16_t* XAD = (LAS bf16_t*)(lds + RW_XAD);
    LAS bf16_t* W2T = (LAS bf16_t*)(lds + RW_W2T); LAS bf16_t* A2T = (LAS bf16_t*)(lds + RW_A2T);
    { const float* w2 = p.in[6] + (size_t)((l * 2 + dir) * 64) * 256 + h * 64; const float* a2 = p.in[8] + (size_t)((l * 2 + dir) * 64) * 256 + h * 64;
#pragma unroll
      for (int i = 0; i < 8; ++i) { const int idx = tid + NTHR * i; const int mm = idx >> 6, c = idx & 63; W2T[c * 72 + mm] = f2bf(w2[mm * 256 + c]); A2T[c * 72 + mm] = f2bf(a2[mm * 256 + c]); } }
    const int ct = tid >> 4, cli = tid & 15, cc4 = cli * 4;
    const f32x4 w0v = *(const f32x4*)(p.in[5] + (l * 2 + dir) * 256 + h * 64 + cc4);
    const f32x4 a0v = *(const f32x4*)(p.in[7] + (l * 2 + dir) * 256 + h * 64 + cc4);
    const f32x4 kkw = *(const f32x4*)(p.in[10] + l * 256 + h * 64 + cc4);
    const f32x4 kaw = *(const f32x4*)(p.in[11] + l * 256 + h * 64 + cc4);
    const f32x4 rkw = *(const f32x4*)(p.in[12] + l * 256 + h * 64 + cc4);
    const int sil = tid >> 4, si = rpart * nrows + sil, sj = (tid & 15) * 4;
    const bool scan_on = sil < nrows;
    f32x4 S = {0.f, 0.f, 0.f, 0.f}, S2 = {1.f, 0.f, 0.f, 0.f};
    u32x2 rc[5], rp_[5], rn[5];
    const int nch = len >> 5;
    RW_ISSUE(0);
    __syncthreads();
    for (int ch = 0; ch < nch; ++ch) {
        const int n0 = ch * 32;
#ifndef REP_ABC
#define REP_ABC 1
#endif
        for (int rep = 0; rep < REP_ABC; ++rep) {
        RW_CONV1(0) RW_CONV1(1) RW_CONV1(2) RW_CONV1(3) RW_CONV1(4)
        RW_BAR();
        if (wave < 4) {
            const int mat = wave >> 1, nb = wave & 1;
            LAS bf16_t* Xs = mat ? XAD : XWD; LAS bf16_t* Ws = mat ? A2T : W2T;
            f32x16 acc = zero16();
#pragma unroll
            for (int ks = 0; ks < 4; ++ks) {
                const bf16x8 a = *(const LAS bf16x8*)(Xs + r32 * 72 + ks * 16 + hh * 8);
                const bf16x8 b = *(const LAS bf16x8*)(Ws + (nb * 32 + r32) * 72 + ks * 16 + hh * 8);
                acc = MFMA32(a, b, acc);
            }
            LAS float* dst = mat ? ALB : WLW;
#pragma unroll
            for (int i = 0; i < 16; ++i) dst[crow(i, hh) * 64 + nb * 32 + r32] = acc[i];
        }
        RW_BAR();
        {
            const f32x4 wl = *(const LAS f32x4*)(WLW + ct * 64 + cc4), al = *(const LAS f32x4*)(ALB + ct * 64 + cc4);
            const f32x4 k4 = *(const LAS f32x4*)(XKD + ct * 64 + cc4), r4 = *(const LAS f32x4*)(XR + ct * 64 + cc4);
            f32x4 w, a, kkr, kd;
            float ssq = 0.f, cd = 0.f;
#pragma unroll
            for (int j = 0; j < 4; ++j) {
                const float sg = sigmoidf_(w0v[j] + wl[j]);
                w[j] = __expf(-0.6065306597126334f * sg);
                a[j] = sigmoidf_(a0v[j] + al[j]);
                kkr[j] = k4[j] * kkw[j]; ssq += kkr[j] * kkr[j];
                kd[j] = k4[j] * (1.f + (a[j] - 1.f) * kaw[j]);
                cd += r4[j] * kd[j] * rkw[j];
            }
            ssq = red16(ssq); cd = red16(cd);
            const float inv = __builtin_amdgcn_rsqf(fmaxf(ssq, 1e-24f));
            f32x4 kkn, b;
#pragma unroll
            for (int j = 0; j < 4; ++j) { kkn[j] = kkr[j] * inv; b[j] = kkn[j] * a[j]; }
            *(LAS f32x4*)(WLW + ct * 64 + cc4) = w; *(LAS f32x4*)(ALB + ct * 64 + cc4) = b; *(LAS f32x4*)(KKN + ct * 64 + cc4) = kkn; *(LAS f32x4*)(XKD + ct * 64 + cc4) = kd;
            if (cli == 0) CD[ct] = cd;
        }
        RW_BAR();
        }
        if (ch + 1 < nch) RW_ISSUE(ch + 1);
        if (scan_on) {
            f32x4 w4 = *(const LAS f32x4*)(WLW + sj), k4 = *(const LAS f32x4*)(KKN + sj), b4 = *(const LAS f32x4*)(ALB + sj), d4 = *(const LAS f32x4*)(XKD + sj), r4 = *(const LAS f32x4*)(XR + sj);
            float v = XV[si];
#pragma unroll 2
            for (int t = 0; t < 32; ++t) {
                const int tn = (t < 31) ? t + 1 : 31;
                const f32x4 w4n = *(const LAS f32x4*)(WLW + tn * 64 + sj), k4n = *(const LAS f32x4*)(KKN + tn * 64 + sj), b4n = *(const LAS f32x4*)(ALB + tn * 64 + sj),
                            d4n = *(const LAS f32x4*)(XKD + tn * 64 + sj), r4n = *(const LAS f32x4*)(XR + tn * 64 + sj);
                const float vn = XV[tn * 64 + si];
                float sa = S[0] * k4[0] + S[1] * k4[1] + S[2] * k4[2] + S[3] * k4[3];
                sa = -red16(sa);
                S = S * w4 + sa * b4 + v * d4;
                float y = S[0] * r4[0] + S[1] * r4[1] + S[2] * r4[2] + S[3] * r4[3];
                y = red16(y);
                if ((tid & 15) == 0) YO[t * 32 + sil] = y;
                w4 = w4n; k4 = k4n; b4 = b4n; d4 = d4n; r4 = r4n; v = vn;
            }
        }
#ifdef PROBE_SCAN2
        if (scan_on) {
            f32x4 w4 = *(const LAS f32x4*)(WLW + sj), k4 = *(const LAS f32x4*)(KKN + sj), b4 = *(const LAS f32x4*)(ALB + sj), d4 = *(const LAS f32x4*)(XKD + sj), r4 = *(const LAS f32x4*)(XR + sj);
            float v = XV[si];
#pragma unroll 2
            for (int t = 0; t < 32; ++t) {
                const int tn = (t < 31) ? t + 1 : 31;
                const f32x4 w4n = *(const LAS f32x4*)(WLW + tn * 64 + sj), k4n = *(const LAS f32x4*)(KKN + tn * 64 + sj), b4n = *(const LAS f32x4*)(ALB + tn * 64 + sj),
                            d4n = *(const LAS f32x4*)(XKD + tn * 64 + sj), r4n = *(const LAS f32x4*)(XR + tn * 64 + sj);
                const float vn = XV[tn * 64 + si];
                float sa = S2[0] * k4[0] + S2[1] * k4[1] + S2[2] * k4[2] + S2[3] * k4[3];
                sa = -red16(sa);
                S2 = S2 * w4 + sa * b4 + v * d4;
                float y = S2[0] * r4[0] + S2[1] * r4[1] + S2[2] * r4[2] + S2[3] * r4[3];
                y = red16(y);
                if ((tid & 15) == 0) YO[1024 + t * 32 + sil] = y;
                w4 = w4n; k4 = k4n; b4 = b4n; d4 = d4n; r4 = r4n; v = vn;
            }
        }
#endif
        RW_BAR();
        {
            const int c2 = cli * 2;
            const int n = n0 + ct; const int pos = dir ? (len - 1 - n) : n; const int tok = start + pos;
            const f32x2 yv = *(const LAS f32x2*)(YO + ct * 32 + c2);
            const unsigned w = cvtpk(yv[0], yv[1]);
            if (c2 < nrows) { if (dir) *(unsigned*)(yb + (size_t)tok * 256 + h * 64 + rpart * nrows + c2) = w; else *(unsigned*)(mix + (size_t)tok * DM + h * 64 + rpart * nrows + c2) = w; }
            if (rpart == 0 && tid < 32) { const int n2 = n0 + tid; const int pos2 = dir ? (len - 1 - n2) : n2; cdot[((size_t)(start + pos2) * 4 + h) * 2 + dir] = CD[tid]; }
        }
    }
    __syncthreads();
}

constexpr int ML_QS = 0, ML_KS = 9216, ML_KT = 18432, ML_VT = 27648, ML_VWT = 36864, ML_PS = 46080, ML_CB = 55296, ML_WGT = 64512, ML_RR = 64768, ML_MROW = 65024,
              ML_SC = 65280, ML_EMT = 65536, ML_DENI = 65792, ML_NS = 66048, ML_A12 = 66304;
DI void mlstm_job(const KP& p, int l, int job, LAS unsigned char* lds, int tid) {
    int seq, hm, dir; seq_of_job(job, seq, hm, dir);
    int start, len; seq_info(seq, start, len);
    const bf16_t* proj = (const bf16_t*)(p.ws + WS_R);
    bf16_t* mix = (bf16_t*)(p.ws + WS_X1);
    bf16_t* hbp = (bf16_t*)(p.ws + WS_HBP);
    const float* cw = p.in[17] + l * 3 * 512;
    const float ibv = p.in[18][(l * 2 + dir) * 4 + hm], fbv = p.in[19][(l * 2 + dir) * 4 + hm];
    const int wave = tid >> 6, lane = tid & 63, r32 = lane & 31, hh = lane >> 5;
    LAS bf16_t* Qs = (LAS bf16_t*)(lds + ML_QS); LAS bf16_t* Ks = (LAS bf16_t*)(lds + ML_KS); LAS bf16_t* KT = (LAS bf16_t*)(lds + ML_KT);
    LAS bf16_t* VT = (LAS bf16_t*)(lds + ML_VT); LAS bf16_t* VWT = (LAS bf16_t*)(lds + ML_VWT); LAS bf16_t* Ps = (LAS bf16_t*)(lds + ML_PS); LAS bf16_t* CB = (LAS bf16_t*)(lds + ML_CB);
    LAS float* WGT = (LAS float*)(lds + ML_WGT); LAS float* RR = (LAS float*)(lds + ML_RR); LAS float* MROW = (LAS float*)(lds + ML_MROW); LAS float* SC = (LAS float*)(lds + ML_SC);
    LAS float* EMT = (LAS float*)(lds + ML_EMT); LAS float* DENI = (LAS float*)(lds + ML_DENI); LAS float* NS = (LAS float*)(lds + ML_NS); LAS float* A12 = (LAS float*)(lds + ML_A12);
    for (int i = tid; i < 64 * 72; i += NTHR) CB[i] = 0;
    if (tid < 64) NS[tid] = 0.f;
    f32x16 Creg = zero16();
    float Mst = 0.f;
    __syncthreads();
    const int nch = len >> 6;
    const int ll = tid >> 3, e8 = (tid & 7) * 8;
    for (int ch = 0; ch < nch; ++ch) {
        {
            const int n = ch * 64 + ll; const int pos = dir ? (len - 1 - n) : n; const int tok = start + pos;
#pragma unroll
            for (int which = 0; which < 2; ++which) {
                const int col = (which ? C_MK : C_MQ) + hm * 64 + e8; const int cwc = (which ? 256 : 0) + hm * 64 + e8;
                const bf16_t* bp = proj + (size_t)tok * NPROJ + col;
                const u32x4 cu = *(const u32x4*)bp; u32x4 pv = {0u, 0u, 0u, 0u}, nv = {0u, 0u, 0u, 0u};
                if (pos > 0) pv = *(const u32x4*)(bp - NPROJ);
                if (pos < len - 1) nv = *(const u32x4*)(bp + NPROJ);
                float o[8];
#pragma unroll
                for (int j = 0; j < 4; ++j) {
                    const f32x2 c0 = *(const f32x2*)(cw + cwc + 2 * j), c1 = *(const f32x2*)(cw + 512 + cwc + 2 * j), c2 = *(const f32x2*)(cw + 1024 + cwc + 2 * j);
                    const float v0 = c0.x * bflo(pv[j]) + c1.x * bflo(cu[j]) + c2.x * bflo(nv[j]);
                    const float v1 = c0.y * bfhi(pv[j]) + c1.y * bfhi(cu[j]) + c2.y * bfhi(nv[j]);
                    o[2 * j] = v0 * sigmoidf_(v0); o[2 * j + 1] = v1 * sigmoidf_(v1);
                }
                if (which) {
#pragma unroll
                    for (int j = 0; j < 8; ++j) o[j] *= 0.125f;
                }
                u32x4 w; w.x = cvtpk(o[0], o[1]); w.y = cvtpk(o[2], o[3]); w.z = cvtpk(o[4], o[5]); w.w = cvtpk(o[6], o[7]);
                if (!which) *(LAS u32x4*)(Qs + ll * 72 + e8) = w;
                else { *(LAS u32x4*)(Ks + ll * 72 + e8) = w;
#pragma unroll
                    for (int j = 0; j < 4; ++j) { KT[(e8 + 2 * j) * 72 + ll] = (bf16_t)(w[j] & 0xffffu); KT[(e8 + 2 * j + 1) * 72 + ll] = (bf16_t)(w[j] >> 16); } }
            }
        }
        if (wave == 0) {
            const int n = ch * 64 + lane; const int pos = dir ? (len - 1 - n) : n; const int tok = start + pos;
            const float igv = bf2f(proj[(size_t)tok * NPROJ + C_IG + dir * 4 + hm]) + ibv;
            const float fgv = bf2f(proj[(size_t)tok * NPROJ + C_FG + dir * 4 + hm]) + fbv;
            const float lf = (fgv > 0.f) ? -log1pf(__expf(-fgv)) : (fgv - log1pf(__expf(fgv)));
            float b = lf;
#pragma unroll
            for (int o = 1; o < 64; o <<= 1) { const float t2 = __shfl_up(b, o); if (lane >= o) b += t2; }
            const float bL = __shfl(b, 63);
            const float g = bL - b + igv;
            float mg = g;
#pragma unroll
            for (int o = 32; o >= 1; o >>= 1) mg = fmaxf(mg, __shfl_xor(mg, o));
            const float wgt = __expf(g - mg);
            const float r = igv - b;
            float cm = r;
#pragma unroll
            for (int o = 1; o < 64; o <<= 1) { const float t2 = __shfl_up(cm, o); if (lane >= o) cm = fmaxf(cm, t2); }
            const float mrow = fmaxf(cm, Mst);
            WGT[lane] = wgt; RR[lane] = r; MROW[lane] = mrow; SC[lane] = __expf(Mst - mrow); EMT[lane] = __expf(-(b + mrow));
            const float Mnew = fmaxf(bL + Mst, mg);
            if (lane == 0) { A12[0] = __expf(bL + Mst - Mnew); A12[1] = __expf(mg - Mnew); }
            Mst = Mnew;
        }
        __syncthreads();
        {
            const int n = ch * 64 + ll; const int pos = dir ? (len - 1 - n) : n; const int tok = start + pos;
            const u32x4 vv = *(const u32x4*)(proj + (size_t)tok * NPROJ + C_MV + hm * 64 + e8);
            const float wg = WGT[ll];
#pragma unroll
            for (int j = 0; j < 4; ++j) {
                VT[(e8 + 2 * j) * 72 + ll] = (bf16_t)(vv[j] & 0xffffu); VT[(e8 + 2 * j + 1) * 72 + ll] = (bf16_t)(vv[j] >> 16);
                const unsigned pw = cvtpk(bflo(vv[j]) * wg, bfhi(vv[j]) * wg);
                VWT[(e8 + 2 * j) * 72 + ll] = (bf16_t)(pw & 0xffffu); VWT[(e8 + 2 * j + 1) * 72 + ll] = (bf16_t)(pw >> 16);
            }
        }
        __syncthreads();
        if (wave < 4) {
            const int tb = wave >> 1, sb = wave & 1;
            f32x16 acc = zero16();
#pragma unroll
            for (int ks = 0; ks < 4; ++ks) {
                const bf16x8 a = *(const LAS bf16x8*)(Qs + (tb * 32 + r32) * 72 + ks * 16 + hh * 8);
                const bf16x8 b = *(const LAS bf16x8*)(Ks + (sb * 32 + r32) * 72 + ks * 16 + hh * 8);
                acc = MFMA32(a, b, acc);
            }
            const int s = sb * 32 + r32; const float rs_ = RR[s];
#pragma unroll
            for (int i = 0; i < 16; ++i) { const int t = tb * 32 + crow(i, hh); const float pvv = (s <= t) ? __expf(rs_ - MROW[t]) * acc[i] : 0.f; Ps[t * 72 + s] = f2bf(pvv); }
        } else {
            const int db = (wave - 4) >> 1, eb = (wave - 4) & 1;
            f32x16 kc = zero16();
#pragma unroll
            for (int ks = 0; ks < 4; ++ks) {
                const bf16x8 a = *(const LAS bf16x8*)(VWT + (db * 32 + r32) * 72 + ks * 16 + hh * 8);
                const bf16x8 b = *(const LAS bf16x8*)(KT + (eb * 32 + r32) * 72 + ks * 16 + hh * 8);
                kc = MFMA32(a, b, kc);
            }
            const float a1 = A12[0], a2 = A12[1];
#pragma unroll
            for (int i = 0; i < 16; ++i) Creg[i] = a1 * Creg[i] + a2 * kc[i];
        }
        __syncthreads();
        f32x16 acc = zero16();
        float ncv = 0.f;
        if (wave < 4) {
            const int tb = wave >> 1, db = wave & 1;
#pragma unroll
            for (int ks = 0; ks < 4; ++ks) {
                const bf16x8 a = *(const LAS bf16x8*)(Qs + (tb * 32 + r32) * 72 + ks * 16 + hh * 8);
                const bf16x8 b = *(const LAS bf16x8*)(CB + (db * 32 + r32) * 72 + ks * 16 + hh * 8);
                acc = MFMA32(a, b, acc);
            }
#pragma unroll
            for (int i = 0; i < 16; ++i) acc[i] *= SC[tb * 32 + crow(i, hh)];
#pragma unroll
            for (int ks = 0; ks < 4; ++ks) {
                const bf16x8 a = *(const LAS bf16x8*)(Ps + (tb * 32 + r32) * 72 + ks * 16 + hh * 8);
                const bf16x8 b = *(const LAS bf16x8*)(VT + (db * 32 + r32) * 72 + ks * 16 + hh * 8);
                acc = MFMA32(a, b, acc);
            }
        } else if (wave == 4) {
            float rsum = 0.f, qn = 0.f;
            for (int e = 0; e < 64; ++e) { rsum += bf2f(Ps[lane * 72 + e]); qn += bf2f(Qs[lane * 72 + e]) * NS[e]; }
            const float den = rsum + SC[lane] * qn;
            DENI[lane] = 1.f / fmaxf(fabsf(den), EMT[lane]);
        } else if (wave == 5) {
            for (int s = 0; s < 64; ++s) ncv += WGT[s] * bf2f(KT[lane * 72 + s]);
        }
        __syncthreads();
        if (wave < 4) {
            const int tb = wave >> 1, db = wave & 1;
#pragma unroll
            for (int i = 0; i < 16; ++i) {
                const int t = tb * 32 + crow(i, hh); const int n = ch * 64 + t; const int pos = dir ? (len - 1 - n) : n; const int tok = start + pos;
                const bf16_t o = f2bf(acc[i] * DENI[t]);
                if (dir) hbp[(size_t)tok * 256 + hm * 64 + db * 32 + r32] = o; else mix[(size_t)tok * DM + 768 + hm * 64 + db * 32 + r32] = o;
            }
        } else {
            const int db = (wave - 4) >> 1, eb = (wave - 4) & 1;
#pragma unroll
            for (int i = 0; i < 16; ++i) CB[(db * 32 + crow(i, hh)) * 72 + eb * 32 + r32] = f2bf(Creg[i]);
            if (wave == 5) NS[lane] = A12[0] * NS[lane] + A12[1] * ncv;
        }
        __syncthreads();
    }
}

DI void mixers_phase(const KP& p, int l, int cidx, LAS unsigned char* lds, int tid, int G, int bid) {
    unsigned* cnt = (unsigned*)(p.ws + WS_CNT) + cidx;
    LAS int* slot = (LAS int*)(lds + 131072);
    for (;;) {
        if (tid == 0) *slot = (int)atomicAdd(cnt, 1u);
        __syncthreads();
        const int item = *slot;
        __syncthreads();
        if (item >= 272 + 1536) break;
        int kind, jb;
        if (item < 64) { kind = 0; jb = item; } else if (item < 80) { kind = 1; jb = item - 64; } else if (item < 208) { kind = 0; jb = item - 80 + 64; }
        else if (item < 272) { kind = 1; jb = item - 208 + 16; } else { kind = 2; jb = item - 272; }
        int t2 = tid; asm volatile("" : "+v"(t2));
#ifndef REP_R
#define REP_R 1
#endif
#ifndef REP_M
#define REP_M 1
#endif
#ifndef REP_T
#define REP_T 1
#endif
        if (kind == 0) { for (int rep = 0; rep < REP_R; ++rep) { rwkv_job(p, l, jb, lds, t2); __syncthreads(); } }
        else if (kind == 1) { for (int rep = 0; rep < REP_M; ++rep) { mlstm_job(p, l, jb, lds, t2); __syncthreads(); } }
        else { for (int rep = 0; rep < REP_T; ++rep) { attn_unit(p, jb, lds, t2); __syncthreads(); } }
        __syncthreads();
    }
}

constexpr int PO_G2T = 0, PO_AS = 69632, PO_GO = 87040;
DI void post_phase(const KP& p, int l, LAS unsigned char* lds, int tid, int G, int bid) {
    const bf16_t* proj = (const bf16_t*)(p.ws + WS_R);
    bf16_t* mix = (bf16_t*)(p.ws + WS_X1);
    const bf16_t* yb = (const bf16_t*)(p.ws + WS_YB);
    const bf16_t* hbp = (const bf16_t*)(p.ws + WS_HBP);
    const float* cdot = (const float*)(p.ws + WS_CDOT);
    const float* mu = p.in[4] + l * 1152;
    const float* lnw = p.in[13] + l * 256; const float* lnb = p.in[14] + l * 256; const float* nw = p.in[20] + l * 256;
    LAS bf16_t* G2T = (LAS bf16_t*)(lds + PO_G2T); LAS bf16_t* AS = (LAS bf16_t*)(lds + PO_AS); LAS bf16_t* GO = (LAS bf16_t*)(lds + PO_GO);
    const int wave = tid >> 6, lane = tid & 63, r32 = lane & 31, hh = lane >> 5;
    { const float* g2 = p.in[9] + (size_t)l * 128 * 256;
      for (int i = 0; i < 64; ++i) { const int idx = tid + NTHR * i; const int mm = idx >> 8, c = idx & 255; G2T[c * 136 + mm] = f2bf(g2[idx]); } }
    __syncthreads();
    for (int unit = bid; unit < T / 64; unit += G) {
        const int tok0 = unit * 64;
        int len; const int st = tok_seq_start(tok0, len);
#pragma unroll
        for (int i = 0; i < 4; ++i) {
            const int q = tid + NTHR * i; const int t = q >> 5, c4 = (q & 31) * 4; const int tok = tok0 + t; const int pos = tok - st;
            const bf16_t* bp = proj + (size_t)tok * NPROJ + C_GD + c4;
            const u32x2 cu = *(const u32x2*)bp; u32x2 pv = {0u, 0u}, nv = {0u, 0u};
            if (pos > 0) pv = *(const u32x2*)(bp - NPROJ);
            if (pos < len - 1) nv = *(const u32x2*)(bp + NPROJ);
            const f32x4 m4 = *(const f32x4*)(mu + C_GD + c4);
            float x[4] = {bflo(cu.x), bfhi(cu.x), bflo(cu.y), bfhi(cu.y)};
            const float pn[4] = {bflo(pv.x) + bflo(nv.x), bfhi(pv.x) + bfhi(nv.x), bflo(pv.y) + bflo(nv.y), bfhi(pv.y) + bfhi(nv.y)};
#pragma unroll
            for (int j = 0; j < 4; ++j) x[j] = sigmoidf_(x[j] + (0.5f * pn[j] - x[j]) * m4[j]);
            u32x2 w; w.x = cvtpk(x[0], x[1]); w.y = cvtpk(x[2], x[3]); *(LAS u32x2*)(AS + t * 136 + c4) = w;
        }
        __syncthreads();
        {
            const int hd = wave & 3, tb = wave >> 2;
            f32x16 a0 = zero16(), a1 = zero16();
#pragma unroll
            for (int ks = 0; ks < 8; ++ks) {
                const bf16x8 a = *(const LAS bf16x8*)(AS + (tb * 32 + r32) * 136 + ks * 16 + hh * 8);
                const bf16x8 b0 = *(const LAS bf16x8*)(G2T + (hd * 64 + r32) * 136 + ks * 16 + hh * 8);
                const bf16x8 b1 = *(const LAS bf16x8*)(G2T + (hd * 64 + 32 + r32) * 136 + ks * 16 + hh * 8);
                a0 = MFMA32(a, b0, a0); a1 = MFMA32(a, b1, a1);
            }
#pragma unroll
            for (int i = 0; i < 16; ++i) { const int t = tb * 32 + crow(i, hh); GO[t * 264 + hd * 64 + r32] = f2bf(a0[i]); GO[t * 264 + hd * 64 + 32 + r32] = f2bf(a1[i]); }
        }
        __syncthreads();
#pragma unroll 1
        for (int it = 0; it < 8; ++it) {
            const int task = tid + NTHR * it; const int grp = task >> 4, li = task & 15; const int t = grp >> 2, hd = grp & 3; const int c4 = li * 4;
            const int tok = tok0 + t; const int pos = tok - st;
            {
                const u32x2 yf = *(const u32x2*)(mix + (size_t)tok * DM + hd * 64 + c4), ybv = *(const u32x2*)(yb + (size_t)tok * 256 + hd * 64 + c4);
                float x[4] = {bflo(yf.x) + bflo(ybv.x), bfhi(yf.x) + bfhi(ybv.x), bflo(yf.y) + bflo(ybv.y), bfhi(yf.y) + bfhi(ybv.y)};
                const float mean = red16(x[0] + x[1] + x[2] + x[3]) * (1.f / 64.f);
                float vs = 0.f;
#pragma unroll
                for (int j = 0; j < 4; ++j) { x[j] -= mean; vs += x[j] * x[j]; }
                const float rstd = rsqrtf(red16(vs) * (1.f / 64.f) + 64e-5f);
                const bf16_t* bp = proj + (size_t)tok * NPROJ + C_V + hd * 64 + c4;
                const u32x2 cu = *(const u32x2*)bp; u32x2 pv = {0u, 0u}, nv = {0u, 0u};
                if (pos > 0) pv = *(const u32x2*)(bp - NPROJ);
                if (pos < len - 1) nv = *(const u32x2*)(bp + NPROJ);
                const f32x4 m4 = *(const f32x4*)(mu + C_V + hd * 64 + c4);
                float v[4] = {bflo(cu.x), bfhi(cu.x), bflo(cu.y), bfhi(cu.y)};
                const float pn[4] = {bflo(pv.x) + bflo(nv.x), bfhi(pv.x) + bfhi(nv.x), bflo(pv.y) + bflo(nv.y), bfhi(pv.y) + bfhi(nv.y)};
                const f32x2 cdv = *(const f32x2*)(cdot + ((size_t)tok * 4 + hd) * 2);
                const float cds = cdv.x + cdv.y;
                const f32x4 lw = *(const f32x4*)(lnw + hd * 64 + c4), lb = *(const f32x4*)(lnb + hd * 64 + c4);
                const u32x2 gv = *(const LAS u32x2*)(GO + t * 264 + hd * 64 + c4);
                const float g[4] = {bflo(gv.x), bfhi(gv.x), bflo(gv.y), bfhi(gv.y)};
                float o[4];
#pragma unroll
                for (int j = 0; j < 4; ++j) { const float vsft = v[j] + (0.5f * pn[j] - v[j]) * m4[j]; o[j] = (x[j] * rstd * lw[j] + lb[j] + cds * vsft) * g[j]; }
                u32x2 w; w.x = cvtpk(o[0], o[1]); w.y = cvtpk(o[2], o[3]); *(u32x2*)(mix + (size_t)tok * DM + hd * 64 + c4) = w;
            }
            {
                const u32x2 hf = *(const u32x2*)(mix + (size_t)tok * DM + 768 + hd * 64 + c4), hb = *(const u32x2*)(hbp + (size_t)tok * 256 + hd * 64 + c4);
                const float x[4] = {bflo(hf.x) + bflo(hb.x), bfhi(hf.x) + bfhi(hb.x), bflo(hf.y) + bflo(hb.y), bfhi(hf.y) + bfhi(hb.y)};
                const float ms = red16(x[0] * x[0] + x[1] * x[1] + x[2] * x[2] + x[3] * x[3]) * (1.f / 64.f);
                const float rinv = rsqrtf(ms + 1e-6f);
                const u32x2 ov = *(const u32x2*)(proj + (size_t)tok * NPROJ + C_MO + hd * 64 + c4);
                const float og[4] = {bflo(ov.x), bfhi(ov.x), bflo(ov.y), bfhi(ov.y)};
                const f32x4 nwv = *(const f32x4*)(nw + hd * 64 + c4);
                float o[4];
#pragma unroll
                for (int j = 0; j < 4; ++j) o[j] = sigmoidf_(og[j]) * x[j] * rinv * nwv[j];
                u32x2 w; w.x = cvtpk(o[0], o[1]); w.y = cvtpk(o[2], o[3]); *(u32x2*)(mix + (size_t)tok * DM + 768 + hd * 64 + c4) = w;
            }
        }
        __syncthreads();
    }
}

DI void final_phase(const KP& p, int tid, int G, int bid) {
    const float* ss = (const float*)(p.ws + WS_SS) + 4 * T;
    const float* g = p.in[25];
    for (size_t i = (size_t)bid * NTHR + tid; i < (size_t)T * 256; i += (size_t)G * NTHR) {
        const int row = (int)(i >> 8), c = (int)(i & 255) * 4;
        const float rs = rsqrtf(ss[row] * (1.f / 1024.f) + 1e-6f);
        f32x4 v = *(const f32x4*)(p.out + i * 4); const f32x4 gv = *(const f32x4*)(g + c);
        v[0] *= rs * gv[0]; v[1] *= rs * gv[1]; v[2] *= rs * gv[2]; v[3] *= rs * gv[3];
        *(f32x4*)(p.out + i * 4) = v;
    }
}

__global__ void __launch_bounds__(NTHR, 2) fwd_kernel(KP p) {
    extern __shared__ __attribute__((aligned(16))) unsigned char lds_raw[];
    LAS unsigned char* lds = (LAS unsigned char*)lds_raw;
    cg::grid_group grid = cg::this_grid();
    int tid = threadIdx.x; const int G = gridDim.x, bid = blockIdx.x;
#define LAUNDER() asm volatile("" : "+v"(tid))
    float* ss = (float*)(p.ws + WS_SS);
    bf16_t* X1 = (bf16_t*)(p.ws + WS_X1);
    bf16_t* PROJ = (bf16_t*)(p.ws + WS_R);
    bf16_t* HB = (bf16_t*)(p.ws + WS_R);
    bf16_t* HID = (bf16_t*)(p.ws + WS_HID);

        LAUNDER();
    p0_phase(p, lds, tid, G, bid);
    grid.sync();
    for (int l = 0; l < 2; ++l) {
        {
            pg8::Gemm g{X1, (const bf16_t*)(p.ws + WS_WIN) + (size_t)l * NPROJ * 1024, T, NPROJ, 1024}; pg8::StaticOrder S; S.init(T, NPROJ, G, bid);
            EpiProj E{PROJ, ss + (2 * l) * T};
            pg8::gemm_phase<EpiProj, pg8::StaticOrder, true, true>(lds, g, S, E);
#ifdef PROBE_P1X2
            grid.sync();
            pg8::gemm_phase<EpiProj, pg8::StaticOrder, true, true>(lds, g, S, E);
#endif
        }
        grid.sync();
        LAUNDER();
        prep_phase(p, l, lds, tid, G, bid);
        grid.sync();
        LAUNDER();
        mixers_phase(p, l, l, lds, tid, G, bid);
#ifdef PROBE_MIX2
        grid.sync(); LAUNDER();
        mixers_phase(p, l, l + 2, lds, tid, G, bid);
#endif
        grid.sync();
        LAUNDER();
        post_phase(p, l, lds, tid, G, bid);
        grid.sync();
        {
            pg8::Gemm g{X1, (const bf16_t*)(p.ws + WS_WOUT) + (size_t)l * 1024 * 1024, T, DM, 1024}; pg8::StaticOrder S; S.init(T, DM, G, bid);
            EpiRes<true, true> E{p.out, HB, ss + (2 * l + 1) * T};
            pg8::gemm_phase<EpiRes<true, true>, pg8::StaticOrder, true, true>(lds, g, S, E);
        }
        grid.sync();
        for (int hf = 0; hf < 2; ++hf) {
            {
                pg8::Gemm g{HB, (const bf16_t*)(p.ws + WS_W1) + (size_t)l * 4096 * 1024 + (size_t)hf * HFF * 1024, T, HFF, 1024}; pg8::StaticOrder S; S.init(T, HFF, G, bid);
                EpiRelu2 E{HID, ss + (2 * l + 1) * T};
                pg8::gemm_phase<EpiRelu2, pg8::StaticOrder, true, true>(lds, g, S, E);
            }
            grid.sync();
            {
                pg8::Gemm g{HID, (const bf16_t*)(p.ws + WS_W2) + (size_t)l * 2 * 1024 * 2048 + (size_t)hf * 1024 * 2048, T, DM, HFF}; pg8::StaticOrder S; S.init(T, DM, G, bid);
                if (hf == 0) { EpiRes<false, false> E{p.out, nullptr, nullptr}; pg8::gemm_phase<EpiRes<false, false>, pg8::StaticOrder, true, true>(lds, g, S, E); }
                else { EpiRes<true, true> E{p.out, X1, ss + (2 * l + 2) * T}; pg8::gemm_phase<EpiRes<true, true>, pg8::StaticOrder, true, true>(lds, g, S, E); }
            }
            grid.sync();
        }
    }
        LAUNDER();
    final_phase(p, tid, G, bid);
}

extern "C" void kernel_launch(void* const* d_in, const int* in_sizes, int n_in, void* d_out, int out_size, void* d_ws, size_t ws_size, hipStream_t stream) {
    static int grid_blocks = 0;
    if (grid_blocks == 0) {
        if (n_in != 26 || out_size != T * DM || ws_size < WS_END) { fprintf(stderr, "kernel_launch: unexpected shapes (n_in %d out %d ws %zu)\n", n_in, out_size, ws_size); grid_blocks = -1; return; }
        int dev = 0, cus = 0, per_cu = 0;
        hipGetDevice(&dev);
        hipDeviceGetAttribute(&cus, hipDeviceAttributeMultiprocessorCount, dev);
        hipFuncSetAttribute((const void*)fwd_kernel, hipFuncAttributeMaxDynamicSharedMemorySize, LDS_BYTES);
        hipOccupancyMaxActiveBlocksPerMultiprocessor(&per_cu, (const void*)fwd_kernel, NTHR, LDS_BYTES);
        if (per_cu < 1) per_cu = 1;
        grid_blocks = cus * per_cu;
        (void)hipGetLastError();
    }
    if (grid_blocks < 0) return;
    KP p{};
    for (int i = 0; i < 26; ++i) p.in[i] = (const float*)d_in[i];
    p.out = (float*)d_out; p.ws = (unsigned char*)d_ws;
    void* args[] = {&p};
    hipError_t e = hipLaunchCooperativeKernel((const void*)fwd_kernel, dim3(grid_blocks), dim3(NTHR), args, LDS_BYTES, stream);
    if (e != hipSuccess) fprintf(stderr, "cooperative launch failed: %s (grid %d)\n", hipGetErrorString(e), grid_blocks);
}
```

```cpp
#include <hip/hip_runtime.h>
#include <hip/hip_cooperative_groups.h>
#include <cstdio>
#include <cstdint>
namespace cg = cooperative_groups;
namespace pg8 {
#define PG8_LAS __attribute__((address_space(3)))
typedef unsigned short bf16_t;
typedef short bf16x8 __attribute__((ext_vector_type(8)));
typedef float f32x4 __attribute__((ext_vector_type(4)));
typedef unsigned u32x4 __attribute__((ext_vector_type(4)));
constexpr int BM = 256, BK = 64, HALF = 128, HTB = HALF * BK * 2  , STAGE_BYTES = 8 * HTB, NXCD = 8, WGM = 8;

__host__ __device__ __forceinline__ int lds_byte(int r, int c) { const int st = (r >> 4) * 2 + (c >> 5), rr = r & 15, cc = c & 31, ob = rr * 64 + cc * 2; return st * 1024 + (ob ^ (((ob >> 9) & 1) << 5)); }
__host__ __device__ __forceinline__ void stage_rc(int b, int& R, int& C) { const int st = b / 1024, sb = b % 1024, swz = sb ^ (((sb >> 9) & 1) << 5); R = (st >> 1) * 16 + swz / 64; C = (st & 1) * 32 + (swz % 64) / 2; }
__host__ __device__ __forceinline__ int perm32(int rho) { const int n = rho >> 4, i = rho & 15; return 8 * (i >> 2) + 4 * n + (i & 3); }

struct Unit { int pm, pn; };
struct Gemm { const bf16_t* A; const bf16_t* Bt; int M, N, K; };

struct StaticOrder {
    int nM, nN, nwg, G, c;
    __host__ __device__ void init(int M, int N, int G_, int c_) { nM = M / BM; nN = N / BM; nwg = nM * nN; G = G_; c = c_; }
    __host__ __device__ bool next(int i, Unit& u) const {
        const long L = (long)i * G + c; if (L >= nwg) return false;
        int wgid = (int)L; { const int q = nwg / NXCD, r = nwg % NXCD, xcd = wgid % NXCD, off = wgid / NXCD; wgid = (xcd < r ? xcd * (q + 1) : r * (q + 1) + (xcd - r) * q) + off; }
        const int nig = WGM * nN, gid = wgid / nig, fm = gid * WGM, gsz = (nM - fm) < WGM ? (nM - fm) : WGM;
        u.pm = fm + ((wgid % nig) % gsz); u.pn = (wgid % nig) / gsz; return true;
    }
    __device__ __forceinline__ void a_ready(const Unit&) const {}
    __device__ __forceinline__ void done(const Unit&) const {}
};

template <class Epi, class Sched, bool ALIGN_EPI = false, bool SP2 = false>
__device__ __forceinline__ void gemm_phase(PG8_LAS unsigned char* lds, const Gemm g, const Sched& S, const Epi& E) {
    int tid_l = threadIdx.x; asm volatile("" : "+v"(tid_l));
    const int tid = tid_l, wid = __builtin_amdgcn_readfirstlane(tid >> 6), lane = tid & 63, wr = wid >> 2, wc = wid & 3, fr = lane & 15, fq = lane >> 4;
    const int K = g.K, nt = K / BK;
    unsigned voffA[2], voffB[2];
#pragma unroll
    for (int i = 0; i < 2; ++i) { int R, C; stage_rc(tid * 16 + i * 8192, R, C); const int Rb = Epi::PERM ? ((R & ~31) + perm32(R & 31)) : R;
        voffA[i] = (unsigned)(R * K + C) * 2u; voffB[i] = (unsigned)(Rb * K + C) * 2u; }
    const size_t kstep = (size_t)(BK * 2);
    const size_t hstep = (size_t)HALF * K * 2;
    const size_t tstep = 2 * hstep;
    const unsigned ldsw = (unsigned)wid * 1024u;
    const int aoff = lds_byte(wr * 64 + fr, fq * 8), boff = lds_byte(wc * 32 + fr, fq * 8);
#define PG8_SA(b, h) (((b) * 2 + (h)) * HTB)
#define PG8_SB(b, h) ((4 + (b) * 2 + (h)) * HTB)
#define PG8_STAGE(bufoff, gbase, voff) do { _Pragma("unroll") for (int _i = 0; _i < 2; ++_i) \
        __builtin_amdgcn_global_load_lds((const unsigned*)((const char*)(gbase) + (voff)[_i]), (PG8_LAS unsigned*)(lds + (bufoff) + ldsw + _i * 8192), 16, 0, 0); } while (0)
#define PG8_LDA(dst, b, h) do { _Pragma("unroll") for (int m = 0; m < 4; ++m) _Pragma("unroll") for (int k = 0; k < 2; ++k) dst[m][k] = *(const PG8_LAS bf16x8*)(lds + PG8_SA(b, h) + aoff + m * 2048 + k * 1024); } while (0)
#define PG8_LDB(dst, b, h) do { _Pragma("unroll") for (int n = 0; n < 2; ++n) _Pragma("unroll") for (int k = 0; k < 2; ++k) dst[n][k] = *(const PG8_LAS bf16x8*)(lds + PG8_SB(b, h) + boff + n * 2048 + k * 1024); } while (0)
#define PG8_MMA(ai, bj, At, Bt) do { __builtin_amdgcn_s_setprio(1); _Pragma("unroll") for (int m = 0; m < 4; ++m) _Pragma("unroll") for (int n = 0; n < 2; ++n) _Pragma("unroll") for (int k = 0; k < 2; ++k) \
        acc[ai][bj][m][n] = __builtin_amdgcn_mfma_f32_16x16x32_bf16(Bt[n][k], At[m][k], acc[ai][bj][m][n], 0, 0, 0); __builtin_amdgcn_s_setprio(0); } while (0)
#define PG8_WAIT_V(n) asm volatile("s_waitcnt vmcnt(" #n ")" ::: "memory")
#define PG8_WAIT_L(n) asm volatile("s_waitcnt lgkmcnt(" #n ")" ::: "memory")
#define PG8_BAR __builtin_amdgcn_s_barrier()
#define PG8_SCHED __builtin_amdgcn_sched_barrier(0)
    Unit cur, nxt; int ui = 0;
    if (!S.next(0, cur)) return;
    f32x4 acc[2][2][4][2];
#pragma unroll
    for (int a = 0; a < 2; ++a)
#pragma unroll
        for (int b = 0; b < 2; ++b)
#pragma unroll
            for (int m = 0; m < 4; ++m)
#pragma unroll
                for (int n = 0; n < 2; ++n) acc[a][b][m][n] = (f32x4){0.f, 0.f, 0.f, 0.f};
    bf16x8 At[4][2], B0[2][2], B1[2][2];
    const char* cA = (const char*)g.A + (size_t)cur.pm * tstep; const char* cB = (const char*)g.Bt + (size_t)cur.pn * tstep;
    S.a_ready(cur);
    if constexpr (SP2) {
        PG8_STAGE(PG8_SB(0, 0), cB, voffB); PG8_STAGE(PG8_SB(0, 1), cB + hstep, voffB); PG8_STAGE(PG8_SA(0, 0), cA, voffA); PG8_STAGE(PG8_SA(0, 1), cA + hstep, voffA);
        if (wr == 1) PG8_BAR;
        PG8_WAIT_V(2); PG8_BAR;
        PG8_STAGE(PG8_SB(1, 0), cB + kstep, voffB); PG8_STAGE(PG8_SA(1, 0), cA + kstep, voffA); PG8_STAGE(PG8_SB(1, 1), cB + hstep + kstep, voffB);
        PG8_WAIT_V(6); PG8_BAR;
    } else {
        PG8_STAGE(PG8_SB(0, 0), cB, voffB); PG8_STAGE(PG8_SA(0, 0), cA, voffA); PG8_STAGE(PG8_SB(0, 1), cB + hstep, voffB); PG8_STAGE(PG8_SA(0, 1), cA + hstep, voffA);
        if (wr == 1) PG8_BAR;
        PG8_WAIT_V(4); PG8_BAR;
        PG8_STAGE(PG8_SB(1, 0), cB + kstep, voffB); PG8_STAGE(PG8_SA(1, 0), cA + kstep, voffA); PG8_STAGE(PG8_SB(1, 1), cB + hstep + kstep, voffB);
        PG8_WAIT_V(6); PG8_BAR;
    }
    for (;;) {
        const bool has_next = S.next(ui + 1, nxt);
        const char* nA = has_next ? (const char*)g.A + (size_t)nxt.pm * tstep : cA; const char* nB = has_next ? (const char*)g.Bt + (size_t)nxt.pn * tstep : cB;
        for (int t = 0; t < nt; t += 2) {
            const bool last = (t == nt - 2);
            const char* a1 = cA + (size_t)(t + 1) * kstep;
            const char* a2 = last ? nA : cA + (size_t)(t + 2) * kstep; const char* b2 = last ? nB : cB + (size_t)(t + 2) * kstep;
            const char* a3 = a2 + kstep; const char* b3 = b2 + kstep;
            if (last && has_next) S.a_ready(nxt);
            if constexpr (SP2) {
            PG8_LDB(B0, 0, 0); PG8_LDB(B1, 0, 1); PG8_SCHED; PG8_LDA(At, 0, 0); PG8_STAGE(PG8_SA(1, 1), a1 + hstep, voffA);
            PG8_WAIT_V(8); PG8_WAIT_L(0); PG8_BAR; PG8_MMA(0, 0, At, B0); PG8_MMA(0, 1, At, B1); PG8_BAR; PG8_SCHED;
            PG8_LDA(At, 0, 1); PG8_STAGE(PG8_SB(0, 0), b2, voffB); PG8_STAGE(PG8_SB(0, 1), b2 + hstep, voffB); PG8_STAGE(PG8_SA(0, 0), a2, voffA);
            PG8_WAIT_V(8); PG8_WAIT_L(0); PG8_BAR; PG8_MMA(1, 0, At, B0); PG8_MMA(1, 1, At, B1); PG8_BAR; PG8_SCHED;
            PG8_LDB(B0, 1, 0); PG8_LDB(B1, 1, 1); PG8_SCHED; PG8_LDA(At, 1, 0); PG8_STAGE(PG8_SA(0, 1), a2 + hstep, voffA);
            PG8_WAIT_V(8); PG8_WAIT_L(0); PG8_BAR; PG8_MMA(0, 0, At, B0); PG8_MMA(0, 1, At, B1); PG8_BAR; PG8_SCHED;
            PG8_LDA(At, 1, 1); PG8_STAGE(PG8_SB(1, 0), b3, voffB); PG8_STAGE(PG8_SB(1, 1), b3 + hstep, voffB); PG8_STAGE(PG8_SA(1, 0), a3, voffA);
            PG8_WAIT_V(8); PG8_WAIT_L(0); PG8_BAR; PG8_MMA(1, 0, At, B0); PG8_MMA(1, 1, At, B1); PG8_BAR; PG8_SCHED;
            } else {
            PG8_LDB(B0, 0, 0); PG8_SCHED; PG8_LDA(At, 0, 0); PG8_STAGE(PG8_SA(1, 1), a1 + hstep, voffA);
            PG8_WAIT_L(8); PG8_BAR; PG8_WAIT_L(0); PG8_MMA(0, 0, At, B0); PG8_BAR; PG8_SCHED;
            PG8_LDB(B1, 0, 1); PG8_STAGE(PG8_SB(0, 0), b2, voffB);
            PG8_BAR; PG8_WAIT_L(0); PG8_MMA(0, 1, At, B1); PG8_BAR;
            PG8_LDA(At, 0, 1); PG8_STAGE(PG8_SA(0, 0), a2, voffA);
            PG8_BAR; PG8_WAIT_L(0); PG8_MMA(1, 0, At, B0); PG8_BAR; PG8_SCHED;
            PG8_STAGE(PG8_SB(0, 1), b2 + hstep, voffB);
            PG8_WAIT_V(6); PG8_BAR; PG8_MMA(1, 1, At, B1); PG8_BAR;
            PG8_LDB(B0, 1, 0); PG8_SCHED; PG8_LDA(At, 1, 0); PG8_STAGE(PG8_SA(0, 1), a2 + hstep, voffA);
            PG8_WAIT_L(8); PG8_BAR; PG8_WAIT_L(0); PG8_MMA(0, 0, At, B0); PG8_BAR; PG8_SCHED;
            PG8_LDB(B1, 1, 1); PG8_STAGE(PG8_SB(1, 0), b3, voffB);
            PG8_BAR; PG8_WAIT_L(0); PG8_MMA(0, 1, At, B1); PG8_BAR;
            PG8_LDA(At, 1, 1); PG8_STAGE(PG8_SA(1, 0), a3, voffA);
            PG8_BAR; PG8_WAIT_L(0); PG8_MMA(1, 0, At, B0); PG8_BAR; PG8_SCHED;
            PG8_STAGE(PG8_SB(1, 1), b3 + hstep, voffB);
            PG8_WAIT_V(6); PG8_BAR; PG8_MMA(1, 1, At, B1); PG8_BAR;
            }
        }
        if constexpr (ALIGN_EPI) { if (wr == 0) PG8_BAR; }
        if constexpr (!Epi::AFTER_DRAIN) { E(acc, cur, wr, wc, fr, fq); S.done(cur); }
        if (!has_next) break;
#pragma unroll
        for (int a = 0; a < 2; ++a)
#pragma unroll
            for (int b = 0; b < 2; ++b)
#pragma unroll
                for (int m = 0; m < 4; ++m)
#pragma unroll
                    for (int n = 0; n < 2; ++n) acc[a][b][m][n] = (f32x4){0.f, 0.f, 0.f, 0.f};
        cur = nxt; cA = nA; cB = nB; ++ui;
        if constexpr (ALIGN_EPI) { if (wr == 1) PG8_BAR; }
    }
    PG8_WAIT_V(0);
    if constexpr (!ALIGN_EPI) { if (wr == 0) PG8_BAR; }
    PG8_BAR;
    if constexpr (Epi::AFTER_DRAIN) { E.fused(acc, cur, wr, wc, fr, fq, lds, wid, lane); S.done(cur); }
#undef PG8_SA
#undef PG8_SB
#undef PG8_STAGE
#undef PG8_LDA
#undef PG8_LDB
#undef PG8_MMA
#undef PG8_WAIT_V
#undef PG8_WAIT_L
#undef PG8_BAR
#undef PG8_SCHED
}
}

#define DI __device__ __forceinline__
#define LAS __attribute__((address_space(3)))
typedef unsigned short bf16_t;
typedef short bf16x8 __attribute__((ext_vector_type(8)));
typedef short s16x4 __attribute__((ext_vector_type(4)));
typedef float f32x4 __attribute__((ext_vector_type(4)));
typedef float f32x2 __attribute__((ext_vector_type(2)));
typedef float f32x16 __attribute__((ext_vector_type(16)));
typedef unsigned u32x4 __attribute__((ext_vector_type(4)));
typedef unsigned u32x2 __attribute__((ext_vector_type(2)));
typedef __bf16 bf16x2_t __attribute__((ext_vector_type(2)));
#define MFMA32(a, b, c) __builtin_amdgcn_mfma_f32_32x32x16_bf16((a), (b), (c), 0, 0, 0)

constexpr int T = 49152, DM = 1024, NPROJ = 3072, NIN = 2960, DFF = 4096, HFF = 2048;
constexpr int C_R = 0, C_K = 256, C_V = 512, C_WD = 768, C_AD = 896, C_GD = 1024;
constexpr int C_AQ = 1152, C_AK = 1664, C_AV = 1792;
constexpr int C_MQ = 1920, C_MK = 2176, C_MV = 2432, C_MO = 2688, C_IG = 2944, C_FG = 2952;
constexpr size_t MiB = 1u << 20;
constexpr size_t WS_SS = 0, WS_CNT = MiB - 4096, WS_CDOT = 1 * MiB, WS_TAB = 2 * MiB + 512 * 1024, WS_WIN = 3 * MiB, WS_WOUT = 15 * MiB,
                 WS_W1 = 19 * MiB, WS_W2 = 35 * MiB, WS_VT = 51 * MiB, WS_YB = 63 * MiB, WS_HBP = 87 * MiB, WS_X1 = 111 * MiB, WS_R = 207 * MiB,
                 WS_HID = WS_R + 96 * MiB, WS_END = 495 * MiB;
constexpr int LDS_BYTES = 134400 + 256;
constexpr int NTHR = 512;

struct KP { const float* in[26]; float* out; unsigned char* ws; };

DI unsigned cvtpk(float lo, float hi) { f32x2 v = {lo, hi}; bf16x2_t b = __builtin_convertvector(v, bf16x2_t); return __builtin_bit_cast(unsigned, b); }
DI unsigned short f2bf(float f) { return (unsigned short)(cvtpk(f, 0.f) & 0xffffu); }
DI float bf2f(unsigned h) { return __builtin_bit_cast(float, h << 16); }
DI float bflo(unsigned w) { return __builtin_bit_cast(float, w << 16); }
DI float bfhi(unsigned w) { return __builtin_bit_cast(float, w & 0xffff0000u); }
DI int crow(int reg, int h) { return (reg & 3) + 8 * (reg >> 2) + 4 * h; }
template <int CTRL> DI float dppf(float v) { return __builtin_bit_cast(float, __builtin_amdgcn_update_dpp(0, __builtin_bit_cast(int, v), CTRL, 0xf, 0xf, true)); }
DI float red8(float v) { v += dppf<0xB1>(v); v += dppf<0x4E>(v); v += dppf<0x141>(v); return v; }
DI float red16(float v) { v = red8(v); v += dppf<0x128>(v); return v; }
DI float frcp(float x) { return __builtin_amdgcn_rcpf(x); }
DI float sigmoidf_(float x) { return frcp(1.f + __expf(-x)); }
DI f32x16 zero16() { f32x16 z; for (int i = 0; i < 16; ++i) z[i] = 0.f; return z; }
DI void seq_of_job(int j, int& seq, int& h, int& dir) { if (j < 16) { seq = 8 + (j >> 3); } else { j -= 16; seq = j >> 3; } h = (j >> 1) & 3; dir = j & 1; }
DI void seq_info(int s, int& start, int& len) { if (s < 8) { start = s * 4096; len = 4096; } else { start = 32768 + (s - 8) * 8192; len = 8192; } }
DI int tok_seq_start(int tok, int& len) { if (tok < 32768) { len = 4096; return tok & ~4095; } len = 8192; return 32768 + ((tok - 32768) & ~8191); }

struct EpiProj {
    static constexpr bool PERM = true, AFTER_DRAIN = false;
    bf16_t* O; const float* ss;
    DI void operator()(const pg8::f32x4 (&acc)[2][2][4][2], const pg8::Unit& u, int wr, int wc, int fr, int fq) const {
        const int row0 = u.pm * 256 + wr * 64 + fr, col0 = u.pn * 256 + wc * 32 + 8 * fq;
#pragma unroll
        for (int ai = 0; ai < 2; ++ai)
#pragma unroll
            for (int m = 0; m < 4; ++m) {
                const int row = row0 + ai * 128 + m * 16;
                const float rs = rsqrtf(ss[row] * (1.f / 1024.f) + 1e-6f);
                bf16_t* rp = O + (size_t)row * NPROJ + col0;
#pragma unroll
                for (int bj = 0; bj < 2; ++bj) {
                    pg8::f32x4 v0 = acc[ai][bj][m][0] * rs, v1 = acc[ai][bj][m][1] * rs;
                    u32x4 w; w.x = cvtpk(v0[0], v0[1]); w.y = cvtpk(v0[2], v0[3]); w.z = cvtpk(v1[0], v1[1]); w.w = cvtpk(v1[2], v1[3]);
                    *(u32x4*)(rp + bj * 128) = w;
                }
            }
    }
};
struct EpiRelu2 {
    static constexpr bool PERM = true, AFTER_DRAIN = false;
    bf16_t* O; const float* ss;
    DI void operator()(const pg8::f32x4 (&acc)[2][2][4][2], const pg8::Unit& u, int wr, int wc, int fr, int fq) const {
        const int row0 = u.pm * 256 + wr * 64 + fr, col0 = u.pn * 256 + wc * 32 + 8 * fq;
#pragma unroll
        for (int ai = 0; ai < 2; ++ai)
#pragma unroll
            for (int m = 0; m < 4; ++m) {
                const int row = row0 + ai * 128 + m * 16;
                const float rs = rsqrtf(ss[row] * (1.f / 1024.f) + 1e-6f);
                bf16_t* rp = O + (size_t)row * HFF + col0;
#pragma unroll
                for (int bj = 0; bj < 2; ++bj) {
                    pg8::f32x4 v0 = acc[ai][bj][m][0] * rs, v1 = acc[ai][bj][m][1] * rs;
#pragma unroll
                    for (int j = 0; j < 4; ++j) { float a = fmaxf(v0[j], 0.f); v0[j] = a * a; float b = fmaxf(v1[j], 0.f); v1[j] = b * b; }
                    u32x4 w; w.x = cvtpk(v0[0], v0[1]); w.y = cvtpk(v0[2], v0[3]); w.z = cvtpk(v1[0], v1[1]); w.w = cvtpk(v1[2], v1[3]);
                    *(u32x4*)(rp + bj * 128) = w;
                }
            }
    }
};
template <bool WRITE_HB, bool DO_SS> struct EpiRes {
    static constexpr bool PERM = true, AFTER_DRAIN = false;
    float* X; bf16_t* HB; float* ss;
    DI void operator()(const pg8::f32x4 (&acc)[2][2][4][2], const pg8::Unit& u, int wr, int wc, int fr, int fq) const {
        const int row0 = u.pm * 256 + wr * 64 + fr, col0 = u.pn * 256 + wc * 32 + 8 * fq;
#pragma unroll
        for (int ai = 0; ai < 2; ++ai)
#pragma unroll
            for (int m = 0; m < 4; ++m) {
                const int row = row0 + ai * 128 + m * 16;
                float* xp = X + (size_t)row * DM + col0;
                float sq = 0.f;
#pragma unroll
                for (int bj = 0; bj < 2; ++bj) {
                    pg8::f32x4 a0 = *(const pg8::f32x4*)(xp + bj * 128), a1 = *(const pg8::f32x4*)(xp + bj * 128 + 4);
                    a0 += acc[ai][bj][m][0]; a1 += acc[ai][bj][m][1];
                    *(pg8::f32x4*)(xp + bj * 128) = a0; *(pg8::f32x4*)(xp + bj * 128 + 4) = a1;
                    if (WRITE_HB) { u32x4 w; w.x = cvtpk(a0[0], a0[1]); w.y = cvtpk(a0[2], a0[3]); w.z = cvtpk(a1[0], a1[1]); w.w = cvtpk(a1[2], a1[3]);
                        *(u32x4*)(HB + (size_t)row * DM + col0 + bj * 128) = w; }
                    if (DO_SS) sq += a0[0] * a0[0] + a0[1] * a0[1] + a0[2] * a0[2] + a0[3] * a0[3] + a1[0] * a1[0] + a1[1] * a1[1] + a1[2] * a1[2] + a1[3] * a1[3];
                }
                if (DO_SS) { sq += __shfl_xor(sq, 16); sq += __shfl_xor(sq, 32); if (fq == 0) atomicAdd(ss + row, sq); }
            }
    }
};

DI void transpose_tile(const float* src, int N, int nvalid, const float* gain, bf16_t* dst, int K, int kt, int nt, LAS float* tile, int tid) {
    const int a = tid & 63, b8 = tid >> 6;
#pragma unroll
    for (int i = 0; i < 8; ++i) { const int k = b8 + 8 * i, n = nt * 64 + a; float v = (n < nvalid) ? src[(size_t)(kt * 64 + k) * N + n] : 0.f; if (gain) v *= gain[kt * 64 + k]; tile[k * 65 + a] = v; }
    __syncthreads();
#pragma unroll
    for (int i = 0; i < 8; ++i) { const int n = b8 + 8 * i; dst[(size_t)(nt * 64 + n) * K + kt * 64 + a] = f2bf(tile[a * 65 + n]); }
    __syncthreads();
}
DI void p0_phase(const KP& p, LAS unsigned char* lds, int tid, int G, int bid) {
    LAS float* tile = (LAS float*)lds;
    for (int it = bid; it < 6144; it += G) {
        const int l = it / 3072; int r = it % 3072;
        const float* src; const float* gain; bf16_t* dst; int N, nvalid, K, kt, nt;
        if (r < 768) { src = p.in[3] + (size_t)l * 1024 * NIN; N = NIN; nvalid = NIN; K = 1024; gain = p.in[2] + l * 1024; dst = (bf16_t*)(p.ws + WS_WIN) + (size_t)l * NPROJ * 1024; kt = r / 48; nt = r % 48; }
        else if (r < 1024) { r -= 768; src = p.in[21] + (size_t)l * 1024 * 1024; N = 1024; nvalid = 1024; K = 1024; gain = nullptr; dst = (bf16_t*)(p.ws + WS_WOUT) + (size_t)l * 1024 * 1024; kt = r / 16; nt = r % 16; }
        else if (r < 2048) { r -= 1024; src = p.in[23] + (size_t)l * 1024 * 4096; N = 4096; nvalid = 4096; K = 1024; gain = p.in[22] + l * 1024; dst = (bf16_t*)(p.ws + WS_W1) + (size_t)l * 4096 * 1024; kt = r / 64; nt = r % 64; }
        else { r -= 2048; const int h = r / 512; r %= 512; src = p.in[24] + (size_t)l * 4096 * 1024 + (size_t)h * 2048 * 1024; N = 1024; nvalid = 1024; K = 2048; gain = nullptr;
               dst = (bf16_t*)(p.ws + WS_W2) + (size_t)l * 2 * 1024 * 2048 + (size_t)h * 1024 * 2048; kt = r / 16; nt = r % 16; }
        transpose_tile(src, N, nvalid, gain, dst, K, kt, nt, tile, tid);
    }
    const int wave = tid >> 6, lane = tid & 63;
    float* ss = (float*)(p.ws + WS_SS);
    bf16_t* xb = (bf16_t*)(p.ws + WS_X1);
    for (int row = bid * 8 + wave; row < T; row += G * 8) {
        const float* xs = (row < 32768) ? p.in[0] + (size_t)row * DM : p.in[1] + (size_t)(row - 32768) * DM;
        float sq = 0.f;
#pragma unroll
        for (int j = 0; j < 4; ++j) {
            const int c = (j * 64 + lane) * 4;
            const f32x4 v = *(const f32x4*)(xs + c);
            *(f32x4*)(p.out + (size_t)row * DM + c) = v;
            u32x2 w; w.x = cvtpk(v[0], v[1]); w.y = cvtpk(v[2], v[3]);
            *(u32x2*)(xb + (size_t)row * DM + c) = w;
            sq += v[0] * v[0] + v[1] * v[1] + v[2] * v[2] + v[3] * v[3];
        }
#pragma unroll
        for (int o = 32; o >= 1; o >>= 1) sq += __shfl_xor(sq, o);
        if (lane == 0) ss[row] = sq;
    }
    for (int i = bid * NTHR + tid; i < 4 * T; i += G * NTHR) ss[T + i] = 0.f;
    if (bid == 0) {
        if (tid < 64) ((unsigned*)(p.ws + WS_CNT))[tid] = 0u;
        float2* tab = (float2*)(p.ws + WS_TAB);
        for (int idx = tid; idx < 2048; idx += NTHR) { const int pos = idx >> 4, f = idx & 15; const float inv = powf(10000.f, -(float)f / 16.f); const float ang = (float)pos * inv; tab[idx] = make_float2(cosf(ang), sinf(ang)); }
    }
}

DI void prep_phase(const KP& p, int l, LAS unsigned char* lds, int tid, int G, int bid) {
    bf16_t* proj = (bf16_t*)(p.ws + WS_R);
    bf16_t* vT = (bf16_t*)(p.ws + WS_VT);
    const float2* tab = (const float2*)(p.ws + WS_TAB);
    const float* qn = p.in[15] + l * 64; const float* kn = p.in[16] + l * 64;
    const int wave = tid >> 6, lane = tid & 63, g = lane >> 4, li = lane & 15;
    LAS bf16_t* vts = (LAS bf16_t*)lds;
    for (int unit = bid; unit < T / 64; unit += G) {
        const int tok0 = unit * 64;
        for (int i = 0; i < 8; ++i) {
            const int tok = tok0 + wave * 8 + i; int len; const int st = tok_seq_start(tok, len); const int pos = tok - st; const int prow = pos >> 6, pcol = pos & 63;
#pragma unroll
            for (int it = 0; it < 3; ++it) {
                const bool act = (it < 2) || (g < 2);
                const int colbase = (it < 2) ? C_AQ + (it * 4 + g) * 64 : C_AK + (g & 1) * 64;
                const float* wn = (it < 2) ? qn : kn;
                bf16_t* ptr = proj + (size_t)tok * NPROJ + colbase + li * 4;
                const u32x2 raw = *(const u32x2*)ptr;
                float x[4] = {bflo(raw.x), bfhi(raw.x), bflo(raw.y), bfhi(raw.y)};
                float sq = x[0] * x[0] + x[1] * x[1] + x[2] * x[2] + x[3] * x[3];
                sq = red16(sq);
                const float rinv = rsqrtf(sq * (1.f / 64.f) + 1e-6f);
                const f32x4 w4 = *(const f32x4*)(wn + li * 4);
                const int idx = (li >> 3) ? pcol : prow; const bool second = (li >> 2) & 1;
                const float scale = (it < 2) ? 0.125f * 1.4426950408889634f : 1.f;
                float o[4];
#pragma unroll
                for (int j = 0; j < 4; ++j) {
                    const float y = x[j] * rinv * w4[j];
                    const float pr = __shfl_xor(y, 4);
                    const int f = (li * 4 + j) & 15;
                    const float2 cs = tab[idx * 16 + f];
                    o[j] = (second ? (y * cs.x + pr * cs.y) : (y * cs.x - pr * cs.y)) * scale;
                }
                if (act) { u32x2 w; w.x = cvtpk(o[0], o[1]); w.y = cvtpk(o[2], o[3]); *(u32x2*)ptr = w; }
            }
        }
#pragma unroll
        for (int i = 0; i < 2; ++i) { const int idx = tid + NTHR * i; const int tl = idx >> 4, c8 = (idx & 15) * 8;
            const u32x4 v = *(const u32x4*)(proj + (size_t)(tok0 + tl) * NPROJ + C_AV + c8); *(LAS u32x4*)(vts + tl * 136 + c8) = v; }
        __syncthreads();
        { const int c = tid >> 2, tq = tid & 3; unsigned w[8];
#pragma unroll
          for (int j = 0; j < 8; ++j) { const unsigned lo = vts[(tq * 16 + 2 * j) * 136 + c], hi = vts[(tq * 16 + 2 * j + 1) * 136 + c]; w[j] = lo | (hi << 16); }
          u32x4 a = {w[0], w[1], w[2], w[3]}, b = {w[4], w[5], w[6], w[7]};
          bf16_t* dp = vT + (size_t)c * T + tok0 + tq * 16; *(u32x4*)dp = a; *(u32x4*)(dp + 8) = b; }
        __syncthreads();
    }
}

DI void attn_unit(const KP& p, int l, int unit, LAS unsigned char* lds, int tid) {
    const float* qnw = p.in[15] + l * 64; const float* knw = p.in[16] + l * 64;
    const bf16_t* proj = (const bf16_t*)(p.ws + WS_R);
    const bf16_t* vT = (const bf16_t*)(p.ws + WS_VT);
    bf16_t* mix = (bf16_t*)(p.ws + WS_X1);
    int seq, kvh, qt;
    if (unit < 512) { seq = 8 + (unit >> 8); const int r = unit & 255; kvh = r >> 7; qt = r & 127; }
    else { const int u2 = unit - 512; seq = u2 >> 7; const int r = u2 & 127; kvh = r >> 6; qt = r & 63; }
    int start, len; seq_info(seq, start, len);
    const int nk = len >> 6;
    const int wave = tid >> 6, lane = tid & 63, r32 = lane & 31, hh = lane >> 5;
    const int head = kvh * 4 + (wave >> 1);
    const int q0 = start + qt * 64 + (wave & 1) * 32;
    bf16x8 qf[4];
    { const bf16_t* qp = proj + (size_t)(q0 + r32) * NPROJ + C_AQ + head * 64 + hh * 8;
#pragma unroll
      for (int ks = 0; ks < 4; ++ks) qf[ks] = *(const bf16x8*)(qp + ks * 16); }
    f32x16 o0 = zero16(), o1 = zero16();
    float lsum = 0.f;
    f32x16 sinit;
    { float mq = fabsf(qnw[lane]), mk = fabsf(knw[lane]);
#pragma unroll
      for (int o = 32; o >= 1; o >>= 1) { mq = fmaxf(mq, __shfl_xor(mq, o)); mk = fmaxf(mk, __shfl_xor(mk, o)); }
      const float bnd = 64.f * 0.125f * 1.4426950408889634f * 1.01f * mq * mk;
#pragma unroll
      for (int i = 0; i < 16; ++i) sinit[i] = -bnd; }
    const int lrow = tid >> 3, lseg = tid & 7;
    const bf16_t* kptr = proj + (size_t)(start + lrow) * NPROJ + C_AK + kvh * 64 + lseg * 8;
    const bf16_t* vptr = vT + (size_t)(kvh * 64 + lrow) * T + start + lseg * 8;
    const int lds_off = lrow * 144 + lseg * 16;
    u32x4 kreg = *(const u32x4*)kptr, vreg = *(const u32x4*)vptr;
    *(LAS u32x4*)(lds + lds_off) = kreg; *(LAS u32x4*)(lds + 9216 + lds_off) = vreg;
    __syncthreads();
    for (int j = 0; j < nk; ++j) {
        const bool more = (j + 1 < nk);
        if (more) { kreg = *(const u32x4*)(kptr + (size_t)(j + 1) * 64 * NPROJ); vreg = *(const u32x4*)(vptr + (j + 1) * 64); }
        LAS unsigned char* Ks = lds + (j & 1) * 18432; LAS unsigned char* Vs = Ks + 9216;
        f32x16 s0 = sinit, s1 = sinit;
#pragma unroll
        for (int ks = 0; ks < 4; ++ks) {
            const bf16x8 a0 = *(const LAS bf16x8*)(Ks + r32 * 144 + (ks * 16 + hh * 8) * 2);
            const bf16x8 a1 = *(const LAS bf16x8*)(Ks + (32 + r32) * 144 + (ks * 16 + hh * 8) * 2);
            s0 = MFMA32(a0, qf[ks], s0); s1 = MFMA32(a1, qf[ks], s1);
        }
        float rs = 0.f;
#pragma unroll
        for (int i = 0; i < 16; ++i) { s0[i] = __builtin_amdgcn_exp2f(s0[i]); rs += s0[i]; }
#pragma unroll
        for (int i = 0; i < 16; ++i) { s1[i] = __builtin_amdgcn_exp2f(s1[i]); rs += s1[i]; }
        lsum += rs;
#pragma unroll
        for (int mb = 0; mb < 2; ++mb)
#pragma unroll
            for (int s = 0; s < 2; ++s) {
                u32x4 pk;
                if (mb == 0) { pk.x = cvtpk(s0[8 * s], s0[8 * s + 1]); pk.y = cvtpk(s0[8 * s + 2], s0[8 * s + 3]); pk.z = cvtpk(s0[8 * s + 4], s0[8 * s + 5]); pk.w = cvtpk(s0[8 * s + 6], s0[8 * s + 7]); }
                else         { pk.x = cvtpk(s1[8 * s], s1[8 * s + 1]); pk.y = cvtpk(s1[8 * s + 2], s1[8 * s + 3]); pk.z = cvtpk(s1[8 * s + 4], s1[8 * s + 5]); pk.w = cvtpk(s1[8 * s + 6], s1[8 * s + 7]); }
                const bf16x8 pb = __builtin_bit_cast(bf16x8, pk);
                const int keyoff = 32 * mb + 16 * s + 4 * hh;
                { const s16x4 lo = *(const LAS s16x4*)(Vs + r32 * 144 + keyoff * 2), hi = *(const LAS s16x4*)(Vs + r32 * 144 + (keyoff + 8) * 2);
                  const bf16x8 va = __builtin_shufflevector(lo, hi, 0, 1, 2, 3, 4, 5, 6, 7); o0 = MFMA32(va, pb, o0); }
                { const s16x4 lo = *(const LAS s16x4*)(Vs + (32 + r32) * 144 + keyoff * 2), hi = *(const LAS s16x4*)(Vs + (32 + r32) * 144 + (keyoff + 8) * 2);
                  const bf16x8 va = __builtin_shufflevector(lo, hi, 0, 1, 2, 3, 4, 5, 6, 7); o1 = MFMA32(va, pb, o1); }
            }
        if (more) { LAS unsigned char* Kn = lds + ((j + 1) & 1) * 18432; *(LAS u32x4*)(Kn + lds_off) = kreg; *(LAS u32x4*)(Kn + 9216 + lds_off) = vreg; }
        __syncthreads();
    }
    lsum += __shfl_xor(lsum, 32);
    const float inv = 1.f / lsum;
    bf16_t* op = mix + (size_t)(q0 + r32) * DM + 256 + head * 64;
#pragma unroll
    for (int g4 = 0; g4 < 4; ++g4) {
        u32x2 w0; w0.x = cvtpk(o0[4 * g4] * inv, o0[4 * g4 + 1] * inv); w0.y = cvtpk(o0[4 * g4 + 2] * inv, o0[4 * g4 + 3] * inv);
        *(u32x2*)(op + 8 * g4 + 4 * hh) = w0;
        u32x2 w1; w1.x = cvtpk(o1[4 * g4] * inv, o1[4 * g4 + 1] * inv); w1.y = cvtpk(o1[4 * g4 + 2] * inv, o1[4 * g4 + 3] * inv);
        *(u32x2*)(op + 32 + 8 * g4 + 4 * hh) = w1;
    }
}

constexpr int RW_BUF = 49152, RW_XR = 0, RW_XKD = 8192, RW_XV = 16384, RW_WLW = 24576, RW_ALB = 32768, RW_KKN = 40960, RW_YO = 98304, RW_XWD = 106496, RW_XAD = 111104,
              RW_W2T = 115712, RW_A2T = 124928, RW_CD = 134144, SLOT_OFF = 134400;
#define RW_BAR() asm volatile("s_waitcnt lgkmcnt(0)\n\ts_barrier" ::: "memory")
#define RW_DECODE(i_) const int t = (pt >> 4) + 16 * ((i_) / 5), c4 = (pt & 15) * 4; constexpr int gi = (i_) % 5; \
            const int col = (gi == 0) ? C_R + h * 64 + c4 : (gi == 1) ? C_K + h * 64 + c4 : (gi == 2) ? C_V + h * 64 + c4 : (gi == 3) ? C_WD + dir * 64 + c4 : C_AD + dir * 64 + c4;
#define RW_ISSUE1(chx, i_) { RW_DECODE(i_) \
            const int n = (chx) * 32 + t; const int pos = dir ? (len - 1 - n) : n; \
            const bf16_t* bp = proj + (size_t)(start + pos) * NPROJ + col; \
            rc[i_] = *(const u32x2*)bp; rp_[i_] = (u32x2){0u, 0u}; rn[i_] = (u32x2){0u, 0u}; \
            if (pos > 0) rp_[i_] = *(const u32x2*)(bp - NPROJ); \
            if (pos < len - 1) rn[i_] = *(const u32x2*)(bp + NPROJ); }
#define RW_ISSUE(chx) do { RW_ISSUE1(chx, 0) RW_ISSUE1(chx, 1) RW_ISSUE1(chx, 2) RW_ISSUE1(chx, 3) RW_ISSUE1(chx, 4) RW_ISSUE1(chx, 5) RW_ISSUE1(chx, 6) RW_ISSUE1(chx, 7) RW_ISSUE1(chx, 8) RW_ISSUE1(chx, 9) } while (0)
#define RW_CONV1(i_) { RW_DECODE(i_) \
            const f32x4 m4 = *(const f32x4*)(mu + col); \
            f32x4 x = {bflo(rc[i_].x), bfhi(rc[i_].x), bflo(rc[i_].y), bfhi(rc[i_].y)}; \
            const f32x4 pn = {bflo(rp_[i_].x) + bflo(rn[i_].x), bfhi(rp_[i_].x) + bfhi(rn[i_].x), bflo(rp_[i_].y) + bflo(rn[i_].y), bfhi(rp_[i_].y) + bfhi(rn[i_].y)}; \
            x = x + (0.5f * pn - x) * m4; \
            if (gi < 3) { LAS float* dst = (gi == 0) ? XR : (gi == 1) ? XKD : XV; *(LAS f32x4*)(dst + t * 64 + c4) = x; } \
            else if (gi == 3) { \
                _Pragma("unroll") for (int j = 0; j < 4; ++j) { const float e = __expf(2.f * x[j]); x[j] = 1.f - 2.f * frcp(e + 1.f); } \
                u32x2 w; w.x = cvtpk(x[0], x[1]); w.y = cvtpk(x[2], x[3]); *(LAS u32x2*)(XWD + t * 72 + c4) = w; } \
            else { u32x2 w; w.x = cvtpk(x[0], x[1]); w.y = cvtpk(x[2], x[3]); *(LAS u32x2*)(XAD + t * 72 + c4) = w; } }
template <int RPL> DI void rwkv_job(const KP& p, int l, int job, LAS unsigned char* lds, int tid) {
    int seq, h, dir, rpart; constexpr int nrows = 16 * RPL;
    if (RPL == 1) { seq = 8 + (job >> 5); h = (job >> 3) & 3; dir = (job >> 2) & 1; rpart = job & 3; }
    else { const int j = job - 64; seq = j >> 4; h = (j >> 2) & 3; dir = (j >> 1) & 1; rpart = j & 1; }
    int start, len; seq_info(seq, start, len);
    const bf16_t* proj = (const bf16_t*)(p.ws + WS_R);
    bf16_t* mix = (bf16_t*)(p.ws + WS_X1);
    bf16_t* yb = (bf16_t*)(p.ws + WS_YB);
    float* cdot = (float*)(p.ws + WS_CDOT);
    const float* mu = p.in[4] + l * 1152;
    const int wave = tid >> 6, lane = tid & 63, r32 = lane & 31, hh = lane >> 5;
    LAS bf16_t* XWD = (LAS bf16_t*)(lds + RW_XWD); LAS bf16_t* XAD = (LAS bf16_t*)(lds + RW_XAD);
    LAS bf16_t* W2T = (LAS bf16_t*)(lds + RW_W2T); LAS bf16_t* A2T = (LAS bf16_t*)(lds + RW_A2T);
    { const float* w2 = p.in[6] + (size_t)((l * 2 + dir) * 64) * 256 + h * 64; const float* a2 = p.in[8] + (size_t)((l * 2 + dir) * 64) * 256 + h * 64;
#pragma unroll
      for (int i = 0; i < 8; ++i) { const int idx = tid + NTHR * i; const int mm = idx >> 6, c = idx & 63; W2T[c * 72 + mm] = f2bf(w2[mm * 256 + c]); A2T[c * 72 + mm] = f2bf(a2[mm * 256 + c]); } }
    const int nch = len >> 5;
    __syncthreads();
    if (tid < 256) {
        const int rp2 = tid >> 4, sj = (tid & 15) * 4;
        f32x4 S0 = {0.f, 0.f, 0.f, 0.f}, S1 = {0.f, 0.f, 0.f, 0.f};
        RW_BAR(); RW_BAR(); RW_BAR();
        for (int ch = 0; ch < nch; ++ch) {
            LAS unsigned char* B = lds + (ch & 1) * RW_BUF;
            LAS float* XR = (LAS float*)(B + RW_XR); LAS float* XKD = (LAS float*)(B + RW_XKD); LAS float* XV = (LAS float*)(B + RW_XV);
            LAS float* WLW = (LAS float*)(B + RW_WLW); LAS float* ALB = (LAS float*)(B + RW_ALB); LAS float* KKN = (LAS float*)(B + RW_KKN);
            LAS float* YO = (LAS float*)(lds + RW_YO + (ch & 1) * 4096);
            f32x4 w4 = *(const LAS f32x4*)(WLW + sj), k4 = *(const LAS f32x4*)(KKN + sj), b4 = *(const LAS f32x4*)(ALB + sj), d4 = *(const LAS f32x4*)(XKD + sj), r4 = *(const LAS f32x4*)(XR + sj);
            f32x2 v2; if (RPL == 2) v2 = *(const LAS f32x2*)(XV + rpart * 32 + 2 * rp2); else { v2[0] = XV[rpart * 16 + rp2]; v2[1] = 0.f; }
#pragma unroll 2
            for (int t = 0; t < 32; ++t) {
                const int tn = (t < 31) ? t + 1 : 31;
                const f32x4 w4n = *(const LAS f32x4*)(WLW + tn * 64 + sj), k4n = *(const LAS f32x4*)(KKN + tn * 64 + sj), b4n = *(const LAS f32x4*)(ALB + tn * 64 + sj),
                            d4n = *(const LAS f32x4*)(XKD + tn * 64 + sj), r4n = *(const LAS f32x4*)(XR + tn * 64 + sj);
                f32x2 v2n; if (RPL == 2) v2n = *(const LAS f32x2*)(XV + tn * 64 + rpart * 32 + 2 * rp2); else { v2n[0] = XV[tn * 64 + rpart * 16 + rp2]; v2n[1] = 0.f; }
                float sa0 = S0[0] * k4[0] + S0[1] * k4[1] + S0[2] * k4[2] + S0[3] * k4[3];
                float sa1 = 0.f, y1 = 0.f;
                if (RPL == 2) sa1 = S1[0] * k4[0] + S1[1] * k4[1] + S1[2] * k4[2] + S1[3] * k4[3];
                sa0 = -red16(sa0); if (RPL == 2) sa1 = -red16(sa1);
                S0 = S0 * w4 + sa0 * b4 + v2[0] * d4;
                if (RPL == 2) S1 = S1 * w4 + sa1 * b4 + v2[1] * d4;
                float y0 = S0[0] * r4[0] + S0[1] * r4[1] + S0[2] * r4[2] + S0[3] * r4[3];
                if (RPL == 2) y1 = S1[0] * r4[0] + S1[1] * r4[1] + S1[2] * r4[2] + S1[3] * r4[3];
                y0 = red16(y0); if (RPL == 2) y1 = red16(y1);
                if ((tid & 15) == 0) { if (RPL == 2) { f32x2 yy = {y0, y1}; *(LAS f32x2*)(YO + t * 32 + 2 * rp2) = yy; } else YO[t * 32 + rp2] = y0; }
                w4 = w4n; k4 = k4n; b4 = b4n; d4 = d4n; r4 = r4n; v2 = v2n;
                if (t == 10 || t == 21) RW_BAR();
            }
            RW_BAR();
        }
    } else {
        const int ptid = tid - 256;
        const int cli = ptid & 15, cc4 = cli * 4;
        const f32x4 w0v = *(const f32x4*)(p.in[5] + (l * 2 + dir) * 256 + h * 64 + cc4);
        const f32x4 a0v = *(const f32x4*)(p.in[7] + (l * 2 + dir) * 256 + h * 64 + cc4);
        const f32x4 kkw = *(const f32x4*)(p.in[10] + l * 256 + h * 64 + cc4);
        const f32x4 kaw = *(const f32x4*)(p.in[11] + l * 256 + h * 64 + cc4);
        const f32x4 rkw = *(const f32x4*)(p.in[12] + l * 256 + h * 64 + cc4);
        u32x2 rc[10], rp_[10], rn[10];
        { int pt = ptid; RW_ISSUE(0); }
        for (int ch = -1; ch < nch; ++ch) {
            int pt = ptid; asm volatile("" : "+v"(pt));
            if (ch >= 1) {
                const int pc = ch - 1;
                LAS float* YO = (LAS float*)(lds + RW_YO + (pc & 1) * 4096); LAS float* CD = (LAS float*)(lds + RW_CD + (pc & 1) * 128);
                const int t = ptid >> 3, c4 = (ptid & 7) * 4;
                const int n = pc * 32 + t; const int pos = dir ? (len - 1 - n) : n; const int tok = start + pos;
                const f32x4 yv = *(const LAS f32x4*)(YO + t * 32 + c4);
                u32x2 w; w.x = cvtpk(yv[0], yv[1]); w.y = cvtpk(yv[2], yv[3]);
                if (c4 < nrows) { if (dir) *(u32x2*)(yb + (size_t)tok * 256 + h * 64 + rpart * nrows + c4) = w; else *(u32x2*)(mix + (size_t)tok * DM + h * 64 + rpart * nrows + c4) = w; }
                if (rpart == 0 && ptid < 32) { const int n2 = pc * 32 + ptid; const int pos2 = dir ? (len - 1 - n2) : n2; cdot[((size_t)(start + pos2) * 4 + h) * 2 + dir] = CD[ptid]; }
            }
            const int nc = ch + 1;
            const bool build = nc < nch;
            LAS unsigned char* B = lds + (nc & 1) * RW_BUF;
            LAS float* XR = (LAS float*)(B + RW_XR); LAS float* XKD = (LAS float*)(B + RW_XKD); LAS float* XV = (LAS float*)(B + RW_XV);
            LAS float* WLW = (LAS float*)(B + RW_WLW); LAS float* ALB = (LAS float*)(B + RW_ALB); LAS float* KKN = (LAS float*)(B + RW_KKN);
            LAS float* CDn = (LAS float*)(lds + RW_CD + (nc & 1) * 128);
            if (build) {
                RW_CONV1(0) RW_CONV1(1) RW_CONV1(2) RW_CONV1(3) RW_CONV1(4) RW_CONV1(5) RW_CONV1(6) RW_CONV1(7) RW_CONV1(8) RW_CONV1(9)
                if (nc + 1 < nch) RW_ISSUE(nc + 1);
            }
            RW_BAR();
            if (build) {
                const int mat = (wave - 4) >> 1, nb = (wave - 4) & 1;
                LAS bf16_t* Xs = mat ? XAD : XWD; LAS bf16_t* Ws = mat ? A2T : W2T;
                f32x16 acc = zero16();
#pragma unroll
                for (int ks = 0; ks < 4; ++ks) {
                    const bf16x8 a = *(const LAS bf16x8*)(Xs + r32 * 72 + ks * 16 + hh * 8);
                    const bf16x8 bb = *(const LAS bf16x8*)(Ws + (nb * 32 + r32) * 72 + ks * 16 + hh * 8);
                    acc = MFMA32(a, bb, acc);
                }
                LAS float* dst = mat ? ALB : WLW;
#pragma unroll
                for (int i = 0; i < 16; ++i) dst[crow(i, hh) * 64 + nb * 32 + r32] = acc[i];
            }
            RW_BAR();
            if (build) {
#pragma unroll
                for (int it = 0; it < 2; ++it) {
                    const int ct = (ptid >> 4) + 16 * it;
                    const f32x4 wl = *(const LAS f32x4*)(WLW + ct * 64 + cc4), al = *(const LAS f32x4*)(ALB + ct * 64 + cc4);
                    const f32x4 k4 = *(const LAS f32x4*)(XKD + ct * 64 + cc4), r4 = *(const LAS f32x4*)(XR + ct * 64 + cc4);
                    f32x4 w, a, kkr, kd;
                    float ssq = 0.f, cd = 0.f;
#pragma unroll
                    for (int j = 0; j < 4; ++j) {
                        const float sg = sigmoidf_(w0v[j] + wl[j]);
                        w[j] = __expf(-0.6065306597126334f * sg);
                        a[j] = sigmoidf_(a0v[j] + al[j]);
                        kkr[j] = k4[j] * kkw[j]; ssq += kkr[j] * kkr[j];
                        kd[j] = k4[j] * (1.f + (a[j] - 1.f) * kaw[j]);
                        cd += r4[j] * kd[j] * rkw[j];
                    }
                    ssq = red16(ssq); cd = red16(cd);
                    const float inv = __builtin_amdgcn_rsqf(fmaxf(ssq, 1e-24f));
                    f32x4 kkn, bv;
#pragma unroll
                    for (int j = 0; j < 4; ++j) { kkn[j] = kkr[j] * inv; bv[j] = kkn[j] * a[j]; }
                    *(LAS f32x4*)(WLW + ct * 64 + cc4) = w; *(LAS f32x4*)(ALB + ct * 64 + cc4) = bv; *(LAS f32x4*)(KKN + ct * 64 + cc4) = kkn; *(LAS f32x4*)(XKD + ct * 64 + cc4) = kd;
                    if (cli == 0) CDn[ct] = cd;
                }
            }
            RW_BAR();
        }
        {
            const int pc = nch - 1;
            LAS float* YO = (LAS float*)(lds + RW_YO + (pc & 1) * 4096); LAS float* CD = (LAS float*)(lds + RW_CD + (pc & 1) * 128);
            const int t = ptid >> 3, c4 = (ptid & 7) * 4;
            const int n = pc * 32 + t; const int pos = dir ? (len - 1 - n) : n; const int tok = start + pos;
            const f32x4 yv = *(const LAS f32x4*)(YO + t * 32 + c4);
            u32x2 w; w.x = cvtpk(yv[0], yv[1]); w.y = cvtpk(yv[2], yv[3]);
            if (c4 < nrows) { if (dir) *(u32x2*)(yb + (size_t)tok * 256 + h * 64 + rpart * nrows + c4) = w; else *(u32x2*)(mix + (size_t)tok * DM + h * 64 + rpart * nrows + c4) = w; }
            if (rpart == 0 && ptid < 32) { const int n2 = pc * 32 + ptid; const int pos2 = dir ? (len - 1 - n2) : n2; cdot[((size_t)(start + pos2) * 4 + h) * 2 + dir] = CD[ptid]; }
        }
    }
    __syncthreads();
}

constexpr int ML_QS = 0, ML_KS = 9216, ML_KT = 18432, ML_VT = 27648, ML_VWT = 36864, ML_PS = 46080, ML_CB = 55296, ML_WGT = 64512, ML_RR = 64768, ML_MROW = 65024,
              ML_SC = 65280, ML_EMT = 65536, ML_DENI = 65792, ML_NS = 66048, ML_A12 = 66304;
DI void mlstm_job(const KP& p, int l, int job, LAS unsigned char* lds, int tid) {
    int seq, hm, dir; seq_of_job(job, seq, hm, dir);
    int start, len; seq_info(seq, start, len);
    const bf16_t* proj = (const bf16_t*)(p.ws + WS_R);
    bf16_t* mix = (bf16_t*)(p.ws + WS_X1);
    bf16_t* hbp = (bf16_t*)(p.ws + WS_HBP);
    const float* cw = p.in[17] + l * 3 * 512;
    const float ibv = p.in[18][(l * 2 + dir) * 4 + hm], fbv = p.in[19][(l * 2 + dir) * 4 + hm];
    const int wave = tid >> 6, lane = tid & 63, r32 = lane & 31, hh = lane >> 5;
    LAS bf16_t* Qs = (LAS bf16_t*)(lds + ML_QS); LAS bf16_t* Ks = (LAS bf16_t*)(lds + ML_KS); LAS bf16_t* KT = (LAS bf16_t*)(lds + ML_KT);
    LAS bf16_t* VT = (LAS bf16_t*)(lds + ML_VT); LAS bf16_t* VWT = (LAS bf16_t*)(lds + ML_VWT); LAS bf16_t* Ps = (LAS bf16_t*)(lds + ML_PS); LAS bf16_t* CB = (LAS bf16_t*)(lds + ML_CB);
    LAS float* WGT = (LAS float*)(lds + ML_WGT); LAS float* RR = (LAS float*)(lds + ML_RR); LAS float* MROW = (LAS float*)(lds + ML_MROW); LAS float* SC = (LAS float*)(lds + ML_SC);
    LAS float* EMT = (LAS float*)(lds + ML_EMT); LAS float* DENI = (LAS float*)(lds + ML_DENI); LAS float* NS = (LAS float*)(lds + ML_NS); LAS float* A12 = (LAS float*)(lds + ML_A12);
    for (int i = tid; i < 64 * 72; i += NTHR) CB[i] = 0;
    if (tid < 64) NS[tid] = 0.f;
    f32x16 Creg = zero16();
    float Mst = 0.f;
    __syncthreads();
    const int nch = len >> 6;
    const int ll = tid >> 3, e8 = (tid & 7) * 8;
    for (int ch = 0; ch < nch; ++ch) {
        {
            const int n = ch * 64 + ll; const int pos = dir ? (len - 1 - n) : n; const int tok = start + pos;
#pragma unroll
            for (int which = 0; which < 2; ++which) {
                const int col = (which ? C_MK : C_MQ) + hm * 64 + e8; const int cwc = (which ? 256 : 0) + hm * 64 + e8;
                const bf16_t* bp = proj + (size_t)tok * NPROJ + col;
                const u32x4 cu = *(const u32x4*)bp; u32x4 pv = {0u, 0u, 0u, 0u}, nv = {0u, 0u, 0u, 0u};
                if (pos > 0) pv = *(const u32x4*)(bp - NPROJ);
                if (pos < len - 1) nv = *(const u32x4*)(bp + NPROJ);
                float o[8];
#pragma unroll
                for (int j = 0; j < 4; ++j) {
                    const f32x2 c0 = *(const f32x2*)(cw + cwc + 2 * j), c1 = *(const f32x2*)(cw + 512 + cwc + 2 * j), c2 = *(const f32x2*)(cw + 1024 + cwc + 2 * j);
                    const float v0 = c0.x * bflo(pv[j]) + c1.x * bflo(cu[j]) + c2.x * bflo(nv[j]);
                    const float v1 = c0.y * bfhi(pv[j]) + c1.y * bfhi(cu[j]) + c2.y * bfhi(nv[j]);
                    o[2 * j] = v0 * sigmoidf_(v0); o[2 * j + 1] = v1 * sigmoidf_(v1);
                }
                if (which) {
#pragma unroll
                    for (int j = 0; j < 8; ++j) o[j] *= 0.125f;
                }
                u32x4 w; w.x = cvtpk(o[0], o[1]); w.y = cvtpk(o[2], o[3]); w.z = cvtpk(o[4], o[5]); w.w = cvtpk(o[6], o[7]);
                if (!which) *(LAS u32x4*)(Qs + ll * 72 + e8) = w;
                else { *(LAS u32x4*)(Ks + ll * 72 + e8) = w;
#pragma unroll
                    for (int j = 0; j < 4; ++j) { KT[(e8 + 2 * j) * 72 + ll] = (bf16_t)(w[j] & 0xffffu); KT[(e8 + 2 * j + 1) * 72 + ll] = (bf16_t)(w[j] >> 16); } }
            }
        }
        if (wave == 0) {
            const int n = ch * 64 + lane; const int pos = dir ? (len - 1 - n) : n; const int tok = start + pos;
            const float igv = bf2f(proj[(size_t)tok * NPROJ + C_IG + dir * 4 + hm]) + ibv;
            const float fgv = bf2f(proj[(size_t)tok * NPROJ + C_FG + dir * 4 + hm]) + fbv;
            const float lf = (fgv > 0.f) ? -log1pf(__expf(-fgv)) : (fgv - log1pf(__expf(fgv)));
            float b = lf;
#pragma unroll
            for (int o = 1; o < 64; o <<= 1) { const float t2 = __shfl_up(b, o); if (lane >= o) b += t2; }
            const float bL = __shfl(b, 63);
            const float g = bL - b + igv;
            float mg = g;
#pragma unroll
            for (int o = 32; o >= 1; o >>= 1) mg = fmaxf(mg, __shfl_xor(mg, o));
            const float wgt = __expf(g - mg);
            const float r = igv - b;
            float cm = r;
#pragma unroll
            for (int o = 1; o < 64; o <<= 1) { const float t2 = __shfl_up(cm, o); if (lane >= o) cm = fmaxf(cm, t2); }
            const float mrow = fmaxf(cm, Mst);
            WGT[lane] = wgt; RR[lane] = r; MROW[lane] = mrow; SC[lane] = __expf(Mst - mrow); EMT[lane] = __expf(-(b + mrow));
            const float Mnew = fmaxf(bL + Mst, mg);
            if (lane == 0) { A12[0] = __expf(bL + Mst - Mnew); A12[1] = __expf(mg - Mnew); }
            Mst = Mnew;
        }
        __syncthreads();
        {
            const int n = ch * 64 + ll; const int pos = dir ? (len - 1 - n) : n; const int tok = start + pos;
            const u32x4 vv = *(const u32x4*)(proj + (size_t)tok * NPROJ + C_MV + hm * 64 + e8);
            const float wg = WGT[ll];
#pragma unroll
            for (int j = 0; j < 4; ++j) {
                VT[(e8 + 2 * j) * 72 + ll] = (bf16_t)(vv[j] & 0xffffu); VT[(e8 + 2 * j + 1) * 72 + ll] = (bf16_t)(vv[j] >> 16);
                const unsigned pw = cvtpk(bflo(vv[j]) * wg, bfhi(vv[j]) * wg);
                VWT[(e8 + 2 * j) * 72 + ll] = (bf16_t)(pw & 0xffffu); VWT[(e8 + 2 * j + 1) * 72 + ll] = (bf16_t)(pw >> 16);
            }
        }
        __syncthreads();
        if (wave < 4) {
            const int tb = wave >> 1, sb = wave & 1;
            f32x16 acc = zero16();
#pragma unroll
            for (int ks = 0; ks < 4; ++ks) {
                const bf16x8 a = *(const LAS bf16x8*)(Qs + (tb * 32 + r32) * 72 + ks * 16 + hh * 8);
                const bf16x8 b = *(const LAS bf16x8*)(Ks + (sb * 32 + r32) * 72 + ks * 16 + hh * 8);
                acc = MFMA32(a, b, acc);
            }
            const int s = sb * 32 + r32; const float rs_ = RR[s];
#pragma unroll
            for (int i = 0; i < 16; ++i) { const int t = tb * 32 + crow(i, hh); const float pvv = (s <= t) ? __expf(rs_ - MROW[t]) * acc[i] : 0.f; Ps[t * 72 + s] = f2bf(pvv); }
        } else {
            const int db = (wave - 4) >> 1, eb = (wave - 4) & 1;
            f32x16 kc = zero16();
#pragma unroll
            for (int ks = 0; ks < 4; ++ks) {
                const bf16x8 a = *(const LAS bf16x8*)(VWT + (db * 32 + r32) * 72 + ks * 16 + hh * 8);
                const bf16x8 b = *(const LAS bf16x8*)(KT + (eb * 32 + r32) * 72 + ks * 16 + hh * 8);
                kc = MFMA32(a, b, kc);
            }
            const float a1 = A12[0], a2 = A12[1];
#pragma unroll
            for (int i = 0; i < 16; ++i) Creg[i] = a1 * Creg[i] + a2 * kc[i];
        }
        __syncthreads();
        f32x16 acc = zero16();
        float ncv = 0.f;
        if (wave < 4) {
            const int tb = wave >> 1, db = wave & 1;
#pragma unroll
            for (int ks = 0; ks < 4; ++ks) {
                const bf16x8 a = *(const LAS bf16x8*)(Qs + (tb * 32 + r32) * 72 + ks * 16 + hh * 8);
                const bf16x8 b = *(const LAS bf16x8*)(CB + (db * 32 + r32) * 72 + ks * 16 + hh * 8);
                acc = MFMA32(a, b, acc);
            }
#pragma unroll
            for (int i = 0; i < 16; ++i) acc[i] *= SC[tb * 32 + crow(i, hh)];
#pragma unroll
            for (int ks = 0; ks < 4; ++ks) {
                const bf16x8 a = *(const LAS bf16x8*)(Ps + (tb * 32 + r32) * 72 + ks * 16 + hh * 8);
                const bf16x8 b = *(const LAS bf16x8*)(VT + (db * 32 + r32) * 72 + ks * 16 + hh * 8);
                acc = MFMA32(a, b, acc);
            }
        } else if (wave == 4) {
            float rsum = 0.f, qn = 0.f;
            for (int e = 0; e < 64; ++e) { rsum += bf2f(Ps[lane * 72 + e]); qn += bf2f(Qs[lane * 72 + e]) * NS[e]; }
            const float den = rsum + SC[lane] * qn;
            DENI[lane] = 1.f / fmaxf(fabsf(den), EMT[lane]);
        } else if (wave == 5) {
            for (int s = 0; s < 64; ++s) ncv += WGT[s] * bf2f(KT[lane * 72 + s]);
        }
        __syncthreads();
        if (wave < 4) {
            const int tb = wave >> 1, db = wave & 1;
#pragma unroll
            for (int i = 0; i < 16; ++i) {
                const int t = tb * 32 + crow(i, hh); const int n = ch * 64 + t; const int pos = dir ? (len - 1 - n) : n; const int tok = start + pos;
                const bf16_t o = f2bf(acc[i] * DENI[t]);
                if (dir) hbp[(size_t)tok * 256 + hm * 64 + db * 32 + r32] = o; else mix[(size_t)tok * DM + 768 + hm * 64 + db * 32 + r32] = o;
            }
        } else {
            const int db = (wave - 4) >> 1, eb = (wave - 4) & 1;
#pragma unroll
            for (int i = 0; i < 16; ++i) CB[(db * 32 + crow(i, hh)) * 72 + eb * 32 + r32] = f2bf(Creg[i]);
            if (wave == 5) NS[lane] = A12[0] * NS[lane] + A12[1] * ncv;
        }
        __syncthreads();
    }
}

DI void mixers_phase(const KP& p, int l, int cidx, LAS unsigned char* lds, int tid, int G, int bid) {
    unsigned* cnt = (unsigned*)(p.ws + WS_CNT) + cidx;
    LAS int* slot = (LAS int*)(lds + SLOT_OFF);
    for (;;) {
        if (tid == 0) *slot = (int)atomicAdd(cnt, 1u);
        __syncthreads();
        const int item = *slot;
        __syncthreads();
        if (item >= 272 + 1536) break;
        int kind, jb;
        if (item < 64) { kind = 0; jb = item; } else if (item < 80) { kind = 1; jb = item - 64; } else if (item < 208) { kind = 3; jb = item - 80 + 64; }
        else if (item < 272) { kind = 1; jb = item - 208 + 16; } else { kind = 2; jb = item - 272; }
        int t2 = tid; asm volatile("" : "+v"(t2));
#ifndef REP_R
#define REP_R 1
#endif
#ifndef REP_M
#define REP_M 1
#endif
#ifndef REP_T
#define REP_T 1
#endif
        if (kind == 0) { rwkv_job<1>(p, l, jb, lds, t2); }
        else if (kind == 3) { rwkv_job<2>(p, l, jb, lds, t2); }
        else if (kind == 1) { for (int rep = 0; rep < REP_M; ++rep) { mlstm_job(p, l, jb, lds, t2); __syncthreads(); } }
        else { for (int rep = 0; rep < REP_T; ++rep) { attn_unit(p, l, jb, lds, t2); __syncthreads(); } }
        __syncthreads();
    }
}

constexpr int PO_G2T = 0, PO_AS = 69632, PO_GO = 87040;
DI void post_phase(const KP& p, int l, LAS unsigned char* lds, int tid, int G, int bid) {
    const bf16_t* proj = (const bf16_t*)(p.ws + WS_R);
    bf16_t* mix = (bf16_t*)(p.ws + WS_X1);
    const bf16_t* yb = (const bf16_t*)(p.ws + WS_YB);
    const bf16_t* hbp = (const bf16_t*)(p.ws + WS_HBP);
    const float* cdot = (const float*)(p.ws + WS_CDOT);
    const float* mu = p.in[4] + l * 1152;
    const float* lnw = p.in[13] + l * 256; const float* lnb = p.in[14] + l * 256; const float* nw = p.in[20] + l * 256;
    LAS bf16_t* G2T = (LAS bf16_t*)(lds + PO_G2T); LAS bf16_t* AS = (LAS bf16_t*)(lds + PO_AS); LAS bf16_t* GO = (LAS bf16_t*)(lds + PO_GO);
    const int wave = tid >> 6, lane = tid & 63, r32 = lane & 31, hh = lane >> 5;
    { const float* g2 = p.in[9] + (size_t)l * 128 * 256;
      for (int i = 0; i < 64; ++i) { const int idx = tid + NTHR * i; const int mm = idx >> 8, c = idx & 255; G2T[c * 136 + mm] = f2bf(g2[idx]); } }
    __syncthreads();
    for (int unit = bid; unit < T / 64; unit += G) {
        const int tok0 = unit * 64;
        int len; const int st = tok_seq_start(tok0, len);
#pragma unroll
        for (int i = 0; i < 4; ++i) {
            const int q = tid + NTHR * i; const int t = q >> 5, c4 = (q & 31) * 4; const int tok = tok0 + t; const int pos = tok - st;
            const bf16_t* bp = proj + (size_t)tok * NPROJ + C_GD + c4;
            const u32x2 cu = *(const u32x2*)bp; u32x2 pv = {0u, 0u}, nv = {0u, 0u};
            if (pos > 0) pv = *(const u32x2*)(bp - NPROJ);
            if (pos < len - 1) nv = *(const u32x2*)(bp + NPROJ);
            const f32x4 m4 = *(const f32x4*)(mu + C_GD + c4);
            float x[4] = {bflo(cu.x), bfhi(cu.x), bflo(cu.y), bfhi(cu.y)};
            const float pn[4] = {bflo(pv.x) + bflo(nv.x), bfhi(pv.x) + bfhi(nv.x), bflo(pv.y) + bflo(nv.y), bfhi(pv.y) + bfhi(nv.y)};
#pragma unroll
            for (int j = 0; j < 4; ++j) x[j] = sigmoidf_(x[j] + (0.5f * pn[j] - x[j]) * m4[j]);
            u32x2 w; w.x = cvtpk(x[0], x[1]); w.y = cvtpk(x[2], x[3]); *(LAS u32x2*)(AS + t * 136 + c4) = w;
        }
        __syncthreads();
        {
            const int hd = wave & 3, tb = wave >> 2;
            f32x16 a0 = zero16(), a1 = zero16();
#pragma unroll
            for (int ks = 0; ks < 8; ++ks) {
                const bf16x8 a = *(const LAS bf16x8*)(AS + (tb * 32 + r32) * 136 + ks * 16 + hh * 8);
                const bf16x8 b0 = *(const LAS bf16x8*)(G2T + (hd * 64 + r32) * 136 + ks * 16 + hh * 8);
                const bf16x8 b1 = *(const LAS bf16x8*)(G2T + (hd * 64 + 32 + r32) * 136 + ks * 16 + hh * 8);
                a0 = MFMA32(a, b0, a0); a1 = MFMA32(a, b1, a1);
            }
#pragma unroll
            for (int i = 0; i < 16; ++i) { const int t = tb * 32 + crow(i, hh); GO[t * 264 + hd * 64 + r32] = f2bf(a0[i]); GO[t * 264 + hd * 64 + 32 + r32] = f2bf(a1[i]); }
        }
        __syncthreads();
#pragma unroll 1
        for (int it = 0; it < 8; ++it) {
            const int task = tid + NTHR * it; const int grp = task >> 4, li = task & 15; const int t = grp >> 2, hd = grp & 3; const int c4 = li * 4;
            const int tok = tok0 + t; const int pos = tok - st;
            {
                const u32x2 yf = *(const u32x2*)(mix + (size_t)tok * DM + hd * 64 + c4), ybv = *(const u32x2*)(yb + (size_t)tok * 256 + hd * 64 + c4);
                float x[4] = {bflo(yf.x) + bflo(ybv.x), bfhi(yf.x) + bfhi(ybv.x), bflo(yf.y) + bflo(ybv.y), bfhi(yf.y) + bfhi(ybv.y)};
                const float mean = red16(x[0] + x[1] + x[2] + x[3]) * (1.f / 64.f);
                float vs = 0.f;
#pragma unroll
                for (int j = 0; j < 4; ++j) { x[j] -= mean; vs += x[j] * x[j]; }
                const float rstd = rsqrtf(red16(vs) * (1.f / 64.f) + 64e-5f);
                const bf16_t* bp = proj + (size_t)tok * NPROJ + C_V + hd * 64 + c4;
                const u32x2 cu = *(const u32x2*)bp; u32x2 pv = {0u, 0u}, nv = {0u, 0u};
                if (pos > 0) pv = *(const u32x2*)(bp - NPROJ);
                if (pos < len - 1) nv = *(const u32x2*)(bp + NPROJ);
                const f32x4 m4 = *(const f32x4*)(mu + C_V + hd * 64 + c4);
                float v[4] = {bflo(cu.x), bfhi(cu.x), bflo(cu.y), bfhi(cu.y)};
                const float pn[4] = {bflo(pv.x) + bflo(nv.x), bfhi(pv.x) + bfhi(nv.x), bflo(pv.y) + bflo(nv.y), bfhi(pv.y) + bfhi(nv.y)};
                const f32x2 cdv = *(const f32x2*)(cdot + ((size_t)tok * 4 + hd) * 2);
                const float cds = cdv.x + cdv.y;
                const f32x4 lw = *(const f32x4*)(lnw + hd * 64 + c4), lb = *(const f32x4*)(lnb + hd * 64 + c4);
                const u32x2 gv = *(const LAS u32x2*)(GO + t * 264 + hd * 64 + c4);
                const float g[4] = {bflo(gv.x), bfhi(gv.x), bflo(gv.y), bfhi(gv.y)};
                float o[4];
#pragma unroll
                for (int j = 0; j < 4; ++j) { const float vsft = v[j] + (0.5f * pn[j] - v[j]) * m4[j]; o[j] = (x[j] * rstd * lw[j] + lb[j] + cds * vsft) * g[j]; }
                u32x2 w; w.x = cvtpk(o[0], o[1]); w.y = cvtpk(o[2], o[3]); *(u32x2*)(mix + (size_t)tok * DM + hd * 64 + c4) = w;
            }
            {
                const u32x2 hf = *(const u32x2*)(mix + (size_t)tok * DM + 768 + hd * 64 + c4), hb = *(const u32x2*)(hbp + (size_t)tok * 256 + hd * 64 + c4);
                const float x[4] = {bflo(hf.x) + bflo(hb.x), bfhi(hf.x) + bfhi(hb.x), bflo(hf.y) + bflo(hb.y), bfhi(hf.y) + bfhi(hb.y)};
                const float ms = red16(x[0] * x[0] + x[1] * x[1] + x[2] * x[2] + x[3] * x[3]) * (1.f / 64.f);
                const float rinv = rsqrtf(ms + 1e-6f);
                const u32x2 ov = *(const u32x2*)(proj + (size_t)tok * NPROJ + C_MO + hd * 64 + c4);
                const float og[4] = {bflo(ov.x), bfhi(ov.x), bflo(ov.y), bfhi(ov.y)};
                const f32x4 nwv = *(const f32x4*)(nw + hd * 64 + c4);
                float o[4];
#pragma unroll
                for (int j = 0; j < 4; ++j) o[j] = sigmoidf_(og[j]) * x[j] * rinv * nwv[j];
                u32x2 w; w.x = cvtpk(o[0], o[1]); w.y = cvtpk(o[2], o[3]); *(u32x2*)(mix + (size_t)tok * DM + 768 + hd * 64 + c4) = w;
            }
        }
        __syncthreads();
    }
}

DI void final_phase(const KP& p, int tid, int G, int bid) {
    const float* ss = (const float*)(p.ws + WS_SS) + 4 * T;
    const float* g = p.in[25];
    for (size_t i = (size_t)bid * NTHR + tid; i < (size_t)T * 256; i += (size_t)G * NTHR) {
        const int row = (int)(i >> 8), c = (int)(i & 255) * 4;
        const float rs = rsqrtf(ss[row] * (1.f / 1024.f) + 1e-6f);
        f32x4 v = *(const f32x4*)(p.out + i * 4); const f32x4 gv = *(const f32x4*)(g + c);
        v[0] *= rs * gv[0]; v[1] *= rs * gv[1]; v[2] *= rs * gv[2]; v[3] *= rs * gv[3];
        *(f32x4*)(p.out + i * 4) = v;
    }
}

__global__ void __launch_bounds__(NTHR, 2) fwd_kernel(KP p) {
    extern __shared__ __attribute__((aligned(16))) unsigned char lds_raw[];
    LAS unsigned char* lds = (LAS unsigned char*)lds_raw;
    cg::grid_group grid = cg::this_grid();
    int tid = threadIdx.x; const int G = gridDim.x, bid = blockIdx.x;
#define LAUNDER() asm volatile("" : "+v"(tid))
    float* ss = (float*)(p.ws + WS_SS);
    bf16_t* X1 = (bf16_t*)(p.ws + WS_X1);
    bf16_t* PROJ = (bf16_t*)(p.ws + WS_R);
    bf16_t* HB = (bf16_t*)(p.ws + WS_R);
    bf16_t* HID = (bf16_t*)(p.ws + WS_HID);

        LAUNDER();
    p0_phase(p, lds, tid, G, bid);
    grid.sync();
    for (int l = 0; l < 2; ++l) {
        {
            pg8::Gemm g{X1, (const bf16_t*)(p.ws + WS_WIN) + (size_t)l * NPROJ * 1024, T, NPROJ, 1024}; pg8::StaticOrder S; S.init(T, NPROJ, G, bid);
            EpiProj E{PROJ, ss + (2 * l) * T};
            pg8::gemm_phase<EpiProj, pg8::StaticOrder, true, true>(lds, g, S, E);
#ifdef PROBE_P1X2
            grid.sync();
            pg8::gemm_phase<EpiProj, pg8::StaticOrder, true, true>(lds, g, S, E);
#endif
        }
        grid.sync();
        LAUNDER();
        prep_phase(p, l, lds, tid, G, bid);
        grid.sync();
        LAUNDER();
        mixers_phase(p, l, l, lds, tid, G, bid);
#ifdef PROBE_MIX2
        grid.sync(); LAUNDER();
        mixers_phase(p, l, l + 2, lds, tid, G, bid);
#endif
        grid.sync();
        LAUNDER();
        post_phase(p, l, lds, tid, G, bid);
        grid.sync();
        {
            pg8::Gemm g{X1, (const bf16_t*)(p.ws + WS_WOUT) + (size_t)l * 1024 * 1024, T, DM, 1024}; pg8::StaticOrder S; S.init(T, DM, G, bid);
            EpiRes<true, true> E{p.out, HB, ss + (2 * l + 1) * T};
            pg8::gemm_phase<EpiRes<true, true>, pg8::StaticOrder, true, true>(lds, g, S, E);
        }
        grid.sync();
        for (int hf = 0; hf < 2; ++hf) {
            {
                pg8::Gemm g{HB, (const bf16_t*)(p.ws + WS_W1) + (size_t)l * 4096 * 1024 + (size_t)hf * HFF * 1024, T, HFF, 1024}; pg8::StaticOrder S; S.init(T, HFF, G, bid);
                EpiRelu2 E{HID, ss + (2 * l + 1) * T};
                pg8::gemm_phase<EpiRelu2, pg8::StaticOrder, true, true>(lds, g, S, E);
            }
            grid.sync();
            {
                pg8::Gemm g{HID, (const bf16_t*)(p.ws + WS_W2) + (size_t)l * 2 * 1024 * 2048 + (size_t)hf * 1024 * 2048, T, DM, HFF}; pg8::StaticOrder S; S.init(T, DM, G, bid);
                if (hf == 0) { EpiRes<false, false> E{p.out, nullptr, nullptr}; pg8::gemm_phase<EpiRes<false, false>, pg8::StaticOrder, true, true>(lds, g, S, E); }
                else { EpiRes<true, true> E{p.out, X1, ss + (2 * l + 2) * T}; pg8::gemm_phase<EpiRes<true, true>, pg8::StaticOrder, true, true>(lds, g, S, E); }
            }
            grid.sync();
        }
    }
        LAUNDER();
    final_phase(p, tid, G, bid);
}

extern "C" void kernel_launch(void* const* d_in, const int* in_sizes, int n_in, void* d_out, int out_size, void* d_ws, size_t ws_size, hipStream_t stream) {
    static int grid_blocks = 0;
    if (grid_blocks == 0) {
        if (n_in != 26 || out_size != T * DM || ws_size < WS_END) { fprintf(stderr, "kernel_launch: unexpected shapes (n_in %d out %d ws %zu)\n", n_in, out_size, ws_size); grid_blocks = -1; return; }
        int dev = 0, cus = 0, per_cu = 0;
        hipGetDevice(&dev);
        hipDeviceGetAttribute(&cus, hipDeviceAttributeMultiprocessorCount, dev);
        hipFuncSetAttribute((const void*)fwd_kernel, hipFuncAttributeMaxDynamicSharedMemorySize, LDS_BYTES);
        hipOccupancyMaxActiveBlocksPerMultiprocessor(&per_cu, (const void*)fwd_kernel, NTHR, LDS_BYTES);
        if (per_cu < 1) per_cu = 1;
        grid_blocks = cus * per_cu;
        (void)hipGetLastError();
    }
    if (grid_blocks < 0) return;
    KP p{};
    for (int i = 0; i < 26; ++i) p.in[i] = (const float*)d_in[i];
    p.out = (float*)d_out; p.ws = (unsigned char*)d_ws;
    void* args[] = {&p};
    hipError_t e = hipLaunchCooperativeKernel((const void*)fwd_kernel, dim3(grid_blocks), dim3(NTHR), args, LDS_BYTES, stream);
    if (e != hipSuccess) fprintf(stderr, "cooperative launch failed: %s (grid %d)\n", hipGetErrorString(e), grid_blocks);
}
```

```cpp
#include <hip/hip_runtime.h>
#include <hip/hip_cooperative_groups.h>
#include <cstdio>
#include <cstdint>
namespace cg = cooperative_groups;
namespace pg8 {
#define PG8_LAS __attribute__((address_space(3)))
typedef unsigned short bf16_t;
typedef short bf16x8 __attribute__((ext_vector_type(8)));
typedef float f32x4 __attribute__((ext_vector_type(4)));
typedef unsigned u32x4 __attribute__((ext_vector_type(4)));
constexpr int BM = 256, BK = 64, HALF = 128, HTB = HALF * BK * 2  , STAGE_BYTES = 8 * HTB, NXCD = 8, WGM = 8;

__host__ __device__ __forceinline__ int lds_byte(int r, int c) { const int st = (r >> 4) * 2 + (c >> 5), rr = r & 15, cc = c & 31, ob = rr * 64 + cc * 2; return st * 1024 + (ob ^ (((ob >> 9) & 1) << 5)); }
__host__ __device__ __forceinline__ void stage_rc(int b, int& R, int& C) { const int st = b / 1024, sb = b % 1024, swz = sb ^ (((sb >> 9) & 1) << 5); R = (st >> 1) * 16 + swz / 64; C = (st & 1) * 32 + (swz % 64) / 2; }
__host__ __device__ __forceinline__ int perm32(int rho) { const int n = rho >> 4, i = rho & 15; return 8 * (i >> 2) + 4 * n + (i & 3); }

struct Unit { int pm, pn; };
struct Gemm { const bf16_t* A; const bf16_t* Bt; int M, N, K; };

struct StaticOrder {
    int nM, nN, nwg, G, c;
    __host__ __device__ void init(int M, int N, int G_, int c_) { nM = M / BM; nN = N / BM; nwg = nM * nN; G = G_; c = c_; }
    __host__ __device__ bool next(int i, Unit& u) const {
        const long L = (long)i * G + c; if (L >= nwg) return false;
        int wgid = (int)L; { const int q = nwg / NXCD, r = nwg % NXCD, xcd = wgid % NXCD, off = wgid / NXCD; wgid = (xcd < r ? xcd * (q + 1) : r * (q + 1) + (xcd - r) * q) + off; }
        const int nig = WGM * nN, gid = wgid / nig, fm = gid * WGM, gsz = (nM - fm) < WGM ? (nM - fm) : WGM;
        u.pm = fm + ((wgid % nig) % gsz); u.pn = (wgid % nig) / gsz; return true;
    }
    __device__ __forceinline__ void a_ready(const Unit&) const {}
    __device__ __forceinline__ void done(const Unit&) const {}
};

template <class Epi, class Sched, bool ALIGN_EPI = false, bool SP2 = false>
__device__ __forceinline__ void gemm_phase(PG8_LAS unsigned char* lds, const Gemm g, const Sched& S, const Epi& E) {
    int tid_l = threadIdx.x; asm volatile("" : "+v"(tid_l));
    const int tid = tid_l, wid = __builtin_amdgcn_readfirstlane(tid >> 6), lane = tid & 63, wr = wid >> 2, wc = wid & 3, fr = lane & 15, fq = lane >> 4;
    const int K = g.K, nt = K / BK;
    unsigned voffA[2], voffB[2];
#pragma unroll
    for (int i = 0; i < 2; ++i) { int R, C; stage_rc(tid * 16 + i * 8192, R, C); const int Rb = Epi::PERM ? ((R & ~31) + perm32(R & 31)) : R;
        voffA[i] = (unsigned)(R * K + C) * 2u; voffB[i] = (unsigned)(Rb * K + C) * 2u; }
    const size_t kstep = (size_t)(BK * 2);
    const size_t hstep = (size_t)HALF * K * 2;
    const size_t tstep = 2 * hstep;
    const unsigned ldsw = (unsigned)wid * 1024u;
    const int aoff = lds_byte(wr * 64 + fr, fq * 8), boff = lds_byte(wc * 32 + fr, fq * 8);
#define PG8_SA(b, h) (((b) * 2 + (h)) * HTB)
#define PG8_SB(b, h) ((4 + (b) * 2 + (h)) * HTB)
#define PG8_STAGE(bufoff, gbase, voff) do { _Pragma("unroll") for (int _i = 0; _i < 2; ++_i) \
        __builtin_amdgcn_global_load_lds((const unsigned*)((const char*)(gbase) + (voff)[_i]), (PG8_LAS unsigned*)(lds + (bufoff) + ldsw + _i * 8192), 16, 0, 0); } while (0)
#define PG8_LDA(dst, b, h) do { _Pragma("unroll") for (int m = 0; m < 4; ++m) _Pragma("unroll") for (int k = 0; k < 2; ++k) dst[m][k] = *(const PG8_LAS bf16x8*)(lds + PG8_SA(b, h) + aoff + m * 2048 + k * 1024); } while (0)
#define PG8_LDB(dst, b, h) do { _Pragma("unroll") for (int n = 0; n < 2; ++n) _Pragma("unroll") for (int k = 0; k < 2; ++k) dst[n][k] = *(const PG8_LAS bf16x8*)(lds + PG8_SB(b, h) + boff + n * 2048 + k * 1024); } while (0)
#define PG8_MMA(ai, bj, At, Bt) do { __builtin_amdgcn_s_setprio(1); _Pragma("unroll") for (int m = 0; m < 4; ++m) _Pragma("unroll") for (int n = 0; n < 2; ++n) _Pragma("unroll") for (int k = 0; k < 2; ++k) \
        acc[ai][bj][m][n] = __builtin_amdgcn_mfma_f32_16x16x32_bf16(Bt[n][k], At[m][k], acc[ai][bj][m][n], 0, 0, 0); __builtin_amdgcn_s_setprio(0); } while (0)
#define PG8_WAIT_V(n) asm volatile("s_waitcnt vmcnt(" #n ")" ::: "memory")
#define PG8_WAIT_L(n) asm volatile("s_waitcnt lgkmcnt(" #n ")" ::: "memory")
#define PG8_BAR __builtin_amdgcn_s_barrier()
#define PG8_SCHED __builtin_amdgcn_sched_barrier(0)
    Unit cur, nxt; int ui = 0;
    if (!S.next(0, cur)) return;
    f32x4 acc[2][2][4][2];
#pragma unroll
    for (int a = 0; a < 2; ++a)
#pragma unroll
        for (int b = 0; b < 2; ++b)
#pragma unroll
            for (int m = 0; m < 4; ++m)
#pragma unroll
                for (int n = 0; n < 2; ++n) acc[a][b][m][n] = (f32x4){0.f, 0.f, 0.f, 0.f};
    bf16x8 At[4][2], B0[2][2], B1[2][2];
    const char* cA = (const char*)g.A + (size_t)cur.pm * tstep; const char* cB = (const char*)g.Bt + (size_t)cur.pn * tstep;
    S.a_ready(cur);
    if constexpr (SP2) {
        PG8_STAGE(PG8_SB(0, 0), cB, voffB); PG8_STAGE(PG8_SB(0, 1), cB + hstep, voffB); PG8_STAGE(PG8_SA(0, 0), cA, voffA); PG8_STAGE(PG8_SA(0, 1), cA + hstep, voffA);
        if (wr == 1) PG8_BAR;
        PG8_WAIT_V(2); PG8_BAR;
        PG8_STAGE(PG8_SB(1, 0), cB + kstep, voffB); PG8_STAGE(PG8_SA(1, 0), cA + kstep, voffA); PG8_STAGE(PG8_SB(1, 1), cB + hstep + kstep, voffB);
        PG8_WAIT_V(6); PG8_BAR;
    } else {
        PG8_STAGE(PG8_SB(0, 0), cB, voffB); PG8_STAGE(PG8_SA(0, 0), cA, voffA); PG8_STAGE(PG8_SB(0, 1), cB + hstep, voffB); PG8_STAGE(PG8_SA(0, 1), cA + hstep, voffA);
        if (wr == 1) PG8_BAR;
        PG8_WAIT_V(4); PG8_BAR;
        PG8_STAGE(PG8_SB(1, 0), cB + kstep, voffB); PG8_STAGE(PG8_SA(1, 0), cA + kstep, voffA); PG8_STAGE(PG8_SB(1, 1), cB + hstep + kstep, voffB);
        PG8_WAIT_V(6); PG8_BAR;
    }
    for (;;) {
        const bool has_next = S.next(ui + 1, nxt);
        const char* nA = has_next ? (const char*)g.A + (size_t)nxt.pm * tstep : cA; const char* nB = has_next ? (const char*)g.Bt + (size_t)nxt.pn * tstep : cB;
        for (int t = 0; t < nt; t += 2) {
            const bool last = (t == nt - 2);
            const char* a1 = cA + (size_t)(t + 1) * kstep;
            const char* a2 = last ? nA : cA + (size_t)(t + 2) * kstep; const char* b2 = last ? nB : cB + (size_t)(t + 2) * kstep;
            const char* a3 = a2 + kstep; const char* b3 = b2 + kstep;
            if (last && has_next) S.a_ready(nxt);
            if constexpr (SP2) {
            PG8_LDB(B0, 0, 0); PG8_LDB(B1, 0, 1); PG8_SCHED; PG8_LDA(At, 0, 0); PG8_STAGE(PG8_SA(1, 1), a1 + hstep, voffA);
            PG8_WAIT_V(8); PG8_WAIT_L(0); PG8_BAR; PG8_MMA(0, 0, At, B0); PG8_MMA(0, 1, At, B1); PG8_BAR; PG8_SCHED;
            PG8_LDA(At, 0, 1); PG8_STAGE(PG8_SB(0, 0), b2, voffB); PG8_STAGE(PG8_SB(0, 1), b2 + hstep, voffB); PG8_STAGE(PG8_SA(0, 0), a2, voffA);
            PG8_WAIT_V(8); PG8_WAIT_L(0); PG8_BAR; PG8_MMA(1, 0, At, B0); PG8_MMA(1, 1, At, B1); PG8_BAR; PG8_SCHED;
            PG8_LDB(B0, 1, 0); PG8_LDB(B1, 1, 1); PG8_SCHED; PG8_LDA(At, 1, 0); PG8_STAGE(PG8_SA(0, 1), a2 + hstep, voffA);
            PG8_WAIT_V(8); PG8_WAIT_L(0); PG8_BAR; PG8_MMA(0, 0, At, B0); PG8_MMA(0, 1, At, B1); PG8_BAR; PG8_SCHED;
            PG8_LDA(At, 1, 1); PG8_STAGE(PG8_SB(1, 0), b3, voffB); PG8_STAGE(PG8_SB(1, 1), b3 + hstep, voffB); PG8_STAGE(PG8_SA(1, 0), a3, voffA);
            PG8_WAIT_V(8); PG8_WAIT_L(0); PG8_BAR; PG8_MMA(1, 0, At, B0); PG8_MMA(1, 1, At, B1); PG8_BAR; PG8_SCHED;
            } else {
            PG8_LDB(B0, 0, 0); PG8_SCHED; PG8_LDA(At, 0, 0); PG8_STAGE(PG8_SA(1, 1), a1 + hstep, voffA);
            PG8_WAIT_L(8); PG8_BAR; PG8_WAIT_L(0); PG8_MMA(0, 0, At, B0); PG8_BAR; PG8_SCHED;
            PG8_LDB(B1, 0, 1); PG8_STAGE(PG8_SB(0, 0), b2, voffB);
            PG8_BAR; PG8_WAIT_L(0); PG8_MMA(0, 1, At, B1); PG8_BAR;
            PG8_LDA(At, 0, 1); PG8_STAGE(PG8_SA(0, 0), a2, voffA);
            PG8_BAR; PG8_WAIT_L(0); PG8_MMA(1, 0, At, B0); PG8_BAR; PG8_SCHED;
            PG8_STAGE(PG8_SB(0, 1), b2 + hstep, voffB);
            PG8_WAIT_V(6); PG8_BAR; PG8_MMA(1, 1, At, B1); PG8_BAR;
            PG8_LDB(B0, 1, 0); PG8_SCHED; PG8_LDA(At, 1, 0); PG8_STAGE(PG8_SA(0, 1), a2 + hstep, voffA);
            PG8_WAIT_L(8); PG8_BAR; PG8_WAIT_L(0); PG8_MMA(0, 0, At, B0); PG8_BAR; PG8_SCHED;
            PG8_LDB(B1, 1, 1); PG8_STAGE(PG8_SB(1, 0), b3, voffB);
            PG8_BAR; PG8_WAIT_L(0); PG8_MMA(0, 1, At, B1); PG8_BAR;
            PG8_LDA(At, 1, 1); PG8_STAGE(PG8_SA(1, 0), a3, voffA);
            PG8_BAR; PG8_WAIT_L(0); PG8_MMA(1, 0, At, B0); PG8_BAR; PG8_SCHED;
            PG8_STAGE(PG8_SB(1, 1), b3 + hstep, voffB);
            PG8_WAIT_V(6); PG8_BAR; PG8_MMA(1, 1, At, B1); PG8_BAR;
            }
        }
        if constexpr (ALIGN_EPI) { if (wr == 0) PG8_BAR; }
        if constexpr (!Epi::AFTER_DRAIN) { E(acc, cur, wr, wc, fr, fq); S.done(cur); }
        if (!has_next) break;
#pragma unroll
        for (int a = 0; a < 2; ++a)
#pragma unroll
            for (int b = 0; b < 2; ++b)
#pragma unroll
                for (int m = 0; m < 4; ++m)
#pragma unroll
                    for (int n = 0; n < 2; ++n) acc[a][b][m][n] = (f32x4){0.f, 0.f, 0.f, 0.f};
        cur = nxt; cA = nA; cB = nB; ++ui;
        if constexpr (ALIGN_EPI) { if (wr == 1) PG8_BAR; }
    }
    PG8_WAIT_V(0);
    if constexpr (!ALIGN_EPI) { if (wr == 0) PG8_BAR; }
    PG8_BAR;
    if constexpr (Epi::AFTER_DRAIN) { E.fused(acc, cur, wr, wc, fr, fq, lds, wid, lane); S.done(cur); }
#undef PG8_SA
#undef PG8_SB
#undef PG8_STAGE
#undef PG8_LDA
#undef PG8_LDB
#undef PG8_MMA
#undef PG8_WAIT_V
#undef PG8_WAIT_L
#undef PG8_BAR
#undef PG8_SCHED
}
}

#define DI __device__ __forceinline__
#define LAS __attribute__((address_space(3)))
typedef unsigned short bf16_t;
typedef short bf16x8 __attribute__((ext_vector_type(8)));
typedef short s16x4 __attribute__((ext_vector_type(4)));
typedef float f32x4 __attribute__((ext_vector_type(4)));
typedef float f32x2 __attribute__((ext_vector_type(2)));
typedef float f32x16 __attribute__((ext_vector_type(16)));
typedef unsigned u32x4 __attribute__((ext_vector_type(4)));
typedef unsigned u32x2 __attribute__((ext_vector_type(2)));
typedef __bf16 bf16x2_t __attribute__((ext_vector_type(2)));
#define MFMA32(a, b, c) __builtin_amdgcn_mfma_f32_32x32x16_bf16((a), (b), (c), 0, 0, 0)

constexpr int T = 49152, DM = 1024, NPROJ = 3072, NIN = 2960, DFF = 4096, HFF = 2048;
constexpr int C_R = 0, C_K = 256, C_V = 512, C_WD = 768, C_AD = 896, C_GD = 1024;
constexpr int C_AQ = 1152, C_AK = 1664, C_AV = 1792;
constexpr int C_MQ = 1920, C_MK = 2176, C_MV = 2432, C_MO = 2688, C_IG = 2944, C_FG = 2952;
constexpr size_t MiB = 1u << 20;
constexpr size_t WS_SS = 0, WS_CNT = MiB - 4096, WS_CDOT = 1 * MiB, WS_TAB = 2 * MiB + 512 * 1024, WS_WIN = 3 * MiB, WS_WOUT = 15 * MiB,
                 WS_W1 = 19 * MiB, WS_W2 = 35 * MiB, WS_VT = 51 * MiB, WS_YB = 63 * MiB, WS_HBP = 87 * MiB, WS_X1 = 111 * MiB, WS_R = 207 * MiB,
                 WS_HID = WS_R + 96 * MiB, WS_END = 495 * MiB;
constexpr int LDS_BYTES = 134400 + 256;
constexpr int NTHR = 512;

struct KP { const float* in[26]; float* out; unsigned char* ws; };

DI unsigned cvtpk(float lo, float hi) { f32x2 v = {lo, hi}; bf16x2_t b = __builtin_convertvector(v, bf16x2_t); return __builtin_bit_cast(unsigned, b); }
DI unsigned short f2bf(float f) { return (unsigned short)(cvtpk(f, 0.f) & 0xffffu); }
DI float bf2f(unsigned h) { return __builtin_bit_cast(float, h << 16); }
DI float bflo(unsigned w) { return __builtin_bit_cast(float, w << 16); }
DI float bfhi(unsigned w) { return __builtin_bit_cast(float, w & 0xffff0000u); }
DI int crow(int reg, int h) { return (reg & 3) + 8 * (reg >> 2) + 4 * h; }
template <int CTRL> DI float dppf(float v) { return __builtin_bit_cast(float, __builtin_amdgcn_update_dpp(0, __builtin_bit_cast(int, v), CTRL, 0xf, 0xf, true)); }
DI float red8(float v) { v += dppf<0xB1>(v); v += dppf<0x4E>(v); v += dppf<0x141>(v); return v; }
DI float red16(float v) { v = red8(v); v += dppf<0x128>(v); return v; }
DI float frcp(float x) { return __builtin_amdgcn_rcpf(x); }
DI float sigmoidf_(float x) { return frcp(1.f + __expf(-x)); }
DI f32x16 zero16() { f32x16 z; for (int i = 0; i < 16; ++i) z[i] = 0.f; return z; }
DI void seq_of_job(int j, int& seq, int& h, int& dir) { if (j < 16) { seq = 8 + (j >> 3); } else { j -= 16; seq = j >> 3; } h = (j >> 1) & 3; dir = j & 1; }
DI void seq_info(int s, int& start, int& len) { if (s < 8) { start = s * 4096; len = 4096; } else { start = 32768 + (s - 8) * 8192; len = 8192; } }
DI int tok_seq_start(int tok, int& len) { if (tok < 32768) { len = 4096; return tok & ~4095; } len = 8192; return 32768 + ((tok - 32768) & ~8191); }

struct EpiProj {
    static constexpr bool PERM = true, AFTER_DRAIN = false;
    bf16_t* O; const float* ss;
    DI void operator()(const pg8::f32x4 (&acc)[2][2][4][2], const pg8::Unit& u, int wr, int wc, int fr, int fq) const {
        const int row0 = u.pm * 256 + wr * 64 + fr, col0 = u.pn * 256 + wc * 32 + 8 * fq;
#pragma unroll
        for (int ai = 0; ai < 2; ++ai)
#pragma unroll
            for (int m = 0; m < 4; ++m) {
                const int row = row0 + ai * 128 + m * 16;
                const float rs = rsqrtf(ss[row] * (1.f / 1024.f) + 1e-6f);
                bf16_t* rp = O + (size_t)row * NPROJ + col0;
#pragma unroll
                for (int bj = 0; bj < 2; ++bj) {
                    pg8::f32x4 v0 = acc[ai][bj][m][0] * rs, v1 = acc[ai][bj][m][1] * rs;
                    u32x4 w; w.x = cvtpk(v0[0], v0[1]); w.y = cvtpk(v0[2], v0[3]); w.z = cvtpk(v1[0], v1[1]); w.w = cvtpk(v1[2], v1[3]);
                    *(u32x4*)(rp + bj * 128) = w;
                }
            }
    }
};
struct EpiRelu2 {
    static constexpr bool PERM = true, AFTER_DRAIN = false;
    bf16_t* O; const float* ss;
    DI void operator()(const pg8::f32x4 (&acc)[2][2][4][2], const pg8::Unit& u, int wr, int wc, int fr, int fq) const {
        const int row0 = u.pm * 256 + wr * 64 + fr, col0 = u.pn * 256 + wc * 32 + 8 * fq;
#pragma unroll
        for (int ai = 0; ai < 2; ++ai)
#pragma unroll
            for (int m = 0; m < 4; ++m) {
                const int row = row0 + ai * 128 + m * 16;
                const float rs = rsqrtf(ss[row] * (1.f / 1024.f) + 1e-6f);
                bf16_t* rp = O + (size_t)row * HFF + col0;
#pragma unroll
                for (int bj = 0; bj < 2; ++bj) {
                    pg8::f32x4 v0 = acc[ai][bj][m][0] * rs, v1 = acc[ai][bj][m][1] * rs;
#pragma unroll
                    for (int j = 0; j < 4; ++j) { float a = fmaxf(v0[j], 0.f); v0[j] = a * a; float b = fmaxf(v1[j], 0.f); v1[j] = b * b; }
                    u32x4 w; w.x = cvtpk(v0[0], v0[1]); w.y = cvtpk(v0[2], v0[3]); w.z = cvtpk(v1[0], v1[1]); w.w = cvtpk(v1[2], v1[3]);
                    *(u32x4*)(rp + bj * 128) = w;
                }
            }
    }
};
template <bool WRITE_HB, bool DO_SS> struct EpiRes {
    static constexpr bool PERM = true, AFTER_DRAIN = false;
    float* X; bf16_t* HB; float* ss;
    DI void operator()(const pg8::f32x4 (&acc)[2][2][4][2], const pg8::Unit& u, int wr, int wc, int fr, int fq) const {
        const int row0 = u.pm * 256 + wr * 64 + fr, col0 = u.pn * 256 + wc * 32 + 8 * fq;
#pragma unroll
        for (int ai = 0; ai < 2; ++ai)
#pragma unroll
            for (int m = 0; m < 4; ++m) {
                const int row = row0 + ai * 128 + m * 16;
                float* xp = X + (size_t)row * DM + col0;
                float sq = 0.f;
#pragma unroll
                for (int bj = 0; bj < 2; ++bj) {
                    pg8::f32x4 a0 = *(const pg8::f32x4*)(xp + bj * 128), a1 = *(const pg8::f32x4*)(xp + bj * 128 + 4);
                    a0 += acc[ai][bj][m][0]; a1 += acc[ai][bj][m][1];
                    *(pg8::f32x4*)(xp + bj * 128) = a0; *(pg8::f32x4*)(xp + bj * 128 + 4) = a1;
                    if (WRITE_HB) { u32x4 w; w.x = cvtpk(a0[0], a0[1]); w.y = cvtpk(a0[2], a0[3]); w.z = cvtpk(a1[0], a1[1]); w.w = cvtpk(a1[2], a1[3]);
                        *(u32x4*)(HB + (size_t)row * DM + col0 + bj * 128) = w; }
                    if (DO_SS) sq += a0[0] * a0[0] + a0[1] * a0[1] + a0[2] * a0[2] + a0[3] * a0[3] + a1[0] * a1[0] + a1[1] * a1[1] + a1[2] * a1[2] + a1[3] * a1[3];
                }
                if (DO_SS) { sq += __shfl_xor(sq, 16); sq += __shfl_xor(sq, 32); if (fq == 0) atomicAdd(ss + row, sq); }
            }
    }
};

DI void transpose_tile(const float* src, int N, int nvalid, const float* gain, bf16_t* dst, int K, int kt, int nt, LAS float* tile, int tid) {
    const int a = tid & 63, b8 = tid >> 6;
#pragma unroll
    for (int i = 0; i < 8; ++i) { const int k = b8 + 8 * i, n = nt * 64 + a; float v = (n < nvalid) ? src[(size_t)(kt * 64 + k) * N + n] : 0.f; if (gain) v *= gain[kt * 64 + k]; tile[k * 65 + a] = v; }
    __syncthreads();
#pragma unroll
    for (int i = 0; i < 8; ++i) { const int n = b8 + 8 * i; dst[(size_t)(nt * 64 + n) * K + kt * 64 + a] = f2bf(tile[a * 65 + n]); }
    __syncthreads();
}
DI void p0_phase(const KP& p, LAS unsigned char* lds, int tid, int G, int bid) {
    LAS float* tile = (LAS float*)lds;
    for (int it = bid; it < 6144; it += G) {
        const int l = it / 3072; int r = it % 3072;
        const float* src; const float* gain; bf16_t* dst; int N, nvalid, K, kt, nt;
        if (r < 768) { src = p.in[3] + (size_t)l * 1024 * NIN; N = NIN; nvalid = NIN; K = 1024; gain = p.in[2] + l * 1024; dst = (bf16_t*)(p.ws + WS_WIN) + (size_t)l * NPROJ * 1024; kt = r / 48; nt = r % 48; }
        else if (r < 1024) { r -= 768; src = p.in[21] + (size_t)l * 1024 * 1024; N = 1024; nvalid = 1024; K = 1024; gain = nullptr; dst = (bf16_t*)(p.ws + WS_WOUT) + (size_t)l * 1024 * 1024; kt = r / 16; nt = r % 16; }
        else if (r < 2048) { r -= 1024; src = p.in[23] + (size_t)l * 1024 * 4096; N = 4096; nvalid = 4096; K = 1024; gain = p.in[22] + l * 1024; dst = (bf16_t*)(p.ws + WS_W1) + (size_t)l * 4096 * 1024; kt = r / 64; nt = r % 64; }
        else { r -= 2048; const int h = r / 512; r %= 512; src = p.in[24] + (size_t)l * 4096 * 1024 + (size_t)h * 2048 * 1024; N = 1024; nvalid = 1024; K = 2048; gain = nullptr;
               dst = (bf16_t*)(p.ws + WS_W2) + (size_t)l * 2 * 1024 * 2048 + (size_t)h * 1024 * 2048; kt = r / 16; nt = r % 16; }
        transpose_tile(src, N, nvalid, gain, dst, K, kt, nt, tile, tid);
    }
    const int wave = tid >> 6, lane = tid & 63;
    float* ss = (float*)(p.ws + WS_SS);
    bf16_t* xb = (bf16_t*)(p.ws + WS_X1);
    for (int row = bid * 8 + wave; row < T; row += G * 8) {
        const float* xs = (row < 32768) ? p.in[0] + (size_t)row * DM : p.in[1] + (size_t)(row - 32768) * DM;
        float sq = 0.f;
#pragma unroll
        for (int j = 0; j < 4; ++j) {
            const int c = (j * 64 + lane) * 4;
            const f32x4 v = *(const f32x4*)(xs + c);
            *(f32x4*)(p.out + (size_t)row * DM + c) = v;
            u32x2 w; w.x = cvtpk(v[0], v[1]); w.y = cvtpk(v[2], v[3]);
            *(u32x2*)(xb + (size_t)row * DM + c) = w;
            sq += v[0] * v[0] + v[1] * v[1] + v[2] * v[2] + v[3] * v[3];
        }
#pragma unroll
        for (int o = 32; o >= 1; o >>= 1) sq += __shfl_xor(sq, o);
        if (lane == 0) ss[row] = sq;
    }
    for (int i = bid * NTHR + tid; i < 4 * T; i += G * NTHR) ss[T + i] = 0.f;
    if (bid == 0) {
        if (tid < 64) ((unsigned*)(p.ws + WS_CNT))[tid] = 0u;
        float2* tab = (float2*)(p.ws + WS_TAB);
        for (int idx = tid; idx < 2048; idx += NTHR) { const int pos = idx >> 4, f = idx & 15; const float inv = powf(10000.f, -(float)f / 16.f); const float ang = (float)pos * inv; tab[idx] = make_float2(cosf(ang), sinf(ang)); }
    }
}

DI void prep_phase(const KP& p, int l, LAS unsigned char* lds, int tid, int G, int bid) {
    bf16_t* proj = (bf16_t*)(p.ws + WS_R);
    bf16_t* vT = (bf16_t*)(p.ws + WS_VT);
    const float2* tab = (const float2*)(p.ws + WS_TAB);
    const float* qn = p.in[15] + l * 64; const float* kn = p.in[16] + l * 64;
    const int wave = tid >> 6, lane = tid & 63, g = lane >> 4, li = lane & 15;
    LAS bf16_t* vts = (LAS bf16_t*)lds;
    for (int unit = bid; unit < T / 64; unit += G) {
        const int tok0 = unit * 64;
        for (int i = 0; i < 8; ++i) {
            const int tok = tok0 + wave * 8 + i; int len; const int st = tok_seq_start(tok, len); const int pos = tok - st; const int prow = pos >> 6, pcol = pos & 63;
#pragma unroll
            for (int it = 0; it < 3; ++it) {
                const bool act = (it < 2) || (g < 2);
                const int colbase = (it < 2) ? C_AQ + (it * 4 + g) * 64 : C_AK + (g & 1) * 64;
                const float* wn = (it < 2) ? qn : kn;
                bf16_t* ptr = proj + (size_t)tok * NPROJ + colbase + li * 4;
                const u32x2 raw = *(const u32x2*)ptr;
                float x[4] = {bflo(raw.x), bfhi(raw.x), bflo(raw.y), bfhi(raw.y)};
                float sq = x[0] * x[0] + x[1] * x[1] + x[2] * x[2] + x[3] * x[3];
                sq = red16(sq);
                const float rinv = rsqrtf(sq * (1.f / 64.f) + 1e-6f);
                const f32x4 w4 = *(const f32x4*)(wn + li * 4);
                const int idx = (li >> 3) ? pcol : prow; const bool second = (li >> 2) & 1;
                const float scale = (it < 2) ? 0.125f * 1.4426950408889634f : 1.f;
                float o[4];
#pragma unroll
                for (int j = 0; j < 4; ++j) {
                    const float y = x[j] * rinv * w4[j];
                    const float pr = __shfl_xor(y, 4);
                    const int f = (li * 4 + j) & 15;
                    const float2 cs = tab[idx * 16 + f];
                    o[j] = (second ? (y * cs.x + pr * cs.y) : (y * cs.x - pr * cs.y)) * scale;
                }
                if (act) { u32x2 w; w.x = cvtpk(o[0], o[1]); w.y = cvtpk(o[2], o[3]); *(u32x2*)ptr = w; }
            }
        }
#pragma unroll
        for (int i = 0; i < 2; ++i) { const int idx = tid + NTHR * i; const int tl = idx >> 4, c8 = (idx & 15) * 8;
            const u32x4 v = *(const u32x4*)(proj + (size_t)(tok0 + tl) * NPROJ + C_AV + c8); *(LAS u32x4*)(vts + tl * 136 + c8) = v; }
        __syncthreads();
        { const int c = tid >> 2, tq = tid & 3; unsigned w[8];
#pragma unroll
          for (int j = 0; j < 8; ++j) { const unsigned lo = vts[(tq * 16 + 2 * j) * 136 + c], hi = vts[(tq * 16 + 2 * j + 1) * 136 + c]; w[j] = lo | (hi << 16); }
          u32x4 a = {w[0], w[1], w[2], w[3]}, b = {w[4], w[5], w[6], w[7]};
          bf16_t* dp = vT + (size_t)c * T + tok0 + tq * 16; *(u32x4*)dp = a; *(u32x4*)(dp + 8) = b; }
        __syncthreads();
    }
}

DI void attn_unit(const KP& p, int l, int unit, LAS unsigned char* lds, int tid) {
    const float* qnw = p.in[15] + l * 64; const float* knw = p.in[16] + l * 64;
    const bf16_t* proj = (const bf16_t*)(p.ws + WS_R);
    const bf16_t* vT = (const bf16_t*)(p.ws + WS_VT);
    bf16_t* mix = (bf16_t*)(p.ws + WS_X1);
    int seq, kvh, qt;
    if (unit < 512) { seq = 8 + (unit >> 8); const int r = unit & 255; kvh = r >> 7; qt = r & 127; }
    else { const int u2 = unit - 512; seq = u2 >> 7; const int r = u2 & 127; kvh = r >> 6; qt = r & 63; }
    int start, len; seq_info(seq, start, len);
    const int nk = len >> 6;
    const int wave = tid >> 6, lane = tid & 63, r32 = lane & 31, hh = lane >> 5;
    const int head = kvh * 4 + (wave >> 1);
    const int q0 = start + qt * 64 + (wave & 1) * 32;
    bf16x8 qf[4];
    { const bf16_t* qp = proj + (size_t)(q0 + r32) * NPROJ + C_AQ + head * 64 + hh * 8;
#pragma unroll
      for (int ks = 0; ks < 4; ++ks) qf[ks] = *(const bf16x8*)(qp + ks * 16); }
    f32x16 o0 = zero16(), o1 = zero16();
    float lsum = 0.f;
    f32x16 sinit;
    { float mq = fabsf(qnw[lane]), mk = fabsf(knw[lane]);
#pragma unroll
      for (int o = 32; o >= 1; o >>= 1) { mq = fmaxf(mq, __shfl_xor(mq, o)); mk = fmaxf(mk, __shfl_xor(mk, o)); }
      const float bnd = 64.f * 0.125f * 1.4426950408889634f * 1.01f * mq * mk;
#pragma unroll
      for (int i = 0; i < 16; ++i) sinit[i] = -bnd; }
    const int lrow = tid >> 3, lseg = tid & 7;
    const bf16_t* kptr = proj + (size_t)(start + lrow) * NPROJ + C_AK + kvh * 64 + lseg * 8;
    const bf16_t* vptr = vT + (size_t)(kvh * 64 + lrow) * T + start + lseg * 8;
    const int lds_off = lrow * 144 + lseg * 16;
    u32x4 kreg = *(const u32x4*)kptr, vreg = *(const u32x4*)vptr;
    *(LAS u32x4*)(lds + lds_off) = kreg; *(LAS u32x4*)(lds + 9216 + lds_off) = vreg;
    __syncthreads();
    for (int j = 0; j < nk; ++j) {
        const bool more = (j + 1 < nk);
        if (more) { kreg = *(const u32x4*)(kptr + (size_t)(j + 1) * 64 * NPROJ); vreg = *(const u32x4*)(vptr + (j + 1) * 64); }
        LAS unsigned char* Ks = lds + (j & 1) * 18432; LAS unsigned char* Vs = Ks + 9216;
        f32x16 s0 = sinit, s1 = sinit;
#pragma unroll
        for (int ks = 0; ks < 4; ++ks) {
            const bf16x8 a0 = *(const LAS bf16x8*)(Ks + r32 * 144 + (ks * 16 + hh * 8) * 2);
            const bf16x8 a1 = *(const LAS bf16x8*)(Ks + (32 + r32) * 144 + (ks * 16 + hh * 8) * 2);
            s0 = MFMA32(a0, qf[ks], s0); s1 = MFMA32(a1, qf[ks], s1);
        }
        float rs = 0.f;
#pragma unroll
        for (int i = 0; i < 16; ++i) { s0[i] = __builtin_amdgcn_exp2f(s0[i]); rs += s0[i]; }
#pragma unroll
        for (int i = 0; i < 16; ++i) { s1[i] = __builtin_amdgcn_exp2f(s1[i]); rs += s1[i]; }
        lsum += rs;
#pragma unroll
        for (int mb = 0; mb < 2; ++mb)
#pragma unroll
            for (int s = 0; s < 2; ++s) {
                u32x4 pk;
                if (mb == 0) { pk.x = cvtpk(s0[8 * s], s0[8 * s + 1]); pk.y = cvtpk(s0[8 * s + 2], s0[8 * s + 3]); pk.z = cvtpk(s0[8 * s + 4], s0[8 * s + 5]); pk.w = cvtpk(s0[8 * s + 6], s0[8 * s + 7]); }
                else         { pk.x = cvtpk(s1[8 * s], s1[8 * s + 1]); pk.y = cvtpk(s1[8 * s + 2], s1[8 * s + 3]); pk.z = cvtpk(s1[8 * s + 4], s1[8 * s + 5]); pk.w = cvtpk(s1[8 * s + 6], s1[8 * s + 7]); }
                const bf16x8 pb = __builtin_bit_cast(bf16x8, pk);
                const int keyoff = 32 * mb + 16 * s + 4 * hh;
                { const s16x4 lo = *(const LAS s16x4*)(Vs + r32 * 144 + keyoff * 2), hi = *(const LAS s16x4*)(Vs + r32 * 144 + (keyoff + 8) * 2);
                  const bf16x8 va = __builtin_shufflevector(lo, hi, 0, 1, 2, 3, 4, 5, 6, 7); o0 = MFMA32(va, pb, o0); }
                { const s16x4 lo = *(const LAS s16x4*)(Vs + (32 + r32) * 144 + keyoff * 2), hi = *(const LAS s16x4*)(Vs + (32 + r32) * 144 + (keyoff + 8) * 2);
                  const bf16x8 va = __builtin_shufflevector(lo, hi, 0, 1, 2, 3, 4, 5, 6, 7); o1 = MFMA32(va, pb, o1); }
            }
        if (more) { LAS unsigned char* Kn = lds + ((j + 1) & 1) * 18432; *(LAS u32x4*)(Kn + lds_off) = kreg; *(LAS u32x4*)(Kn + 9216 + lds_off) = vreg; }
        __syncthreads();
    }
    lsum += __shfl_xor(lsum, 32);
    const float inv = 1.f / lsum;
    bf16_t* op = mix + (size_t)(q0 + r32) * DM + 256 + head * 64;
#pragma unroll
    for (int g4 = 0; g4 < 4; ++g4) {
        u32x2 w0; w0.x = cvtpk(o0[4 * g4] * inv, o0[4 * g4 + 1] * inv); w0.y = cvtpk(o0[4 * g4 + 2] * inv, o0[4 * g4 + 3] * inv);
        *(u32x2*)(op + 8 * g4 + 4 * hh) = w0;
        u32x2 w1; w1.x = cvtpk(o1[4 * g4] * inv, o1[4 * g4 + 1] * inv); w1.y = cvtpk(o1[4 * g4 + 2] * inv, o1[4 * g4 + 3] * inv);
        *(u32x2*)(op + 32 + 8 * g4 + 4 * hh) = w1;
    }
}

constexpr int RW_BUF = 49152, RW_XR = 0, RW_XKD = 8192, RW_XV = 16384, RW_WLW = 24576, RW_ALB = 32768, RW_KKN = 40960, RW_YO = 98304, RW_XWD = 106496, RW_XAD = 111104,
              RW_W2T = 115712, RW_A2T = 124928, RW_CD = 134144, SLOT_OFF = 134400;
#define RW_BAR() asm volatile("s_waitcnt lgkmcnt(0)\n\ts_barrier" ::: "memory")
#define RW_DECODE(i_) const int t = (pt >> 4) + 16 * ((i_) / 5), c4 = (pt & 15) * 4; constexpr int gi = (i_) % 5; \
            const int col = (gi == 0) ? C_R + h * 64 + c4 : (gi == 1) ? C_K + h * 64 + c4 : (gi == 2) ? C_V + h * 64 + c4 : (gi == 3) ? C_WD + dir * 64 + c4 : C_AD + dir * 64 + c4;
#define RW_ISSUE1(chx, i_) { RW_DECODE(i_) \
            const int n = (chx) * 32 + t; const int pos = dir ? (len - 1 - n) : n; \
            const bf16_t* bp = proj + (size_t)(start + pos) * NPROJ + col; \
            rc[i_] = *(const u32x2*)bp; rp_[i_] = (u32x2){0u, 0u}; rn[i_] = (u32x2){0u, 0u}; \
            if (pos > 0) rp_[i_] = *(const u32x2*)(bp - NPROJ); \
            if (pos < len - 1) rn[i_] = *(const u32x2*)(bp + NPROJ); }
#define RW_ISSUE(chx) do { RW_ISSUE1(chx, 0) RW_ISSUE1(chx, 1) RW_ISSUE1(chx, 2) RW_ISSUE1(chx, 3) RW_ISSUE1(chx, 4) RW_ISSUE1(chx, 5) RW_ISSUE1(chx, 6) RW_ISSUE1(chx, 7) RW_ISSUE1(chx, 8) RW_ISSUE1(chx, 9) } while (0)
#define RW_CONV1(i_) { RW_DECODE(i_) \
            const f32x4 m4 = mureg[gi]; \
            f32x4 x = {bflo(rc[i_].x), bfhi(rc[i_].x), bflo(rc[i_].y), bfhi(rc[i_].y)}; \
            const f32x4 pn = {bflo(rp_[i_].x) + bflo(rn[i_].x), bfhi(rp_[i_].x) + bfhi(rn[i_].x), bflo(rp_[i_].y) + bflo(rn[i_].y), bfhi(rp_[i_].y) + bfhi(rn[i_].y)}; \
            x = x + (0.5f * pn - x) * m4; \
            if (gi < 3) { LAS float* dst = (gi == 0) ? XR : (gi == 1) ? XKD : XV; *(LAS f32x4*)(dst + t * 64 + c4) = x; } \
            else if (gi == 3) { \
                _Pragma("unroll") for (int j = 0; j < 4; ++j) { const float e = __expf(2.f * x[j]); x[j] = 1.f - 2.f * frcp(e + 1.f); } \
                u32x2 w; w.x = cvtpk(x[0], x[1]); w.y = cvtpk(x[2], x[3]); *(LAS u32x2*)(XWD + t * 72 + c4) = w; } \
            else { u32x2 w; w.x = cvtpk(x[0], x[1]); w.y = cvtpk(x[2], x[3]); *(LAS u32x2*)(XAD + t * 72 + c4) = w; } }
DI void rwkv_job(const KP& p, int l, int job, LAS unsigned char* lds, int tid) {
    int seq, h, dir, rpart; constexpr int nrows = 32;
    { int j = job; if (j < 32) { seq = 8 + (j >> 4); } else { j -= 32; seq = j >> 4; } h = (j >> 2) & 3; dir = (j >> 1) & 1; rpart = j & 1; }
    int start, len; seq_info(seq, start, len);
    const bf16_t* proj = (const bf16_t*)(p.ws + WS_R);
    bf16_t* mix = (bf16_t*)(p.ws + WS_X1);
    bf16_t* yb = (bf16_t*)(p.ws + WS_YB);
    float* cdot = (float*)(p.ws + WS_CDOT);
    const float* mu = p.in[4] + l * 1152;
    const int wave = tid >> 6, lane = tid & 63, r32 = lane & 31, hh = lane >> 5;
    LAS bf16_t* XWD = (LAS bf16_t*)(lds + RW_XWD); LAS bf16_t* XAD = (LAS bf16_t*)(lds + RW_XAD);
    LAS bf16_t* W2T = (LAS bf16_t*)(lds + RW_W2T); LAS bf16_t* A2T = (LAS bf16_t*)(lds + RW_A2T);
    { const float* w2 = p.in[6] + (size_t)((l * 2 + dir) * 64) * 256 + h * 64; const float* a2 = p.in[8] + (size_t)((l * 2 + dir) * 64) * 256 + h * 64;
#pragma unroll
      for (int i = 0; i < 8; ++i) { const int idx = tid + NTHR * i; const int mm = idx >> 6, c = idx & 63; W2T[c * 72 + mm] = f2bf(w2[mm * 256 + c]); A2T[c * 72 + mm] = f2bf(a2[mm * 256 + c]); } }
    const int nch = len >> 5;
    __syncthreads();
    if (tid < 256) {
        const int srow = tid >> 3, sj = (tid & 7) * 8;
        f32x4 Sa = {0.f, 0.f, 0.f, 0.f}, Sb = {0.f, 0.f, 0.f, 0.f};
        RW_BAR(); RW_BAR(); RW_BAR();
#define RW_LD(dst, arr, tt) const f32x4 dst##a = *(const LAS f32x4*)((arr) + (tt) * 64 + sj), dst##b = *(const LAS f32x4*)((arr) + (tt) * 64 + sj + 4)
        for (int ch = 0; ch < nch; ++ch) {
            LAS unsigned char* B = lds + (ch & 1) * RW_BUF;
            LAS float* XR = (LAS float*)(B + RW_XR); LAS float* XKD = (LAS float*)(B + RW_XKD); LAS float* XV = (LAS float*)(B + RW_XV);
            LAS float* WLW = (LAS float*)(B + RW_WLW); LAS float* ALB = (LAS float*)(B + RW_ALB); LAS float* KKN = (LAS float*)(B + RW_KKN);
            LAS float* YO = (LAS float*)(lds + RW_YO + (ch & 1) * 4096);
            f32x4 wa = *(const LAS f32x4*)(WLW + sj), wb = *(const LAS f32x4*)(WLW + sj + 4), ka = *(const LAS f32x4*)(KKN + sj), kb = *(const LAS f32x4*)(KKN + sj + 4);
            f32x4 ba = *(const LAS f32x4*)(ALB + sj), bb = *(const LAS f32x4*)(ALB + sj + 4), da = *(const LAS f32x4*)(XKD + sj), db = *(const LAS f32x4*)(XKD + sj + 4);
            f32x4 ra = *(const LAS f32x4*)(XR + sj), rb = *(const LAS f32x4*)(XR + sj + 4);
            float v = XV[rpart * 32 + srow];
#pragma unroll 2
            for (int t = 0; t < 32; ++t) {
                const int tn = (t < 31) ? t + 1 : 31;
                RW_LD(wn, WLW, tn); RW_LD(kn, KKN, tn); RW_LD(bn, ALB, tn); RW_LD(dn, XKD, tn); RW_LD(rn_, XR, tn);
                const float vn = XV[tn * 64 + rpart * 32 + srow];
                const f32x4 pa = Sa * ka + Sb * kb;
                float sa = (pa[0] + pa[1]) + (pa[2] + pa[3]);
                sa = -red8(sa);
                Sa = Sa * wa + sa * ba + v * da;
                Sb = Sb * wb + sa * bb + v * db;
                const f32x4 py = Sa * ra + Sb * rb;
                float y = (py[0] + py[1]) + (py[2] + py[3]);
                y = red8(y);
                if ((tid & 7) == 0) YO[t * 32 + srow] = y;
                wa = wna; wb = wnb; ka = kna; kb = knb; ba = bna; bb = bnb; da = dna; db = dnb; ra = rn_a; rb = rn_b; v = vn;
                if (t == 19 || t == 23) RW_BAR();
            }
            RW_BAR();
        }
    } else {
        const int ptid = tid - 256;
        const int cli = ptid & 15, cc4 = cli * 4;
        const f32x4 w0v = *(const f32x4*)(p.in[5] + (l * 2 + dir) * 256 + h * 64 + cc4);
        const f32x4 a0v = *(const f32x4*)(p.in[7] + (l * 2 + dir) * 256 + h * 64 + cc4);
        const f32x4 kkw = *(const f32x4*)(p.in[10] + l * 256 + h * 64 + cc4);
        const f32x4 kaw = *(const f32x4*)(p.in[11] + l * 256 + h * 64 + cc4);
        const f32x4 rkw = *(const f32x4*)(p.in[12] + l * 256 + h * 64 + cc4);
        u32x2 rc[10], rp_[10], rn[10];
        f32x4 mureg[5];
        { const int c4 = (ptid & 15) * 4;
          mureg[0] = *(const f32x4*)(mu + C_R + h * 64 + c4); mureg[1] = *(const f32x4*)(mu + C_K + h * 64 + c4); mureg[2] = *(const f32x4*)(mu + C_V + h * 64 + c4);
          mureg[3] = *(const f32x4*)(mu + C_WD + dir * 64 + c4); mureg[4] = *(const f32x4*)(mu + C_AD + dir * 64 + c4); }
        { int pt = ptid; RW_ISSUE(0); }
        for (int ch = -1; ch < nch; ++ch) {
            int pt = ptid; asm volatile("" : "+v"(pt));
            if (ch >= 1) {
                const int pc = ch - 1;
                LAS float* YO = (LAS float*)(lds + RW_YO + (pc & 1) * 4096); LAS float* CD = (LAS float*)(lds + RW_CD + (pc & 1) * 128);
                const int t = ptid >> 3, c4 = (ptid & 7) * 4;
                const int n = pc * 32 + t; const int pos = dir ? (len - 1 - n) : n; const int tok = start + pos;
                const f32x4 yv = *(const LAS f32x4*)(YO + t * 32 + c4);
                u32x2 w; w.x = cvtpk(yv[0], yv[1]); w.y = cvtpk(yv[2], yv[3]);
                if (c4 < nrows) { if (dir) *(u32x2*)(yb + (size_t)tok * 256 + h * 64 + rpart * nrows + c4) = w; else *(u32x2*)(mix + (size_t)tok * DM + h * 64 + rpart * nrows + c4) = w; }
                if (rpart == 0 && ptid < 32) { const int n2 = pc * 32 + ptid; const int pos2 = dir ? (len - 1 - n2) : n2; cdot[((size_t)(start + pos2) * 4 + h) * 2 + dir] = CD[ptid]; }
            }
            const int nc = ch + 1;
            const bool build = nc < nch;
            LAS unsigned char* B = lds + (nc & 1) * RW_BUF;
            LAS float* XR = (LAS float*)(B + RW_XR); LAS float* XKD = (LAS float*)(B + RW_XKD); LAS float* XV = (LAS float*)(B + RW_XV);
            LAS float* WLW = (LAS float*)(B + RW_WLW); LAS float* ALB = (LAS float*)(B + RW_ALB); LAS float* KKN = (LAS float*)(B + RW_KKN);
            LAS float* CDn = (LAS float*)(lds + RW_CD + (nc & 1) * 128);
            if (build) {
                RW_CONV1(0) RW_CONV1(1) RW_CONV1(2) RW_CONV1(3) RW_CONV1(4) RW_CONV1(5) RW_CONV1(6) RW_CONV1(7) RW_CONV1(8) RW_CONV1(9)
                if (nc + 1 < nch) RW_ISSUE(nc + 1);
            }
            RW_BAR();
            if (build) {
                const int mat = (wave - 4) >> 1, nb = (wave - 4) & 1;
                LAS bf16_t* Xs = mat ? XAD : XWD; LAS bf16_t* Ws = mat ? A2T : W2T;
                f32x16 acc = zero16();
#pragma unroll
                for (int ks = 0; ks < 4; ++ks) {
                    const bf16x8 a = *(const LAS bf16x8*)(Xs + r32 * 72 + ks * 16 + hh * 8);
                    const bf16x8 bb = *(const LAS bf16x8*)(Ws + (nb * 32 + r32) * 72 + ks * 16 + hh * 8);
                    acc = MFMA32(a, bb, acc);
                }
                LAS float* dst = mat ? ALB : WLW;
#pragma unroll
                for (int i = 0; i < 16; ++i) dst[crow(i, hh) * 64 + nb * 32 + r32] = acc[i];
            }
            RW_BAR();
            if (build) {
#pragma unroll
                for (int it = 0; it < 2; ++it) {
                    const int ct = (ptid >> 4) + 16 * it;
                    const f32x4 wl = *(const LAS f32x4*)(WLW + ct * 64 + cc4), al = *(const LAS f32x4*)(ALB + ct * 64 + cc4);
                    const f32x4 k4 = *(const LAS f32x4*)(XKD + ct * 64 + cc4), r4 = *(const LAS f32x4*)(XR + ct * 64 + cc4);
                    f32x4 w, a, kkr, kd;
                    float ssq = 0.f, cd = 0.f;
#pragma unroll
                    for (int j = 0; j < 4; ++j) {
                        const float sg = sigmoidf_(w0v[j] + wl[j]);
                        w[j] = __expf(-0.6065306597126334f * sg);
                        a[j] = sigmoidf_(a0v[j] + al[j]);
                        kkr[j] = k4[j] * kkw[j]; ssq += kkr[j] * kkr[j];
                        kd[j] = k4[j] * (1.f + (a[j] - 1.f) * kaw[j]);
                        cd += r4[j] * kd[j] * rkw[j];
                    }
                    ssq = red16(ssq); cd = red16(cd);
                    const float inv = __builtin_amdgcn_rsqf(fmaxf(ssq, 1e-24f));
                    f32x4 kkn, bv;
#pragma unroll
                    for (int j = 0; j < 4; ++j) { kkn[j] = kkr[j] * inv; bv[j] = kkn[j] * a[j]; }
                    *(LAS f32x4*)(WLW + ct * 64 + cc4) = w; *(LAS f32x4*)(ALB + ct * 64 + cc4) = bv; *(LAS f32x4*)(KKN + ct * 64 + cc4) = kkn; *(LAS f32x4*)(XKD + ct * 64 + cc4) = kd;
                    if (cli == 0) CDn[ct] = cd;
                }
            }
            RW_BAR();
        }
        {
            const int pc = nch - 1;
            LAS float* YO = (LAS float*)(lds + RW_YO + (pc & 1) * 4096); LAS float* CD = (LAS float*)(lds + RW_CD + (pc & 1) * 128);
            const int t = ptid >> 3, c4 = (ptid & 7) * 4;
            const int n = pc * 32 + t; const int pos = dir ? (len - 1 - n) : n; const int tok = start + pos;
            const f32x4 yv = *(const LAS f32x4*)(YO + t * 32 + c4);
            u32x2 w; w.x = cvtpk(yv[0], yv[1]); w.y = cvtpk(yv[2], yv[3]);
            if (c4 < nrows) { if (dir) *(u32x2*)(yb + (size_t)tok * 256 + h * 64 + rpart * nrows + c4) = w; else *(u32x2*)(mix + (size_t)tok * DM + h * 64 + rpart * nrows + c4) = w; }
            if (rpart == 0 && ptid < 32) { const int n2 = pc * 32 + ptid; const int pos2 = dir ? (len - 1 - n2) : n2; cdot[((size_t)(start + pos2) * 4 + h) * 2 + dir] = CD[ptid]; }
        }
    }
    __syncthreads();
}

constexpr int ML_QS = 0, ML_KS = 9216, ML_KT = 18432, ML_VT = 27648, ML_VWT = 36864, ML_PS = 46080, ML_CB = 55296, ML_WGT = 64512, ML_RR = 64768, ML_MROW = 65024,
              ML_SC = 65280, ML_EMT = 65536, ML_DENI = 65792, ML_NS = 66048, ML_A12 = 66304;
DI void mlstm_job(const KP& p, int l, int job, LAS unsigned char* lds, int tid) {
    int seq, hm, dir; seq_of_job(job, seq, hm, dir);
    int start, len; seq_info(seq, start, len);
    const bf16_t* proj = (const bf16_t*)(p.ws + WS_R);
    bf16_t* mix = (bf16_t*)(p.ws + WS_X1);
    bf16_t* hbp = (bf16_t*)(p.ws + WS_HBP);
    const float* cw = p.in[17] + l * 3 * 512;
    const float ibv = p.in[18][(l * 2 + dir) * 4 + hm], fbv = p.in[19][(l * 2 + dir) * 4 + hm];
    const int wave = tid >> 6, lane = tid & 63, r32 = lane & 31, hh = lane >> 5;
    LAS bf16_t* Qs = (LAS bf16_t*)(lds + ML_QS); LAS bf16_t* Ks = (LAS bf16_t*)(lds + ML_KS); LAS bf16_t* KT = (LAS bf16_t*)(lds + ML_KT);
    LAS bf16_t* VT = (LAS bf16_t*)(lds + ML_VT); LAS bf16_t* VWT = (LAS bf16_t*)(lds + ML_VWT); LAS bf16_t* Ps = (LAS bf16_t*)(lds + ML_PS); LAS bf16_t* CB = (LAS bf16_t*)(lds + ML_CB);
    LAS float* WGT = (LAS float*)(lds + ML_WGT); LAS float* RR = (LAS float*)(lds + ML_RR); LAS float* MROW = (LAS float*)(lds + ML_MROW); LAS float* SC = (LAS float*)(lds + ML_SC);
    LAS float* EMT = (LAS float*)(lds + ML_EMT); LAS float* DENI = (LAS float*)(lds + ML_DENI); LAS float* NS = (LAS float*)(lds + ML_NS); LAS float* A12 = (LAS float*)(lds + ML_A12);
    for (int i = tid; i < 64 * 72; i += NTHR) CB[i] = 0;
    if (tid < 64) NS[tid] = 0.f;
    f32x16 Creg = zero16();
    float Mst = 0.f;
    __syncthreads();
    const int nch = len >> 6;
    const int ll = tid >> 3, e8 = (tid & 7) * 8;
    for (int ch = 0; ch < nch; ++ch) {
        {
            const int n = ch * 64 + ll; const int pos = dir ? (len - 1 - n) : n; const int tok = start + pos;
#pragma unroll
            for (int which = 0; which < 2; ++which) {
                const int col = (which ? C_MK : C_MQ) + hm * 64 + e8; const int cwc = (which ? 256 : 0) + hm * 64 + e8;
                const bf16_t* bp = proj + (size_t)tok * NPROJ + col;
                const u32x4 cu = *(const u32x4*)bp; u32x4 pv = {0u, 0u, 0u, 0u}, nv = {0u, 0u, 0u, 0u};
                if (pos > 0) pv = *(const u32x4*)(bp - NPROJ);
                if (pos < len - 1) nv = *(const u32x4*)(bp + NPROJ);
                float o[8];
#pragma unroll
                for (int j = 0; j < 4; ++j) {
                    const f32x2 c0 = *(const f32x2*)(cw + cwc + 2 * j), c1 = *(const f32x2*)(cw + 512 + cwc + 2 * j), c2 = *(const f32x2*)(cw + 1024 + cwc + 2 * j);
                    const float v0 = c0.x * bflo(pv[j]) + c1.x * bflo(cu[j]) + c2.x * bflo(nv[j]);
                    const float v1 = c0.y * bfhi(pv[j]) + c1.y * bfhi(cu[j]) + c2.y * bfhi(nv[j]);
                    o[2 * j] = v0 * sigmoidf_(v0); o[2 * j + 1] = v1 * sigmoidf_(v1);
                }
                if (which) {
#pragma unroll
                    for (int j = 0; j < 8; ++j) o[j] *= 0.125f;
                }
                u32x4 w; w.x = cvtpk(o[0], o[1]); w.y = cvtpk(o[2], o[3]); w.z = cvtpk(o[4], o[5]); w.w = cvtpk(o[6], o[7]);
                if (!which) *(LAS u32x4*)(Qs + ll * 72 + e8) = w;
                else { *(LAS u32x4*)(Ks + ll * 72 + e8) = w;
#pragma unroll
                    for (int j = 0; j < 4; ++j) { KT[(e8 + 2 * j) * 72 + ll] = (bf16_t)(w[j] & 0xffffu); KT[(e8 + 2 * j + 1) * 72 + ll] = (bf16_t)(w[j] >> 16); } }
            }
        }
        if (wave == 0) {
            const int n = ch * 64 + lane; const int pos = dir ? (len - 1 - n) : n; const int tok = start + pos;
            const float igv = bf2f(proj[(size_t)tok * NPROJ + C_IG + dir * 4 + hm]) + ibv;
            const float fgv = bf2f(proj[(size_t)tok * NPROJ + C_FG + dir * 4 + hm]) + fbv;
            const float lf = (fgv > 0.f) ? -log1pf(__expf(-fgv)) : (fgv - log1pf(__expf(fgv)));
            float b = lf;
#pragma unroll
            for (int o = 1; o < 64; o <<= 1) { const float t2 = __shfl_up(b, o); if (lane >= o) b += t2; }
            const float bL = __shfl(b, 63);
            const float g = bL - b + igv;
            float mg = g;
#pragma unroll
            for (int o = 32; o >= 1; o >>= 1) mg = fmaxf(mg, __shfl_xor(mg, o));
            const float wgt = __expf(g - mg);
            const float r = igv - b;
            float cm = r;
#pragma unroll
            for (int o = 1; o < 64; o <<= 1) { const float t2 = __shfl_up(cm, o); if (lane >= o) cm = fmaxf(cm, t2); }
            const float mrow = fmaxf(cm, Mst);
            WGT[lane] = wgt; RR[lane] = r; MROW[lane] = mrow; SC[lane] = __expf(Mst - mrow); EMT[lane] = __expf(-(b + mrow));
            const float Mnew = fmaxf(bL + Mst, mg);
            if (lane == 0) { A12[0] = __expf(bL + Mst - Mnew); A12[1] = __expf(mg - Mnew); }
            Mst = Mnew;
        }
        __syncthreads();
        {
            const int n = ch * 64 + ll; const int pos = dir ? (len - 1 - n) : n; const int tok = start + pos;
            const u32x4 vv = *(const u32x4*)(proj + (size_t)tok * NPROJ + C_MV + hm * 64 + e8);
            const float wg = WGT[ll];
#pragma unroll
            for (int j = 0; j < 4; ++j) {
                VT[(e8 + 2 * j) * 72 + ll] = (bf16_t)(vv[j] & 0xffffu); VT[(e8 + 2 * j + 1) * 72 + ll] = (bf16_t)(vv[j] >> 16);
                const unsigned pw = cvtpk(bflo(vv[j]) * wg, bfhi(vv[j]) * wg);
                VWT[(e8 + 2 * j) * 72 + ll] = (bf16_t)(pw & 0xffffu); VWT[(e8 + 2 * j + 1) * 72 + ll] = (bf16_t)(pw >> 16);
            }
        }
        __syncthreads();
        if (wave < 4) {
            const int tb = wave >> 1, sb = wave & 1;
            f32x16 acc = zero16();
#pragma unroll
            for (int ks = 0; ks < 4; ++ks) {
                const bf16x8 a = *(const LAS bf16x8*)(Qs + (tb * 32 + r32) * 72 + ks * 16 + hh * 8);
                const bf16x8 b = *(const LAS bf16x8*)(Ks + (sb * 32 + r32) * 72 + ks * 16 + hh * 8);
                acc = MFMA32(a, b, acc);
            }
            const int s = sb * 32 + r32; const float rs_ = RR[s];
#pragma unroll
            for (int i = 0; i < 16; ++i) { const int t = tb * 32 + crow(i, hh); const float pvv = (s <= t) ? __expf(rs_ - MROW[t]) * acc[i] : 0.f; Ps[t * 72 + s] = f2bf(pvv); }
        } else {
            const int db = (wave - 4) >> 1, eb = (wave - 4) & 1;
            f32x16 kc = zero16();
#pragma unroll
            for (int ks = 0; ks < 4; ++ks) {
                const bf16x8 a = *(const LAS bf16x8*)(VWT + (db * 32 + r32) * 72 + ks * 16 + hh * 8);
                const bf16x8 b = *(const LAS bf16x8*)(KT + (eb * 32 + r32) * 72 + ks * 16 + hh * 8);
                kc = MFMA32(a, b, kc);
            }
            const float a1 = A12[0], a2 = A12[1];
#pragma unroll
            for (int i = 0; i < 16; ++i) Creg[i] = a1 * Creg[i] + a2 * kc[i];
        }
        __syncthreads();
        f32x16 acc = zero16();
        float ncv = 0.f;
        if (wave < 4) {
            const int tb = wave >> 1, db = wave & 1;
#pragma unroll
            for (int ks = 0; ks < 4; ++ks) {
                const bf16x8 a = *(const LAS bf16x8*)(Qs + (tb * 32 + r32) * 72 + ks * 16 + hh * 8);
                const bf16x8 b = *(const LAS bf16x8*)(CB + (db * 32 + r32) * 72 + ks * 16 + hh * 8);
                acc = MFMA32(a, b, acc);
            }
#pragma unroll
            for (int i = 0; i < 16; ++i) acc[i] *= SC[tb * 32 + crow(i, hh)];
#pragma unroll
            for (int ks = 0; ks < 4; ++ks) {
                const bf16x8 a = *(const LAS bf16x8*)(Ps + (tb * 32 + r32) * 72 + ks * 16 + hh * 8);
                const bf16x8 b = *(const LAS bf16x8*)(VT + (db * 32 + r32) * 72 + ks * 16 + hh * 8);
                acc = MFMA32(a, b, acc);
            }
        } else if (wave == 4) {
            float rsum = 0.f, qn = 0.f;
            for (int e = 0; e < 64; ++e) { rsum += bf2f(Ps[lane * 72 + e]); qn += bf2f(Qs[lane * 72 + e]) * NS[e]; }
            const float den = rsum + SC[lane] * qn;
            DENI[lane] = 1.f / fmaxf(fabsf(den), EMT[lane]);
        } else if (wave == 5) {
            for (int s = 0; s < 64; ++s) ncv += WGT[s] * bf2f(KT[lane * 72 + s]);
        }
        __syncthreads();
        if (wave < 4) {
            const int tb = wave >> 1, db = wave & 1;
#pragma unroll
            for (int i = 0; i < 16; ++i) {
                const int t = tb * 32 + crow(i, hh); const int n = ch * 64 + t; const int pos = dir ? (len - 1 - n) : n; const int tok = start + pos;
                const bf16_t o = f2bf(acc[i] * DENI[t]);
                if (dir) hbp[(size_t)tok * 256 + hm * 64 + db * 32 + r32] = o; else mix[(size_t)tok * DM + 768 + hm * 64 + db * 32 + r32] = o;
            }
        } else {
            const int db = (wave - 4) >> 1, eb = (wave - 4) & 1;
#pragma unroll
            for (int i = 0; i < 16; ++i) CB[(db * 32 + crow(i, hh)) * 72 + eb * 32 + r32] = f2bf(Creg[i]);
            if (wave == 5) NS[lane] = A12[0] * NS[lane] + A12[1] * ncv;
        }
        __syncthreads();
    }
}

DI void mixers_phase(const KP& p, int l, int cidx, LAS unsigned char* lds, int tid, int G, int bid) {
    unsigned* cnt = (unsigned*)(p.ws + WS_CNT) + cidx;
    LAS int* slot = (LAS int*)(lds + SLOT_OFF);
    for (;;) {
        if (tid == 0) *slot = (int)atomicAdd(cnt, 1u);
        __syncthreads();
        const int item = *slot;
        __syncthreads();
        if (item >= 240 + 1536) break;
        int kind, jb;
        if (item < 32) { kind = 0; jb = item; } else if (item < 48) { kind = 1; jb = item - 32; } else if (item < 176) { kind = 0; jb = item - 48 + 32; }
        else if (item < 240) { kind = 1; jb = item - 176 + 16; } else { kind = 2; jb = item - 240; }
        int t2 = tid; asm volatile("" : "+v"(t2));
#ifndef REP_R
#define REP_R 1
#endif
#ifndef REP_M
#define REP_M 1
#endif
#ifndef REP_T
#define REP_T 1
#endif
        if (kind == 0) { rwkv_job(p, l, jb, lds, t2); }
        else if (kind == 1) { for (int rep = 0; rep < REP_M; ++rep) { mlstm_job(p, l, jb, lds, t2); __syncthreads(); } }
        else { for (int rep = 0; rep < REP_T; ++rep) { attn_unit(p, l, jb, lds, t2); __syncthreads(); } }
        __syncthreads();
    }
}

constexpr int PO_G2T = 0, PO_AS = 69632, PO_GO = 87040;
DI void post_phase(const KP& p, int l, LAS unsigned char* lds, int tid, int G, int bid) {
    const bf16_t* proj = (const bf16_t*)(p.ws + WS_R);
    bf16_t* mix = (bf16_t*)(p.ws + WS_X1);
    const bf16_t* yb = (const bf16_t*)(p.ws + WS_YB);
    const bf16_t* hbp = (const bf16_t*)(p.ws + WS_HBP);
    const float* cdot = (const float*)(p.ws + WS_CDOT);
    const float* mu = p.in[4] + l * 1152;
    const float* lnw = p.in[13] + l * 256; const float* lnb = p.in[14] + l * 256; const float* nw = p.in[20] + l * 256;
    LAS bf16_t* G2T = (LAS bf16_t*)(lds + PO_G2T); LAS bf16_t* AS = (LAS bf16_t*)(lds + PO_AS); LAS bf16_t* GO = (LAS bf16_t*)(lds + PO_GO);
    const int wave = tid >> 6, lane = tid & 63, r32 = lane & 31, hh = lane >> 5;
    { const float* g2 = p.in[9] + (size_t)l * 128 * 256;
      for (int i = 0; i < 64; ++i) { const int idx = tid + NTHR * i; const int mm = idx >> 8, c = idx & 255; G2T[c * 136 + mm] = f2bf(g2[idx]); } }
    __syncthreads();
    for (int unit = bid; unit < T / 64; unit += G) {
        const int tok0 = unit * 64;
        int len; const int st = tok_seq_start(tok0, len);
#pragma unroll
        for (int i = 0; i < 4; ++i) {
            const int q = tid + NTHR * i; const int t = q >> 5, c4 = (q & 31) * 4; const int tok = tok0 + t; const int pos = tok - st;
            const bf16_t* bp = proj + (size_t)tok * NPROJ + C_GD + c4;
            const u32x2 cu = *(const u32x2*)bp; u32x2 pv = {0u, 0u}, nv = {0u, 0u};
            if (pos > 0) pv = *(const u32x2*)(bp - NPROJ);
            if (pos < len - 1) nv = *(const u32x2*)(bp + NPROJ);
            const f32x4 m4 = *(const f32x4*)(mu + C_GD + c4);
            float x[4] = {bflo(cu.x), bfhi(cu.x), bflo(cu.y), bfhi(cu.y)};
            const float pn[4] = {bflo(pv.x) + bflo(nv.x), bfhi(pv.x) + bfhi(nv.x), bflo(pv.y) + bflo(nv.y), bfhi(pv.y) + bfhi(nv.y)};
#pragma unroll
            for (int j = 0; j < 4; ++j) x[j] = sigmoidf_(x[j] + (0.5f * pn[j] - x[j]) * m4[j]);
            u32x2 w; w.x = cvtpk(x[0], x[1]); w.y = cvtpk(x[2], x[3]); *(LAS u32x2*)(AS + t * 136 + c4) = w;
        }
        __syncthreads();
        {
            const int hd = wave & 3, tb = wave >> 2;
            f32x16 a0 = zero16(), a1 = zero16();
#pragma unroll
            for (int ks = 0; ks < 8; ++ks) {
                const bf16x8 a = *(const LAS bf16x8*)(AS + (tb * 32 + r32) * 136 + ks * 16 + hh * 8);
                const bf16x8 b0 = *(const LAS bf16x8*)(G2T + (hd * 64 + r32) * 136 + ks * 16 + hh * 8);
                const bf16x8 b1 = *(const LAS bf16x8*)(G2T + (hd * 64 + 32 + r32) * 136 + ks * 16 + hh * 8);
                a0 = MFMA32(a, b0, a0); a1 = MFMA32(a, b1, a1);
            }
#pragma unroll
            for (int i = 0; i < 16; ++i) { const int t = tb * 32 + crow(i, hh); GO[t * 264 + hd * 64 + r32] = f2bf(a0[i]); GO[t * 264 + hd * 64 + 32 + r32] = f2bf(a1[i]); }
        }
        __syncthreads();
#pragma unroll 1
        for (int it = 0; it < 8; ++it) {
            const int task = tid + NTHR * it; const int grp = task >> 4, li = task & 15; const int t = grp >> 2, hd = grp & 3; const int c4 = li * 4;
            const int tok = tok0 + t; const int pos = tok - st;
            {
                const u32x2 yf = *(const u32x2*)(mix + (size_t)tok * DM + hd * 64 + c4), ybv = *(const u32x2*)(yb + (size_t)tok * 256 + hd * 64 + c4);
                float x[4] = {bflo(yf.x) + bflo(ybv.x), bfhi(yf.x) + bfhi(ybv.x), bflo(yf.y) + bflo(ybv.y), bfhi(yf.y) + bfhi(ybv.y)};
                const float mean = red16(x[0] + x[1] + x[2] + x[3]) * (1.f / 64.f);
                float vs = 0.f;
#pragma unroll
                for (int j = 0; j < 4; ++j) { x[j] -= mean; vs += x[j] * x[j]; }
                const float rstd = rsqrtf(red16(vs) * (1.f / 64.f) + 64e-5f);
                const bf16_t* bp = proj + (size_t)tok * NPROJ + C_V + hd * 64 + c4;
                const u32x2 cu = *(const u32x2*)bp; u32x2 pv = {0u, 0u}, nv = {0u, 0u};
                if (pos > 0) pv = *(const u32x2*)(bp - NPROJ);
                if (pos < len - 1) nv = *(const u32x2*)(bp + NPROJ);
                const f32x4 m4 = *(const f32x4*)(mu + C_V + hd * 64 + c4);
                float v[4] = {bflo(cu.x), bfhi(cu.x), bflo(cu.y), bfhi(cu.y)};
                const float pn[4] = {bflo(pv.x) + bflo(nv.x), bfhi(pv.x) + bfhi(nv.x), bflo(pv.y) + bflo(nv.y), bfhi(pv.y) + bfhi(nv.y)};
                const f32x2 cdv = *(const f32x2*)(cdot + ((size_t)tok * 4 + hd) * 2);
                const float cds = cdv.x + cdv.y;
                const f32x4 lw = *(const f32x4*)(lnw + hd * 64 + c4), lb = *(const f32x4*)(lnb + hd * 64 + c4);
                const u32x2 gv = *(const LAS u32x2*)(GO + t * 264 + hd * 64 + c4);
                const float g[4] = {bflo(gv.x), bfhi(gv.x), bflo(gv.y), bfhi(gv.y)};
                float o[4];
#pragma unroll
                for (int j = 0; j < 4; ++j) { const float vsft = v[j] + (0.5f * pn[j] - v[j]) * m4[j]; o[j] = (x[j] * rstd * lw[j] + lb[j] + cds * vsft) * g[j]; }
                u32x2 w; w.x = cvtpk(o[0], o[1]); w.y = cvtpk(o[2], o[3]); *(u32x2*)(mix + (size_t)tok * DM + hd * 64 + c4) = w;
            }
            {
                const u32x2 hf = *(const u32x2*)(mix + (size_t)tok * DM + 768 + hd * 64 + c4), hb = *(const u32x2*)(hbp + (size_t)tok * 256 + hd * 64 + c4);
                const float x[4] = {bflo(hf.x) + bflo(hb.x), bfhi(hf.x) + bfhi(hb.x), bflo(hf.y) + bflo(hb.y), bfhi(hf.y) + bfhi(hb.y)};
                const float ms = red16(x[0] * x[0] + x[1] * x[1] + x[2] * x[2] + x[3] * x[3]) * (1.f / 64.f);
                const float rinv = rsqrtf(ms + 1e-6f);
                const u32x2 ov = *(const u32x2*)(proj + (size_t)tok * NPROJ + C_MO + hd * 64 + c4);
                const float og[4] = {bflo(ov.x), bfhi(ov.x), bflo(ov.y), bfhi(ov.y)};
                const f32x4 nwv = *(const f32x4*)(nw + hd * 64 + c4);
                float o[4];
#pragma unroll
                for (int j = 0; j < 4; ++j) o[j] = sigmoidf_(og[j]) * x[j] * rinv * nwv[j];
                u32x2 w; w.x = cvtpk(o[0], o[1]); w.y = cvtpk(o[2], o[3]); *(u32x2*)(mix + (size_t)tok * DM + 768 + hd * 64 + c4) = w;
            }
        }
        __syncthreads();
    }
}

DI void final_phase(const KP& p, int tid, int G, int bid) {
    const float* ss = (const float*)(p.ws + WS_SS) + 4 * T;
    const float* g = p.in[25];
    for (size_t i = (size_t)bid * NTHR + tid; i < (size_t)T * 256; i += (size_t)G * NTHR) {
        const int row = (int)(i >> 8), c = (int)(i & 255) * 4;
        const float rs = rsqrtf(ss[row] * (1.f / 1024.f) + 1e-6f);
        f32x4 v = *(const f32x4*)(p.out + i * 4); const f32x4 gv = *(const f32x4*)(g + c);
        v[0] *= rs * gv[0]; v[1] *= rs * gv[1]; v[2] *= rs * gv[2]; v[3] *= rs * gv[3];
        *(f32x4*)(p.out + i * 4) = v;
    }
}

__global__ void __launch_bounds__(NTHR, 2) fwd_kernel(KP p) {
    extern __shared__ __attribute__((aligned(16))) unsigned char lds_raw[];
    LAS unsigned char* lds = (LAS unsigned char*)lds_raw;
    cg::grid_group grid = cg::this_grid();
    int tid = threadIdx.x; const int G = gridDim.x, bid = blockIdx.x;
#define LAUNDER() asm volatile("" : "+v"(tid))
    float* ss = (float*)(p.ws + WS_SS);
    bf16_t* X1 = (bf16_t*)(p.ws + WS_X1);
    bf16_t* PROJ = (bf16_t*)(p.ws + WS_R);
    bf16_t* HB = (bf16_t*)(p.ws + WS_R);
    bf16_t* HID = (bf16_t*)(p.ws + WS_HID);

        LAUNDER();
    p0_phase(p, lds, tid, G, bid);
    grid.sync();
#ifdef PROBE_P0X2
    LAUNDER(); p0_phase(p, lds, tid, G, bid);
    grid.sync();
#endif
#ifdef PROBE_SYNC10
    for (int i = 0; i < 10; ++i) grid.sync();
#endif
    for (int l = 0; l < 2; ++l) {
        {
            pg8::Gemm g{X1, (const bf16_t*)(p.ws + WS_WIN) + (size_t)l * NPROJ * 1024, T, NPROJ, 1024}; pg8::StaticOrder S; S.init(T, NPROJ, G, bid);
            EpiProj E{PROJ, ss + (2 * l) * T};
            pg8::gemm_phase<EpiProj, pg8::StaticOrder, true, true>(lds, g, S, E);
#ifdef PROBE_P1X2
            grid.sync();
            pg8::gemm_phase<EpiProj, pg8::StaticOrder, true, true>(lds, g, S, E);
#endif
        }
        grid.sync();
        LAUNDER();
        prep_phase(p, l, lds, tid, G, bid);
        grid.sync();
        LAUNDER();
        mixers_phase(p, l, l, lds, tid, G, bid);
#ifdef PROBE_MIX2
        grid.sync(); LAUNDER();
        mixers_phase(p, l, l + 2, lds, tid, G, bid);
#endif
        grid.sync();
        LAUNDER();
        post_phase(p, l, lds, tid, G, bid);
        grid.sync();
        {
            pg8::Gemm g{X1, (const bf16_t*)(p.ws + WS_WOUT) + (size_t)l * 1024 * 1024, T, DM, 1024}; pg8::StaticOrder S; S.init(T, DM, G, bid);
            EpiRes<true, true> E{p.out, HB, ss + (2 * l + 1) * T};
            pg8::gemm_phase<EpiRes<true, true>, pg8::StaticOrder, true, true>(lds, g, S, E);
        }
        grid.sync();
        for (int hf = 0; hf < 2; ++hf) {
            {
                pg8::Gemm g{HB, (const bf16_t*)(p.ws + WS_W1) + (size_t)l * 4096 * 1024 + (size_t)hf * HFF * 1024, T, HFF, 1024}; pg8::StaticOrder S; S.init(T, HFF, G, bid);
                EpiRelu2 E{HID, ss + (2 * l + 1) * T};
                pg8::gemm_phase<EpiRelu2, pg8::StaticOrder, true, true>(lds, g, S, E);
            }
            grid.sync();
            {
                pg8::Gemm g{HID, (const bf16_t*)(p.ws + WS_W2) + (size_t)l * 2 * 1024 * 2048 + (size_t)hf * 1024 * 2048, T, DM, HFF}; pg8::StaticOrder S; S.init(T, DM, G, bid);
                if (hf == 0) { EpiRes<false, false> E{p.out, nullptr, nullptr}; pg8::gemm_phase<EpiRes<false, false>, pg8::StaticOrder, true, true>(lds, g, S, E); }
                else { EpiRes<true, true> E{p.out, X1, ss + (2 * l + 2) * T}; pg8::gemm_phase<EpiRes<true, true>, pg8::StaticOrder, true, true>(lds, g, S, E); }
            }
            grid.sync();
        }
    }
        LAUNDER();
    final_phase(p, tid, G, bid);
}

extern "C" void kernel_launch(void* const* d_in, const int* in_sizes, int n_in, void* d_out, int out_size, void* d_ws, size_t ws_size, hipStream_t stream) {
    static int grid_blocks = 0;
    if (grid_blocks == 0) {
        if (n_in != 26 || out_size != T * DM || ws_size < WS_END) { fprintf(stderr, "kernel_launch: unexpected shapes (n_in %d out %d ws %zu)\n", n_in, out_size, ws_size); grid_blocks = -1; return; }
        int dev = 0, cus = 0, per_cu = 0;
        hipGetDevice(&dev);
        hipDeviceGetAttribute(&cus, hipDeviceAttributeMultiprocessorCount, dev);
        hipFuncSetAttribute((const void*)fwd_kernel, hipFuncAttributeMaxDynamicSharedMemorySize, LDS_BYTES);
        hipOccupancyMaxActiveBlocksPerMultiprocessor(&per_cu, (const void*)fwd_kernel, NTHR, LDS_BYTES);
        if (per_cu < 1) per_cu = 1;
        grid_blocks = cus * per_cu;
        (void)hipGetLastError();
    }
    if (grid_blocks < 0) return;
    KP p{};
    for (int i = 0; i < 26; ++i) p.in[i] = (const float*)d_in[i];
    p.out = (float*)d_out; p.ws = (unsigned char*)d_ws;
    void* args[] = {&p};
    hipError_t e = hipLaunchCooperativeKernel((const void*)fwd_kernel, dim3(grid_blocks), dim3(NTHR), args, LDS_BYTES, stream);
    if (e != hipSuccess) fprintf(stderr, "cooperative launch failed: %s (grid %d)\n", hipGetErrorString(e), grid_blocks);
}
```

```cpp
#include <hip/hip_runtime.h>
#include <hip/hip_cooperative_groups.h>
#include <cstdio>
#include <cstdint>
namespace cg = cooperative_groups;
namespace pg8 {
#define PG8_LAS __attribute__((address_space(3)))
typedef unsigned short bf16_t;
typedef short bf16x8 __attribute__((ext_vector_type(8)));
typedef float f32x4 __attribute__((ext_vector_type(4)));
typedef unsigned u32x4 __attribute__((ext_vector_type(4)));
constexpr int BM = 256, BK = 64, HALF = 128, HTB = HALF * BK * 2  , STAGE_BYTES = 8 * HTB, NXCD = 8, WGM = 8;

__host__ __device__ __forceinline__ int lds_byte(int r, int c) { const int st = (r >> 4) * 2 + (c >> 5), rr = r & 15, cc = c & 31, ob = rr * 64 + cc * 2; return st * 1024 + (ob ^ (((ob >> 9) & 1) << 5)); }
__host__ __device__ __forceinline__ void stage_rc(int b, int& R, int& C) { const int st = b / 1024, sb = b % 1024, swz = sb ^ (((sb >> 9) & 1) << 5); R = (st >> 1) * 16 + swz / 64; C = (st & 1) * 32 + (swz % 64) / 2; }
__host__ __device__ __forceinline__ int perm32(int rho) { const int n = rho >> 4, i = rho & 15; return 8 * (i >> 2) + 4 * n + (i & 3); }

struct Unit { int pm, pn; };
struct Gemm { const bf16_t* A; const bf16_t* Bt; int M, N, K; };

struct StaticOrder {
    int nM, nN, nwg, G, c;
    __host__ __device__ void init(int M, int N, int G_, int c_) { nM = M / BM; nN = N / BM; nwg = nM * nN; G = G_; c = c_; }
    __host__ __device__ bool next(int i, Unit& u) const {
        const long L = (long)i * G + c; if (L >= nwg) return false;
        int wgid = (int)L; { const int q = nwg / NXCD, r = nwg % NXCD, xcd = wgid % NXCD, off = wgid / NXCD; wgid = (xcd < r ? xcd * (q + 1) : r * (q + 1) + (xcd - r) * q) + off; }
        const int nig = WGM * nN, gid = wgid / nig, fm = gid * WGM, gsz = (nM - fm) < WGM ? (nM - fm) : WGM;
        u.pm = fm + ((wgid % nig) % gsz); u.pn = (wgid % nig) / gsz; return true;
    }
    __device__ __forceinline__ void a_ready(const Unit&) const {}
    __device__ __forceinline__ void done(const Unit&) const {}
};

template <class Epi, class Sched, bool ALIGN_EPI = false, bool SP2 = false>
__device__ __forceinline__ void gemm_phase(PG8_LAS unsigned char* lds, const Gemm g, const Sched& S, const Epi& E) {
    int tid_l = threadIdx.x; asm volatile("" : "+v"(tid_l));
    const int tid = tid_l, wid = __builtin_amdgcn_readfirstlane(tid >> 6), lane = tid & 63, wr = wid >> 2, wc = wid & 3, fr = lane & 15, fq = lane >> 4;
    const int K = g.K, nt = K / BK;
    unsigned voffA[2], voffB[2];
#pragma unroll
    for (int i = 0; i < 2; ++i) { int R, C; stage_rc(tid * 16 + i * 8192, R, C); const int Rb = Epi::PERM ? ((R & ~31) + perm32(R & 31)) : R;
        voffA[i] = (unsigned)(R * K + C) * 2u; voffB[i] = (unsigned)(Rb * K + C) * 2u; }
    const size_t kstep = (size_t)(BK * 2);
    const size_t hstep = (size_t)HALF * K * 2;
    const size_t tstep = 2 * hstep;
    const unsigned ldsw = (unsigned)wid * 1024u;
    const int aoff = lds_byte(wr * 64 + fr, fq * 8), boff = lds_byte(wc * 32 + fr, fq * 8);
#define PG8_SA(b, h) (((b) * 2 + (h)) * HTB)
#define PG8_SB(b, h) ((4 + (b) * 2 + (h)) * HTB)
#define PG8_STAGE(bufoff, gbase, voff) do { _Pragma("unroll") for (int _i = 0; _i < 2; ++_i) \
        __builtin_amdgcn_global_load_lds((const unsigned*)((const char*)(gbase) + (voff)[_i]), (PG8_LAS unsigned*)(lds + (bufoff) + ldsw + _i * 8192), 16, 0, 0); } while (0)
#define PG8_LDA(dst, b, h) do { _Pragma("unroll") for (int m = 0; m < 4; ++m) _Pragma("unroll") for (int k = 0; k < 2; ++k) dst[m][k] = *(const PG8_LAS bf16x8*)(lds + PG8_SA(b, h) + aoff + m * 2048 + k * 1024); } while (0)
#define PG8_LDB(dst, b, h) do { _Pragma("unroll") for (int n = 0; n < 2; ++n) _Pragma("unroll") for (int k = 0; k < 2; ++k) dst[n][k] = *(const PG8_LAS bf16x8*)(lds + PG8_SB(b, h) + boff + n * 2048 + k * 1024); } while (0)
#define PG8_MMA(ai, bj, At, Bt) do { __builtin_amdgcn_s_setprio(1); _Pragma("unroll") for (int m = 0; m < 4; ++m) _Pragma("unroll") for (int n = 0; n < 2; ++n) _Pragma("unroll") for (int k = 0; k < 2; ++k) \
        acc[ai][bj][m][n] = __builtin_amdgcn_mfma_f32_16x16x32_bf16(Bt[n][k], At[m][k], acc[ai][bj][m][n], 0, 0, 0); __builtin_amdgcn_s_setprio(0); } while (0)
#define PG8_WAIT_V(n) asm volatile("s_waitcnt vmcnt(" #n ")" ::: "memory")
#define PG8_WAIT_L(n) asm volatile("s_waitcnt lgkmcnt(" #n ")" ::: "memory")
#define PG8_BAR __builtin_amdgcn_s_barrier()
#define PG8_SCHED __builtin_amdgcn_sched_barrier(0)
    Unit cur, nxt; int ui = 0;
    if (!S.next(0, cur)) return;
    f32x4 acc[2][2][4][2];
#pragma unroll
    for (int a = 0; a < 2; ++a)
#pragma unroll
        for (int b = 0; b < 2; ++b)
#pragma unroll
            for (int m = 0; m < 4; ++m)
#pragma unroll
                for (int n = 0; n < 2; ++n) acc[a][b][m][n] = (f32x4){0.f, 0.f, 0.f, 0.f};
    bf16x8 At[4][2], B0[2][2], B1[2][2];
    const char* cA = (const char*)g.A + (size_t)cur.pm * tstep; const char* cB = (const char*)g.Bt + (size_t)cur.pn * tstep;
    S.a_ready(cur);
    if constexpr (SP2) {
        PG8_STAGE(PG8_SB(0, 0), cB, voffB); PG8_STAGE(PG8_SB(0, 1), cB + hstep, voffB); PG8_STAGE(PG8_SA(0, 0), cA, voffA); PG8_STAGE(PG8_SA(0, 1), cA + hstep, voffA);
        if (wr == 1) PG8_BAR;
        PG8_WAIT_V(2); PG8_BAR;
        PG8_STAGE(PG8_SB(1, 0), cB + kstep, voffB); PG8_STAGE(PG8_SA(1, 0), cA + kstep, voffA); PG8_STAGE(PG8_SB(1, 1), cB + hstep + kstep, voffB);
        PG8_WAIT_V(6); PG8_BAR;
    } else {
        PG8_STAGE(PG8_SB(0, 0), cB, voffB); PG8_STAGE(PG8_SA(0, 0), cA, voffA); PG8_STAGE(PG8_SB(0, 1), cB + hstep, voffB); PG8_STAGE(PG8_SA(0, 1), cA + hstep, voffA);
        if (wr == 1) PG8_BAR;
        PG8_WAIT_V(4); PG8_BAR;
        PG8_STAGE(PG8_SB(1, 0), cB + kstep, voffB); PG8_STAGE(PG8_SA(1, 0), cA + kstep, voffA); PG8_STAGE(PG8_SB(1, 1), cB + hstep + kstep, voffB);
        PG8_WAIT_V(6); PG8_BAR;
    }
    for (;;) {
        const bool has_next = S.next(ui + 1, nxt);
        const char* nA = has_next ? (const char*)g.A + (size_t)nxt.pm * tstep : cA; const char* nB = has_next ? (const char*)g.Bt + (size_t)nxt.pn * tstep : cB;
        for (int t = 0; t < nt; t += 2) {
            const bool last = (t == nt - 2);
            const char* a1 = cA + (size_t)(t + 1) * kstep;
            const char* a2 = last ? nA : cA + (size_t)(t + 2) * kstep; const char* b2 = last ? nB : cB + (size_t)(t + 2) * kstep;
            const char* a3 = a2 + kstep; const char* b3 = b2 + kstep;
            if (last && has_next) S.a_ready(nxt);
            if constexpr (SP2) {
            PG8_LDB(B0, 0, 0); PG8_LDB(B1, 0, 1); PG8_SCHED; PG8_LDA(At, 0, 0); PG8_STAGE(PG8_SA(1, 1), a1 + hstep, voffA);
            PG8_WAIT_V(8); PG8_WAIT_L(0); PG8_BAR; PG8_MMA(0, 0, At, B0); PG8_MMA(0, 1, At, B1); PG8_BAR; PG8_SCHED;
            PG8_LDA(At, 0, 1); PG8_STAGE(PG8_SB(0, 0), b2, voffB); PG8_STAGE(PG8_SB(0, 1), b2 + hstep, voffB); PG8_STAGE(PG8_SA(0, 0), a2, voffA);
            PG8_WAIT_V(8); PG8_WAIT_L(0); PG8_BAR; PG8_MMA(1, 0, At, B0); PG8_MMA(1, 1, At, B1); PG8_BAR; PG8_SCHED;
            PG8_LDB(B0, 1, 0); PG8_LDB(B1, 1, 1); PG8_SCHED; PG8_LDA(At, 1, 0); PG8_STAGE(PG8_SA(0, 1), a2 + hstep, voffA);
            PG8_WAIT_V(8); PG8_WAIT_L(0); PG8_BAR; PG8_MMA(0, 0, At, B0); PG8_MMA(0, 1, At, B1); PG8_BAR; PG8_SCHED;
            PG8_LDA(At, 1, 1); PG8_STAGE(PG8_SB(1, 0), b3, voffB); PG8_STAGE(PG8_SB(1, 1), b3 + hstep, voffB); PG8_STAGE(PG8_SA(1, 0), a3, voffA);
            PG8_WAIT_V(8); PG8_WAIT_L(0); PG8_BAR; PG8_MMA(1, 0, At, B0); PG8_MMA(1, 1, At, B1); PG8_BAR; PG8_SCHED;
            } else {
            PG8_LDB(B0, 0, 0); PG8_SCHED; PG8_LDA(At, 0, 0); PG8_STAGE(PG8_SA(1, 1), a1 + hstep, voffA);
            PG8_WAIT_L(8); PG8_BAR; PG8_WAIT_L(0); PG8_MMA(0, 0, At, B0); PG8_BAR; PG8_SCHED;
            PG8_LDB(B1, 0, 1); PG8_STAGE(PG8_SB(0, 0), b2, voffB);
            PG8_BAR; PG8_WAIT_L(0); PG8_MMA(0, 1, At, B1); PG8_BAR;
            PG8_LDA(At, 0, 1); PG8_STAGE(PG8_SA(0, 0), a2, voffA);
            PG8_BAR; PG8_WAIT_L(0); PG8_MMA(1, 0, At, B0); PG8_BAR; PG8_SCHED;
            PG8_STAGE(PG8_SB(0, 1), b2 + hstep, voffB);
            PG8_WAIT_V(6); PG8_BAR; PG8_MMA(1, 1, At, B1); PG8_BAR;
            PG8_LDB(B0, 1, 0); PG8_SCHED; PG8_LDA(At, 1, 0); PG8_STAGE(PG8_SA(0, 1), a2 + hstep, voffA);
            PG8_WAIT_L(8); PG8_BAR; PG8_WAIT_L(0); PG8_MMA(0, 0, At, B0); PG8_BAR; PG8_SCHED;
            PG8_LDB(B1, 1, 1); PG8_STAGE(PG8_SB(1, 0), b3, voffB);
            PG8_BAR; PG8_WAIT_L(0); PG8_MMA(0, 1, At, B1); PG8_BAR;
            PG8_LDA(At, 1, 1); PG8_STAGE(PG8_SA(1, 0), a3, voffA);
            PG8_BAR; PG8_WAIT_L(0); PG8_MMA(1, 0, At, B0); PG8_BAR; PG8_SCHED;
            PG8_STAGE(PG8_SB(1, 1), b3 + hstep, voffB);
            PG8_WAIT_V(6); PG8_BAR; PG8_MMA(1, 1, At, B1); PG8_BAR;
            }
        }
        if constexpr (ALIGN_EPI) { if (wr == 0) PG8_BAR; }
        if constexpr (!Epi::AFTER_DRAIN) { E(acc, cur, wr, wc, fr, fq); S.done(cur); }
        if (!has_next) break;
#pragma unroll
        for (int a = 0; a < 2; ++a)
#pragma unroll
            for (int b = 0; b < 2; ++b)
#pragma unroll
                for (int m = 0; m < 4; ++m)
#pragma unroll
                    for (int n = 0; n < 2; ++n) acc[a][b][m][n] = (f32x4){0.f, 0.f, 0.f, 0.f};
        cur = nxt; cA = nA; cB = nB; ++ui;
        if constexpr (ALIGN_EPI) { if (wr == 1) PG8_BAR; }
    }
    PG8_WAIT_V(0);
    if constexpr (!ALIGN_EPI) { if (wr == 0) PG8_BAR; }
    PG8_BAR;
    if constexpr (Epi::AFTER_DRAIN) { E.fused(acc, cur, wr, wc, fr, fq, lds, wid, lane); S.done(cur); }
#undef PG8_SA
#undef PG8_SB
#undef PG8_STAGE
#undef PG8_LDA
#undef PG8_LDB
#undef PG8_MMA
#undef PG8_WAIT_V
#undef PG8_WAIT_L
#undef PG8_BAR
#undef PG8_SCHED
}
}

#define DI __device__ __forceinline__
#define LAS __attribute__((address_space(3)))
typedef unsigned short bf16_t;
typedef short bf16x8 __attribute__((ext_vector_type(8)));
typedef short s16x4 __attribute__((ext_vector_type(4)));
typedef float f32x4 __attribute__((ext_vector_type(4)));
typedef float f32x2 __attribute__((ext_vector_type(2)));
typedef float f32x16 __attribute__((ext_vector_type(16)));
typedef unsigned u32x4 __attribute__((ext_vector_type(4)));
typedef unsigned u32x2 __attribute__((ext_vector_type(2)));
typedef __bf16 bf16x2_t __attribute__((ext_vector_type(2)));
#define MFMA32(a, b, c) __builtin_amdgcn_mfma_f32_32x32x16_bf16((a), (b), (c), 0, 0, 0)

constexpr int T = 49152, DM = 1024, NPROJ = 3072, NIN = 2960, DFF = 4096, HFF = 2048;
constexpr int C_R = 0, C_K = 256, C_V = 512, C_WD = 768, C_AD = 896, C_GD = 1024;
constexpr int C_AQ = 1152, C_AK = 1664, C_AV = 1792;
constexpr int C_MQ = 1920, C_MK = 2176, C_MV = 2432, C_MO = 2688, C_IG = 2944, C_FG = 2952;
constexpr size_t MiB = 1u << 20;
constexpr size_t WS_SS = 0, WS_CNT = MiB - 4096, WS_CDOT = 1 * MiB, WS_TAB = 2 * MiB + 512 * 1024, WS_BAR = 2 * MiB + 768 * 1024, WS_WIN = 3 * MiB, WS_WOUT = 15 * MiB,
                 WS_W1 = 19 * MiB, WS_W2 = 35 * MiB, WS_VT = 51 * MiB, WS_YB = 63 * MiB, WS_HBP = 87 * MiB, WS_X1 = 111 * MiB, WS_R = 207 * MiB,
                 WS_HID = WS_R + 96 * MiB, WS_END = 495 * MiB;
constexpr int LDS_BYTES = 134400 + 256;
constexpr int NTHR = 512;

struct KP { const float* in[26]; float* out; unsigned char* ws; };

DI unsigned cvtpk(float lo, float hi) { f32x2 v = {lo, hi}; bf16x2_t b = __builtin_convertvector(v, bf16x2_t); return __builtin_bit_cast(unsigned, b); }
DI unsigned short f2bf(float f) { return (unsigned short)(cvtpk(f, 0.f) & 0xffffu); }
DI float bf2f(unsigned h) { return __builtin_bit_cast(float, h << 16); }
DI float bflo(unsigned w) { return __builtin_bit_cast(float, w << 16); }
DI float bfhi(unsigned w) { return __builtin_bit_cast(float, w & 0xffff0000u); }
DI int crow(int reg, int h) { return (reg & 3) + 8 * (reg >> 2) + 4 * h; }
template <int CTRL> DI float dppf(float v) { return __builtin_bit_cast(float, __builtin_amdgcn_update_dpp(0, __builtin_bit_cast(int, v), CTRL, 0xf, 0xf, true)); }
DI float red8(float v) { v += dppf<0xB1>(v); v += dppf<0x4E>(v); v += dppf<0x141>(v); return v; }
DI float red16(float v) { v = red8(v); v += dppf<0x128>(v); return v; }
DI float frcp(float x) { return __builtin_amdgcn_rcpf(x); }
DI float sigmoidf_(float x) { return frcp(1.f + __expf(-x)); }
DI f32x16 zero16() { f32x16 z; for (int i = 0; i < 16; ++i) z[i] = 0.f; return z; }
DI void seq_of_job(int j, int& seq, int& h, int& dir) { if (j < 16) { seq = 8 + (j >> 3); } else { j -= 16; seq = j >> 3; } h = (j >> 1) & 3; dir = j & 1; }
DI void seq_info(int s, int& start, int& len) { if (s < 8) { start = s * 4096; len = 4096; } else { start = 32768 + (s - 8) * 8192; len = 8192; } }
DI int tok_seq_start(int tok, int& len) { if (tok < 32768) { len = 4096; return tok & ~4095; } len = 8192; return 32768 + ((tok - 32768) & ~8191); }

#define XB_TMO      128
#define XB_XCNT(j)  (256  + 64 * (j))
#define XB_XSUB(j)  (1280 + 64 * (j))
#define XB_XGEN(j)  (2304 + 64 * (j))
#define XB_TOP      3328
#define XB_TOPGEN   3392
#define XCD_BAR_WORDS 3456
#define XB_SPIN_CAP (1u << 18)

__device__ __forceinline__ unsigned xb_ld(unsigned* p)              { return __hip_atomic_load(p, __ATOMIC_RELAXED, __HIP_MEMORY_SCOPE_AGENT); }
__device__ __forceinline__ unsigned xb_add(unsigned* p, unsigned v) { return __hip_atomic_fetch_add(p, v, __ATOMIC_RELAXED, __HIP_MEMORY_SCOPE_AGENT); }
__device__ __forceinline__ unsigned xb_xcc_id() { return (unsigned)__builtin_amdgcn_s_getreg((3 << 11) | 20) & 0xFu; }
#define XB_SPIN(cond, bar) do { unsigned _sp = 0; while (cond) { __builtin_amdgcn_s_sleep(1); \
    if ((++_sp & 255u) == 0u) { if (xb_ld(&(bar)[XB_TMO])) break; if (_sp > XB_SPIN_CAP) { atomicAdd(&(bar)[XB_TMO], 1u); break; } } } } while (0)

struct XcdBarrier {
    unsigned* bar; unsigned x;
    volatile LAS unsigned* st;
};

__device__ __forceinline__ XcdBarrier xcd_barrier_post(unsigned* bar, volatile LAS unsigned* st) {
    XcdBarrier b; b.bar = bar; b.x = xb_xcc_id(); b.st = st;
    if (threadIdx.x == 0) (void)xb_add(&bar[XB_XCNT(b.x)], 1u);
    return b;
}
__device__ __forceinline__ void xcd_barrier_complete(unsigned* bar, unsigned x, unsigned& nloc, unsigned& nx) {
    const unsigned G = gridDim.x * gridDim.y * gridDim.z;
    unsigned sum, cnt, mine, sp = 0u;
    for (;;) {
        sum = 0u; cnt = 0u; mine = 0u;
#pragma unroll
        for (unsigned j = 0; j < 16; ++j) { const unsigned c = xb_ld(&bar[XB_XCNT(j)]); sum += c; cnt += (c > 0u) ? 1u : 0u; mine = (j == x) ? c : mine; }
        if (sum == G) break;
        __builtin_amdgcn_s_sleep(1);
        if ((++sp & 255u) == 0u) { if (xb_ld(&bar[XB_TMO])) break; if (sp > XB_SPIN_CAP) { atomicAdd(&bar[XB_TMO], 1u); break; } }
    }
    nloc = mine > 0u ? mine : 1u; nx = cnt > 0u ? cnt : 1u;
}

__device__ __forceinline__ void xcd_barrier(const XcdBarrier& b) {
    asm volatile("s_waitcnt vmcnt(0)" ::: "memory");
    __syncthreads();
    if (threadIdx.x == 0) {
        unsigned* bar = b.bar;
        __builtin_amdgcn_s_waitcnt(0);
        unsigned nloc = b.st[0], nx = b.st[1];
        if (nloc == 0u) { xcd_barrier_complete(bar, b.x, nloc, nx); b.st[0] = nloc; b.st[1] = nx; }
        const unsigned old = xb_add(&bar[XB_XSUB(b.x)], 1u);
        const unsigned gen = old / nloc;
        if (old + 1u == (gen + 1u) * nloc) {
            __builtin_amdgcn_fence(__ATOMIC_RELEASE, "agent");
            asm volatile("s_waitcnt vmcnt(0)" ::: "memory");
            const unsigned og = xb_add(&bar[XB_TOP], 1u);
            const unsigned tg = og / nx;
            if (og + 1u == (tg + 1u) * nx) xb_add(&bar[XB_TOPGEN], 1u);
            else XB_SPIN(xb_ld(&bar[XB_TOPGEN]) == tg, bar);
            __builtin_amdgcn_fence(__ATOMIC_ACQUIRE, "agent");
            xb_add(&bar[XB_XGEN(b.x)], 1u);
            asm volatile("s_waitcnt vmcnt(0)" ::: "memory");
        } else {
            XB_SPIN(xb_ld(&bar[XB_XGEN(b.x)]) == gen, bar);
            __builtin_amdgcn_fence(__ATOMIC_ACQUIRE, "agent");
            asm volatile("s_waitcnt vmcnt(0)" ::: "memory");
        }
    }
    __syncthreads();
}

struct EpiProj {
    static constexpr bool PERM = true, AFTER_DRAIN = false;
    bf16_t* O; const float* ss;
    DI void operator()(const pg8::f32x4 (&acc)[2][2][4][2], const pg8::Unit& u, int wr, int wc, int fr, int fq) const {
        const int row0 = u.pm * 256 + wr * 64 + fr, col0 = u.pn * 256 + wc * 32 + 8 * fq;
#pragma unroll
        for (int ai = 0; ai < 2; ++ai)
#pragma unroll
            for (int m = 0; m < 4; ++m) {
                const int row = row0 + ai * 128 + m * 16;
                const float rs = rsqrtf(ss[row] * (1.f / 1024.f) + 1e-6f);
                bf16_t* rp = O + (size_t)row * NPROJ + col0;
#pragma unroll
                for (int bj = 0; bj < 2; ++bj) {
                    pg8::f32x4 v0 = acc[ai][bj][m][0] * rs, v1 = acc[ai][bj][m][1] * rs;
                    u32x4 w; w.x = cvtpk(v0[0], v0[1]); w.y = cvtpk(v0[2], v0[3]); w.z = cvtpk(v1[0], v1[1]); w.w = cvtpk(v1[2], v1[3]);
                    *(u32x4*)(rp + bj * 128) = w;
                }
            }
    }
};
struct EpiRelu2 {
    static constexpr bool PERM = true, AFTER_DRAIN = false;
    bf16_t* O; const float* ss;
    DI void operator()(const pg8::f32x4 (&acc)[2][2][4][2], const pg8::Unit& u, int wr, int wc, int fr, int fq) const {
        const int row0 = u.pm * 256 + wr * 64 + fr, col0 = u.pn * 256 + wc * 32 + 8 * fq;
#pragma unroll
        for (int ai = 0; ai < 2; ++ai)
#pragma unroll
            for (int m = 0; m < 4; ++m) {
                const int row = row0 + ai * 128 + m * 16;
                const float rs = rsqrtf(ss[row] * (1.f / 1024.f) + 1e-6f);
                bf16_t* rp = O + (size_t)row * HFF + col0;
#pragma unroll
                for (int bj = 0; bj < 2; ++bj) {
                    pg8::f32x4 v0 = acc[ai][bj][m][0] * rs, v1 = acc[ai][bj][m][1] * rs;
#pragma unroll
                    for (int j = 0; j < 4; ++j) { float a = fmaxf(v0[j], 0.f); v0[j] = a * a; float b = fmaxf(v1[j], 0.f); v1[j] = b * b; }
                    u32x4 w; w.x = cvtpk(v0[0], v0[1]); w.y = cvtpk(v0[2], v0[3]); w.z = cvtpk(v1[0], v1[1]); w.w = cvtpk(v1[2], v1[3]);
                    *(u32x4*)(rp + bj * 128) = w;
                }
            }
    }
};
template <bool WRITE_HB, bool DO_SS> struct EpiRes {
    static constexpr bool PERM = true, AFTER_DRAIN = false;
    float* X; bf16_t* HB; float* ss;
    DI void operator()(const pg8::f32x4 (&acc)[2][2][4][2], const pg8::Unit& u, int wr, int wc, int fr, int fq) const {
        const int row0 = u.pm * 256 + wr * 64 + fr, col0 = u.pn * 256 + wc * 32 + 8 * fq;
#pragma unroll
        for (int ai = 0; ai < 2; ++ai)
#pragma unroll
            for (int m = 0; m < 4; ++m) {
                const int row = row0 + ai * 128 + m * 16;
                float* xp = X + (size_t)row * DM + col0;
                float sq = 0.f;
#pragma unroll
                for (int bj = 0; bj < 2; ++bj) {
                    pg8::f32x4 a0 = *(const pg8::f32x4*)(xp + bj * 128), a1 = *(const pg8::f32x4*)(xp + bj * 128 + 4);
                    a0 += acc[ai][bj][m][0]; a1 += acc[ai][bj][m][1];
                    *(pg8::f32x4*)(xp + bj * 128) = a0; *(pg8::f32x4*)(xp + bj * 128 + 4) = a1;
                    if (WRITE_HB) { u32x4 w; w.x = cvtpk(a0[0], a0[1]); w.y = cvtpk(a0[2], a0[3]); w.z = cvtpk(a1[0], a1[1]); w.w = cvtpk(a1[2], a1[3]);
                        *(u32x4*)(HB + (size_t)row * DM + col0 + bj * 128) = w; }
                    if (DO_SS) sq += a0[0] * a0[0] + a0[1] * a0[1] + a0[2] * a0[2] + a0[3] * a0[3] + a1[0] * a1[0] + a1[1] * a1[1] + a1[2] * a1[2] + a1[3] * a1[3];
                }
                if (DO_SS) { sq += __shfl_xor(sq, 16); sq += __shfl_xor(sq, 32); if (fq == 0) atomicAdd(ss + row, sq); }
            }
    }
};

DI void transpose_tile(const float* src, int N, int nvalid, const float* gain, bf16_t* dst, int K, int kt, int nt, LAS float* tile, int tid) {
    const int a = tid & 63, b8 = tid >> 6;
#pragma unroll
    for (int i = 0; i < 8; ++i) { const int k = b8 + 8 * i, n = nt * 64 + a; float v = (n < nvalid) ? src[(size_t)(kt * 64 + k) * N + n] : 0.f; if (gain) v *= gain[kt * 64 + k]; tile[k * 65 + a] = v; }
    __syncthreads();
#pragma unroll
    for (int i = 0; i < 8; ++i) { const int n = b8 + 8 * i; dst[(size_t)(nt * 64 + n) * K + kt * 64 + a] = f2bf(tile[a * 65 + n]); }
    __syncthreads();
}
DI void p0_phase(const KP& p, LAS unsigned char* lds, int tid, int G, int bid) {
    LAS float* tile = (LAS float*)lds;
    for (int it = bid; it < 6144; it += G) {
        const int l = it / 3072; int r = it % 3072;
        const float* src; const float* gain; bf16_t* dst; int N, nvalid, K, kt, nt;
        if (r < 768) { src = p.in[3] + (size_t)l * 1024 * NIN; N = NIN; nvalid = NIN; K = 1024; gain = p.in[2] + l * 1024; dst = (bf16_t*)(p.ws + WS_WIN) + (size_t)l * NPROJ * 1024; kt = r / 48; nt = r % 48; }
        else if (r < 1024) { r -= 768; src = p.in[21] + (size_t)l * 1024 * 1024; N = 1024; nvalid = 1024; K = 1024; gain = nullptr; dst = (bf16_t*)(p.ws + WS_WOUT) + (size_t)l * 1024 * 1024; kt = r / 16; nt = r % 16; }
        else if (r < 2048) { r -= 1024; src = p.in[23] + (size_t)l * 1024 * 4096; N = 4096; nvalid = 4096; K = 1024; gain = p.in[22] + l * 1024; dst = (bf16_t*)(p.ws + WS_W1) + (size_t)l * 4096 * 1024; kt = r / 64; nt = r % 64; }
        else { r -= 2048; const int h = r / 512; r %= 512; src = p.in[24] + (size_t)l * 4096 * 1024 + (size_t)h * 2048 * 1024; N = 1024; nvalid = 1024; K = 2048; gain = nullptr;
               dst = (bf16_t*)(p.ws + WS_W2) + (size_t)l * 2 * 1024 * 2048 + (size_t)h * 1024 * 2048; kt = r / 16; nt = r % 16; }
        transpose_tile(src, N, nvalid, gain, dst, K, kt, nt, tile, tid);
    }
    const int wave = tid >> 6, lane = tid & 63;
    float* ss = (float*)(p.ws + WS_SS);
    bf16_t* xb = (bf16_t*)(p.ws + WS_X1);
    for (int row = bid * 8 + wave; row < T; row += G * 8) {
        const float* xs = (row < 32768) ? p.in[0] + (size_t)row * DM : p.in[1] + (size_t)(row - 32768) * DM;
        float sq = 0.f;
#pragma unroll
        for (int j = 0; j < 4; ++j) {
            const int c = (j * 64 + lane) * 4;
            const f32x4 v = *(const f32x4*)(xs + c);
            *(f32x4*)(p.out + (size_t)row * DM + c) = v;
            u32x2 w; w.x = cvtpk(v[0], v[1]); w.y = cvtpk(v[2], v[3]);
            *(u32x2*)(xb + (size_t)row * DM + c) = w;
            sq += v[0] * v[0] + v[1] * v[1] + v[2] * v[2] + v[3] * v[3];
        }
#pragma unroll
        for (int o = 32; o >= 1; o >>= 1) sq += __shfl_xor(sq, o);
        if (lane == 0) ss[row] = sq;
    }
    for (int i = bid * NTHR + tid; i < 4 * T; i += G * NTHR) ss[T + i] = 0.f;
    if (bid == 0) {
        if (tid < 64) ((unsigned*)(p.ws + WS_CNT))[tid] = 0u;
        float2* tab = (float2*)(p.ws + WS_TAB);
        for (int idx = tid; idx < 2048; idx += NTHR) { const int pos = idx >> 4, f = idx & 15; const float inv = powf(10000.f, -(float)f / 16.f); const float ang = (float)pos * inv; tab[idx] = make_float2(cosf(ang), sinf(ang)); }
    }
}

DI void prep_phase(const KP& p, int l, LAS unsigned char* lds, int tid, int G, int bid) {
    bf16_t* proj = (bf16_t*)(p.ws + WS_R);
    bf16_t* vT = (bf16_t*)(p.ws + WS_VT);
    const float2* tab = (const float2*)(p.ws + WS_TAB);
    const float* qn = p.in[15] + l * 64; const float* kn = p.in[16] + l * 64;
    const int wave = tid >> 6, lane = tid & 63, g = lane >> 4, li = lane & 15;
    LAS bf16_t* vts = (LAS bf16_t*)lds;
    for (int unit = bid; unit < T / 64; unit += G) {
        const int tok0 = unit * 64;
        for (int i = 0; i < 8; ++i) {
            const int tok = tok0 + wave * 8 + i; int len; const int st = tok_seq_start(tok, len); const int pos = tok - st; const int prow = pos >> 6, pcol = pos & 63;
#pragma unroll
            for (int it = 0; it < 3; ++it) {
                const bool act = (it < 2) || (g < 2);
                const int colbase = (it < 2) ? C_AQ + (it * 4 + g) * 64 : C_AK + (g & 1) * 64;
                const float* wn = (it < 2) ? qn : kn;
                bf16_t* ptr = proj + (size_t)tok * NPROJ + colbase + li * 4;
                const u32x2 raw = *(const u32x2*)ptr;
                float x[4] = {bflo(raw.x), bfhi(raw.x), bflo(raw.y), bfhi(raw.y)};
                float sq = x[0] * x[0] + x[1] * x[1] + x[2] * x[2] + x[3] * x[3];
                sq = red16(sq);
                const float rinv = rsqrtf(sq * (1.f / 64.f) + 1e-6f);
                const f32x4 w4 = *(const f32x4*)(wn + li * 4);
                const int idx = (li >> 3) ? pcol : prow; const bool second = (li >> 2) & 1;
                const float scale = (it < 2) ? 0.125f * 1.4426950408889634f : 1.f;
                float o[4];
#pragma unroll
                for (int j = 0; j < 4; ++j) {
                    const float y = x[j] * rinv * w4[j];
                    const float pr = __shfl_xor(y, 4);
                    const int f = (li * 4 + j) & 15;
                    const float2 cs = tab[idx * 16 + f];
                    o[j] = (second ? (y * cs.x + pr * cs.y) : (y * cs.x - pr * cs.y)) * scale;
                }
                if (act) { u32x2 w; w.x = cvtpk(o[0], o[1]); w.y = cvtpk(o[2], o[3]); *(u32x2*)ptr = w; }
            }
        }
#pragma unroll
        for (int i = 0; i < 2; ++i) { const int idx = tid + NTHR * i; const int tl = idx >> 4, c8 = (idx & 15) * 8;
            const u32x4 v = *(const u32x4*)(proj + (size_t)(tok0 + tl) * NPROJ + C_AV + c8); *(LAS u32x4*)(vts + tl * 136 + c8) = v; }
        __syncthreads();
        { const int c = tid >> 2, tq = tid & 3; unsigned w[8];
#pragma unroll
          for (int j = 0; j < 8; ++j) { const unsigned lo = vts[(tq * 16 + 2 * j) * 136 + c], hi = vts[(tq * 16 + 2 * j + 1) * 136 + c]; w[j] = lo | (hi << 16); }
          u32x4 a = {w[0], w[1], w[2], w[3]}, b = {w[4], w[5], w[6], w[7]};
          bf16_t* dp = vT + (size_t)c * T + tok0 + tq * 16; *(u32x4*)dp = a; *(u32x4*)(dp + 8) = b; }
        __syncthreads();
    }
}

DI void attn_unit(const KP& p, int l, int unit, LAS unsigned char* lds, int tid) {
    const float* qnw = p.in[15] + l * 64; const float* knw = p.in[16] + l * 64;
    const bf16_t* proj = (const bf16_t*)(p.ws + WS_R);
    const bf16_t* vT = (const bf16_t*)(p.ws + WS_VT);
    bf16_t* mix = (bf16_t*)(p.ws + WS_X1);
    int seq, kvh, qt;
    if (unit < 512) { seq = 8 + (unit >> 8); const int r = unit & 255; kvh = r >> 7; qt = r & 127; }
    else { const int u2 = unit - 512; seq = u2 >> 7; const int r = u2 & 127; kvh = r >> 6; qt = r & 63; }
    int start, len; seq_info(seq, start, len);
    const int nk = len >> 6;
    const int wave = tid >> 6, lane = tid & 63, r32 = lane & 31, hh = lane >> 5;
    const int head = kvh * 4 + (wave >> 1);
    const int q0 = start + qt * 64 + (wave & 1) * 32;
    bf16x8 qf[4];
    { const bf16_t* qp = proj + (size_t)(q0 + r32) * NPROJ + C_AQ + head * 64 + hh * 8;
#pragma unroll
      for (int ks = 0; ks < 4; ++ks) qf[ks] = *(const bf16x8*)(qp + ks * 16); }
    f32x16 o0 = zero16(), o1 = zero16();
    float lsum = 0.f;
    f32x16 sinit;
    { float mq = fabsf(qnw[lane]), mk = fabsf(knw[lane]);
#pragma unroll
      for (int o = 32; o >= 1; o >>= 1) { mq = fmaxf(mq, __shfl_xor(mq, o)); mk = fmaxf(mk, __shfl_xor(mk, o)); }
      const float bnd = 64.f * 0.125f * 1.4426950408889634f * 1.01f * mq * mk;
#pragma unroll
      for (int i = 0; i < 16; ++i) sinit[i] = -bnd; }
    const int lrow = tid >> 3, lseg = tid & 7;
    const bf16_t* kptr = proj + (size_t)(start + lrow) * NPROJ + C_AK + kvh * 64 + lseg * 8;
    const bf16_t* vptr = vT + (size_t)(kvh * 64 + lrow) * T + start + lseg * 8;
    const int lds_off = lrow * 144 + lseg * 16;
    u32x4 kreg = *(const u32x4*)kptr, vreg = *(const u32x4*)vptr;
    *(LAS u32x4*)(lds + lds_off) = kreg; *(LAS u32x4*)(lds + 9216 + lds_off) = vreg;
    __syncthreads();
    for (int j = 0; j < nk; ++j) {
        const bool more = (j + 1 < nk);
        if (more) { kreg = *(const u32x4*)(kptr + (size_t)(j + 1) * 64 * NPROJ); vreg = *(const u32x4*)(vptr + (j + 1) * 64); }
        LAS unsigned char* Ks = lds + (j & 1) * 18432; LAS unsigned char* Vs = Ks + 9216;
        f32x16 s0 = sinit, s1 = sinit;
#pragma unroll
        for (int ks = 0; ks < 4; ++ks) {
            const bf16x8 a0 = *(const LAS bf16x8*)(Ks + r32 * 144 + (ks * 16 + hh * 8) * 2);
            const bf16x8 a1 = *(const LAS bf16x8*)(Ks + (32 + r32) * 144 + (ks * 16 + hh * 8) * 2);
            s0 = MFMA32(a0, qf[ks], s0); s1 = MFMA32(a1, qf[ks], s1);
        }
        float rs = 0.f;
#pragma unroll
        for (int i = 0; i < 16; ++i) { s0[i] = __builtin_amdgcn_exp2f(s0[i]); rs += s0[i]; }
#pragma unroll
        for (int i = 0; i < 16; ++i) { s1[i] = __builtin_amdgcn_exp2f(s1[i]); rs += s1[i]; }
        lsum += rs;
#pragma unroll
        for (int mb = 0; mb < 2; ++mb)
#pragma unroll
            for (int s = 0; s < 2; ++s) {
                u32x4 pk;
                if (mb == 0) { pk.x = cvtpk(s0[8 * s], s0[8 * s + 1]); pk.y = cvtpk(s0[8 * s + 2], s0[8 * s + 3]); pk.z = cvtpk(s0[8 * s + 4], s0[8 * s + 5]); pk.w = cvtpk(s0[8 * s + 6], s0[8 * s + 7]); }
                else         { pk.x = cvtpk(s1[8 * s], s1[8 * s + 1]); pk.y = cvtpk(s1[8 * s + 2], s1[8 * s + 3]); pk.z = cvtpk(s1[8 * s + 4], s1[8 * s + 5]); pk.w = cvtpk(s1[8 * s + 6], s1[8 * s + 7]); }
                const bf16x8 pb = __builtin_bit_cast(bf16x8, pk);
                const int keyoff = 32 * mb + 16 * s + 4 * hh;
                { const s16x4 lo = *(const LAS s16x4*)(Vs + r32 * 144 + keyoff * 2), hi = *(const LAS s16x4*)(Vs + r32 * 144 + (keyoff + 8) * 2);
                  const bf16x8 va = __builtin_shufflevector(lo, hi, 0, 1, 2, 3, 4, 5, 6, 7); o0 = MFMA32(va, pb, o0); }
                { const s16x4 lo = *(const LAS s16x4*)(Vs + (32 + r32) * 144 + keyoff * 2), hi = *(const LAS s16x4*)(Vs + (32 + r32) * 144 + (keyoff + 8) * 2);
                  const bf16x8 va = __builtin_shufflevector(lo, hi, 0, 1, 2, 3, 4, 5, 6, 7); o1 = MFMA32(va, pb, o1); }
            }
        if (more) { LAS unsigned char* Kn = lds + ((j + 1) & 1) * 18432; *(LAS u32x4*)(Kn + lds_off) = kreg; *(LAS u32x4*)(Kn + 9216 + lds_off) = vreg; }
        __syncthreads();
    }
    lsum += __shfl_xor(lsum, 32);
    const float inv = 1.f / lsum;
    bf16_t* op = mix + (size_t)(q0 + r32) * DM + 256 + head * 64;
#pragma unroll
    for (int g4 = 0; g4 < 4; ++g4) {
        u32x2 w0; w0.x = cvtpk(o0[4 * g4] * inv, o0[4 * g4 + 1] * inv); w0.y = cvtpk(o0[4 * g4 + 2] * inv, o0[4 * g4 + 3] * inv);
        *(u32x2*)(op + 8 * g4 + 4 * hh) = w0;
        u32x2 w1; w1.x = cvtpk(o1[4 * g4] * inv, o1[4 * g4 + 1] * inv); w1.y = cvtpk(o1[4 * g4 + 2] * inv, o1[4 * g4 + 3] * inv);
        *(u32x2*)(op + 32 + 8 * g4 + 4 * hh) = w1;
    }
}

constexpr int RW_BUF = 49152, RW_XR = 0, RW_XKD = 8192, RW_XV = 16384, RW_WLW = 24576, RW_ALB = 32768, RW_KKN = 40960, RW_YO = 98304, RW_XWD = 106496, RW_XAD = 111104,
              RW_W2T = 115712, RW_A2T = 124928, RW_CD = 134144, SLOT_OFF = 134400;
#define RW_BAR() asm volatile("s_waitcnt lgkmcnt(0)\n\ts_barrier" ::: "memory")
#define RW_DECODE(i_) const int t = (pt >> 4) + 16 * ((i_) / 5), c4 = (pt & 15) * 4; constexpr int gi = (i_) % 5; \
            const int col = (gi == 0) ? C_R + h * 64 + c4 : (gi == 1) ? C_K + h * 64 + c4 : (gi == 2) ? C_V + h * 64 + c4 : (gi == 3) ? C_WD + dir * 64 + c4 : C_AD + dir * 64 + c4;
#define RW_ISSUE1(chx, i_) { RW_DECODE(i_) \
            const int n = (chx) * 32 + t; const int pos = dir ? (len - 1 - n) : n; \
            const bf16_t* bp = proj + (size_t)(start + pos) * NPROJ + col; \
            rc[i_] = *(const u32x2*)bp; rp_[i_] = (u32x2){0u, 0u}; rn[i_] = (u32x2){0u, 0u}; \
            if (pos > 0) rp_[i_] = *(const u32x2*)(bp - NPROJ); \
            if (pos < len - 1) rn[i_] = *(const u32x2*)(bp + NPROJ); }
#define RW_ISSUE(chx) do { RW_ISSUE1(chx, 0) RW_ISSUE1(chx, 1) RW_ISSUE1(chx, 2) RW_ISSUE1(chx, 3) RW_ISSUE1(chx, 4) RW_ISSUE1(chx, 5) RW_ISSUE1(chx, 6) RW_ISSUE1(chx, 7) RW_ISSUE1(chx, 8) RW_ISSUE1(chx, 9) } while (0)
#define RW_CONV1(i_) { RW_DECODE(i_) \
            const f32x4 m4 = mureg[gi]; \
            f32x4 x = {bflo(rc[i_].x), bfhi(rc[i_].x), bflo(rc[i_].y), bfhi(rc[i_].y)}; \
            const f32x4 pn = {bflo(rp_[i_].x) + bflo(rn[i_].x), bfhi(rp_[i_].x) + bfhi(rn[i_].x), bflo(rp_[i_].y) + bflo(rn[i_].y), bfhi(rp_[i_].y) + bfhi(rn[i_].y)}; \
            x = x + (0.5f * pn - x) * m4; \
            if (gi < 3) { LAS float* dst = (gi == 0) ? XR : (gi == 1) ? XKD : XV; *(LAS f32x4*)(dst + t * 64 + c4) = x; } \
            else if (gi == 3) { \
                _Pragma("unroll") for (int j = 0; j < 4; ++j) { const float e = __expf(2.f * x[j]); x[j] = 1.f - 2.f * frcp(e + 1.f); } \
                u32x2 w; w.x = cvtpk(x[0], x[1]); w.y = cvtpk(x[2], x[3]); *(LAS u32x2*)(XWD + t * 72 + c4) = w; } \
            else { u32x2 w; w.x = cvtpk(x[0], x[1]); w.y = cvtpk(x[2], x[3]); *(LAS u32x2*)(XAD + t * 72 + c4) = w; } }
DI void rwkv_job(const KP& p, int l, int job, LAS unsigned char* lds, int tid) {
    int seq, h, dir, rpart; constexpr int nrows = 32;
    { int j = job; if (j < 32) { seq = 8 + (j >> 4); } else { j -= 32; seq = j >> 4; } h = (j >> 2) & 3; dir = (j >> 1) & 1; rpart = j & 1; }
    int start, len; seq_info(seq, start, len);
    const bf16_t* proj = (const bf16_t*)(p.ws + WS_R);
    bf16_t* mix = (bf16_t*)(p.ws + WS_X1);
    bf16_t* yb = (bf16_t*)(p.ws + WS_YB);
    float* cdot = (float*)(p.ws + WS_CDOT);
    const float* mu = p.in[4] + l * 1152;
    const int wave = tid >> 6, lane = tid & 63, r32 = lane & 31, hh = lane >> 5;
    LAS bf16_t* XWD = (LAS bf16_t*)(lds + RW_XWD); LAS bf16_t* XAD = (LAS bf16_t*)(lds + RW_XAD);
    LAS bf16_t* W2T = (LAS bf16_t*)(lds + RW_W2T); LAS bf16_t* A2T = (LAS bf16_t*)(lds + RW_A2T);
    { const float* w2 = p.in[6] + (size_t)((l * 2 + dir) * 64) * 256 + h * 64; const float* a2 = p.in[8] + (size_t)((l * 2 + dir) * 64) * 256 + h * 64;
#pragma unroll
      for (int i = 0; i < 8; ++i) { const int idx = tid + NTHR * i; const int mm = idx >> 6, c = idx & 63; W2T[c * 72 + mm] = f2bf(w2[mm * 256 + c]); A2T[c * 72 + mm] = f2bf(a2[mm * 256 + c]); } }
    const int nch = len >> 5;
    __syncthreads();
    if (tid < 256) {
        const int srow = tid >> 3, sj = (tid & 7) * 8;
        f32x4 Sa = {0.f, 0.f, 0.f, 0.f}, Sb = {0.f, 0.f, 0.f, 0.f};
        RW_BAR(); RW_BAR(); RW_BAR();
#define RW_LD(dst, arr, tt) const f32x4 dst##a = *(const LAS f32x4*)((arr) + (tt) * 64 + sj), dst##b = *(const LAS f32x4*)((arr) + (tt) * 64 + sj + 4)
        for (int ch = 0; ch < nch; ++ch) {
            LAS unsigned char* B = lds + (ch & 1) * RW_BUF;
            LAS float* XR = (LAS float*)(B + RW_XR); LAS float* XKD = (LAS float*)(B + RW_XKD); LAS float* XV = (LAS float*)(B + RW_XV);
            LAS float* WLW = (LAS float*)(B + RW_WLW); LAS float* ALB = (LAS float*)(B + RW_ALB); LAS float* KKN = (LAS float*)(B + RW_KKN);
            LAS float* YO = (LAS float*)(lds + RW_YO + (ch & 1) * 4096);
            f32x4 wa = *(const LAS f32x4*)(WLW + sj), wb = *(const LAS f32x4*)(WLW + sj + 4), ka = *(const LAS f32x4*)(KKN + sj), kb = *(const LAS f32x4*)(KKN + sj + 4);
            f32x4 ba = *(const LAS f32x4*)(ALB + sj), bb = *(const LAS f32x4*)(ALB + sj + 4), da = *(const LAS f32x4*)(XKD + sj), db = *(const LAS f32x4*)(XKD + sj + 4);
            f32x4 ra = *(const LAS f32x4*)(XR + sj), rb = *(const LAS f32x4*)(XR + sj + 4);
            float v = XV[rpart * 32 + srow];
#pragma unroll 2
            for (int t = 0; t < 32; ++t) {
                const int tn = (t < 31) ? t + 1 : 31;
                RW_LD(wn, WLW, tn); RW_LD(kn, KKN, tn); RW_LD(bn, ALB, tn); RW_LD(dn, XKD, tn); RW_LD(rn_, XR, tn);
                const float vn = XV[tn * 64 + rpart * 32 + srow];
                const f32x4 pa = Sa * ka + Sb * kb;
                float sa = (pa[0] + pa[1]) + (pa[2] + pa[3]);
                sa = -red8(sa);
                Sa = Sa * wa + sa * ba + v * da;
                Sb = Sb * wb + sa * bb + v * db;
                const f32x4 py = Sa * ra + Sb * rb;
                float y = (py[0] + py[1]) + (py[2] + py[3]);
                y = red8(y);
                if ((tid & 7) == 0) YO[t * 32 + srow] = y;
                wa = wna; wb = wnb; ka = kna; kb = knb; ba = bna; bb = bnb; da = dna; db = dnb; ra = rn_a; rb = rn_b; v = vn;
                if (t == 19 || t == 23) RW_BAR();
            }
            RW_BAR();
        }
    } else {
        const int ptid = tid - 256;
        const int cli = ptid & 15, cc4 = cli * 4;
        const f32x4 w0v = *(const f32x4*)(p.in[5] + (l * 2 + dir) * 256 + h * 64 + cc4);
        const f32x4 a0v = *(const f32x4*)(p.in[7] + (l * 2 + dir) * 256 + h * 64 + cc4);
        const f32x4 kkw = *(const f32x4*)(p.in[10] + l * 256 + h * 64 + cc4);
        const f32x4 kaw = *(const f32x4*)(p.in[11] + l * 256 + h * 64 + cc4);
        const f32x4 rkw = *(const f32x4*)(p.in[12] + l * 256 + h * 64 + cc4);
        u32x2 rc[10], rp_[10], rn[10];
        f32x4 mureg[5];
        { const int c4 = (ptid & 15) * 4;
          mureg[0] = *(const f32x4*)(mu + C_R + h * 64 + c4); mureg[1] = *(const f32x4*)(mu + C_K + h * 64 + c4); mureg[2] = *(const f32x4*)(mu + C_V + h * 64 + c4);
          mureg[3] = *(const f32x4*)(mu + C_WD + dir * 64 + c4); mureg[4] = *(const f32x4*)(mu + C_AD + dir * 64 + c4); }
        { int pt = ptid; RW_ISSUE(0); }
        for (int ch = -1; ch < nch; ++ch) {
            int pt = ptid; asm volatile("" : "+v"(pt));
            if (ch >= 1) {
                const int pc = ch - 1;
                LAS float* YO = (LAS float*)(lds + RW_YO + (pc & 1) * 4096); LAS float* CD = (LAS float*)(lds + RW_CD + (pc & 1) * 128);
                const int t = ptid >> 3, c4 = (ptid & 7) * 4;
                const int n = pc * 32 + t; const int pos = dir ? (len - 1 - n) : n; const int tok = start + pos;
                const f32x4 yv = *(const LAS f32x4*)(YO + t * 32 + c4);
                u32x2 w; w.x = cvtpk(yv[0], yv[1]); w.y = cvtpk(yv[2], yv[3]);
                if (c4 < nrows) { if (dir) *(u32x2*)(yb + (size_t)tok * 256 + h * 64 + rpart * nrows + c4) = w; else *(u32x2*)(mix + (size_t)tok * DM + h * 64 + rpart * nrows + c4) = w; }
                if (rpart == 0 && ptid < 32) { const int n2 = pc * 32 + ptid; const int pos2 = dir ? (len - 1 - n2) : n2; cdot[((size_t)(start + pos2) * 4 + h) * 2 + dir] = CD[ptid]; }
            }
            const int nc = ch + 1;
            const bool build = nc < nch;
            LAS unsigned char* B = lds + (nc & 1) * RW_BUF;
            LAS float* XR = (LAS float*)(B + RW_XR); LAS float* XKD = (LAS float*)(B + RW_XKD); LAS float* XV = (LAS float*)(B + RW_XV);
            LAS float* WLW = (LAS float*)(B + RW_WLW); LAS float* ALB = (LAS float*)(B + RW_ALB); LAS float* KKN = (LAS float*)(B + RW_KKN);
            LAS float* CDn = (LAS float*)(lds + RW_CD + (nc & 1) * 128);
            if (build) {
                RW_CONV1(0) RW_CONV1(1) RW_CONV1(2) RW_CONV1(3) RW_CONV1(4) RW_CONV1(5) RW_CONV1(6) RW_CONV1(7) RW_CONV1(8) RW_CONV1(9)
                if (nc + 1 < nch) RW_ISSUE(nc + 1);
            }
            RW_BAR();
            if (build) {
                const int mat = (wave - 4) >> 1, nb = (wave - 4) & 1;
                LAS bf16_t* Xs = mat ? XAD : XWD; LAS bf16_t* Ws = mat ? A2T : W2T;
                f32x16 acc = zero16();
#pragma unroll
                for (int ks = 0; ks < 4; ++ks) {
                    const bf16x8 a = *(const LAS bf16x8*)(Xs + r32 * 72 + ks * 16 + hh * 8);
                    const bf16x8 bb = *(const LAS bf16x8*)(Ws + (nb * 32 + r32) * 72 + ks * 16 + hh * 8);
                    acc = MFMA32(a, bb, acc);
                }
                LAS float* dst = mat ? ALB : WLW;
#pragma unroll
                for (int i = 0; i < 16; ++i) dst[crow(i, hh) * 64 + nb * 32 + r32] = acc[i];
            }
            RW_BAR();
            if (build) {
#pragma unroll
                for (int it = 0; it < 2; ++it) {
                    const int ct = (ptid >> 4) + 16 * it;
                    const f32x4 wl = *(const LAS f32x4*)(WLW + ct * 64 + cc4), al = *(const LAS f32x4*)(ALB + ct * 64 + cc4);
                    const f32x4 k4 = *(const LAS f32x4*)(XKD + ct * 64 + cc4), r4 = *(const LAS f32x4*)(XR + ct * 64 + cc4);
                    f32x4 w, a, kkr, kd;
                    float ssq = 0.f, cd = 0.f;
#pragma unroll
                    for (int j = 0; j < 4; ++j) {
                        const float sg = sigmoidf_(w0v[j] + wl[j]);
                        w[j] = __expf(-0.6065306597126334f * sg);
                        a[j] = sigmoidf_(a0v[j] + al[j]);
                        kkr[j] = k4[j] * kkw[j]; ssq += kkr[j] * kkr[j];
                        kd[j] = k4[j] * (1.f + (a[j] - 1.f) * kaw[j]);
                        cd += r4[j] * kd[j] * rkw[j];
                    }
                    ssq = red16(ssq); cd = red16(cd);
                    const float inv = __builtin_amdgcn_rsqf(fmaxf(ssq, 1e-24f));
                    f32x4 kkn, bv;
#pragma unroll
                    for (int j = 0; j < 4; ++j) { kkn[j] = kkr[j] * inv; bv[j] = kkn[j] * a[j]; }
                    *(LAS f32x4*)(WLW + ct * 64 + cc4) = w; *(LAS f32x4*)(ALB + ct * 64 + cc4) = bv; *(LAS f32x4*)(KKN + ct * 64 + cc4) = kkn; *(LAS f32x4*)(XKD + ct * 64 + cc4) = kd;
                    if (cli == 0) CDn[ct] = cd;
                }
            }
            RW_BAR();
        }
        {
            const int pc = nch - 1;
            LAS float* YO = (LAS float*)(lds + RW_YO + (pc & 1) * 4096); LAS float* CD = (LAS float*)(lds + RW_CD + (pc & 1) * 128);
            const int t = ptid >> 3, c4 = (ptid & 7) * 4;
            const int n = pc * 32 + t; const int pos = dir ? (len - 1 - n) : n; const int tok = start + pos;
            const f32x4 yv = *(const LAS f32x4*)(YO + t * 32 + c4);
            u32x2 w; w.x = cvtpk(yv[0], yv[1]); w.y = cvtpk(yv[2], yv[3]);
            if (c4 < nrows) { if (dir) *(u32x2*)(yb + (size_t)tok * 256 + h * 64 + rpart * nrows + c4) = w; else *(u32x2*)(mix + (size_t)tok * DM + h * 64 + rpart * nrows + c4) = w; }
            if (rpart == 0 && ptid < 32) { const int n2 = pc * 32 + ptid; const int pos2 = dir ? (len - 1 - n2) : n2; cdot[((size_t)(start + pos2) * 4 + h) * 2 + dir] = CD[ptid]; }
        }
    }
    __syncthreads();
}

constexpr int ML_QS = 0, ML_KS = 9216, ML_KT = 18432, ML_VT = 27648, ML_VWT = 36864, ML_PS = 46080, ML_CB = 55296, ML_WGT = 64512, ML_RR = 64768, ML_MROW = 65024,
              ML_SC = 65280, ML_EMT = 65536, ML_DENI = 65792, ML_NS = 66048, ML_A12 = 66304;
DI void mlstm_job(const KP& p, int l, int job, LAS unsigned char* lds, int tid) {
    int seq, hm, dir; seq_of_job(job, seq, hm, dir);
    int start, len; seq_info(seq, start, len);
    const bf16_t* proj = (const bf16_t*)(p.ws + WS_R);
    bf16_t* mix = (bf16_t*)(p.ws + WS_X1);
    bf16_t* hbp = (bf16_t*)(p.ws + WS_HBP);
    const float* cw = p.in[17] + l * 3 * 512;
    const float ibv = p.in[18][(l * 2 + dir) * 4 + hm], fbv = p.in[19][(l * 2 + dir) * 4 + hm];
    const int wave = tid >> 6, lane = tid & 63, r32 = lane & 31, hh = lane >> 5;
    LAS bf16_t* Qs = (LAS bf16_t*)(lds + ML_QS); LAS bf16_t* Ks = (LAS bf16_t*)(lds + ML_KS); LAS bf16_t* KT = (LAS bf16_t*)(lds + ML_KT);
    LAS bf16_t* VT = (LAS bf16_t*)(lds + ML_VT); LAS bf16_t* VWT = (LAS bf16_t*)(lds + ML_VWT); LAS bf16_t* Ps = (LAS bf16_t*)(lds + ML_PS); LAS bf16_t* CB = (LAS bf16_t*)(lds + ML_CB);
    LAS float* WGT = (LAS float*)(lds + ML_WGT); LAS float* RR = (LAS float*)(lds + ML_RR); LAS float* MROW = (LAS float*)(lds + ML_MROW); LAS float* SC = (LAS float*)(lds + ML_SC);
    LAS float* EMT = (LAS float*)(lds + ML_EMT); LAS float* DENI = (LAS float*)(lds + ML_DENI); LAS float* NS = (LAS float*)(lds + ML_NS); LAS float* A12 = (LAS float*)(lds + ML_A12);
    for (int i = tid; i < 64 * 72; i += NTHR) CB[i] = 0;
    if (tid < 64) NS[tid] = 0.f;
    f32x16 Creg = zero16();
    float Mst = 0.f;
    __syncthreads();
    const int nch = len >> 6;
    const int ll = tid >> 3, e8 = (tid & 7) * 8;
    for (int ch = 0; ch < nch; ++ch) {
        {
            const int n = ch * 64 + ll; const int pos = dir ? (len - 1 - n) : n; const int tok = start + pos;
#pragma unroll
            for (int which = 0; which < 2; ++which) {
                const int col = (which ? C_MK : C_MQ) + hm * 64 + e8; const int cwc = (which ? 256 : 0) + hm * 64 + e8;
                const bf16_t* bp = proj + (size_t)tok * NPROJ + col;
                const u32x4 cu = *(const u32x4*)bp; u32x4 pv = {0u, 0u, 0u, 0u}, nv = {0u, 0u, 0u, 0u};
                if (pos > 0) pv = *(const u32x4*)(bp - NPROJ);
                if (pos < len - 1) nv = *(const u32x4*)(bp + NPROJ);
                float o[8];
#pragma unroll
                for (int j = 0; j < 4; ++j) {
                    const f32x2 c0 = *(const f32x2*)(cw + cwc + 2 * j), c1 = *(const f32x2*)(cw + 512 + cwc + 2 * j), c2 = *(const f32x2*)(cw + 1024 + cwc + 2 * j);
                    const float v0 = c0.x * bflo(pv[j]) + c1.x * bflo(cu[j]) + c2.x * bflo(nv[j]);
                    const float v1 = c0.y * bfhi(pv[j]) + c1.y * bfhi(cu[j]) + c2.y * bfhi(nv[j]);
                    o[2 * j] = v0 * sigmoidf_(v0); o[2 * j + 1] = v1 * sigmoidf_(v1);
                }
                if (which) {
#pragma unroll
                    for (int j = 0; j < 8; ++j) o[j] *= 0.125f;
                }
                u32x4 w; w.x = cvtpk(o[0], o[1]); w.y = cvtpk(o[2], o[3]); w.z = cvtpk(o[4], o[5]); w.w = cvtpk(o[6], o[7]);
                if (!which) *(LAS u32x4*)(Qs + ll * 72 + e8) = w;
                else { *(LAS u32x4*)(Ks + ll * 72 + e8) = w;
#pragma unroll
                    for (int j = 0; j < 4; ++j) { KT[(e8 + 2 * j) * 72 + ll] = (bf16_t)(w[j] & 0xffffu); KT[(e8 + 2 * j + 1) * 72 + ll] = (bf16_t)(w[j] >> 16); } }
            }
        }
        if (wave == 0) {
            const int n = ch * 64 + lane; const int pos = dir ? (len - 1 - n) : n; const int tok = start + pos;
            const float igv = bf2f(proj[(size_t)tok * NPROJ + C_IG + dir * 4 + hm]) + ibv;
            const float fgv = bf2f(proj[(size_t)tok * NPROJ + C_FG + dir * 4 + hm]) + fbv;
            const float lf = (fgv > 0.f) ? -log1pf(__expf(-fgv)) : (fgv - log1pf(__expf(fgv)));
            float b = lf;
#pragma unroll
            for (int o = 1; o < 64; o <<= 1) { const float t2 = __shfl_up(b, o); if (lane >= o) b += t2; }
            const float bL = __shfl(b, 63);
            const float g = bL - b + igv;
            float mg = g;
#pragma unroll
            for (int o = 32; o >= 1; o >>= 1) mg = fmaxf(mg, __shfl_xor(mg, o));
            const float wgt = __expf(g - mg);
            const float r = igv - b;
            float cm = r;
#pragma unroll
            for (int o = 1; o < 64; o <<= 1) { const float t2 = __shfl_up(cm, o); if (lane >= o) cm = fmaxf(cm, t2); }
            const float mrow = fmaxf(cm, Mst);
            WGT[lane] = wgt; RR[lane] = r; MROW[lane] = mrow; SC[lane] = __expf(Mst - mrow); EMT[lane] = __expf(-(b + mrow));
            const float Mnew = fmaxf(bL + Mst, mg);
            if (lane == 0) { A12[0] = __expf(bL + Mst - Mnew); A12[1] = __expf(mg - Mnew); }
            Mst = Mnew;
        }
        __syncthreads();
        {
            const int n = ch * 64 + ll; const int pos = dir ? (len - 1 - n) : n; const int tok = start + pos;
            const u32x4 vv = *(const u32x4*)(proj + (size_t)tok * NPROJ + C_MV + hm * 64 + e8);
            const float wg = WGT[ll];
#pragma unroll
            for (int j = 0; j < 4; ++j) {
                VT[(e8 + 2 * j) * 72 + ll] = (bf16_t)(vv[j] & 0xffffu); VT[(e8 + 2 * j + 1) * 72 + ll] = (bf16_t)(vv[j] >> 16);
                const unsigned pw = cvtpk(bflo(vv[j]) * wg, bfhi(vv[j]) * wg);
                VWT[(e8 + 2 * j) * 72 + ll] = (bf16_t)(pw & 0xffffu); VWT[(e8 + 2 * j + 1) * 72 + ll] = (bf16_t)(pw >> 16);
            }
        }
        __syncthreads();
        if (wave < 4) {
            const int tb = wave >> 1, sb = wave & 1;
            f32x16 acc = zero16();
#pragma unroll
            for (int ks = 0; ks < 4; ++ks) {
                const bf16x8 a = *(const LAS bf16x8*)(Qs + (tb * 32 + r32) * 72 + ks * 16 + hh * 8);
                const bf16x8 b = *(const LAS bf16x8*)(Ks + (sb * 32 + r32) * 72 + ks * 16 + hh * 8);
                acc = MFMA32(a, b, acc);
            }
            const int s = sb * 32 + r32; const float rs_ = RR[s];
#pragma unroll
            for (int i = 0; i < 16; ++i) { const int t = tb * 32 + crow(i, hh); const float pvv = (s <= t) ? __expf(rs_ - MROW[t]) * acc[i] : 0.f; Ps[t * 72 + s] = f2bf(pvv); }
        } else {
            const int db = (wave - 4) >> 1, eb = (wave - 4) & 1;
            f32x16 kc = zero16();
#pragma unroll
            for (int ks = 0; ks < 4; ++ks) {
                const bf16x8 a = *(const LAS bf16x8*)(VWT + (db * 32 + r32) * 72 + ks * 16 + hh * 8);
                const bf16x8 b = *(const LAS bf16x8*)(KT + (eb * 32 + r32) * 72 + ks * 16 + hh * 8);
                kc = MFMA32(a, b, kc);
            }
            const float a1 = A12[0], a2 = A12[1];
#pragma unroll
            for (int i = 0; i < 16; ++i) Creg[i] = a1 * Creg[i] + a2 * kc[i];
        }
        __syncthreads();
        f32x16 acc = zero16();
        float ncv = 0.f;
        if (wave < 4) {
            const int tb = wave >> 1, db = wave & 1;
#pragma unroll
            for (int ks = 0; ks < 4; ++ks) {
                const bf16x8 a = *(const LAS bf16x8*)(Qs + (tb * 32 + r32) * 72 + ks * 16 + hh * 8);
                const bf16x8 b = *(const LAS bf16x8*)(CB + (db * 32 + r32) * 72 + ks * 16 + hh * 8);
                acc = MFMA32(a, b, acc);
            }
#pragma unroll
            for (int i = 0; i < 16; ++i) acc[i] *= SC[tb * 32 + crow(i, hh)];
#pragma unroll
            for (int ks = 0; ks < 4; ++ks) {
                const bf16x8 a = *(const LAS bf16x8*)(Ps + (tb * 32 + r32) * 72 + ks * 16 + hh * 8);
                const bf16x8 b = *(const LAS bf16x8*)(VT + (db * 32 + r32) * 72 + ks * 16 + hh * 8);
                acc = MFMA32(a, b, acc);
            }
        } else if (wave == 4) {
            float rsum = 0.f, qn = 0.f;
            for (int e = 0; e < 64; ++e) { rsum += bf2f(Ps[lane * 72 + e]); qn += bf2f(Qs[lane * 72 + e]) * NS[e]; }
            const float den = rsum + SC[lane] * qn;
            DENI[lane] = 1.f / fmaxf(fabsf(den), EMT[lane]);
        } else if (wave == 5) {
            for (int s = 0; s < 64; ++s) ncv += WGT[s] * bf2f(KT[lane * 72 + s]);
        }
        __syncthreads();
        if (wave < 4) {
            const int tb = wave >> 1, db = wave & 1;
#pragma unroll
            for (int i = 0; i < 16; ++i) {
                const int t = tb * 32 + crow(i, hh); const int n = ch * 64 + t; const int pos = dir ? (len - 1 - n) : n; const int tok = start + pos;
                const bf16_t o = f2bf(acc[i] * DENI[t]);
                if (dir) hbp[(size_t)tok * 256 + hm * 64 + db * 32 + r32] = o; else mix[(size_t)tok * DM + 768 + hm * 64 + db * 32 + r32] = o;
            }
        } else {
            const int db = (wave - 4) >> 1, eb = (wave - 4) & 1;
#pragma unroll
            for (int i = 0; i < 16; ++i) CB[(db * 32 + crow(i, hh)) * 72 + eb * 32 + r32] = f2bf(Creg[i]);
            if (wave == 5) NS[lane] = A12[0] * NS[lane] + A12[1] * ncv;
        }
        __syncthreads();
    }
}

DI void mixers_phase(const KP& p, int l, int cidx, LAS unsigned char* lds, int tid, int G, int bid) {
    unsigned* cnt = (unsigned*)(p.ws + WS_CNT) + cidx;
    LAS int* slot = (LAS int*)(lds + SLOT_OFF);
    for (;;) {
        if (tid == 0) *slot = (int)atomicAdd(cnt, 1u);
        __syncthreads();
        const int item = *slot;
        __syncthreads();
        if (item >= 240 + 1536) break;
        int kind, jb;
        if (item < 32) { kind = 0; jb = item; } else if (item < 48) { kind = 1; jb = item - 32; } else if (item < 176) { kind = 0; jb = item - 48 + 32; }
        else if (item < 240) { kind = 1; jb = item - 176 + 16; } else { kind = 2; jb = item - 240; }
        int t2 = tid; asm volatile("" : "+v"(t2));
#ifndef REP_R
#define REP_R 1
#endif
#ifndef REP_M
#define REP_M 1
#endif
#ifndef REP_T
#define REP_T 1
#endif
        if (kind == 0) { rwkv_job(p, l, jb, lds, t2); }
        else if (kind == 1) { for (int rep = 0; rep < REP_M; ++rep) { mlstm_job(p, l, jb, lds, t2); __syncthreads(); } }
        else { for (int rep = 0; rep < REP_T; ++rep) { attn_unit(p, l, jb, lds, t2); __syncthreads(); } }
        __syncthreads();
    }
}

constexpr int PO_G2T = 0, PO_AS = 69632, PO_GO = 87040;
DI void post_phase(const KP& p, int l, LAS unsigned char* lds, int tid, int G, int bid) {
    const bf16_t* proj = (const bf16_t*)(p.ws + WS_R);
    bf16_t* mix = (bf16_t*)(p.ws + WS_X1);
    const bf16_t* yb = (const bf16_t*)(p.ws + WS_YB);
    const bf16_t* hbp = (const bf16_t*)(p.ws + WS_HBP);
    const float* cdot = (const float*)(p.ws + WS_CDOT);
    const float* mu = p.in[4] + l * 1152;
    const float* lnw = p.in[13] + l * 256; const float* lnb = p.in[14] + l * 256; const float* nw = p.in[20] + l * 256;
    LAS bf16_t* G2T = (LAS bf16_t*)(lds + PO_G2T); LAS bf16_t* AS = (LAS bf16_t*)(lds + PO_AS); LAS bf16_t* GO = (LAS bf16_t*)(lds + PO_GO);
    const int wave = tid >> 6, lane = tid & 63, r32 = lane & 31, hh = lane >> 5;
    { const float* g2 = p.in[9] + (size_t)l * 128 * 256;
      for (int i = 0; i < 64; ++i) { const int idx = tid + NTHR * i; const int mm = idx >> 8, c = idx & 255; G2T[c * 136 + mm] = f2bf(g2[idx]); } }
    __syncthreads();
    for (int unit = bid; unit < T / 64; unit += G) {
        const int tok0 = unit * 64;
        int len; const int st = tok_seq_start(tok0, len);
#pragma unroll
        for (int i = 0; i < 4; ++i) {
            const int q = tid + NTHR * i; const int t = q >> 5, c4 = (q & 31) * 4; const int tok = tok0 + t; const int pos = tok - st;
            const bf16_t* bp = proj + (size_t)tok * NPROJ + C_GD + c4;
            const u32x2 cu = *(const u32x2*)bp; u32x2 pv = {0u, 0u}, nv = {0u, 0u};
            if (pos > 0) pv = *(const u32x2*)(bp - NPROJ);
            if (pos < len - 1) nv = *(const u32x2*)(bp + NPROJ);
            const f32x4 m4 = *(const f32x4*)(mu + C_GD + c4);
            float x[4] = {bflo(cu.x), bfhi(cu.x), bflo(cu.y), bfhi(cu.y)};
            const float pn[4] = {bflo(pv.x) + bflo(nv.x), bfhi(pv.x) + bfhi(nv.x), bflo(pv.y) + bflo(nv.y), bfhi(pv.y) + bfhi(nv.y)};
#pragma unroll
            for (int j = 0; j < 4; ++j) x[j] = sigmoidf_(x[j] + (0.5f * pn[j] - x[j]) * m4[j]);
            u32x2 w; w.x = cvtpk(x[0], x[1]); w.y = cvtpk(x[2], x[3]); *(LAS u32x2*)(AS + t * 136 + c4) = w;
        }
        __syncthreads();
        {
            const int hd = wave & 3, tb = wave >> 2;
            f32x16 a0 = zero16(), a1 = zero16();
#pragma unroll
            for (int ks = 0; ks < 8; ++ks) {
                const bf16x8 a = *(const LAS bf16x8*)(AS + (tb * 32 + r32) * 136 + ks * 16 + hh * 8);
                const bf16x8 b0 = *(const LAS bf16x8*)(G2T + (hd * 64 + r32) * 136 + ks * 16 + hh * 8);
                const bf16x8 b1 = *(const LAS bf16x8*)(G2T + (hd * 64 + 32 + r32) * 136 + ks * 16 + hh * 8);
                a0 = MFMA32(a, b0, a0); a1 = MFMA32(a, b1, a1);
            }
#pragma unroll
            for (int i = 0; i < 16; ++i) { const int t = tb * 32 + crow(i, hh); GO[t * 264 + hd * 64 + r32] = f2bf(a0[i]); GO[t * 264 + hd * 64 + 32 + r32] = f2bf(a1[i]); }
        }
        __syncthreads();
#pragma unroll 1
        for (int it = 0; it < 8; ++it) {
            const int task = tid + NTHR * it; const int grp = task >> 4, li = task & 15; const int t = grp >> 2, hd = grp & 3; const int c4 = li * 4;
            const int tok = tok0 + t; const int pos = tok - st;
            {
                const u32x2 yf = *(const u32x2*)(mix + (size_t)tok * DM + hd * 64 + c4), ybv = *(const u32x2*)(yb + (size_t)tok * 256 + hd * 64 + c4);
                float x[4] = {bflo(yf.x) + bflo(ybv.x), bfhi(yf.x) + bfhi(ybv.x), bflo(yf.y) + bflo(ybv.y), bfhi(yf.y) + bfhi(ybv.y)};
                const float mean = red16(x[0] + x[1] + x[2] + x[3]) * (1.f / 64.f);
                float vs = 0.f;
#pragma unroll
                for (int j = 0; j < 4; ++j) { x[j] -= mean; vs += x[j] * x[j]; }
                const float rstd = rsqrtf(red16(vs) * (1.f / 64.f) + 64e-5f);
                const bf16_t* bp = proj + (size_t)tok * NPROJ + C_V + hd * 64 + c4;
                const u32x2 cu = *(const u32x2*)bp; u32x2 pv = {0u, 0u}, nv = {0u, 0u};
                if (pos > 0) pv = *(const u32x2*)(bp - NPROJ);
                if (pos < len - 1) nv = *(const u32x2*)(bp + NPROJ);
                const f32x4 m4 = *(const f32x4*)(mu + C_V + hd * 64 + c4);
                float v[4] = {bflo(cu.x), bfhi(cu.x), bflo(cu.y), bfhi(cu.y)};
                const float pn[4] = {bflo(pv.x) + bflo(nv.x), bfhi(pv.x) + bfhi(nv.x), bflo(pv.y) + bflo(nv.y), bfhi(pv.y) + bfhi(nv.y)};
                const f32x2 cdv = *(const f32x2*)(cdot + ((size_t)tok * 4 + hd) * 2);
                const float cds = cdv.x + cdv.y;
                const f32x4 lw = *(const f32x4*)(lnw + hd * 64 + c4), lb = *(const f32x4*)(lnb + hd * 64 + c4);
                const u32x2 gv = *(const LAS u32x2*)(GO + t * 264 + hd * 64 + c4);
                const float g[4] = {bflo(gv.x), bfhi(gv.x), bflo(gv.y), bfhi(gv.y)};
                float o[4];
#pragma unroll
                for (int j = 0; j < 4; ++j) { const float vsft = v[j] + (0.5f * pn[j] - v[j]) * m4[j]; o[j] = (x[j] * rstd * lw[j] + lb[j] + cds * vsft) * g[j]; }
                u32x2 w; w.x = cvtpk(o[0], o[1]); w.y = cvtpk(o[2], o[3]); *(u32x2*)(mix + (size_t)tok * DM + hd * 64 + c4) = w;
            }
            {
                const u32x2 hf = *(const u32x2*)(mix + (size_t)tok * DM + 768 + hd * 64 + c4), hb = *(const u32x2*)(hbp + (size_t)tok * 256 + hd * 64 + c4);
                const float x[4] = {bflo(hf.x) + bflo(hb.x), bfhi(hf.x) + bfhi(hb.x), bflo(hf.y) + bflo(hb.y), bfhi(hf.y) + bfhi(hb.y)};
                const float ms = red16(x[0] * x[0] + x[1] * x[1] + x[2] * x[2] + x[3] * x[3]) * (1.f / 64.f);
                const float rinv = rsqrtf(ms + 1e-6f);
                const u32x2 ov = *(const u32x2*)(proj + (size_t)tok * NPROJ + C_MO + hd * 64 + c4);
                const float og[4] = {bflo(ov.x), bfhi(ov.x), bflo(ov.y), bfhi(ov.y)};
                const f32x4 nwv = *(const f32x4*)(nw + hd * 64 + c4);
                float o[4];
#pragma unroll
                for (int j = 0; j < 4; ++j) o[j] = sigmoidf_(og[j]) * x[j] * rinv * nwv[j];
                u32x2 w; w.x = cvtpk(o[0], o[1]); w.y = cvtpk(o[2], o[3]); *(u32x2*)(mix + (size_t)tok * DM + 768 + hd * 64 + c4) = w;
            }
        }
        __syncthreads();
    }
}

DI void final_phase(const KP& p, int tid, int G, int bid) {
    const float* ss = (const float*)(p.ws + WS_SS) + 4 * T;
    const float* g = p.in[25];
    for (size_t i = (size_t)bid * NTHR + tid; i < (size_t)T * 256; i += (size_t)G * NTHR) {
        const int row = (int)(i >> 8), c = (int)(i & 255) * 4;
        const float rs = rsqrtf(ss[row] * (1.f / 1024.f) + 1e-6f);
        f32x4 v = *(const f32x4*)(p.out + i * 4); const f32x4 gv = *(const f32x4*)(g + c);
        v[0] *= rs * gv[0]; v[1] *= rs * gv[1]; v[2] *= rs * gv[2]; v[3] *= rs * gv[3];
        *(f32x4*)(p.out + i * 4) = v;
    }
}

__global__ void __launch_bounds__(NTHR, 2) fwd_kernel(KP p) {
    extern __shared__ __attribute__((aligned(16))) unsigned char lds_raw[];
    LAS unsigned char* lds = (LAS unsigned char*)lds_raw;
    cg::grid_group grid = cg::this_grid();
    int tid = threadIdx.x; const int G = gridDim.x, bid = blockIdx.x;
#define LAUNDER() asm volatile("" : "+v"(tid))
    float* ss = (float*)(p.ws + WS_SS);
    bf16_t* X1 = (bf16_t*)(p.ws + WS_X1);
    bf16_t* PROJ = (bf16_t*)(p.ws + WS_R);
    bf16_t* HB = (bf16_t*)(p.ws + WS_R);
    bf16_t* HID = (bf16_t*)(p.ws + WS_HID);

        LAUNDER();
    volatile LAS unsigned* bst = (volatile LAS unsigned*)(lds + SLOT_OFF + 16);
    if (tid == 0) { bst[0] = 0u; bst[1] = 0u; }
    __syncthreads();
    const XcdBarrier xbar = xcd_barrier_post((unsigned*)(p.ws + WS_BAR), bst);
#define GSYNC() xcd_barrier(xbar)
    p0_phase(p, lds, tid, G, bid);
    grid.sync();
#ifdef PROBE_SYNC20
    for (int i = 0; i < 20; ++i) GSYNC();
#endif
#ifdef PROBE_P0X2
    LAUNDER(); p0_phase(p, lds, tid, G, bid);
    GSYNC();
#endif
#ifdef PROBE_SYNC10
    for (int i = 0; i < 10; ++i) GSYNC();
#endif
    for (int l = 0; l < 2; ++l) {
        {
            pg8::Gemm g{X1, (const bf16_t*)(p.ws + WS_WIN) + (size_t)l * NPROJ * 1024, T, NPROJ, 1024}; pg8::StaticOrder S; S.init(T, NPROJ, G, bid);
            EpiProj E{PROJ, ss + (2 * l) * T};
            pg8::gemm_phase<EpiProj, pg8::StaticOrder, true, true>(lds, g, S, E);
#ifdef PROBE_P1X2
            GSYNC();
            pg8::gemm_phase<EpiProj, pg8::StaticOrder, true, true>(lds, g, S, E);
#endif
        }
        GSYNC();
        LAUNDER();
        prep_phase(p, l, lds, tid, G, bid);
        GSYNC();
        LAUNDER();
        mixers_phase(p, l, l, lds, tid, G, bid);
#ifdef PROBE_MIX2
        GSYNC(); LAUNDER();
        mixers_phase(p, l, l + 2, lds, tid, G, bid);
#endif
        GSYNC();
        LAUNDER();
        post_phase(p, l, lds, tid, G, bid);
        GSYNC();
        {
            pg8::Gemm g{X1, (const bf16_t*)(p.ws + WS_WOUT) + (size_t)l * 1024 * 1024, T, DM, 1024}; pg8::StaticOrder S; S.init(T, DM, G, bid);
            EpiRes<true, true> E{p.out, HB, ss + (2 * l + 1) * T};
            pg8::gemm_phase<EpiRes<true, true>, pg8::StaticOrder, true, true>(lds, g, S, E);
        }
        GSYNC();
        for (int hf = 0; hf < 2; ++hf) {
            {
                pg8::Gemm g{HB, (const bf16_t*)(p.ws + WS_W1) + (size_t)l * 4096 * 1024 + (size_t)hf * HFF * 1024, T, HFF, 1024}; pg8::StaticOrder S; S.init(T, HFF, G, bid);
                EpiRelu2 E{HID, ss + (2 * l + 1) * T};
                pg8::gemm_phase<EpiRelu2, pg8::StaticOrder, true, true>(lds, g, S, E);
            }
            GSYNC();
            {
                pg8::Gemm g{HID, (const bf16_t*)(p.ws + WS_W2) + (size_t)l * 2 * 1024 * 2048 + (size_t)hf * 1024 * 2048, T, DM, HFF}; pg8::StaticOrder S; S.init(T, DM, G, bid);
                if (hf == 0) { EpiRes<false, false> E{p.out, nullptr, nullptr}; pg8::gemm_phase<EpiRes<false, false>, pg8::StaticOrder, true, true>(lds, g, S, E); }
                else { EpiRes<true, true> E{p.out, X1, ss + (2 * l + 2) * T}; pg8::gemm_phase<EpiRes<true, true>, pg8::StaticOrder, true, true>(lds, g, S, E); }
            }
            GSYNC();
        }
    }
        LAUNDER();
    final_phase(p, tid, G, bid);
}

extern "C" void kernel_launch(void* const* d_in, const int* in_sizes, int n_in, void* d_out, int out_size, void* d_ws, size_t ws_size, hipStream_t stream) {
    static int grid_blocks = 0;
    if (grid_blocks == 0) {
        if (n_in != 26 || out_size != T * DM || ws_size < WS_END) { fprintf(stderr, "kernel_launch: unexpected shapes (n_in %d out %d ws %zu)\n", n_in, out_size, ws_size); grid_blocks = -1; return; }
        int dev = 0, cus = 0, per_cu = 0;
        hipGetDevice(&dev);
        hipDeviceGetAttribute(&cus, hipDeviceAttributeMultiprocessorCount, dev);
        hipFuncSetAttribute((const void*)fwd_kernel, hipFuncAttributeMaxDynamicSharedMemorySize, LDS_BYTES);
        hipOccupancyMaxActiveBlocksPerMultiprocessor(&per_cu, (const void*)fwd_kernel, NTHR, LDS_BYTES);
        if (per_cu < 1) per_cu = 1;
        grid_blocks = cus * per_cu;
        (void)hipGetLastError();
    }
    if (grid_blocks < 0) return;
    KP p{};
    for (int i = 0; i < 26; ++i) p.in[i] = (const float*)d_in[i];
    p.out = (float*)d_out; p.ws = (unsigned char*)d_ws;
    (void)hipMemsetAsync((char*)d_ws + WS_BAR, 0, 16384, stream);
    void* args[] = {&p};
    hipError_t e = hipLaunchCooperativeKernel((const void*)fwd_kernel, dim3(grid_blocks), dim3(NTHR), args, LDS_BYTES, stream);
    if (e != hipSuccess) fprintf(stderr, "cooperative launch failed: %s (grid %d)\n", hipGetErrorString(e), grid_blocks);
}
```

```cpp
#include <hip/hip_runtime.h>
#include <hip/hip_cooperative_groups.h>
#include <cstdio>
#include <cstdint>
namespace cg = cooperative_groups;
namespace pg8 {
#define PG8_LAS __attribute__((address_space(3)))
typedef unsigned short bf16_t;
typedef short bf16x8 __attribute__((ext_vector_type(8)));
typedef float f32x4 __attribute__((ext_vector_type(4)));
typedef unsigned u32x4 __attribute__((ext_vector_type(4)));
constexpr int BM = 256, BK = 64, HALF = 128, HTB = HALF * BK * 2  , STAGE_BYTES = 8 * HTB, NXCD = 8, WGM = 8;

__host__ __device__ __forceinline__ int lds_byte(int r, int c) { const int st = (r >> 4) * 2 + (c >> 5), rr = r & 15, cc = c & 31, ob = rr * 64 + cc * 2; return st * 1024 + (ob ^ (((ob >> 9) & 1) << 5)); }
__host__ __device__ __forceinline__ void stage_rc(int b, int& R, int& C) { const int st = b / 1024, sb = b % 1024, swz = sb ^ (((sb >> 9) & 1) << 5); R = (st >> 1) * 16 + swz / 64; C = (st & 1) * 32 + (swz % 64) / 2; }
__host__ __device__ __forceinline__ int perm32(int rho) { const int n = rho >> 4, i = rho & 15; return 8 * (i >> 2) + 4 * n + (i & 3); }

struct Unit { int pm, pn; };
struct Gemm { const bf16_t* A; const bf16_t* Bt; int M, N, K; };

struct StaticOrder {
    int nM, nN, nwg, G, c;
    __host__ __device__ void init(int M, int N, int G_, int c_) { nM = M / BM; nN = N / BM; nwg = nM * nN; G = G_; c = c_; }
    __host__ __device__ bool next(int i, Unit& u) const {
        const long L = (long)i * G + c; if (L >= nwg) return false;
        int wgid = (int)L; { const int q = nwg / NXCD, r = nwg % NXCD, xcd = wgid % NXCD, off = wgid / NXCD; wgid = (xcd < r ? xcd * (q + 1) : r * (q + 1) + (xcd - r) * q) + off; }
        const int nig = WGM * nN, gid = wgid / nig, fm = gid * WGM, gsz = (nM - fm) < WGM ? (nM - fm) : WGM;
        u.pm = fm + ((wgid % nig) % gsz); u.pn = (wgid % nig) / gsz; return true;
    }
    __device__ __forceinline__ void a_ready(const Unit&) const {}
    __device__ __forceinline__ void done(const Unit&) const {}
};

template <class Epi, class Sched, bool ALIGN_EPI = false, bool SP2 = false>
__device__ __forceinline__ void gemm_phase(PG8_LAS unsigned char* lds, const Gemm g, const Sched& S, const Epi& E) {
    int tid_l = threadIdx.x; asm volatile("" : "+v"(tid_l));
    const int tid = tid_l, wid = __builtin_amdgcn_readfirstlane(tid >> 6), lane = tid & 63, wr = wid >> 2, wc = wid & 3, fr = lane & 15, fq = lane >> 4;
    const int K = g.K, nt = K / BK;
    unsigned voffA[2], voffB[2];
#pragma unroll
    for (int i = 0; i < 2; ++i) { int R, C; stage_rc(tid * 16 + i * 8192, R, C); const int Rb = Epi::PERM ? ((R & ~31) + perm32(R & 31)) : R;
        voffA[i] = (unsigned)(R * K + C) * 2u; voffB[i] = (unsigned)(Rb * K + C) * 2u; }
    const size_t kstep = (size_t)(BK * 2);
    const size_t hstep = (size_t)HALF * K * 2;
    const size_t tstep = 2 * hstep;
    const unsigned ldsw = (unsigned)wid * 1024u;
    const int aoff = lds_byte(wr * 64 + fr, fq * 8), boff = lds_byte(wc * 32 + fr, fq * 8);
#define PG8_SA(b, h) (((b) * 2 + (h)) * HTB)
#define PG8_SB(b, h) ((4 + (b) * 2 + (h)) * HTB)
#define PG8_STAGE(bufoff, gbase, voff) do { _Pragma("unroll") for (int _i = 0; _i < 2; ++_i) \
        __builtin_amdgcn_global_load_lds((const unsigned*)((const char*)(gbase) + (voff)[_i]), (PG8_LAS unsigned*)(lds + (bufoff) + ldsw + _i * 8192), 16, 0, 0); } while (0)
#define PG8_LDA(dst, b, h) do { _Pragma("unroll") for (int m = 0; m < 4; ++m) _Pragma("unroll") for (int k = 0; k < 2; ++k) dst[m][k] = *(const PG8_LAS bf16x8*)(lds + PG8_SA(b, h) + aoff + m * 2048 + k * 1024); } while (0)
#define PG8_LDB(dst, b, h) do { _Pragma("unroll") for (int n = 0; n < 2; ++n) _Pragma("unroll") for (int k = 0; k < 2; ++k) dst[n][k] = *(const PG8_LAS bf16x8*)(lds + PG8_SB(b, h) + boff + n * 2048 + k * 1024); } while (0)
#define PG8_MMA(ai, bj, At, Bt) do { __builtin_amdgcn_s_setprio(1); _Pragma("unroll") for (int m = 0; m < 4; ++m) _Pragma("unroll") for (int n = 0; n < 2; ++n) _Pragma("unroll") for (int k = 0; k < 2; ++k) \
        acc[ai][bj][m][n] = __builtin_amdgcn_mfma_f32_16x16x32_bf16(Bt[n][k], At[m][k], acc[ai][bj][m][n], 0, 0, 0); __builtin_amdgcn_s_setprio(0); } while (0)
#define PG8_WAIT_V(n) asm volatile("s_waitcnt vmcnt(" #n ")" ::: "memory")
#define PG8_WAIT_L(n) asm volatile("s_waitcnt lgkmcnt(" #n ")" ::: "memory")
#define PG8_BAR __builtin_amdgcn_s_barrier()
#define PG8_SCHED __builtin_amdgcn_sched_barrier(0)
    Unit cur, nxt; int ui = 0;
    if (!S.next(0, cur)) return;
    f32x4 acc[2][2][4][2];
#pragma unroll
    for (int a = 0; a < 2; ++a)
#pragma unroll
        for (int b = 0; b < 2; ++b)
#pragma unroll
            for (int m = 0; m < 4; ++m)
#pragma unroll
                for (int n = 0; n < 2; ++n) acc[a][b][m][n] = (f32x4){0.f, 0.f, 0.f, 0.f};
    bf16x8 At[4][2], B0[2][2], B1[2][2];
    const char* cA = (const char*)g.A + (size_t)cur.pm * tstep; const char* cB = (const char*)g.Bt + (size_t)cur.pn * tstep;
    S.a_ready(cur);
    if constexpr (SP2) {
        PG8_STAGE(PG8_SB(0, 0), cB, voffB); PG8_STAGE(PG8_SB(0, 1), cB + hstep, voffB); PG8_STAGE(PG8_SA(0, 0), cA, voffA); PG8_STAGE(PG8_SA(0, 1), cA + hstep, voffA);
        if (wr == 1) PG8_BAR;
        PG8_WAIT_V(2); PG8_BAR;
        PG8_STAGE(PG8_SB(1, 0), cB + kstep, voffB); PG8_STAGE(PG8_SA(1, 0), cA + kstep, voffA); PG8_STAGE(PG8_SB(1, 1), cB + hstep + kstep, voffB);
        PG8_WAIT_V(6); PG8_BAR;
    } else {
        PG8_STAGE(PG8_SB(0, 0), cB, voffB); PG8_STAGE(PG8_SA(0, 0), cA, voffA); PG8_STAGE(PG8_SB(0, 1), cB + hstep, voffB); PG8_STAGE(PG8_SA(0, 1), cA + hstep, voffA);
        if (wr == 1) PG8_BAR;
        PG8_WAIT_V(4); PG8_BAR;
        PG8_STAGE(PG8_SB(1, 0), cB + kstep, voffB); PG8_STAGE(PG8_SA(1, 0), cA + kstep, voffA); PG8_STAGE(PG8_SB(1, 1), cB + hstep + kstep, voffB);
        PG8_WAIT_V(6); PG8_BAR;
    }
    for (;;) {
        const bool has_next = S.next(ui + 1, nxt);
        const char* nA = has_next ? (const char*)g.A + (size_t)nxt.pm * tstep : cA; const char* nB = has_next ? (const char*)g.Bt + (size_t)nxt.pn * tstep : cB;
        for (int t = 0; t < nt; t += 2) {
            const bool last = (t == nt - 2);
            const char* a1 = cA + (size_t)(t + 1) * kstep;
            const char* a2 = last ? nA : cA + (size_t)(t + 2) * kstep; const char* b2 = last ? nB : cB + (size_t)(t + 2) * kstep;
            const char* a3 = a2 + kstep; const char* b3 = b2 + kstep;
            if (last && has_next) S.a_ready(nxt);
            if constexpr (SP2) {
            PG8_LDB(B0, 0, 0); PG8_LDB(B1, 0, 1); PG8_SCHED; PG8_LDA(At, 0, 0); PG8_STAGE(PG8_SA(1, 1), a1 + hstep, voffA);
            PG8_WAIT_V(8); PG8_WAIT_L(0); PG8_BAR; PG8_MMA(0, 0, At, B0); PG8_MMA(0, 1, At, B1); PG8_BAR; PG8_SCHED;
            PG8_LDA(At, 0, 1); PG8_STAGE(PG8_SB(0, 0), b2, voffB); PG8_STAGE(PG8_SB(0, 1), b2 + hstep, voffB); PG8_STAGE(PG8_SA(0, 0), a2, voffA);
            PG8_WAIT_V(8); PG8_WAIT_L(0); PG8_BAR; PG8_MMA(1, 0, At, B0); PG8_MMA(1, 1, At, B1); PG8_BAR; PG8_SCHED;
            PG8_LDB(B0, 1, 0); PG8_LDB(B1, 1, 1); PG8_SCHED; PG8_LDA(At, 1, 0); PG8_STAGE(PG8_SA(0, 1), a2 + hstep, voffA);
            PG8_WAIT_V(8); PG8_WAIT_L(0); PG8_BAR; PG8_MMA(0, 0, At, B0); PG8_MMA(0, 1, At, B1); PG8_BAR; PG8_SCHED;
            PG8_LDA(At, 1, 1); PG8_STAGE(PG8_SB(1, 0), b3, voffB); PG8_STAGE(PG8_SB(1, 1), b3 + hstep, voffB); PG8_STAGE(PG8_SA(1, 0), a3, voffA);
            PG8_WAIT_V(8); PG8_WAIT_L(0); PG8_BAR; PG8_MMA(1, 0, At, B0); PG8_MMA(1, 1, At, B1); PG8_BAR; PG8_SCHED;
            } else {
            PG8_LDB(B0, 0, 0); PG8_SCHED; PG8_LDA(At, 0, 0); PG8_STAGE(PG8_SA(1, 1), a1 + hstep, voffA);
            PG8_WAIT_L(8); PG8_BAR; PG8_WAIT_L(0); PG8_MMA(0, 0, At, B0); PG8_BAR; PG8_SCHED;
            PG8_LDB(B1, 0, 1); PG8_STAGE(PG8_SB(0, 0), b2, voffB);
            PG8_BAR; PG8_WAIT_L(0); PG8_MMA(0, 1, At, B1); PG8_BAR;
            PG8_LDA(At, 0, 1); PG8_STAGE(PG8_SA(0, 0), a2, voffA);
            PG8_BAR; PG8_WAIT_L(0); PG8_MMA(1, 0, At, B0); PG8_BAR; PG8_SCHED;
            PG8_STAGE(PG8_SB(0, 1), b2 + hstep, voffB);
            PG8_WAIT_V(6); PG8_BAR; PG8_MMA(1, 1, At, B1); PG8_BAR;
            PG8_LDB(B0, 1, 0); PG8_SCHED; PG8_LDA(At, 1, 0); PG8_STAGE(PG8_SA(0, 1), a2 + hstep, voffA);
            PG8_WAIT_L(8); PG8_BAR; PG8_WAIT_L(0); PG8_MMA(0, 0, At, B0); PG8_BAR; PG8_SCHED;
            PG8_LDB(B1, 1, 1); PG8_STAGE(PG8_SB(1, 0), b3, voffB);
            PG8_BAR; PG8_WAIT_L(0); PG8_MMA(0, 1, At, B1); PG8_BAR;
            PG8_LDA(At, 1, 1); PG8_STAGE(PG8_SA(1, 0), a3, voffA);
            PG8_BAR; PG8_WAIT_L(0); PG8_MMA(1, 0, At, B0); PG8_BAR; PG8_SCHED;
            PG8_STAGE(PG8_SB(1, 1), b3 + hstep, voffB);
            PG8_WAIT_V(6); PG8_BAR; PG8_MMA(1, 1, At, B1); PG8_BAR;
            }
        }
        if constexpr (ALIGN_EPI) { if (wr == 0) PG8_BAR; }
        if constexpr (!Epi::AFTER_DRAIN) { E(acc, cur, wr, wc, fr, fq); S.done(cur); }
        if (!has_next) break;
#pragma unroll
        for (int a = 0; a < 2; ++a)
#pragma unroll
            for (int b = 0; b < 2; ++b)
#pragma unroll
                for (int m = 0; m < 4; ++m)
#pragma unroll
                    for (int n = 0; n < 2; ++n) acc[a][b][m][n] = (f32x4){0.f, 0.f, 0.f, 0.f};
        cur = nxt; cA = nA; cB = nB; ++ui;
        if constexpr (ALIGN_EPI) { if (wr == 1) PG8_BAR; }
    }
    PG8_WAIT_V(0);
    if constexpr (!ALIGN_EPI) { if (wr == 0) PG8_BAR; }
    PG8_BAR;
    if constexpr (Epi::AFTER_DRAIN) { E.fused(acc, cur, wr, wc, fr, fq, lds, wid, lane); S.done(cur); }
#undef PG8_SA
#undef PG8_SB
#undef PG8_STAGE
#undef PG8_LDA
#undef PG8_LDB
#undef PG8_MMA
#undef PG8_WAIT_V
#undef PG8_WAIT_L
#undef PG8_BAR
#undef PG8_SCHED
}
}

#define DI __device__ __forceinline__
#define LAS __attribute__((address_space(3)))
typedef unsigned short bf16_t;
typedef short bf16x8 __attribute__((ext_vector_type(8)));
typedef short s16x4 __attribute__((ext_vector_type(4)));
typedef float f32x4 __attribute__((ext_vector_type(4)));
typedef float f32x2 __attribute__((ext_vector_type(2)));
typedef float f32x16 __attribute__((ext_vector_type(16)));
typedef unsigned u32x4 __attribute__((ext_vector_type(4)));
typedef unsigned u32x2 __attribute__((ext_vector_type(2)));
typedef __bf16 bf16x2_t __attribute__((ext_vector_type(2)));
#define MFMA32(a, b, c) __builtin_amdgcn_mfma_f32_32x32x16_bf16((a), (b), (c), 0, 0, 0)

constexpr int T = 49152, DM = 1024, NPROJ = 3072, NIN = 2960, DFF = 4096, HFF = 2048;
constexpr int C_R = 0, C_K = 256, C_V = 512, C_WD = 768, C_AD = 896, C_GD = 1024;
constexpr int C_AQ = 1152, C_AK = 1664, C_AV = 1792;
constexpr int C_MQ = 1920, C_MK = 2176, C_MV = 2432, C_MO = 2688, C_IG = 2944, C_FG = 2952;
constexpr size_t MiB = 1u << 20;
constexpr size_t WS_SS = 0, WS_CNT = MiB - 4096, WS_CDOT = 1 * MiB, WS_TAB = 2 * MiB + 512 * 1024, WS_BAR = 2 * MiB + 768 * 1024, WS_WIN = 3 * MiB, WS_WOUT = 15 * MiB,
                 WS_W1 = 19 * MiB, WS_W2 = 35 * MiB, WS_VT = 51 * MiB, WS_YB = 63 * MiB, WS_HBP = 87 * MiB, WS_X1 = 111 * MiB, WS_R = 207 * MiB,
                 WS_HID = WS_R + 96 * MiB, WS_END = 495 * MiB;
constexpr int LDS_BYTES = 134400 + 256;
constexpr int NTHR = 512;

struct KP { const float* in[26]; float* out; unsigned char* ws; };

DI unsigned cvtpk(float lo, float hi) { f32x2 v = {lo, hi}; bf16x2_t b = __builtin_convertvector(v, bf16x2_t); return __builtin_bit_cast(unsigned, b); }
DI unsigned short f2bf(float f) { return (unsigned short)(cvtpk(f, 0.f) & 0xffffu); }
DI float bf2f(unsigned h) { return __builtin_bit_cast(float, h << 16); }
DI float bflo(unsigned w) { return __builtin_bit_cast(float, w << 16); }
DI float bfhi(unsigned w) { return __builtin_bit_cast(float, w & 0xffff0000u); }
DI int crow(int reg, int h) { return (reg & 3) + 8 * (reg >> 2) + 4 * h; }
template <int CTRL> DI float dppf(float v) { return __builtin_bit_cast(float, __builtin_amdgcn_update_dpp(0, __builtin_bit_cast(int, v), CTRL, 0xf, 0xf, true)); }
DI float red8(float v) { v += dppf<0xB1>(v); v += dppf<0x4E>(v); v += dppf<0x141>(v); return v; }
DI float red16(float v) { v = red8(v); v += dppf<0x128>(v); return v; }
DI float frcp(float x) { return __builtin_amdgcn_rcpf(x); }
DI float sigmoidf_(float x) { return frcp(1.f + __expf(-x)); }
DI f32x16 zero16() { f32x16 z; for (int i = 0; i < 16; ++i) z[i] = 0.f; return z; }
DI void seq_of_job(int j, int& seq, int& h, int& dir) { if (j < 16) { seq = 8 + (j >> 3); } else { j -= 16; seq = j >> 3; } h = (j >> 1) & 3; dir = j & 1; }
DI void seq_info(int s, int& start, int& len) { if (s < 8) { start = s * 4096; len = 4096; } else { start = 32768 + (s - 8) * 8192; len = 8192; } }
DI int tok_seq_start(int tok, int& len) { if (tok < 32768) { len = 4096; return tok & ~4095; } len = 8192; return 32768 + ((tok - 32768) & ~8191); }

#define XB_TMO      128
#define XB_XCNT(j)  (256  + 64 * (j))
#define XB_XSUB(j)  (1280 + 64 * (j))
#define XB_XGEN(j)  (2304 + 64 * (j))
#define XB_TOP      3328
#define XB_TOPGEN   3392
#define XCD_BAR_WORDS 3456
#define XB_SPIN_CAP (1u << 18)

__device__ __forceinline__ unsigned xb_ld(unsigned* p)              { return __hip_atomic_load(p, __ATOMIC_RELAXED, __HIP_MEMORY_SCOPE_AGENT); }
__device__ __forceinline__ unsigned xb_add(unsigned* p, unsigned v) { return __hip_atomic_fetch_add(p, v, __ATOMIC_RELAXED, __HIP_MEMORY_SCOPE_AGENT); }
__device__ __forceinline__ unsigned xb_xcc_id() { return (unsigned)__builtin_amdgcn_s_getreg((3 << 11) | 20) & 0xFu; }
#define XB_SPIN(cond, bar) do { unsigned _sp = 0; while (cond) { __builtin_amdgcn_s_sleep(1); \
    if ((++_sp & 255u) == 0u) { if (xb_ld(&(bar)[XB_TMO])) break; if (_sp > XB_SPIN_CAP) { atomicAdd(&(bar)[XB_TMO], 1u); break; } } } } while (0)

struct XcdBarrier {
    unsigned* bar; unsigned x;
    volatile LAS unsigned* st;
};

__device__ __forceinline__ XcdBarrier xcd_barrier_post(unsigned* bar, volatile LAS unsigned* st) {
    XcdBarrier b; b.bar = bar; b.x = xb_xcc_id(); b.st = st;
    if (threadIdx.x == 0) (void)xb_add(&bar[XB_XCNT(b.x)], 1u);
    return b;
}
__device__ __forceinline__ void xcd_barrier_complete(unsigned* bar, unsigned x, unsigned& nloc, unsigned& nx) {
    const unsigned G = gridDim.x * gridDim.y * gridDim.z;
    unsigned sum, cnt, mine, sp = 0u;
    for (;;) {
        sum = 0u; cnt = 0u; mine = 0u;
#pragma unroll
        for (unsigned j = 0; j < 16; ++j) { const unsigned c = xb_ld(&bar[XB_XCNT(j)]); sum += c; cnt += (c > 0u) ? 1u : 0u; mine = (j == x) ? c : mine; }
        if (sum == G) break;
        __builtin_amdgcn_s_sleep(1);
        if ((++sp & 255u) == 0u) { if (xb_ld(&bar[XB_TMO])) break; if (sp > XB_SPIN_CAP) { atomicAdd(&bar[XB_TMO], 1u); break; } }
    }
    nloc = mine > 0u ? mine : 1u; nx = cnt > 0u ? cnt : 1u;
}

__device__ __forceinline__ void xcd_barrier(const XcdBarrier& b) {
    asm volatile("s_waitcnt vmcnt(0)" ::: "memory");
    __syncthreads();
    if (threadIdx.x == 0) {
        unsigned* bar = b.bar;
        __builtin_amdgcn_s_waitcnt(0);
        unsigned nloc = b.st[0], nx = b.st[1];
        if (nloc == 0u) { xcd_barrier_complete(bar, b.x, nloc, nx); b.st[0] = nloc; b.st[1] = nx; }
        const unsigned old = xb_add(&bar[XB_XSUB(b.x)], 1u);
        const unsigned gen = old / nloc;
        if (old + 1u == (gen + 1u) * nloc) {
            __builtin_amdgcn_fence(__ATOMIC_RELEASE, "agent");
            asm volatile("s_waitcnt vmcnt(0)" ::: "memory");
            const unsigned og = xb_add(&bar[XB_TOP], 1u);
            const unsigned tg = og / nx;
            if (og + 1u == (tg + 1u) * nx) xb_add(&bar[XB_TOPGEN], 1u);
            else XB_SPIN(xb_ld(&bar[XB_TOPGEN]) == tg, bar);
            __builtin_amdgcn_fence(__ATOMIC_ACQUIRE, "agent");
            xb_add(&bar[XB_XGEN(b.x)], 1u);
            asm volatile("s_waitcnt vmcnt(0)" ::: "memory");
        } else {
            XB_SPIN(xb_ld(&bar[XB_XGEN(b.x)]) == gen, bar);
            __builtin_amdgcn_fence(__ATOMIC_ACQUIRE, "agent");
            asm volatile("s_waitcnt vmcnt(0)" ::: "memory");
        }
    }
    __syncthreads();
}

struct EpiProj {
    static constexpr bool PERM = true, AFTER_DRAIN = false;
    bf16_t* O; const float* ss;
    DI void operator()(const pg8::f32x4 (&acc)[2][2][4][2], const pg8::Unit& u, int wr, int wc, int fr, int fq) const {
        const int row0 = u.pm * 256 + wr * 64 + fr, col0 = u.pn * 256 + wc * 32 + 8 * fq;
#pragma unroll
        for (int ai = 0; ai < 2; ++ai)
#pragma unroll
            for (int m = 0; m < 4; ++m) {
                const int row = row0 + ai * 128 + m * 16;
                const float rs = rsqrtf(ss[row] * (1.f / 1024.f) + 1e-6f);
                bf16_t* rp = O + (size_t)row * NPROJ + col0;
#pragma unroll
                for (int bj = 0; bj < 2; ++bj) {
                    pg8::f32x4 v0 = acc[ai][bj][m][0] * rs, v1 = acc[ai][bj][m][1] * rs;
                    u32x4 w; w.x = cvtpk(v0[0], v0[1]); w.y = cvtpk(v0[2], v0[3]); w.z = cvtpk(v1[0], v1[1]); w.w = cvtpk(v1[2], v1[3]);
                    *(u32x4*)(rp + bj * 128) = w;
                }
            }
    }
};
struct EpiRelu2 {
    static constexpr bool PERM = true, AFTER_DRAIN = false;
    bf16_t* O; const float* ss;
    DI void operator()(const pg8::f32x4 (&acc)[2][2][4][2], const pg8::Unit& u, int wr, int wc, int fr, int fq) const {
        const int row0 = u.pm * 256 + wr * 64 + fr, col0 = u.pn * 256 + wc * 32 + 8 * fq;
#pragma unroll
        for (int ai = 0; ai < 2; ++ai)
#pragma unroll
            for (int m = 0; m < 4; ++m) {
                const int row = row0 + ai * 128 + m * 16;
                const float rs = rsqrtf(ss[row] * (1.f / 1024.f) + 1e-6f);
                bf16_t* rp = O + (size_t)row * HFF + col0;
#pragma unroll
                for (int bj = 0; bj < 2; ++bj) {
                    pg8::f32x4 v0 = acc[ai][bj][m][0] * rs, v1 = acc[ai][bj][m][1] * rs;
#pragma unroll
                    for (int j = 0; j < 4; ++j) { float a = fmaxf(v0[j], 0.f); v0[j] = a * a; float b = fmaxf(v1[j], 0.f); v1[j] = b * b; }
                    u32x4 w; w.x = cvtpk(v0[0], v0[1]); w.y = cvtpk(v0[2], v0[3]); w.z = cvtpk(v1[0], v1[1]); w.w = cvtpk(v1[2], v1[3]);
                    *(u32x4*)(rp + bj * 128) = w;
                }
            }
    }
};
template <bool WRITE_HB, bool DO_SS, bool FIRST = false> struct EpiRes {
    static constexpr bool PERM = true, AFTER_DRAIN = false;
    float* X; bf16_t* HB; float* ss; const float* xin0; const float* xin1;
    DI void operator()(const pg8::f32x4 (&acc)[2][2][4][2], const pg8::Unit& u, int wr, int wc, int fr, int fq) const {
        const int row0 = u.pm * 256 + wr * 64 + fr, col0 = u.pn * 256 + wc * 32 + 8 * fq;
#pragma unroll
        for (int ai = 0; ai < 2; ++ai)
#pragma unroll
            for (int m = 0; m < 4; ++m) {
                const int row = row0 + ai * 128 + m * 16;
                float* xp = X + (size_t)row * DM + col0;
                const float* rp = FIRST ? ((row < 32768 ? xin0 + (size_t)row * DM : xin1 + (size_t)(row - 32768) * DM) + col0) : xp;
                float sq = 0.f;
#pragma unroll
                for (int bj = 0; bj < 2; ++bj) {
                    pg8::f32x4 a0 = *(const pg8::f32x4*)(rp + bj * 128), a1 = *(const pg8::f32x4*)(rp + bj * 128 + 4);
                    a0 += acc[ai][bj][m][0]; a1 += acc[ai][bj][m][1];
                    *(pg8::f32x4*)(xp + bj * 128) = a0; *(pg8::f32x4*)(xp + bj * 128 + 4) = a1;
                    if (WRITE_HB) { u32x4 w; w.x = cvtpk(a0[0], a0[1]); w.y = cvtpk(a0[2], a0[3]); w.z = cvtpk(a1[0], a1[1]); w.w = cvtpk(a1[2], a1[3]);
                        *(u32x4*)(HB + (size_t)row * DM + col0 + bj * 128) = w; }
                    if (DO_SS) sq += a0[0] * a0[0] + a0[1] * a0[1] + a0[2] * a0[2] + a0[3] * a0[3] + a1[0] * a1[0] + a1[1] * a1[1] + a1[2] * a1[2] + a1[3] * a1[3];
                }
                if (DO_SS) { sq += __shfl_xor(sq, 16); sq += __shfl_xor(sq, 32); if (fq == 0) atomicAdd(ss + row, sq); }
            }
    }
};

DI void transpose_tile(const float* src, int N, int nvalid, const float* gain, bf16_t* dst, int K, int kt, int nt, LAS float* tile, int tid) {
    const int a = tid & 63, b8 = tid >> 6;
#pragma unroll
    for (int i = 0; i < 8; ++i) { const int k = b8 + 8 * i, n = nt * 64 + a; float v = (n < nvalid) ? src[(size_t)(kt * 64 + k) * N + n] : 0.f; if (gain) v *= gain[kt * 64 + k]; tile[k * 65 + a] = v; }
    __syncthreads();
#pragma unroll
    for (int i = 0; i < 8; ++i) { const int n = b8 + 8 * i; dst[(size_t)(nt * 64 + n) * K + kt * 64 + a] = f2bf(tile[a * 65 + n]); }
    __syncthreads();
}
DI void convert_tile(const KP& p, int it, LAS float* tile, int tid) {
    {
        const int l = it / 3072; int r = it % 3072;
        const float* src; const float* gain; bf16_t* dst; int N, nvalid, K, kt, nt;
        if (r < 768) { src = p.in[3] + (size_t)l * 1024 * NIN; N = NIN; nvalid = NIN; K = 1024; gain = p.in[2] + l * 1024; dst = (bf16_t*)(p.ws + WS_WIN) + (size_t)l * NPROJ * 1024; kt = r / 48; nt = r % 48; }
        else if (r < 1024) { r -= 768; src = p.in[21] + (size_t)l * 1024 * 1024; N = 1024; nvalid = 1024; K = 1024; gain = nullptr; dst = (bf16_t*)(p.ws + WS_WOUT) + (size_t)l * 1024 * 1024; kt = r / 16; nt = r % 16; }
        else if (r < 2048) { r -= 1024; src = p.in[23] + (size_t)l * 1024 * 4096; N = 4096; nvalid = 4096; K = 1024; gain = p.in[22] + l * 1024; dst = (bf16_t*)(p.ws + WS_W1) + (size_t)l * 4096 * 1024; kt = r / 64; nt = r % 64; }
        else { r -= 2048; const int h = r / 512; r %= 512; src = p.in[24] + (size_t)l * 4096 * 1024 + (size_t)h * 2048 * 1024; N = 1024; nvalid = 1024; K = 2048; gain = nullptr;
               dst = (bf16_t*)(p.ws + WS_W2) + (size_t)l * 2 * 1024 * 2048 + (size_t)h * 1024 * 2048; kt = r / 16; nt = r % 16; }
        transpose_tile(src, N, nvalid, gain, dst, K, kt, nt, tile, tid);
    }
}
DI void p0_phase(const KP& p, LAS unsigned char* lds, int tid, int G, int bid) {
    LAS float* tile = (LAS float*)lds;
    for (int it = bid; it < 768; it += G) convert_tile(p, it, tile, tid);
    const int wave = tid >> 6, lane = tid & 63;
    float* ss = (float*)(p.ws + WS_SS);
    bf16_t* xb = (bf16_t*)(p.ws + WS_X1);
    for (int row = bid * 8 + wave; row < T; row += G * 8) {
        const float* xs = (row < 32768) ? p.in[0] + (size_t)row * DM : p.in[1] + (size_t)(row - 32768) * DM;
        float sq = 0.f;
#pragma unroll
        for (int j = 0; j < 4; ++j) {
            const int c = (j * 64 + lane) * 4;
            const f32x4 v = *(const f32x4*)(xs + c);
            u32x2 w; w.x = cvtpk(v[0], v[1]); w.y = cvtpk(v[2], v[3]);
            *(u32x2*)(xb + (size_t)row * DM + c) = w;
            sq += v[0] * v[0] + v[1] * v[1] + v[2] * v[2] + v[3] * v[3];
        }
#pragma unroll
        for (int o = 32; o >= 1; o >>= 1) sq += __shfl_xor(sq, o);
        if (lane == 0) ss[row] = sq;
    }
    for (int i = bid * NTHR + tid; i < 4 * T; i += G * NTHR) ss[T + i] = 0.f;
    if (bid == 0) {
        if (tid < 64) ((unsigned*)(p.ws + WS_CNT))[tid] = 0u;
        float2* tab = (float2*)(p.ws + WS_TAB);
        for (int idx = tid; idx < 2048; idx += NTHR) { const int pos = idx >> 4, f = idx & 15; const float inv = powf(10000.f, -(float)f / 16.f); const float ang = (float)pos * inv; tab[idx] = make_float2(cosf(ang), sinf(ang)); }
    }
}

DI void prep_phase(const KP& p, int l, LAS unsigned char* lds, int tid, int G, int bid) {
    bf16_t* proj = (bf16_t*)(p.ws + WS_R);
    bf16_t* vT = (bf16_t*)(p.ws + WS_VT);
    const float2* tab = (const float2*)(p.ws + WS_TAB);
    const float* qn = p.in[15] + l * 64; const float* kn = p.in[16] + l * 64;
    const int wave = tid >> 6, lane = tid & 63, g = lane >> 4, li = lane & 15;
    LAS bf16_t* vts = (LAS bf16_t*)lds;
    for (int unit = bid; unit < T / 64; unit += G) {
        const int tok0 = unit * 64;
        for (int i = 0; i < 8; ++i) {
            const int tok = tok0 + wave * 8 + i; int len; const int st = tok_seq_start(tok, len); const int pos = tok - st; const int prow = pos >> 6, pcol = pos & 63;
#pragma unroll
            for (int it = 0; it < 3; ++it) {
                const bool act = (it < 2) || (g < 2);
                const int colbase = (it < 2) ? C_AQ + (it * 4 + g) * 64 : C_AK + (g & 1) * 64;
                const float* wn = (it < 2) ? qn : kn;
                bf16_t* ptr = proj + (size_t)tok * NPROJ + colbase + li * 4;
                const u32x2 raw = *(const u32x2*)ptr;
                float x[4] = {bflo(raw.x), bfhi(raw.x), bflo(raw.y), bfhi(raw.y)};
                float sq = x[0] * x[0] + x[1] * x[1] + x[2] * x[2] + x[3] * x[3];
                sq = red16(sq);
                const float rinv = rsqrtf(sq * (1.f / 64.f) + 1e-6f);
                const f32x4 w4 = *(const f32x4*)(wn + li * 4);
                const int idx = (li >> 3) ? pcol : prow; const bool second = (li >> 2) & 1;
                const float scale = (it < 2) ? 0.125f * 1.4426950408889634f : 1.f;
                float o[4];
#pragma unroll
                for (int j = 0; j < 4; ++j) {
                    const float y = x[j] * rinv * w4[j];
                    const float pr = __shfl_xor(y, 4);
                    const int f = (li * 4 + j) & 15;
                    const float2 cs = tab[idx * 16 + f];
                    o[j] = (second ? (y * cs.x + pr * cs.y) : (y * cs.x - pr * cs.y)) * scale;
                }
                if (act) { u32x2 w; w.x = cvtpk(o[0], o[1]); w.y = cvtpk(o[2], o[3]); *(u32x2*)ptr = w; }
            }
        }
#pragma unroll
        for (int i = 0; i < 2; ++i) { const int idx = tid + NTHR * i; const int tl = idx >> 4, c8 = (idx & 15) * 8;
            const u32x4 v = *(const u32x4*)(proj + (size_t)(tok0 + tl) * NPROJ + C_AV + c8); *(LAS u32x4*)(vts + tl * 136 + c8) = v; }
        __syncthreads();
        { const int c = tid >> 2, tq = tid & 3; unsigned w[8];
#pragma unroll
          for (int j = 0; j < 8; ++j) { const unsigned lo = vts[(tq * 16 + 2 * j) * 136 + c], hi = vts[(tq * 16 + 2 * j + 1) * 136 + c]; w[j] = lo | (hi << 16); }
          u32x4 a = {w[0], w[1], w[2], w[3]}, b = {w[4], w[5], w[6], w[7]};
          bf16_t* dp = vT + (size_t)c * T + tok0 + tq * 16; *(u32x4*)dp = a; *(u32x4*)(dp + 8) = b; }
        __syncthreads();
    }
}

DI void attn_unit(const KP& p, int l, int unit, LAS unsigned char* lds, int tid) {
    const float* qnw = p.in[15] + l * 64; const float* knw = p.in[16] + l * 64;
    const bf16_t* proj = (const bf16_t*)(p.ws + WS_R);
    const bf16_t* vT = (const bf16_t*)(p.ws + WS_VT);
    bf16_t* mix = (bf16_t*)(p.ws + WS_X1);
    int seq, kvh, qt;
    if (unit < 512) { seq = 8 + (unit >> 8); const int r = unit & 255; kvh = r >> 7; qt = r & 127; }
    else { const int u2 = unit - 512; seq = u2 >> 7; const int r = u2 & 127; kvh = r >> 6; qt = r & 63; }
    int start, len; seq_info(seq, start, len);
    const int nk = len >> 6;
    const int wave = tid >> 6, lane = tid & 63, r32 = lane & 31, hh = lane >> 5;
    const int head = kvh * 4 + (wave >> 1);
    const int q0 = start + qt * 64 + (wave & 1) * 32;
    bf16x8 qf[4];
    { const bf16_t* qp = proj + (size_t)(q0 + r32) * NPROJ + C_AQ + head * 64 + hh * 8;
#pragma unroll
      for (int ks = 0; ks < 4; ++ks) qf[ks] = *(const bf16x8*)(qp + ks * 16); }
    f32x16 o0 = zero16(), o1 = zero16();
    float lsum = 0.f;
    f32x16 sinit;
    { float mq = fabsf(qnw[lane]), mk = fabsf(knw[lane]);
#pragma unroll
      for (int o = 32; o >= 1; o >>= 1) { mq = fmaxf(mq, __shfl_xor(mq, o)); mk = fmaxf(mk, __shfl_xor(mk, o)); }
      const float bnd = 64.f * 0.125f * 1.4426950408889634f * 1.01f * mq * mk;
#pragma unroll
      for (int i = 0; i < 16; ++i) sinit[i] = -bnd; }
    const int lrow = tid >> 3, lseg = tid & 7;
    const bf16_t* kptr = proj + (size_t)(start + lrow) * NPROJ + C_AK + kvh * 64 + lseg * 8;
    const bf16_t* vptr = vT + (size_t)(kvh * 64 + lrow) * T + start + lseg * 8;
    const int lds_off = lrow * 144 + lseg * 16;
    u32x4 kreg = *(const u32x4*)kptr, vreg = *(const u32x4*)vptr;
    *(LAS u32x4*)(lds + lds_off) = kreg; *(LAS u32x4*)(lds + 9216 + lds_off) = vreg;
    __syncthreads();
    for (int j = 0; j < nk; ++j) {
        const bool more = (j + 1 < nk);
        if (more) { kreg = *(const u32x4*)(kptr + (size_t)(j + 1) * 64 * NPROJ); vreg = *(const u32x4*)(vptr + (j + 1) * 64); }
        LAS unsigned char* Ks = lds + (j & 1) * 18432; LAS unsigned char* Vs = Ks + 9216;
        f32x16 s0 = sinit, s1 = sinit;
#pragma unroll
        for (int ks = 0; ks < 4; ++ks) {
            const bf16x8 a0 = *(const LAS bf16x8*)(Ks + r32 * 144 + (ks * 16 + hh * 8) * 2);
            const bf16x8 a1 = *(const LAS bf16x8*)(Ks + (32 + r32) * 144 + (ks * 16 + hh * 8) * 2);
            s0 = MFMA32(a0, qf[ks], s0); s1 = MFMA32(a1, qf[ks], s1);
        }
        float rs = 0.f;
#pragma unroll
        for (int i = 0; i < 16; ++i) { s0[i] = __builtin_amdgcn_exp2f(s0[i]); rs += s0[i]; }
#pragma unroll
        for (int i = 0; i < 16; ++i) { s1[i] = __builtin_amdgcn_exp2f(s1[i]); rs += s1[i]; }
        lsum += rs;
#pragma unroll
        for (int mb = 0; mb < 2; ++mb)
#pragma unroll
            for (int s = 0; s < 2; ++s) {
                u32x4 pk;
                if (mb == 0) { pk.x = cvtpk(s0[8 * s], s0[8 * s + 1]); pk.y = cvtpk(s0[8 * s + 2], s0[8 * s + 3]); pk.z = cvtpk(s0[8 * s + 4], s0[8 * s + 5]); pk.w = cvtpk(s0[8 * s + 6], s0[8 * s + 7]); }
                else         { pk.x = cvtpk(s1[8 * s], s1[8 * s + 1]); pk.y = cvtpk(s1[8 * s + 2], s1[8 * s + 3]); pk.z = cvtpk(s1[8 * s + 4], s1[8 * s + 5]); pk.w = cvtpk(s1[8 * s + 6], s1[8 * s + 7]); }
                const bf16x8 pb = __builtin_bit_cast(bf16x8, pk);
                const int keyoff = 32 * mb + 16 * s + 4 * hh;
                { const s16x4 lo = *(const LAS s16x4*)(Vs + r32 * 144 + keyoff * 2), hi = *(const LAS s16x4*)(Vs + r32 * 144 + (keyoff + 8) * 2);
                  const bf16x8 va = __builtin_shufflevector(lo, hi, 0, 1, 2, 3, 4, 5, 6, 7); o0 = MFMA32(va, pb, o0); }
                { const s16x4 lo = *(const LAS s16x4*)(Vs + (32 + r32) * 144 + keyoff * 2), hi = *(const LAS s16x4*)(Vs + (32 + r32) * 144 + (keyoff + 8) * 2);
                  const bf16x8 va = __builtin_shufflevector(lo, hi, 0, 1, 2, 3, 4, 5, 6, 7); o1 = MFMA32(va, pb, o1); }
            }
        if (more) { LAS unsigned char* Kn = lds + ((j + 1) & 1) * 18432; *(LAS u32x4*)(Kn + lds_off) = kreg; *(LAS u32x4*)(Kn + 9216 + lds_off) = vreg; }
        __syncthreads();
    }
    lsum += __shfl_xor(lsum, 32);
    const float inv = 1.f / lsum;
    bf16_t* op = mix + (size_t)(q0 + r32) * DM + 256 + head * 64;
#pragma unroll
    for (int g4 = 0; g4 < 4; ++g4) {
        u32x2 w0; w0.x = cvtpk(o0[4 * g4] * inv, o0[4 * g4 + 1] * inv); w0.y = cvtpk(o0[4 * g4 + 2] * inv, o0[4 * g4 + 3] * inv);
        *(u32x2*)(op + 8 * g4 + 4 * hh) = w0;
        u32x2 w1; w1.x = cvtpk(o1[4 * g4] * inv, o1[4 * g4 + 1] * inv); w1.y = cvtpk(o1[4 * g4 + 2] * inv, o1[4 * g4 + 3] * inv);
        *(u32x2*)(op + 32 + 8 * g4 + 4 * hh) = w1;
    }
}

constexpr int RW_BUF = 49152, RW_XR = 0, RW_XKD = 8192, RW_XV = 16384, RW_WLW = 24576, RW_ALB = 32768, RW_KKN = 40960, RW_YO = 98304, RW_XWD = 106496, RW_XAD = 111104,
              RW_W2T = 115712, RW_A2T = 124928, RW_CD = 134144, SLOT_OFF = 134400;
#define RW_BAR() asm volatile("s_waitcnt lgkmcnt(0)\n\ts_barrier" ::: "memory")
#define RW_DECODE(i_) const int t = (pt >> 4) + 16 * ((i_) / 5), c4 = (pt & 15) * 4; constexpr int gi = (i_) % 5; \
            const int col = (gi == 0) ? C_R + h * 64 + c4 : (gi == 1) ? C_K + h * 64 + c4 : (gi == 2) ? C_V + h * 64 + c4 : (gi == 3) ? C_WD + dir * 64 + c4 : C_AD + dir * 64 + c4;
#define RW_ISSUE1(chx, i_) { RW_DECODE(i_) \
            const int n = (chx) * 32 + t; const int pos = dir ? (len - 1 - n) : n; \
            const bf16_t* bp = proj + (size_t)(start + pos) * NPROJ + col; \
            rc[i_] = *(const u32x2*)bp; rp_[i_] = (u32x2){0u, 0u}; rn[i_] = (u32x2){0u, 0u}; \
            if (pos > 0) rp_[i_] = *(const u32x2*)(bp - NPROJ); \
            if (pos < len - 1) rn[i_] = *(const u32x2*)(bp + NPROJ); }
#define RW_ISSUE(chx) do { RW_ISSUE1(chx, 0) RW_ISSUE1(chx, 1) RW_ISSUE1(chx, 2) RW_ISSUE1(chx, 3) RW_ISSUE1(chx, 4) RW_ISSUE1(chx, 5) RW_ISSUE1(chx, 6) RW_ISSUE1(chx, 7) RW_ISSUE1(chx, 8) RW_ISSUE1(chx, 9) } while (0)
#define RW_CONV1(i_) { RW_DECODE(i_) \
            const f32x4 m4 = mureg[gi]; \
            f32x4 x = {bflo(rc[i_].x), bfhi(rc[i_].x), bflo(rc[i_].y), bfhi(rc[i_].y)}; \
            const f32x4 pn = {bflo(rp_[i_].x) + bflo(rn[i_].x), bfhi(rp_[i_].x) + bfhi(rn[i_].x), bflo(rp_[i_].y) + bflo(rn[i_].y), bfhi(rp_[i_].y) + bfhi(rn[i_].y)}; \
            x = x + (0.5f * pn - x) * m4; \
            if (gi < 3) { LAS float* dst = (gi == 0) ? XR : (gi == 1) ? XKD : XV; *(LAS f32x4*)(dst + t * 64 + c4) = x; } \
            else if (gi == 3) { \
                _Pragma("unroll") for (int j = 0; j < 4; ++j) { const float e = __expf(2.f * x[j]); x[j] = 1.f - 2.f * frcp(e + 1.f); } \
                u32x2 w; w.x = cvtpk(x[0], x[1]); w.y = cvtpk(x[2], x[3]); *(LAS u32x2*)(XWD + t * 72 + c4) = w; } \
            else { u32x2 w; w.x = cvtpk(x[0], x[1]); w.y = cvtpk(x[2], x[3]); *(LAS u32x2*)(XAD + t * 72 + c4) = w; } }
DI void rwkv_job(const KP& p, int l, int job, LAS unsigned char* lds, int tid) {
    int seq, h, dir, rpart; constexpr int nrows = 32;
    { int j = job; if (j < 32) { seq = 8 + (j >> 4); } else { j -= 32; seq = j >> 4; } h = (j >> 2) & 3; dir = (j >> 1) & 1; rpart = j & 1; }
    int start, len; seq_info(seq, start, len);
    const bf16_t* proj = (const bf16_t*)(p.ws + WS_R);
    bf16_t* mix = (bf16_t*)(p.ws + WS_X1);
    bf16_t* yb = (bf16_t*)(p.ws + WS_YB);
    float* cdot = (float*)(p.ws + WS_CDOT);
    const float* mu = p.in[4] + l * 1152;
    const int wave = tid >> 6, lane = tid & 63, r32 = lane & 31, hh = lane >> 5;
    LAS bf16_t* XWD = (LAS bf16_t*)(lds + RW_XWD); LAS bf16_t* XAD = (LAS bf16_t*)(lds + RW_XAD);
    LAS bf16_t* W2T = (LAS bf16_t*)(lds + RW_W2T); LAS bf16_t* A2T = (LAS bf16_t*)(lds + RW_A2T);
    { const float* w2 = p.in[6] + (size_t)((l * 2 + dir) * 64) * 256 + h * 64; const float* a2 = p.in[8] + (size_t)((l * 2 + dir) * 64) * 256 + h * 64;
#pragma unroll
      for (int i = 0; i < 8; ++i) { const int idx = tid + NTHR * i; const int mm = idx >> 6, c = idx & 63; W2T[c * 72 + mm] = f2bf(w2[mm * 256 + c]); A2T[c * 72 + mm] = f2bf(a2[mm * 256 + c]); } }
    const int nch = len >> 5;
    __syncthreads();
    if (tid < 256) {
        const int srow = tid >> 3, sj = (tid & 7) * 8;
        f32x4 Sa = {0.f, 0.f, 0.f, 0.f}, Sb = {0.f, 0.f, 0.f, 0.f};
        RW_BAR(); RW_BAR(); RW_BAR();
#define RW_LD(dst, arr, tt) const f32x4 dst##a = *(const LAS f32x4*)((arr) + (tt) * 64 + sj), dst##b = *(const LAS f32x4*)((arr) + (tt) * 64 + sj + 4)
        for (int ch = 0; ch < nch; ++ch) {
            LAS unsigned char* B = lds + (ch & 1) * RW_BUF;
            LAS float* XR = (LAS float*)(B + RW_XR); LAS float* XKD = (LAS float*)(B + RW_XKD); LAS float* XV = (LAS float*)(B + RW_XV);
            LAS float* WLW = (LAS float*)(B + RW_WLW); LAS float* ALB = (LAS float*)(B + RW_ALB); LAS float* KKN = (LAS float*)(B + RW_KKN);
            LAS float* YO = (LAS float*)(lds + RW_YO + (ch & 1) * 4096);
            f32x4 wa = *(const LAS f32x4*)(WLW + sj), wb = *(const LAS f32x4*)(WLW + sj + 4), ka = *(const LAS f32x4*)(KKN + sj), kb = *(const LAS f32x4*)(KKN + sj + 4);
            f32x4 ba = *(const LAS f32x4*)(ALB + sj), bb = *(const LAS f32x4*)(ALB + sj + 4), da = *(const LAS f32x4*)(XKD + sj), db = *(const LAS f32x4*)(XKD + sj + 4);
            f32x4 ra = *(const LAS f32x4*)(XR + sj), rb = *(const LAS f32x4*)(XR + sj + 4);
            float v = XV[rpart * 32 + srow];
#pragma unroll 2
            for (int t = 0; t < 32; ++t) {
                const int tn = (t < 31) ? t + 1 : 31;
                RW_LD(wn, WLW, tn); RW_LD(kn, KKN, tn); RW_LD(bn, ALB, tn); RW_LD(dn, XKD, tn); RW_LD(rn_, XR, tn);
                const float vn = XV[tn * 64 + rpart * 32 + srow];
                const f32x4 pa = Sa * ka + Sb * kb;
                float sa = (pa[0] + pa[1]) + (pa[2] + pa[3]);
                sa = -red8(sa);
                Sa = Sa * wa + sa * ba + v * da;
                Sb = Sb * wb + sa * bb + v * db;
                const f32x4 py = Sa * ra + Sb * rb;
                float y = (py[0] + py[1]) + (py[2] + py[3]);
                y = red8(y);
                if ((tid & 7) == 0) YO[t * 32 + srow] = y;
                wa = wna; wb = wnb; ka = kna; kb = knb; ba = bna; bb = bnb; da = dna; db = dnb; ra = rn_a; rb = rn_b; v = vn;
                if (t == 19 || t == 23) RW_BAR();
            }
            RW_BAR();
        }
    } else {
        const int ptid = tid - 256;
        const int cli = ptid & 15, cc4 = cli * 4;
        const f32x4 w0v = *(const f32x4*)(p.in[5] + (l * 2 + dir) * 256 + h * 64 + cc4);
        const f32x4 a0v = *(const f32x4*)(p.in[7] + (l * 2 + dir) * 256 + h * 64 + cc4);
        const f32x4 kkw = *(const f32x4*)(p.in[10] + l * 256 + h * 64 + cc4);
        const f32x4 kaw = *(const f32x4*)(p.in[11] + l * 256 + h * 64 + cc4);
        const f32x4 rkw = *(const f32x4*)(p.in[12] + l * 256 + h * 64 + cc4);
        u32x2 rc[10], rp_[10], rn[10];
        f32x4 mureg[5];
        { const int c4 = (ptid & 15) * 4;
          mureg[0] = *(const f32x4*)(mu + C_R + h * 64 + c4); mureg[1] = *(const f32x4*)(mu + C_K + h * 64 + c4); mureg[2] = *(const f32x4*)(mu + C_V + h * 64 + c4);
          mureg[3] = *(const f32x4*)(mu + C_WD + dir * 64 + c4); mureg[4] = *(const f32x4*)(mu + C_AD + dir * 64 + c4); }
        { int pt = ptid; RW_ISSUE(0); }
        for (int ch = -1; ch < nch; ++ch) {
            int pt = ptid; asm volatile("" : "+v"(pt));
            if (ch >= 1) {
                const int pc = ch - 1;
                LAS float* YO = (LAS float*)(lds + RW_YO + (pc & 1) * 4096); LAS float* CD = (LAS float*)(lds + RW_CD + (pc & 1) * 128);
                const int t = ptid >> 3, c4 = (ptid & 7) * 4;
                const int n = pc * 32 + t; const int pos = dir ? (len - 1 - n) : n; const int tok = start + pos;
                const f32x4 yv = *(const LAS f32x4*)(YO + t * 32 + c4);
                u32x2 w; w.x = cvtpk(yv[0], yv[1]); w.y = cvtpk(yv[2], yv[3]);
                if (c4 < nrows) { if (dir) *(u32x2*)(yb + (size_t)tok * 256 + h * 64 + rpart * nrows + c4) = w; else *(u32x2*)(mix + (size_t)tok * DM + h * 64 + rpart * nrows + c4) = w; }
                if (rpart == 0 && ptid < 32) { const int n2 = pc * 32 + ptid; const int pos2 = dir ? (len - 1 - n2) : n2; cdot[((size_t)(start + pos2) * 4 + h) * 2 + dir] = CD[ptid]; }
            }
            const int nc = ch + 1;
            const bool build = nc < nch;
            LAS unsigned char* B = lds + (nc & 1) * RW_BUF;
            LAS float* XR = (LAS float*)(B + RW_XR); LAS float* XKD = (LAS float*)(B + RW_XKD); LAS float* XV = (LAS float*)(B + RW_XV);
            LAS float* WLW = (LAS float*)(B + RW_WLW); LAS float* ALB = (LAS float*)(B + RW_ALB); LAS float* KKN = (LAS float*)(B + RW_KKN);
            LAS float* CDn = (LAS float*)(lds + RW_CD + (nc & 1) * 128);
            if (build) {
                RW_CONV1(0) RW_CONV1(1) RW_CONV1(2) RW_CONV1(3) RW_CONV1(4) RW_CONV1(5) RW_CONV1(6) RW_CONV1(7) RW_CONV1(8) RW_CONV1(9)
                if (nc + 1 < nch) RW_ISSUE(nc + 1);
            }
            RW_BAR();
            if (build) {
                const int mat = (wave - 4) >> 1, nb = (wave - 4) & 1;
                LAS bf16_t* Xs = mat ? XAD : XWD; LAS bf16_t* Ws = mat ? A2T : W2T;
                f32x16 acc = zero16();
#pragma unroll
                for (int ks = 0; ks < 4; ++ks) {
                    const bf16x8 a = *(const LAS bf16x8*)(Xs + r32 * 72 + ks * 16 + hh * 8);
                    const bf16x8 bb = *(const LAS bf16x8*)(Ws + (nb * 32 + r32) * 72 + ks * 16 + hh * 8);
                    acc = MFMA32(a, bb, acc);
                }
                LAS float* dst = mat ? ALB : WLW;
#pragma unroll
                for (int i = 0; i < 16; ++i) dst[crow(i, hh) * 64 + nb * 32 + r32] = acc[i];
            }
            RW_BAR();
            if (build) {
#pragma unroll
                for (int it = 0; it < 2; ++it) {
                    const int ct = (ptid >> 4) + 16 * it;
                    const f32x4 wl = *(const LAS f32x4*)(WLW + ct * 64 + cc4), al = *(const LAS f32x4*)(ALB + ct * 64 + cc4);
                    const f32x4 k4 = *(const LAS f32x4*)(XKD + ct * 64 + cc4), r4 = *(const LAS f32x4*)(XR + ct * 64 + cc4);
                    f32x4 w, a, kkr, kd;
                    float ssq = 0.f, cd = 0.f;
#pragma unroll
                    for (int j = 0; j < 4; ++j) {
                        const float sg = sigmoidf_(w0v[j] + wl[j]);
                        w[j] = __expf(-0.6065306597126334f * sg);
                        a[j] = sigmoidf_(a0v[j] + al[j]);
                        kkr[j] = k4[j] * kkw[j]; ssq += kkr[j] * kkr[j];
                        kd[j] = k4[j] * (1.f + (a[j] - 1.f) * kaw[j]);
                        cd += r4[j] * kd[j] * rkw[j];
                    }
                    ssq = red16(ssq); cd = red16(cd);
                    const float inv = __builtin_amdgcn_rsqf(fmaxf(ssq, 1e-24f));
                    f32x4 kkn, bv;
#pragma unroll
                    for (int j = 0; j < 4; ++j) { kkn[j] = kkr[j] * inv; bv[j] = kkn[j] * a[j]; }
                    *(LAS f32x4*)(WLW + ct * 64 + cc4) = w; *(LAS f32x4*)(ALB + ct * 64 + cc4) = bv; *(LAS f32x4*)(KKN + ct * 64 + cc4) = kkn; *(LAS f32x4*)(XKD + ct * 64 + cc4) = kd;
                    if (cli == 0) CDn[ct] = cd;
                }
            }
            RW_BAR();
        }
        {
            const int pc = nch - 1;
            LAS float* YO = (LAS float*)(lds + RW_YO + (pc & 1) * 4096); LAS float* CD = (LAS float*)(lds + RW_CD + (pc & 1) * 128);
            const int t = ptid >> 3, c4 = (ptid & 7) * 4;
            const int n = pc * 32 + t; const int pos = dir ? (len - 1 - n) : n; const int tok = start + pos;
            const f32x4 yv = *(const LAS f32x4*)(YO + t * 32 + c4);
            u32x2 w; w.x = cvtpk(yv[0], yv[1]); w.y = cvtpk(yv[2], yv[3]);
            if (c4 < nrows) { if (dir) *(u32x2*)(yb + (size_t)tok * 256 + h * 64 + rpart * nrows + c4) = w; else *(u32x2*)(mix + (size_t)tok * DM + h * 64 + rpart * nrows + c4) = w; }
            if (rpart == 0 && ptid < 32) { const int n2 = pc * 32 + ptid; const int pos2 = dir ? (len - 1 - n2) : n2; cdot[((size_t)(start + pos2) * 4 + h) * 2 + dir] = CD[ptid]; }
        }
    }
    __syncthreads();
}

constexpr int ML_QS = 0, ML_KS = 9216, ML_KT = 18432, ML_VT = 27648, ML_VWT = 36864, ML_PS = 46080, ML_CB = 55296, ML_WGT = 64512, ML_RR = 64768, ML_MROW = 65024,
              ML_SC = 65280, ML_EMT = 65536, ML_DENI = 65792, ML_NS = 66048, ML_A12 = 66304;
DI void mlstm_job(const KP& p, int l, int job, LAS unsigned char* lds, int tid) {
    int seq, hm, dir; seq_of_job(job, seq, hm, dir);
    int start, len; seq_info(seq, start, len);
    const bf16_t* proj = (const bf16_t*)(p.ws + WS_R);
    bf16_t* mix = (bf16_t*)(p.ws + WS_X1);
    bf16_t* hbp = (bf16_t*)(p.ws + WS_HBP);
    const float* cw = p.in[17] + l * 3 * 512;
    const float ibv = p.in[18][(l * 2 + dir) * 4 + hm], fbv = p.in[19][(l * 2 + dir) * 4 + hm];
    const int wave = tid >> 6, lane = tid & 63, r32 = lane & 31, hh = lane >> 5;
    LAS bf16_t* Qs = (LAS bf16_t*)(lds + ML_QS); LAS bf16_t* Ks = (LAS bf16_t*)(lds + ML_KS); LAS bf16_t* KT = (LAS bf16_t*)(lds + ML_KT);
    LAS bf16_t* VT = (LAS bf16_t*)(lds + ML_VT); LAS bf16_t* VWT = (LAS bf16_t*)(lds + ML_VWT); LAS bf16_t* Ps = (LAS bf16_t*)(lds + ML_PS); LAS bf16_t* CB = (LAS bf16_t*)(lds + ML_CB);
    LAS float* WGT = (LAS float*)(lds + ML_WGT); LAS float* RR = (LAS float*)(lds + ML_RR); LAS float* MROW = (LAS float*)(lds + ML_MROW); LAS float* SC = (LAS float*)(lds + ML_SC);
    LAS float* EMT = (LAS float*)(lds + ML_EMT); LAS float* DENI = (LAS float*)(lds + ML_DENI); LAS float* NS = (LAS float*)(lds + ML_NS); LAS float* A12 = (LAS float*)(lds + ML_A12);
    for (int i = tid; i < 64 * 72; i += NTHR) CB[i] = 0;
    if (tid < 64) NS[tid] = 0.f;
    f32x16 Creg = zero16();
    float Mst = 0.f;
    __syncthreads();
    const int nch = len >> 6;
    const int ll = tid >> 3, e8 = (tid & 7) * 8;
    for (int ch = 0; ch < nch; ++ch) {
        {
            const int n = ch * 64 + ll; const int pos = dir ? (len - 1 - n) : n; const int tok = start + pos;
#pragma unroll
            for (int which = 0; which < 2; ++which) {
                const int col = (which ? C_MK : C_MQ) + hm * 64 + e8; const int cwc = (which ? 256 : 0) + hm * 64 + e8;
                const bf16_t* bp = proj + (size_t)tok * NPROJ + col;
                const u32x4 cu = *(const u32x4*)bp; u32x4 pv = {0u, 0u, 0u, 0u}, nv = {0u, 0u, 0u, 0u};
                if (pos > 0) pv = *(const u32x4*)(bp - NPROJ);
                if (pos < len - 1) nv = *(const u32x4*)(bp + NPROJ);
                float o[8];
#pragma unroll
                for (int j = 0; j < 4; ++j) {
                    const f32x2 c0 = *(const f32x2*)(cw + cwc + 2 * j), c1 = *(const f32x2*)(cw + 512 + cwc + 2 * j), c2 = *(const f32x2*)(cw + 1024 + cwc + 2 * j);
                    const float v0 = c0.x * bflo(pv[j]) + c1.x * bflo(cu[j]) + c2.x * bflo(nv[j]);
                    const float v1 = c0.y * bfhi(pv[j]) + c1.y * bfhi(cu[j]) + c2.y * bfhi(nv[j]);
                    o[2 * j] = v0 * sigmoidf_(v0); o[2 * j + 1] = v1 * sigmoidf_(v1);
                }
                if (which) {
#pragma unroll
                    for (int j = 0; j < 8; ++j) o[j] *= 0.125f;
                }
                u32x4 w; w.x = cvtpk(o[0], o[1]); w.y = cvtpk(o[2], o[3]); w.z = cvtpk(o[4], o[5]); w.w = cvtpk(o[6], o[7]);
                if (!which) *(LAS u32x4*)(Qs + ll * 72 + e8) = w;
                else { *(LAS u32x4*)(Ks + ll * 72 + e8) = w;
#pragma unroll
                    for (int j = 0; j < 4; ++j) { KT[(e8 + 2 * j) * 72 + ll] = (bf16_t)(w[j] & 0xffffu); KT[(e8 + 2 * j + 1) * 72 + ll] = (bf16_t)(w[j] >> 16); } }
            }
        }
        if (wave == 0) {
            const int n = ch * 64 + lane; const int pos = dir ? (len - 1 - n) : n; const int tok = start + pos;
            const float igv = bf2f(proj[(size_t)tok * NPROJ + C_IG + dir * 4 + hm]) + ibv;
            const float fgv = bf2f(proj[(size_t)tok * NPROJ + C_FG + dir * 4 + hm]) + fbv;
            const float lf = (fgv > 0.f) ? -log1pf(__expf(-fgv)) : (fgv - log1pf(__expf(fgv)));
            float b = lf;
#pragma unroll
            for (int o = 1; o < 64; o <<= 1) { const float t2 = __shfl_up(b, o); if (lane >= o) b += t2; }
            const float bL = __shfl(b, 63);
            const float g = bL - b + igv;
            float mg = g;
#pragma unroll
            for (int o = 32; o >= 1; o >>= 1) mg = fmaxf(mg, __shfl_xor(mg, o));
            const float wgt = __expf(g - mg);
            const float r = igv - b;
            float cm = r;
#pragma unroll
            for (int o = 1; o < 64; o <<= 1) { const float t2 = __shfl_up(cm, o); if (lane >= o) cm = fmaxf(cm, t2); }
            const float mrow = fmaxf(cm, Mst);
            WGT[lane] = wgt; RR[lane] = r; MROW[lane] = mrow; SC[lane] = __expf(Mst - mrow); EMT[lane] = __expf(-(b + mrow));
            const float Mnew = fmaxf(bL + Mst, mg);
            if (lane == 0) { A12[0] = __expf(bL + Mst - Mnew); A12[1] = __expf(mg - Mnew); }
            Mst = Mnew;
        }
        __syncthreads();
        {
            const int n = ch * 64 + ll; const int pos = dir ? (len - 1 - n) : n; const int tok = start + pos;
            const u32x4 vv = *(const u32x4*)(proj + (size_t)tok * NPROJ + C_MV + hm * 64 + e8);
            const float wg = WGT[ll];
#pragma unroll
            for (int j = 0; j < 4; ++j) {
                VT[(e8 + 2 * j) * 72 + ll] = (bf16_t)(vv[j] & 0xffffu); VT[(e8 + 2 * j + 1) * 72 + ll] = (bf16_t)(vv[j] >> 16);
                const unsigned pw = cvtpk(bflo(vv[j]) * wg, bfhi(vv[j]) * wg);
                VWT[(e8 + 2 * j) * 72 + ll] = (bf16_t)(pw & 0xffffu); VWT[(e8 + 2 * j + 1) * 72 + ll] = (bf16_t)(pw >> 16);
            }
        }
        __syncthreads();
        if (wave < 4) {
            const int tb = wave >> 1, sb = wave & 1;
            f32x16 acc = zero16();
#pragma unroll
            for (int ks = 0; ks < 4; ++ks) {
                const bf16x8 a = *(const LAS bf16x8*)(Qs + (tb * 32 + r32) * 72 + ks * 16 + hh * 8);
                const bf16x8 b = *(const LAS bf16x8*)(Ks + (sb * 32 + r32) * 72 + ks * 16 + hh * 8);
                acc = MFMA32(a, b, acc);
            }
            const int s = sb * 32 + r32; const float rs_ = RR[s];
#pragma unroll
            for (int i = 0; i < 16; ++i) { const int t = tb * 32 + crow(i, hh); const float pvv = (s <= t) ? __expf(rs_ - MROW[t]) * acc[i] : 0.f; Ps[t * 72 + s] = f2bf(pvv); }
        } else {
            const int db = (wave - 4) >> 1, eb = (wave - 4) & 1;
            f32x16 kc = zero16();
#pragma unroll
            for (int ks = 0; ks < 4; ++ks) {
                const bf16x8 a = *(const LAS bf16x8*)(VWT + (db * 32 + r32) * 72 + ks * 16 + hh * 8);
                const bf16x8 b = *(const LAS bf16x8*)(KT + (eb * 32 + r32) * 72 + ks * 16 + hh * 8);
                kc = MFMA32(a, b, kc);
            }
            const float a1 = A12[0], a2 = A12[1];
#pragma unroll
            for (int i = 0; i < 16; ++i) Creg[i] = a1 * Creg[i] + a2 * kc[i];
        }
        __syncthreads();
        f32x16 acc = zero16();
        float ncv = 0.f;
        if (wave < 4) {
            const int tb = wave >> 1, db = wave & 1;
#pragma unroll
            for (int ks = 0; ks < 4; ++ks) {
                const bf16x8 a = *(const LAS bf16x8*)(Qs + (tb * 32 + r32) * 72 + ks * 16 + hh * 8);
                const bf16x8 b = *(const LAS bf16x8*)(CB + (db * 32 + r32) * 72 + ks * 16 + hh * 8);
                acc = MFMA32(a, b, acc);
            }
#pragma unroll
            for (int i = 0; i < 16; ++i) acc[i] *= SC[tb * 32 + crow(i, hh)];
#pragma unroll
            for (int ks = 0; ks < 4; ++ks) {
                const bf16x8 a = *(const LAS bf16x8*)(Ps + (tb * 32 + r32) * 72 + ks * 16 + hh * 8);
                const bf16x8 b = *(const LAS bf16x8*)(VT + (db * 32 + r32) * 72 + ks * 16 + hh * 8);
                acc = MFMA32(a, b, acc);
            }
        } else if (wave == 4) {
            float rsum = 0.f, qn = 0.f;
            for (int e = 0; e < 64; ++e) { rsum += bf2f(Ps[lane * 72 + e]); qn += bf2f(Qs[lane * 72 + e]) * NS[e]; }
            const float den = rsum + SC[lane] * qn;
            DENI[lane] = 1.f / fmaxf(fabsf(den), EMT[lane]);
        } else if (wave == 5) {
            for (int s = 0; s < 64; ++s) ncv += WGT[s] * bf2f(KT[lane * 72 + s]);
        }
        __syncthreads();
        if (wave < 4) {
            const int tb = wave >> 1, db = wave & 1;
#pragma unroll
            for (int i = 0; i < 16; ++i) {
                const int t = tb * 32 + crow(i, hh); const int n = ch * 64 + t; const int pos = dir ? (len - 1 - n) : n; const int tok = start + pos;
                const bf16_t o = f2bf(acc[i] * DENI[t]);
                if (dir) hbp[(size_t)tok * 256 + hm * 64 + db * 32 + r32] = o; else mix[(size_t)tok * DM + 768 + hm * 64 + db * 32 + r32] = o;
            }
        } else {
            const int db = (wave - 4) >> 1, eb = (wave - 4) & 1;
#pragma unroll
            for (int i = 0; i < 16; ++i) CB[(db * 32 + crow(i, hh)) * 72 + eb * 32 + r32] = f2bf(Creg[i]);
            if (wave == 5) NS[lane] = A12[0] * NS[lane] + A12[1] * ncv;
        }
        __syncthreads();
    }
}

DI void mixers_phase(const KP& p, int l, int cidx, LAS unsigned char* lds, int tid, int G, int bid) {
    unsigned* cnt = (unsigned*)(p.ws + WS_CNT) + cidx;
    LAS int* slot = (LAS int*)(lds + SLOT_OFF);
    for (;;) {
        if (tid == 0) *slot = (int)atomicAdd(cnt, 1u);
        __syncthreads();
        const int item = *slot;
        __syncthreads();
        if (item >= 240 + 1536) {
            if (l != 0 || item >= 240 + 1536 + 1344) break;
            const int t0 = 768 + (item - 1776) * 4;
            for (int q = 0; q < 4; ++q) convert_tile(p, t0 + q, (LAS float*)lds, tid);
            continue;
        }
        int kind, jb;
        if (item < 32) { kind = 0; jb = item; } else if (item < 48) { kind = 1; jb = item - 32; } else if (item < 176) { kind = 0; jb = item - 48 + 32; }
        else if (item < 240) { kind = 1; jb = item - 176 + 16; } else { kind = 2; jb = item - 240; }
        int t2 = tid; asm volatile("" : "+v"(t2));
#ifndef REP_R
#define REP_R 1
#endif
#ifndef REP_M
#define REP_M 1
#endif
#ifndef REP_T
#define REP_T 1
#endif
        if (kind == 0) { rwkv_job(p, l, jb, lds, t2); }
        else if (kind == 1) { for (int rep = 0; rep < REP_M; ++rep) { mlstm_job(p, l, jb, lds, t2); __syncthreads(); } }
        else { for (int rep = 0; rep < REP_T; ++rep) { attn_unit(p, l, jb, lds, t2); __syncthreads(); } }
        __syncthreads();
    }
}

constexpr int PO_G2T = 0, PO_AS = 69632, PO_GO = 87040;
DI void post_phase(const KP& p, int l, LAS unsigned char* lds, int tid, int G, int bid) {
    const bf16_t* proj = (const bf16_t*)(p.ws + WS_R);
    bf16_t* mix = (bf16_t*)(p.ws + WS_X1);
    const bf16_t* yb = (const bf16_t*)(p.ws + WS_YB);
    const bf16_t* hbp = (const bf16_t*)(p.ws + WS_HBP);
    const float* cdot = (const float*)(p.ws + WS_CDOT);
    const float* mu = p.in[4] + l * 1152;
    const float* lnw = p.in[13] + l * 256; const float* lnb = p.in[14] + l * 256; const float* nw = p.in[20] + l * 256;
    LAS bf16_t* G2T = (LAS bf16_t*)(lds + PO_G2T); LAS bf16_t* AS = (LAS bf16_t*)(lds + PO_AS); LAS bf16_t* GO = (LAS bf16_t*)(lds + PO_GO);
    const int wave = tid >> 6, lane = tid & 63, r32 = lane & 31, hh = lane >> 5;
    { const float* g2 = p.in[9] + (size_t)l * 128 * 256;
      for (int i = 0; i < 64; ++i) { const int idx = tid + NTHR * i; const int mm = idx >> 8, c = idx & 255; G2T[c * 136 + mm] = f2bf(g2[idx]); } }
    __syncthreads();
    for (int unit = bid; unit < T / 64; unit += G) {
        const int tok0 = unit * 64;
        int len; const int st = tok_seq_start(tok0, len);
#pragma unroll
        for (int i = 0; i < 4; ++i) {
            const int q = tid + NTHR * i; const int t = q >> 5, c4 = (q & 31) * 4; const int tok = tok0 + t; const int pos = tok - st;
            const bf16_t* bp = proj + (size_t)tok * NPROJ + C_GD + c4;
            const u32x2 cu = *(const u32x2*)bp; u32x2 pv = {0u, 0u}, nv = {0u, 0u};
            if (pos > 0) pv = *(const u32x2*)(bp - NPROJ);
            if (pos < len - 1) nv = *(const u32x2*)(bp + NPROJ);
            const f32x4 m4 = *(const f32x4*)(mu + C_GD + c4);
            float x[4] = {bflo(cu.x), bfhi(cu.x), bflo(cu.y), bfhi(cu.y)};
            const float pn[4] = {bflo(pv.x) + bflo(nv.x), bfhi(pv.x) + bfhi(nv.x), bflo(pv.y) + bflo(nv.y), bfhi(pv.y) + bfhi(nv.y)};
#pragma unroll
            for (int j = 0; j < 4; ++j) x[j] = sigmoidf_(x[j] + (0.5f * pn[j] - x[j]) * m4[j]);
            u32x2 w; w.x = cvtpk(x[0], x[1]); w.y = cvtpk(x[2], x[3]); *(LAS u32x2*)(AS + t * 136 + c4) = w;
        }
        __syncthreads();
        {
            const int hd = wave & 3, tb = wave >> 2;
            f32x16 a0 = zero16(), a1 = zero16();
#pragma unroll
            for (int ks = 0; ks < 8; ++ks) {
                const bf16x8 a = *(const LAS bf16x8*)(AS + (tb * 32 + r32) * 136 + ks * 16 + hh * 8);
                const bf16x8 b0 = *(const LAS bf16x8*)(G2T + (hd * 64 + r32) * 136 + ks * 16 + hh * 8);
                const bf16x8 b1 = *(const LAS bf16x8*)(G2T + (hd * 64 + 32 + r32) * 136 + ks * 16 + hh * 8);
                a0 = MFMA32(a, b0, a0); a1 = MFMA32(a, b1, a1);
            }
#pragma unroll
            for (int i = 0; i < 16; ++i) { const int t = tb * 32 + crow(i, hh); GO[t * 264 + hd * 64 + r32] = f2bf(a0[i]); GO[t * 264 + hd * 64 + 32 + r32] = f2bf(a1[i]); }
        }
        __syncthreads();
#pragma unroll 1
        for (int it = 0; it < 8; ++it) {
            const int task = tid + NTHR * it; const int grp = task >> 4, li = task & 15; const int t = grp >> 2, hd = grp & 3; const int c4 = li * 4;
            const int tok = tok0 + t; const int pos = tok - st;
            {
                const u32x2 yf = *(const u32x2*)(mix + (size_t)tok * DM + hd * 64 + c4), ybv = *(const u32x2*)(yb + (size_t)tok * 256 + hd * 64 + c4);
                float x[4] = {bflo(yf.x) + bflo(ybv.x), bfhi(yf.x) + bfhi(ybv.x), bflo(yf.y) + bflo(ybv.y), bfhi(yf.y) + bfhi(ybv.y)};
                const float mean = red16(x[0] + x[1] + x[2] + x[3]) * (1.f / 64.f);
                float vs = 0.f;
#pragma unroll
                for (int j = 0; j < 4; ++j) { x[j] -= mean; vs += x[j] * x[j]; }
                const float rstd = rsqrtf(red16(vs) * (1.f / 64.f) + 64e-5f);
                const bf16_t* bp = proj + (size_t)tok * NPROJ + C_V + hd * 64 + c4;
                const u32x2 cu = *(const u32x2*)bp; u32x2 pv = {0u, 0u}, nv = {0u, 0u};
                if (pos > 0) pv = *(const u32x2*)(bp - NPROJ);
                if (pos < len - 1) nv = *(const u32x2*)(bp + NPROJ);
                const f32x4 m4 = *(const f32x4*)(mu + C_V + hd * 64 + c4);
                float v[4] = {bflo(cu.x), bfhi(cu.x), bflo(cu.y), bfhi(cu.y)};
                const float pn[4] = {bflo(pv.x) + bflo(nv.x), bfhi(pv.x) + bfhi(nv.x), bflo(pv.y) + bflo(nv.y), bfhi(pv.y) + bfhi(nv.y)};
                const f32x2 cdv = *(const f32x2*)(cdot + ((size_t)tok * 4 + hd) * 2);
                const float cds = cdv.x + cdv.y;
                const f32x4 lw = *(const f32x4*)(lnw + hd * 64 + c4), lb = *(const f32x4*)(lnb + hd * 64 + c4);
                const u32x2 gv = *(const LAS u32x2*)(GO + t * 264 + hd * 64 + c4);
                const float g[4] = {bflo(gv.x), bfhi(gv.x), bflo(gv.y), bfhi(gv.y)};
                float o[4];
#pragma unroll
                for (int j = 0; j < 4; ++j) { const float vsft = v[j] + (0.5f * pn[j] - v[j]) * m4[j]; o[j] = (x[j] * rstd * lw[j] + lb[j] + cds * vsft) * g[j]; }
                u32x2 w; w.x = cvtpk(o[0], o[1]); w.y = cvtpk(o[2], o[3]); *(u32x2*)(mix + (size_t)tok * DM + hd * 64 + c4) = w;
            }
            {
                const u32x2 hf = *(const u32x2*)(mix + (size_t)tok * DM + 768 + hd * 64 + c4), hb = *(const u32x2*)(hbp + (size_t)tok * 256 + hd * 64 + c4);
                const float x[4] = {bflo(hf.x) + bflo(hb.x), bfhi(hf.x) + bfhi(hb.x), bflo(hf.y) + bflo(hb.y), bfhi(hf.y) + bfhi(hb.y)};
                const float ms = red16(x[0] * x[0] + x[1] * x[1] + x[2] * x[2] + x[3] * x[3]) * (1.f / 64.f);
                const float rinv = rsqrtf(ms + 1e-6f);
                const u32x2 ov = *(const u32x2*)(proj + (size_t)tok * NPROJ + C_MO + hd * 64 + c4);
                const float og[4] = {bflo(ov.x), bfhi(ov.x), bflo(ov.y), bfhi(ov.y)};
                const f32x4 nwv = *(const f32x4*)(nw + hd * 64 + c4);
                float o[4];
#pragma unroll
                for (int j = 0; j < 4; ++j) o[j] = sigmoidf_(og[j]) * x[j] * rinv * nwv[j];
                u32x2 w; w.x = cvtpk(o[0], o[1]); w.y = cvtpk(o[2], o[3]); *(u32x2*)(mix + (size_t)tok * DM + 768 + hd * 64 + c4) = w;
            }
        }
        __syncthreads();
    }
}

DI void final_phase(const KP& p, int tid, int G, int bid) {
    const float* ss = (const float*)(p.ws + WS_SS) + 4 * T;
    const float* g = p.in[25];
    for (size_t i = (size_t)bid * NTHR + tid; i < (size_t)T * 256; i += (size_t)G * NTHR) {
        const int row = (int)(i >> 8), c = (int)(i & 255) * 4;
        const float rs = rsqrtf(ss[row] * (1.f / 1024.f) + 1e-6f);
        f32x4 v = *(const f32x4*)(p.out + i * 4); const f32x4 gv = *(const f32x4*)(g + c);
        v[0] *= rs * gv[0]; v[1] *= rs * gv[1]; v[2] *= rs * gv[2]; v[3] *= rs * gv[3];
        *(f32x4*)(p.out + i * 4) = v;
    }
}

__global__ void __launch_bounds__(NTHR, 2) fwd_kernel(KP p) {
    extern __shared__ __attribute__((aligned(16))) unsigned char lds_raw[];
    LAS unsigned char* lds = (LAS unsigned char*)lds_raw;
    cg::grid_group grid = cg::this_grid();
    int tid = threadIdx.x; const int G = gridDim.x, bid = blockIdx.x;
#define LAUNDER() asm volatile("" : "+v"(tid))
    float* ss = (float*)(p.ws + WS_SS);
    bf16_t* X1 = (bf16_t*)(p.ws + WS_X1);
    bf16_t* PROJ = (bf16_t*)(p.ws + WS_R);
    bf16_t* HB = (bf16_t*)(p.ws + WS_R);
    bf16_t* HID = (bf16_t*)(p.ws + WS_HID);

        LAUNDER();
    volatile LAS unsigned* bst = (volatile LAS unsigned*)(lds + SLOT_OFF + 16);
    if (tid == 0) { bst[0] = 0u; bst[1] = 0u; }
    __syncthreads();
    const XcdBarrier xbar = xcd_barrier_post((unsigned*)(p.ws + WS_BAR), bst);
#define GSYNC() xcd_barrier(xbar)
    p0_phase(p, lds, tid, G, bid);
    grid.sync();
#ifdef PROBE_SYNC20
    for (int i = 0; i < 20; ++i) GSYNC();
#endif
#ifdef PROBE_P0X2
    LAUNDER(); p0_phase(p, lds, tid, G, bid);
    GSYNC();
#endif
#ifdef PROBE_SYNC10
    for (int i = 0; i < 10; ++i) GSYNC();
#endif
    for (int l = 0; l < 2; ++l) {
        {
            pg8::Gemm g{X1, (const bf16_t*)(p.ws + WS_WIN) + (size_t)l * NPROJ * 1024, T, NPROJ, 1024}; pg8::StaticOrder S; S.init(T, NPROJ, G, bid);
            EpiProj E{PROJ, ss + (2 * l) * T};
            pg8::gemm_phase<EpiProj, pg8::StaticOrder, true, true>(lds, g, S, E);
#ifdef PROBE_P1X2
            GSYNC();
            pg8::gemm_phase<EpiProj, pg8::StaticOrder, true, true>(lds, g, S, E);
#endif
        }
        GSYNC();
        LAUNDER();
        prep_phase(p, l, lds, tid, G, bid);
        GSYNC();
        LAUNDER();
        mixers_phase(p, l, l, lds, tid, G, bid);
#ifdef PROBE_MIX2
        GSYNC(); LAUNDER();
        mixers_phase(p, l, l + 2, lds, tid, G, bid);
#endif
        GSYNC();
        LAUNDER();
        post_phase(p, l, lds, tid, G, bid);
        GSYNC();
        {
            pg8::Gemm g{X1, (const bf16_t*)(p.ws + WS_WOUT) + (size_t)l * 1024 * 1024, T, DM, 1024}; pg8::StaticOrder S; S.init(T, DM, G, bid);
            if (l == 0) { EpiRes<true, true, true> E{p.out, HB, ss + (2 * l + 1) * T, p.in[0], p.in[1]}; pg8::gemm_phase<EpiRes<true, true, true>, pg8::StaticOrder, true, true>(lds, g, S, E); }
            else { EpiRes<true, true> E{p.out, HB, ss + (2 * l + 1) * T, nullptr, nullptr}; pg8::gemm_phase<EpiRes<true, true>, pg8::StaticOrder, true, true>(lds, g, S, E); }
        }
        GSYNC();
        for (int hf = 0; hf < 2; ++hf) {
            {
                pg8::Gemm g{HB, (const bf16_t*)(p.ws + WS_W1) + (size_t)l * 4096 * 1024 + (size_t)hf * HFF * 1024, T, HFF, 1024}; pg8::StaticOrder S; S.init(T, HFF, G, bid);
                EpiRelu2 E{HID, ss + (2 * l + 1) * T};
                pg8::gemm_phase<EpiRelu2, pg8::StaticOrder, true, true>(lds, g, S, E);
            }
            GSYNC();
            {
                pg8::Gemm g{HID, (const bf16_t*)(p.ws + WS_W2) + (size_t)l * 2 * 1024 * 2048 + (size_t)hf * 1024 * 2048, T, DM, HFF}; pg8::StaticOrder S; S.init(T, DM, G, bid);
                if (hf == 0) { EpiRes<false, false> E{p.out, nullptr, nullptr, nullptr, nullptr}; pg8::gemm_phase<EpiRes<false, false>, pg8::StaticOrder, true, true>(lds, g, S, E); }
                else { EpiRes<true, true> E{p.out, X1, ss + (2 * l + 2) * T, nullptr, nullptr}; pg8::gemm_phase<EpiRes<true, true>, pg8::StaticOrder, true, true>(lds, g, S, E); }
            }
            GSYNC();
        }
    }
        LAUNDER();
    final_phase(p, tid, G, bid);
}

extern "C" void kernel_launch(void* const* d_in, const int* in_sizes, int n_in, void* d_out, int out_size, void* d_ws, size_t ws_size, hipStream_t stream) {
    static int grid_blocks = 0;
    if (grid_blocks == 0) {
        if (n_in != 26 || out_size != T * DM || ws_size < WS_END) { fprintf(stderr, "kernel_launch: unexpected shapes (n_in %d out %d ws %zu)\n", n_in, out_size, ws_size); grid_blocks = -1; return; }
        int dev = 0, cus = 0, per_cu = 0;
        hipGetDevice(&dev);
        hipDeviceGetAttribute(&cus, hipDeviceAttributeMultiprocessorCount, dev);
        hipFuncSetAttribute((const void*)fwd_kernel, hipFuncAttributeMaxDynamicSharedMemorySize, LDS_BYTES);
        hipOccupancyMaxActiveBlocksPerMultiprocessor(&per_cu, (const void*)fwd_kernel, NTHR, LDS_BYTES);
        if (per_cu < 1) per_cu = 1;
        grid_blocks = cus * per_cu;
        (void)hipGetLastError();
    }
    if (grid_blocks < 0) return;
    KP p{};
    for (int i = 0; i < 26; ++i) p.in[i] = (const float*)d_in[i];
    p.out = (float*)d_out; p.ws = (unsigned char*)d_ws;
    (void)hipMemsetAsync((char*)d_ws + WS_BAR, 0, 16384, stream);
    void* args[] = {&p};
    hipError_t e = hipLaunchCooperativeKernel((const void*)fwd_kernel, dim3(grid_blocks), dim3(NTHR), args, LDS_BYTES, stream);
    if (e != hipSuccess) fprintf(stderr, "cooperative launch failed: %s (grid %d)\n", hipGetErrorString(e), grid_blocks);
}
```

```cpp
#include <hip/hip_runtime.h>
#include <hip/hip_cooperative_groups.h>
#include <cstdio>
#include <cstdint>
namespace cg = cooperative_groups;
namespace pg8 {
#define PG8_LAS __attribute__((address_space(3)))
typedef unsigned short bf16_t;
typedef short bf16x8 __attribute__((ext_vector_type(8)));
typedef float f32x4 __attribute__((ext_vector_type(4)));
typedef unsigned u32x4 __attribute__((ext_vector_type(4)));
constexpr int BM = 256, BK = 64, HALF = 128, HTB = HALF * BK * 2  , STAGE_BYTES = 8 * HTB, NXCD = 8, WGM = 8;

__host__ __device__ __forceinline__ int lds_byte(int r, int c) { const int st = (r >> 4) * 2 + (c >> 5), rr = r & 15, cc = c & 31, ob = rr * 64 + cc * 2; return st * 1024 + (ob ^ (((ob >> 9) & 1) << 5)); }
__host__ __device__ __forceinline__ void stage_rc(int b, int& R, int& C) { const int st = b / 1024, sb = b % 1024, swz = sb ^ (((sb >> 9) & 1) << 5); R = (st >> 1) * 16 + swz / 64; C = (st & 1) * 32 + (swz % 64) / 2; }
__host__ __device__ __forceinline__ int perm32(int rho) { const int n = rho >> 4, i = rho & 15; return 8 * (i >> 2) + 4 * n + (i & 3); }

struct Unit { int pm, pn; };
struct Gemm { const bf16_t* A; const bf16_t* Bt; int M, N, K; };

struct StaticOrder {
    int nM, nN, nwg, G, c;
    __host__ __device__ void init(int M, int N, int G_, int c_) { nM = M / BM; nN = N / BM; nwg = nM * nN; G = G_; c = c_; }
    __host__ __device__ bool next(int i, Unit& u) const {
        const long L = (long)i * G + c; if (L >= nwg) return false;
        int wgid = (int)L; { const int q = nwg / NXCD, r = nwg % NXCD, xcd = wgid % NXCD, off = wgid / NXCD; wgid = (xcd < r ? xcd * (q + 1) : r * (q + 1) + (xcd - r) * q) + off; }
        const int nig = WGM * nN, gid = wgid / nig, fm = gid * WGM, gsz = (nM - fm) < WGM ? (nM - fm) : WGM;
        u.pm = fm + ((wgid % nig) % gsz); u.pn = (wgid % nig) / gsz; return true;
    }
    __device__ __forceinline__ void a_ready(const Unit&) const {}
    __device__ __forceinline__ void done(const Unit&) const {}
};

template <class Epi, class Sched, bool ALIGN_EPI = false, bool SP2 = false>
__device__ __forceinline__ void gemm_phase(PG8_LAS unsigned char* lds, const Gemm g, const Sched& S, const Epi& E) {
    int tid_l = threadIdx.x; asm volatile("" : "+v"(tid_l));
    const int tid = tid_l, wid = __builtin_amdgcn_readfirstlane(tid >> 6), lane = tid & 63, wr = wid >> 2, wc = wid & 3, fr = lane & 15, fq = lane >> 4;
    const int K = g.K, nt = K / BK;
    unsigned voffA[2], voffB[2];
#pragma unroll
    for (int i = 0; i < 2; ++i) { int R, C; stage_rc(tid * 16 + i * 8192, R, C); const int Rb = Epi::PERM ? ((R & ~31) + perm32(R & 31)) : R;
        voffA[i] = (unsigned)(R * K + C) * 2u; voffB[i] = (unsigned)(Rb * K + C) * 2u; }
    const size_t kstep = (size_t)(BK * 2);
    const size_t hstep = (size_t)HALF * K * 2;
    const size_t tstep = 2 * hstep;
    const unsigned ldsw = (unsigned)wid * 1024u;
    const int aoff = lds_byte(wr * 64 + fr, fq * 8), boff = lds_byte(wc * 32 + fr, fq * 8);
#define PG8_SA(b, h) (((b) * 2 + (h)) * HTB)
#define PG8_SB(b, h) ((4 + (b) * 2 + (h)) * HTB)
#define PG8_STAGE(bufoff, gbase, voff) do { _Pragma("unroll") for (int _i = 0; _i < 2; ++_i) \
        __builtin_amdgcn_global_load_lds((const unsigned*)((const char*)(gbase) + (voff)[_i]), (PG8_LAS unsigned*)(lds + (bufoff) + ldsw + _i * 8192), 16, 0, 0); } while (0)
#define PG8_LDA(dst, b, h) do { _Pragma("unroll") for (int m = 0; m < 4; ++m) _Pragma("unroll") for (int k = 0; k < 2; ++k) dst[m][k] = *(const PG8_LAS bf16x8*)(lds + PG8_SA(b, h) + aoff + m * 2048 + k * 1024); } while (0)
#define PG8_LDB(dst, b, h) do { _Pragma("unroll") for (int n = 0; n < 2; ++n) _Pragma("unroll") for (int k = 0; k < 2; ++k) dst[n][k] = *(const PG8_LAS bf16x8*)(lds + PG8_SB(b, h) + boff + n * 2048 + k * 1024); } while (0)
#define PG8_MMA(ai, bj, At, Bt) do { __builtin_amdgcn_s_setprio(1); _Pragma("unroll") for (int m = 0; m < 4; ++m) _Pragma("unroll") for (int n = 0; n < 2; ++n) _Pragma("unroll") for (int k = 0; k < 2; ++k) \
        acc[ai][bj][m][n] = __builtin_amdgcn_mfma_f32_16x16x32_bf16(Bt[n][k], At[m][k], acc[ai][bj][m][n], 0, 0, 0); __builtin_amdgcn_s_setprio(0); } while (0)
#define PG8_WAIT_V(n) asm volatile("s_waitcnt vmcnt(" #n ")" ::: "memory")
#define PG8_WAIT_L(n) asm volatile("s_waitcnt lgkmcnt(" #n ")" ::: "memory")
#define PG8_BAR __builtin_amdgcn_s_barrier()
#define PG8_SCHED __builtin_amdgcn_sched_barrier(0)
    Unit cur, nxt; int ui = 0;
    if (!S.next(0, cur)) return;
    f32x4 acc[2][2][4][2];
#pragma unroll
    for (int a = 0; a < 2; ++a)
#pragma unroll
        for (int b = 0; b < 2; ++b)
#pragma unroll
            for (int m = 0; m < 4; ++m)
#pragma unroll
                for (int n = 0; n < 2; ++n) acc[a][b][m][n] = (f32x4){0.f, 0.f, 0.f, 0.f};
    bf16x8 At[4][2], B0[2][2], B1[2][2];
    const char* cA = (const char*)g.A + (size_t)cur.pm * tstep; const char* cB = (const char*)g.Bt + (size_t)cur.pn * tstep;
    S.a_ready(cur);
    if constexpr (SP2) {
        PG8_STAGE(PG8_SB(0, 0), cB, voffB); PG8_STAGE(PG8_SB(0, 1), cB + hstep, voffB); PG8_STAGE(PG8_SA(0, 0), cA, voffA); PG8_STAGE(PG8_SA(0, 1), cA + hstep, voffA);
        if (wr == 1) PG8_BAR;
        PG8_WAIT_V(2); PG8_BAR;
        PG8_STAGE(PG8_SB(1, 0), cB + kstep, voffB); PG8_STAGE(PG8_SA(1, 0), cA + kstep, voffA); PG8_STAGE(PG8_SB(1, 1), cB + hstep + kstep, voffB);
        PG8_WAIT_V(6); PG8_BAR;
    } else {
        PG8_STAGE(PG8_SB(0, 0), cB, voffB); PG8_STAGE(PG8_SA(0, 0), cA, voffA); PG8_STAGE(PG8_SB(0, 1), cB + hstep, voffB); PG8_STAGE(PG8_SA(0, 1), cA + hstep, voffA);
        if (wr == 1) PG8_BAR;
        PG8_WAIT_V(4); PG8_BAR;
        PG8_STAGE(PG8_SB(1, 0), cB + kstep, voffB); PG8_STAGE(PG8_SA(1, 0), cA + kstep, voffA); PG8_STAGE(PG8_SB(1, 1), cB + hstep + kstep, voffB);
        PG8_WAIT_V(6); PG8_BAR;
    }
    for (;;) {
        const bool has_next = S.next(ui + 1, nxt);
        const char* nA = has_next ? (const char*)g.A + (size_t)nxt.pm * tstep : cA; const char* nB = has_next ? (const char*)g.Bt + (size_t)nxt.pn * tstep : cB;
        for (int t = 0; t < nt; t += 2) {
            const bool last = (t == nt - 2);
            const char* a1 = cA + (size_t)(t + 1) * kstep;
            const char* a2 = last ? nA : cA + (size_t)(t + 2) * kstep; const char* b2 = last ? nB : cB + (size_t)(t + 2) * kstep;
            const char* a3 = a2 + kstep; const char* b3 = b2 + kstep;
            if (last && has_next) S.a_ready(nxt);
            if constexpr (SP2) {
            PG8_LDB(B0, 0, 0); PG8_LDB(B1, 0, 1); PG8_SCHED; PG8_LDA(At, 0, 0); PG8_STAGE(PG8_SA(1, 1), a1 + hstep, voffA);
            PG8_WAIT_V(8); PG8_WAIT_L(0); PG8_BAR; PG8_MMA(0, 0, At, B0); PG8_MMA(0, 1, At, B1); PG8_BAR; PG8_SCHED;
            PG8_LDA(At, 0, 1); PG8_STAGE(PG8_SB(0, 0), b2, voffB); PG8_STAGE(PG8_SB(0, 1), b2 + hstep, voffB); PG8_STAGE(PG8_SA(0, 0), a2, voffA);
            PG8_WAIT_V(8); PG8_WAIT_L(0); PG8_BAR; PG8_MMA(1, 0, At, B0); PG8_MMA(1, 1, At, B1); PG8_BAR; PG8_SCHED;
            PG8_LDB(B0, 1, 0); PG8_LDB(B1, 1, 1); PG8_SCHED; PG8_LDA(At, 1, 0); PG8_STAGE(PG8_SA(0, 1), a2 + hstep, voffA);
            PG8_WAIT_V(8); PG8_WAIT_L(0); PG8_BAR; PG8_MMA(0, 0, At, B0); PG8_MMA(0, 1, At, B1); PG8_BAR; PG8_SCHED;
            PG8_LDA(At, 1, 1); PG8_STAGE(PG8_SB(1, 0), b3, voffB); PG8_STAGE(PG8_SB(1, 1), b3 + hstep, voffB); PG8_STAGE(PG8_SA(1, 0), a3, voffA);
            PG8_WAIT_V(8); PG8_WAIT_L(0); PG8_BAR; PG8_MMA(1, 0, At, B0); PG8_MMA(1, 1, At, B1); PG8_BAR; PG8_SCHED;
            } else {
            PG8_LDB(B0, 0, 0); PG8_SCHED; PG8_LDA(At, 0, 0); PG8_STAGE(PG8_SA(1, 1), a1 + hstep, voffA);
            PG8_WAIT_L(8); PG8_BAR; PG8_WAIT_L(0); PG8_MMA(0, 0, At, B0); PG8_BAR; PG8_SCHED;
            PG8_LDB(B1, 0, 1); PG8_STAGE(PG8_SB(0, 0), b2, voffB);
            PG8_BAR; PG8_WAIT_L(0); PG8_MMA(0, 1, At, B1); PG8_BAR;
            PG8_LDA(At, 0, 1); PG8_STAGE(PG8_SA(0, 0), a2, voffA);
            PG8_BAR; PG8_WAIT_L(0); PG8_MMA(1, 0, At, B0); PG8_BAR; PG8_SCHED;
            PG8_STAGE(PG8_SB(0, 1), b2 + hstep, voffB);
            PG8_WAIT_V(6); PG8_BAR; PG8_MMA(1, 1, At, B1); PG8_BAR;
            PG8_LDB(B0, 1, 0); PG8_SCHED; PG8_LDA(At, 1, 0); PG8_STAGE(PG8_SA(0, 1), a2 + hstep, voffA);
            PG8_WAIT_L(8); PG8_BAR; PG8_WAIT_L(0); PG8_MMA(0, 0, At, B0); PG8_BAR; PG8_SCHED;
            PG8_LDB(B1, 1, 1); PG8_STAGE(PG8_SB(1, 0), b3, voffB);
            PG8_BAR; PG8_WAIT_L(0); PG8_MMA(0, 1, At, B1); PG8_BAR;
            PG8_LDA(At, 1, 1); PG8_STAGE(PG8_SA(1, 0), a3, voffA);
            PG8_BAR; PG8_WAIT_L(0); PG8_MMA(1, 0, At, B0); PG8_BAR; PG8_SCHED;
            PG8_STAGE(PG8_SB(1, 1), b3 + hstep, voffB);
            PG8_WAIT_V(6); PG8_BAR; PG8_MMA(1, 1, At, B1); PG8_BAR;
            }
        }
        if constexpr (ALIGN_EPI) { if (wr == 0) PG8_BAR; }
        if constexpr (!Epi::AFTER_DRAIN) { E(acc, cur, wr, wc, fr, fq); S.done(cur); }
        if (!has_next) break;
#pragma unroll
        for (int a = 0; a < 2; ++a)
#pragma unroll
            for (int b = 0; b < 2; ++b)
#pragma unroll
                for (int m = 0; m < 4; ++m)
#pragma unroll
                    for (int n = 0; n < 2; ++n) acc[a][b][m][n] = (f32x4){0.f, 0.f, 0.f, 0.f};
        cur = nxt; cA = nA; cB = nB; ++ui;
        if constexpr (ALIGN_EPI) { if (wr == 1) PG8_BAR; }
    }
    PG8_WAIT_V(0);
    if constexpr (!ALIGN_EPI) { if (wr == 0) PG8_BAR; }
    PG8_BAR;
    if constexpr (Epi::AFTER_DRAIN) { E.fused(acc, cur, wr, wc, fr, fq, lds, wid, lane); S.done(cur); }
#undef PG8_SA
#undef PG8_SB
#undef PG8_STAGE
#undef PG8_LDA
#undef PG8_LDB
#undef PG8_MMA
#undef PG8_WAIT_V
#undef PG8_WAIT_L
#undef PG8_BAR
#undef PG8_SCHED
}
}

#define DI __device__ __forceinline__
#define LAS __attribute__((address_space(3)))
typedef unsigned short bf16_t;
typedef short bf16x8 __attribute__((ext_vector_type(8)));
typedef short s16x4 __attribute__((ext_vector_type(4)));
typedef float f32x4 __attribute__((ext_vector_type(4)));
typedef float f32x2 __attribute__((ext_vector_type(2)));
typedef float f32x16 __attribute__((ext_vector_type(16)));
typedef unsigned u32x4 __attribute__((ext_vector_type(4)));
typedef unsigned u32x2 __attribute__((ext_vector_type(2)));
typedef __bf16 bf16x2_t __attribute__((ext_vector_type(2)));
#define MFMA32(a, b, c) __builtin_amdgcn_mfma_f32_32x32x16_bf16((a), (b), (c), 0, 0, 0)

constexpr int T = 49152, DM = 1024, NPROJ = 3072, NIN = 2960, DFF = 4096, HFF = 2048;
constexpr int C_R = 0, C_K = 256, C_V = 512, C_WD = 768, C_AD = 896, C_GD = 1024;
constexpr int C_AQ = 1152, C_AK = 1664, C_AV = 1792;
constexpr int C_MQ = 1920, C_MK = 2176, C_MV = 2432, C_MO = 2688, C_IG = 2944, C_FG = 2952;
constexpr size_t MiB = 1u << 20;
constexpr size_t WS_SS = 0, WS_CNT = MiB - 4096, WS_CDOT = 1 * MiB, WS_TAB = 2 * MiB + 512 * 1024, WS_BAR = 2 * MiB + 768 * 1024, WS_WIN = 3 * MiB, WS_WOUT = 15 * MiB,
                 WS_W1 = 19 * MiB, WS_W2 = 35 * MiB, WS_VT = 51 * MiB, WS_YB = 63 * MiB, WS_HBP = 87 * MiB, WS_X1 = 111 * MiB, WS_R = 207 * MiB,
                 WS_HID = WS_R + 96 * MiB, WS_END = 495 * MiB;
constexpr int LDS_BYTES = 134400 + 256;
constexpr int NTHR = 512;

struct KP { const float* in[26]; float* out; unsigned char* ws; };

DI unsigned cvtpk(float lo, float hi) { f32x2 v = {lo, hi}; bf16x2_t b = __builtin_convertvector(v, bf16x2_t); return __builtin_bit_cast(unsigned, b); }
DI unsigned short f2bf(float f) { return (unsigned short)(cvtpk(f, 0.f) & 0xffffu); }
DI float bf2f(unsigned h) { return __builtin_bit_cast(float, h << 16); }
DI float bflo(unsigned w) { return __builtin_bit_cast(float, w << 16); }
DI float bfhi(unsigned w) { return __builtin_bit_cast(float, w & 0xffff0000u); }
DI int crow(int reg, int h) { return (reg & 3) + 8 * (reg >> 2) + 4 * h; }
template <int CTRL> DI float dppf(float v) { return __builtin_bit_cast(float, __builtin_amdgcn_update_dpp(0, __builtin_bit_cast(int, v), CTRL, 0xf, 0xf, true)); }
DI float red8(float v) { v += dppf<0xB1>(v); v += dppf<0x4E>(v); v += dppf<0x141>(v); return v; }
DI float red16(float v) { v = red8(v); v += dppf<0x128>(v); return v; }
DI float frcp(float x) { return __builtin_amdgcn_rcpf(x); }
DI float sigmoidf_(float x) { return frcp(1.f + __expf(-x)); }
DI f32x16 zero16() { f32x16 z; for (int i = 0; i < 16; ++i) z[i] = 0.f; return z; }
DI void seq_of_job(int j, int& seq, int& h, int& dir) { if (j < 16) { seq = 8 + (j >> 3); } else { j -= 16; seq = j >> 3; } h = (j >> 1) & 3; dir = j & 1; }
DI void seq_info(int s, int& start, int& len) { if (s < 8) { start = s * 4096; len = 4096; } else { start = 32768 + (s - 8) * 8192; len = 8192; } }
DI int tok_seq_start(int tok, int& len) { if (tok < 32768) { len = 4096; return tok & ~4095; } len = 8192; return 32768 + ((tok - 32768) & ~8191); }

#define XB_TMO      128
#define XB_XCNT(j)  (256  + 64 * (j))
#define XB_XSUB(j)  (1280 + 64 * (j))
#define XB_XGEN(j)  (2304 + 64 * (j))
#define XB_TOP      3328
#define XB_TOPGEN   3392
#define XCD_BAR_WORDS 3456
#define XB_SPIN_CAP (1u << 18)

__device__ __forceinline__ unsigned xb_ld(unsigned* p)              { return __hip_atomic_load(p, __ATOMIC_RELAXED, __HIP_MEMORY_SCOPE_AGENT); }
__device__ __forceinline__ unsigned xb_add(unsigned* p, unsigned v) { return __hip_atomic_fetch_add(p, v, __ATOMIC_RELAXED, __HIP_MEMORY_SCOPE_AGENT); }
__device__ __forceinline__ unsigned xb_xcc_id() { return (unsigned)__builtin_amdgcn_s_getreg((3 << 11) | 20) & 0xFu; }
#define XB_SPIN(cond, bar) do { unsigned _sp = 0; while (cond) { __builtin_amdgcn_s_sleep(1); \
    if ((++_sp & 255u) == 0u) { if (xb_ld(&(bar)[XB_TMO])) break; if (_sp > XB_SPIN_CAP) { atomicAdd(&(bar)[XB_TMO], 1u); break; } } } } while (0)

struct XcdBarrier {
    unsigned* bar; unsigned x;
    volatile LAS unsigned* st;
};

__device__ __forceinline__ XcdBarrier xcd_barrier_post(unsigned* bar, volatile LAS unsigned* st) {
    XcdBarrier b; b.bar = bar; b.x = xb_xcc_id(); b.st = st;
    if (threadIdx.x == 0) (void)xb_add(&bar[XB_XCNT(b.x)], 1u);
    return b;
}
__device__ __forceinline__ void xcd_barrier_complete(unsigned* bar, unsigned x, unsigned& nloc, unsigned& nx) {
    const unsigned G = gridDim.x * gridDim.y * gridDim.z;
    unsigned sum, cnt, mine, sp = 0u;
    for (;;) {
        sum = 0u; cnt = 0u; mine = 0u;
#pragma unroll
        for (unsigned j = 0; j < 16; ++j) { const unsigned c = xb_ld(&bar[XB_XCNT(j)]); sum += c; cnt += (c > 0u) ? 1u : 0u; mine = (j == x) ? c : mine; }
        if (sum == G) break;
        __builtin_amdgcn_s_sleep(1);
        if ((++sp & 255u) == 0u) { if (xb_ld(&bar[XB_TMO])) break; if (sp > XB_SPIN_CAP) { atomicAdd(&bar[XB_TMO], 1u); break; } }
    }
    nloc = mine > 0u ? mine : 1u; nx = cnt > 0u ? cnt : 1u;
}

__device__ __forceinline__ void xcd_barrier(const XcdBarrier& b) {
    asm volatile("s_waitcnt vmcnt(0)" ::: "memory");
    __syncthreads();
    if (threadIdx.x == 0) {
        unsigned* bar = b.bar;
        __builtin_amdgcn_s_waitcnt(0);
        unsigned nloc = b.st[0], nx = b.st[1];
        if (nloc == 0u) { xcd_barrier_complete(bar, b.x, nloc, nx); b.st[0] = nloc; b.st[1] = nx; }
        const unsigned old = xb_add(&bar[XB_XSUB(b.x)], 1u);
        const unsigned gen = old / nloc;
        if (old + 1u == (gen + 1u) * nloc) {
            __builtin_amdgcn_fence(__ATOMIC_RELEASE, "agent");
            asm volatile("s_waitcnt vmcnt(0)" ::: "memory");
            const unsigned og = xb_add(&bar[XB_TOP], 1u);
            const unsigned tg = og / nx;
            if (og + 1u == (tg + 1u) * nx) xb_add(&bar[XB_TOPGEN], 1u);
            else XB_SPIN(xb_ld(&bar[XB_TOPGEN]) == tg, bar);
            __builtin_amdgcn_fence(__ATOMIC_ACQUIRE, "agent");
            xb_add(&bar[XB_XGEN(b.x)], 1u);
            asm volatile("s_waitcnt vmcnt(0)" ::: "memory");
        } else {
            XB_SPIN(xb_ld(&bar[XB_XGEN(b.x)]) == gen, bar);
            __builtin_amdgcn_fence(__ATOMIC_ACQUIRE, "agent");
            asm volatile("s_waitcnt vmcnt(0)" ::: "memory");
        }
    }
    __syncthreads();
}

struct EpiProj {
    static constexpr bool PERM = true, AFTER_DRAIN = false;
    bf16_t* O; const float* ss;
    DI void operator()(const pg8::f32x4 (&acc)[2][2][4][2], const pg8::Unit& u, int wr, int wc, int fr, int fq) const {
        const int row0 = u.pm * 256 + wr * 64 + fr, col0 = u.pn * 256 + wc * 32 + 8 * fq;
#pragma unroll
        for (int ai = 0; ai < 2; ++ai)
#pragma unroll
            for (int m = 0; m < 4; ++m) {
                const int row = row0 + ai * 128 + m * 16;
                const float rs = rsqrtf(ss[row] * (1.f / 1024.f) + 1e-6f);
                bf16_t* rp = O + (size_t)row * NPROJ + col0;
#pragma unroll
                for (int bj = 0; bj < 2; ++bj) {
                    pg8::f32x4 v0 = acc[ai][bj][m][0] * rs, v1 = acc[ai][bj][m][1] * rs;
                    u32x4 w; w.x = cvtpk(v0[0], v0[1]); w.y = cvtpk(v0[2], v0[3]); w.z = cvtpk(v1[0], v1[1]); w.w = cvtpk(v1[2], v1[3]);
                    *(u32x4*)(rp + bj * 128) = w;
                }
            }
    }
};
struct EpiRelu2 {
    static constexpr bool PERM = true, AFTER_DRAIN = false;
    bf16_t* O; const float* ss;
    DI void operator()(const pg8::f32x4 (&acc)[2][2][4][2], const pg8::Unit& u, int wr, int wc, int fr, int fq) const {
        const int row0 = u.pm * 256 + wr * 64 + fr, col0 = u.pn * 256 + wc * 32 + 8 * fq;
#pragma unroll
        for (int ai = 0; ai < 2; ++ai)
#pragma unroll
            for (int m = 0; m < 4; ++m) {
                const int row = row0 + ai * 128 + m * 16;
                const float rs = rsqrtf(ss[row] * (1.f / 1024.f) + 1e-6f);
                bf16_t* rp = O + (size_t)row * HFF + col0;
#pragma unroll
                for (int bj = 0; bj < 2; ++bj) {
                    pg8::f32x4 v0 = acc[ai][bj][m][0] * rs, v1 = acc[ai][bj][m][1] * rs;
#pragma unroll
                    for (int j = 0; j < 4; ++j) { float a = fmaxf(v0[j], 0.f); v0[j] = a * a; float b = fmaxf(v1[j], 0.f); v1[j] = b * b; }
                    u32x4 w; w.x = cvtpk(v0[0], v0[1]); w.y = cvtpk(v0[2], v0[3]); w.z = cvtpk(v1[0], v1[1]); w.w = cvtpk(v1[2], v1[3]);
                    *(u32x4*)(rp + bj * 128) = w;
                }
            }
    }
};
struct EpiPart {
    static constexpr bool PERM = true, AFTER_DRAIN = false;
    bf16_t* O;
    DI void operator()(const pg8::f32x4 (&acc)[2][2][4][2], const pg8::Unit& u, int wr, int wc, int fr, int fq) const {
        const int row0 = u.pm * 256 + wr * 64 + fr, col0 = u.pn * 256 + wc * 32 + 8 * fq;
#pragma unroll
        for (int ai = 0; ai < 2; ++ai)
#pragma unroll
            for (int m = 0; m < 4; ++m) {
                bf16_t* rp = O + (size_t)(row0 + ai * 128 + m * 16) * DM + col0;
#pragma unroll
                for (int bj = 0; bj < 2; ++bj) {
                    const pg8::f32x4 v0 = acc[ai][bj][m][0], v1 = acc[ai][bj][m][1];
                    u32x4 w; w.x = cvtpk(v0[0], v0[1]); w.y = cvtpk(v0[2], v0[3]); w.z = cvtpk(v1[0], v1[1]); w.w = cvtpk(v1[2], v1[3]);
                    *(u32x4*)(rp + bj * 128) = w;
                }
            }
    }
};
template <bool WRITE_HB, bool DO_SS, bool FIRST = false, bool PART = false> struct EpiRes {
    static constexpr bool PERM = true, AFTER_DRAIN = false;
    float* X; bf16_t* HB; float* ss; const float* xin0; const float* xin1;
    DI void operator()(const pg8::f32x4 (&acc)[2][2][4][2], const pg8::Unit& u, int wr, int wc, int fr, int fq) const {
        const int row0 = u.pm * 256 + wr * 64 + fr, col0 = u.pn * 256 + wc * 32 + 8 * fq;
#pragma unroll
        for (int ai = 0; ai < 2; ++ai)
#pragma unroll
            for (int m = 0; m < 4; ++m) {
                const int row = row0 + ai * 128 + m * 16;
                float* xp = X + (size_t)row * DM + col0;
                const float* rp = FIRST ? ((row < 32768 ? xin0 + (size_t)row * DM : xin1 + (size_t)(row - 32768) * DM) + col0) : xp;
                float sq = 0.f;
#pragma unroll
                for (int bj = 0; bj < 2; ++bj) {
                    pg8::f32x4 a0 = *(const pg8::f32x4*)(rp + bj * 128), a1 = *(const pg8::f32x4*)(rp + bj * 128 + 4);
                    a0 += acc[ai][bj][m][0]; a1 += acc[ai][bj][m][1];
                    if (PART) { const u32x4 pw = *(const u32x4*)(HB + (size_t)row * DM + col0 + bj * 128);
                        a0[0] += bflo(pw.x); a0[1] += bfhi(pw.x); a0[2] += bflo(pw.y); a0[3] += bfhi(pw.y); a1[0] += bflo(pw.z); a1[1] += bfhi(pw.z); a1[2] += bflo(pw.w); a1[3] += bfhi(pw.w); }
                    *(pg8::f32x4*)(xp + bj * 128) = a0; *(pg8::f32x4*)(xp + bj * 128 + 4) = a1;
                    if (WRITE_HB) { u32x4 w; w.x = cvtpk(a0[0], a0[1]); w.y = cvtpk(a0[2], a0[3]); w.z = cvtpk(a1[0], a1[1]); w.w = cvtpk(a1[2], a1[3]);
                        *(u32x4*)(HB + (size_t)row * DM + col0 + bj * 128) = w; }
                    if (DO_SS) sq += a0[0] * a0[0] + a0[1] * a0[1] + a0[2] * a0[2] + a0[3] * a0[3] + a1[0] * a1[0] + a1[1] * a1[1] + a1[2] * a1[2] + a1[3] * a1[3];
                }
                if (DO_SS) { sq += __shfl_xor(sq, 16); sq += __shfl_xor(sq, 32); if (fq == 0) atomicAdd(ss + row, sq); }
            }
    }
};

DI void transpose_tile(const float* src, int N, int nvalid, const float* gain, bf16_t* dst, int K, int kt, int nt, LAS float* tile, int tid) {
    const int a = tid & 63, b8 = tid >> 6;
#pragma unroll
    for (int i = 0; i < 8; ++i) { const int k = b8 + 8 * i, n = nt * 64 + a; float v = (n < nvalid) ? src[(size_t)(kt * 64 + k) * N + n] : 0.f; if (gain) v *= gain[kt * 64 + k]; tile[k * 65 + a] = v; }
    __syncthreads();
#pragma unroll
    for (int i = 0; i < 8; ++i) { const int n = b8 + 8 * i; dst[(size_t)(nt * 64 + n) * K + kt * 64 + a] = f2bf(tile[a * 65 + n]); }
    __syncthreads();
}
DI void convert_tile(const KP& p, int it, LAS float* tile, int tid) {
    {
        const int l = it / 3072; int r = it % 3072;
        const float* src; const float* gain; bf16_t* dst; int N, nvalid, K, kt, nt;
        if (r < 768) { src = p.in[3] + (size_t)l * 1024 * NIN; N = NIN; nvalid = NIN; K = 1024; gain = p.in[2] + l * 1024; dst = (bf16_t*)(p.ws + WS_WIN) + (size_t)l * NPROJ * 1024; kt = r / 48; nt = r % 48; }
        else if (r < 1024) { r -= 768; src = p.in[21] + (size_t)l * 1024 * 1024; N = 1024; nvalid = 1024; K = 1024; gain = nullptr; dst = (bf16_t*)(p.ws + WS_WOUT) + (size_t)l * 1024 * 1024; kt = r / 16; nt = r % 16; }
        else if (r < 2048) { r -= 1024; src = p.in[23] + (size_t)l * 1024 * 4096; N = 4096; nvalid = 4096; K = 1024; gain = p.in[22] + l * 1024; dst = (bf16_t*)(p.ws + WS_W1) + (size_t)l * 4096 * 1024; kt = r / 64; nt = r % 64; }
        else { r -= 2048; const int h = r / 512; r %= 512; src = p.in[24] + (size_t)l * 4096 * 1024 + (size_t)h * 2048 * 1024; N = 1024; nvalid = 1024; K = 2048; gain = nullptr;
               dst = (bf16_t*)(p.ws + WS_W2) + (size_t)l * 2 * 1024 * 2048 + (size_t)h * 1024 * 2048; kt = r / 16; nt = r % 16; }
        transpose_tile(src, N, nvalid, gain, dst, K, kt, nt, tile, tid);
    }
}
DI void p0_phase(const KP& p, LAS unsigned char* lds, int tid, int G, int bid) {
    LAS float* tile = (LAS float*)lds;
    for (int it = bid; it < 768; it += G) convert_tile(p, it, tile, tid);
    const int wave = tid >> 6, lane = tid & 63;
    float* ss = (float*)(p.ws + WS_SS);
    bf16_t* xb = (bf16_t*)(p.ws + WS_X1);
    for (int row0 = (bid * 8 + wave) * 2; row0 < T; row0 += G * 8 * 2) {
        f32x4 v[2][4];
#pragma unroll
        for (int r = 0; r < 2; ++r) {
            const int row = row0 + r;
            const float* xs = (row < 32768) ? p.in[0] + (size_t)row * DM : p.in[1] + (size_t)(row - 32768) * DM;
#pragma unroll
            for (int j = 0; j < 4; ++j) v[r][j] = *(const f32x4*)(xs + (j * 64 + lane) * 4);
        }
#pragma unroll
        for (int r = 0; r < 2; ++r) {
            const int row = row0 + r;
            float sq = 0.f;
#pragma unroll
            for (int j = 0; j < 4; ++j) {
                const f32x4 x = v[r][j];
                u32x2 w; w.x = cvtpk(x[0], x[1]); w.y = cvtpk(x[2], x[3]);
                *(u32x2*)(xb + (size_t)row * DM + (j * 64 + lane) * 4) = w;
                sq += x[0] * x[0] + x[1] * x[1] + x[2] * x[2] + x[3] * x[3];
            }
#pragma unroll
            for (int o = 32; o >= 1; o >>= 1) sq += __shfl_xor(sq, o);
            if (lane == 0) ss[row] = sq;
        }
    }
    for (int i = bid * NTHR + tid; i < 4 * T; i += G * NTHR) ss[T + i] = 0.f;
    if (bid == 0) {
        if (tid < 64) ((unsigned*)(p.ws + WS_CNT))[tid] = 0u;
        float2* tab = (float2*)(p.ws + WS_TAB);
        for (int idx = tid; idx < 2048; idx += NTHR) { const int pos = idx >> 4, f = idx & 15; const float inv = powf(10000.f, -(float)f / 16.f); const float ang = (float)pos * inv; tab[idx] = make_float2(cosf(ang), sinf(ang)); }
    }
}

DI void prep_phase(const KP& p, int l, LAS unsigned char* lds, int tid, int G, int bid) {
    bf16_t* proj = (bf16_t*)(p.ws + WS_R);
    bf16_t* vT = (bf16_t*)(p.ws + WS_VT);
    const float2* tab = (const float2*)(p.ws + WS_TAB);
    const float* qn = p.in[15] + l * 64; const float* kn = p.in[16] + l * 64;
    const int wave = tid >> 6, lane = tid & 63, g = lane >> 4, li = lane & 15;
    LAS bf16_t* vts = (LAS bf16_t*)lds;
    for (int unit = bid; unit < T / 64; unit += G) {
        const int tok0 = unit * 64;
        u32x2 raw[8][3];
#pragma unroll
        for (int i = 0; i < 8; ++i) {
            const int tok = tok0 + wave * 8 + i;
#pragma unroll
            for (int it = 0; it < 3; ++it) {
                const int colbase = (it < 2) ? C_AQ + (it * 4 + g) * 64 : C_AK + (g & 1) * 64;
                raw[i][it] = *(const u32x2*)(proj + (size_t)tok * NPROJ + colbase + li * 4);
            }
        }
#pragma unroll
        for (int i = 0; i < 8; ++i) {
            const int tok = tok0 + wave * 8 + i; int len; const int st = tok_seq_start(tok, len); const int pos = tok - st; const int prow = pos >> 6, pcol = pos & 63;
#pragma unroll
            for (int it = 0; it < 3; ++it) {
                const bool act = (it < 2) || (g < 2);
                const int colbase = (it < 2) ? C_AQ + (it * 4 + g) * 64 : C_AK + (g & 1) * 64;
                const float* wn = (it < 2) ? qn : kn;
                bf16_t* ptr = proj + (size_t)tok * NPROJ + colbase + li * 4;
                const u32x2 rw = raw[i][it];
                float x[4] = {bflo(rw.x), bfhi(rw.x), bflo(rw.y), bfhi(rw.y)};
                float sq = x[0] * x[0] + x[1] * x[1] + x[2] * x[2] + x[3] * x[3];
                sq = red16(sq);
                const float rinv = rsqrtf(sq * (1.f / 64.f) + 1e-6f);
                const f32x4 w4 = *(const f32x4*)(wn + li * 4);
                const int idx = (li >> 3) ? pcol : prow; const bool second = (li >> 2) & 1;
                const float scale = (it < 2) ? 0.125f * 1.4426950408889634f : 1.f;
                float o[4];
#pragma unroll
                for (int j = 0; j < 4; ++j) {
                    const float y = x[j] * rinv * w4[j];
                    const float pr = __shfl_xor(y, 4);
                    const int f = (li * 4 + j) & 15;
                    const float2 cs = tab[idx * 16 + f];
                    o[j] = (second ? (y * cs.x + pr * cs.y) : (y * cs.x - pr * cs.y)) * scale;
                }
                if (act) { u32x2 w; w.x = cvtpk(o[0], o[1]); w.y = cvtpk(o[2], o[3]); *(u32x2*)ptr = w; }
            }
        }
#pragma unroll
        for (int i = 0; i < 2; ++i) { const int idx = tid + NTHR * i; const int tl = idx >> 4, c8 = (idx & 15) * 8;
            const u32x4 v = *(const u32x4*)(proj + (size_t)(tok0 + tl) * NPROJ + C_AV + c8); *(LAS u32x4*)(vts + tl * 136 + c8) = v; }
        __syncthreads();
        { const int c = tid >> 2, tq = tid & 3; unsigned w[8];
#pragma unroll
          for (int j = 0; j < 8; ++j) { const unsigned lo = vts[(tq * 16 + 2 * j) * 136 + c], hi = vts[(tq * 16 + 2 * j + 1) * 136 + c]; w[j] = lo | (hi << 16); }
          u32x4 a = {w[0], w[1], w[2], w[3]}, b = {w[4], w[5], w[6], w[7]};
          bf16_t* dp = vT + (size_t)c * T + tok0 + tq * 16; *(u32x4*)dp = a; *(u32x4*)(dp + 8) = b; }
        __syncthreads();
    }
}

DI void attn_unit(const KP& p, int l, int unit, LAS unsigned char* lds, int tid) {
    const float* qnw = p.in[15] + l * 64; const float* knw = p.in[16] + l * 64;
    const bf16_t* proj = (const bf16_t*)(p.ws + WS_R);
    const bf16_t* vT = (const bf16_t*)(p.ws + WS_VT);
    bf16_t* mix = (bf16_t*)(p.ws + WS_X1);
    int seq, kvh, qt;
    if (unit < 512) { seq = 8 + (unit >> 8); const int r = unit & 255; kvh = r >> 7; qt = r & 127; }
    else { const int u2 = unit - 512; seq = u2 >> 7; const int r = u2 & 127; kvh = r >> 6; qt = r & 63; }
    int start, len; seq_info(seq, start, len);
    const int nk = len >> 6;
    const int wave = tid >> 6, lane = tid & 63, r32 = lane & 31, hh = lane >> 5;
    const int head = kvh * 4 + (wave >> 1);
    const int q0 = start + qt * 64 + (wave & 1) * 32;
    bf16x8 qf[4];
    { const bf16_t* qp = proj + (size_t)(q0 + r32) * NPROJ + C_AQ + head * 64 + hh * 8;
#pragma unroll
      for (int ks = 0; ks < 4; ++ks) qf[ks] = *(const bf16x8*)(qp + ks * 16); }
    f32x16 o0 = zero16(), o1 = zero16();
    float lsum = 0.f;
    f32x16 sinit;
    { float mq = fabsf(qnw[lane]), mk = fabsf(knw[lane]);
#pragma unroll
      for (int o = 32; o >= 1; o >>= 1) { mq = fmaxf(mq, __shfl_xor(mq, o)); mk = fmaxf(mk, __shfl_xor(mk, o)); }
      const float bnd = 64.f * 0.125f * 1.4426950408889634f * 1.01f * mq * mk;
#pragma unroll
      for (int i = 0; i < 16; ++i) sinit[i] = -bnd; }
    const int lrow = tid >> 3, lseg = tid & 7;
    const bf16_t* kptr = proj + (size_t)(start + lrow) * NPROJ + C_AK + kvh * 64 + lseg * 8;
    const bf16_t* vptr = vT + (size_t)(kvh * 64 + lrow) * T + start + lseg * 8;
    const int lds_off = lrow * 144 + lseg * 16;
    u32x4 kreg = *(const u32x4*)kptr, vreg = *(const u32x4*)vptr;
    *(LAS u32x4*)(lds + lds_off) = kreg; *(LAS u32x4*)(lds + 9216 + lds_off) = vreg;
    kreg = *(const u32x4*)(kptr + (size_t)64 * NPROJ); vreg = *(const u32x4*)(vptr + 64);
    u32x4 kreg2 = kreg, vreg2 = vreg;
    __syncthreads();
    for (int j = 0; j < nk; ++j) {
        const bool more = (j + 1 < nk);
        if (j + 2 < nk) { kreg2 = *(const u32x4*)(kptr + (size_t)(j + 2) * 64 * NPROJ); vreg2 = *(const u32x4*)(vptr + (j + 2) * 64); }
        LAS unsigned char* Ks = lds + (j & 1) * 18432; LAS unsigned char* Vs = Ks + 9216;
        f32x16 s0 = sinit, s1 = sinit;
#pragma unroll
        for (int ks = 0; ks < 4; ++ks) {
            const bf16x8 a0 = *(const LAS bf16x8*)(Ks + r32 * 144 + (ks * 16 + hh * 8) * 2);
            const bf16x8 a1 = *(const LAS bf16x8*)(Ks + (32 + r32) * 144 + (ks * 16 + hh * 8) * 2);
            s0 = MFMA32(a0, qf[ks], s0); s1 = MFMA32(a1, qf[ks], s1);
        }
        float rs = 0.f;
#pragma unroll
        for (int i = 0; i < 16; ++i) { s0[i] = __builtin_amdgcn_exp2f(s0[i]); rs += s0[i]; }
#pragma unroll
        for (int i = 0; i < 16; ++i) { s1[i] = __builtin_amdgcn_exp2f(s1[i]); rs += s1[i]; }
        lsum += rs;
#pragma unroll
        for (int mb = 0; mb < 2; ++mb)
#pragma unroll
            for (int s = 0; s < 2; ++s) {
                u32x4 pk;
                if (mb == 0) { pk.x = cvtpk(s0[8 * s], s0[8 * s + 1]); pk.y = cvtpk(s0[8 * s + 2], s0[8 * s + 3]); pk.z = cvtpk(s0[8 * s + 4], s0[8 * s + 5]); pk.w = cvtpk(s0[8 * s + 6], s0[8 * s + 7]); }
                else         { pk.x = cvtpk(s1[8 * s], s1[8 * s + 1]); pk.y = cvtpk(s1[8 * s + 2], s1[8 * s + 3]); pk.z = cvtpk(s1[8 * s + 4], s1[8 * s + 5]); pk.w = cvtpk(s1[8 * s + 6], s1[8 * s + 7]); }
                const bf16x8 pb = __builtin_bit_cast(bf16x8, pk);
                const int keyoff = 32 * mb + 16 * s + 4 * hh;
                { const s16x4 lo = *(const LAS s16x4*)(Vs + r32 * 144 + keyoff * 2), hi = *(const LAS s16x4*)(Vs + r32 * 144 + (keyoff + 8) * 2);
                  const bf16x8 va = __builtin_shufflevector(lo, hi, 0, 1, 2, 3, 4, 5, 6, 7); o0 = MFMA32(va, pb, o0); }
                { const s16x4 lo = *(const LAS s16x4*)(Vs + (32 + r32) * 144 + keyoff * 2), hi = *(const LAS s16x4*)(Vs + (32 + r32) * 144 + (keyoff + 8) * 2);
                  const bf16x8 va = __builtin_shufflevector(lo, hi, 0, 1, 2, 3, 4, 5, 6, 7); o1 = MFMA32(va, pb, o1); }
            }
        if (more) { LAS unsigned char* Kn = lds + ((j + 1) & 1) * 18432; *(LAS u32x4*)(Kn + lds_off) = kreg; *(LAS u32x4*)(Kn + 9216 + lds_off) = vreg; }
        asm volatile("s_waitcnt lgkmcnt(0)\n\ts_barrier" ::: "memory");
        kreg = kreg2; vreg = vreg2;
    }
    lsum += __shfl_xor(lsum, 32);
    const float inv = 1.f / lsum;
    bf16_t* op = mix + (size_t)(q0 + r32) * DM + 256 + head * 64;
#pragma unroll
    for (int g4 = 0; g4 < 4; ++g4) {
        u32x2 w0; w0.x = cvtpk(o0[4 * g4] * inv, o0[4 * g4 + 1] * inv); w0.y = cvtpk(o0[4 * g4 + 2] * inv, o0[4 * g4 + 3] * inv);
        *(u32x2*)(op + 8 * g4 + 4 * hh) = w0;
        u32x2 w1; w1.x = cvtpk(o1[4 * g4] * inv, o1[4 * g4 + 1] * inv); w1.y = cvtpk(o1[4 * g4 + 2] * inv, o1[4 * g4 + 3] * inv);
        *(u32x2*)(op + 32 + 8 * g4 + 4 * hh) = w1;
    }
}

constexpr int RW_BUF = 49152, RW_XR = 0, RW_XKD = 8192, RW_XV = 16384, RW_WLW = 24576, RW_ALB = 32768, RW_KKN = 40960, RW_YO = 98304, RW_XWD = 106496, RW_XAD = 111104,
              RW_W2T = 115712, RW_A2T = 124928, RW_CD = 134144, SLOT_OFF = 134400;
#define RW_BAR() asm volatile("s_waitcnt lgkmcnt(0)\n\ts_barrier" ::: "memory")
#define RW_DECODE(i_) const int t = (pt >> 4) + 16 * ((i_) / 5), c4 = (pt & 15) * 4; constexpr int gi = (i_) % 5; \
            const int col = (gi == 0) ? C_R + h * 64 + c4 : (gi == 1) ? C_K + h * 64 + c4 : (gi == 2) ? C_V + h * 64 + c4 : (gi == 3) ? C_WD + dir * 64 + c4 : C_AD + dir * 64 + c4;
#define RW_ISSUE1(chx, i_) { RW_DECODE(i_) \
            const int n = (chx) * 32 + t; const int pos = dir ? (len - 1 - n) : n; \
            const bf16_t* bp = proj + (size_t)(start + pos) * NPROJ + col; \
            rc[i_] = *(const u32x2*)bp; rp_[i_] = (u32x2){0u, 0u}; rn[i_] = (u32x2){0u, 0u}; \
            if (pos > 0) rp_[i_] = *(const u32x2*)(bp - NPROJ); \
            if (pos < len - 1) rn[i_] = *(const u32x2*)(bp + NPROJ); }
#define RW_ISSUE(chx) do { RW_ISSUE1(chx, 0) RW_ISSUE1(chx, 1) RW_ISSUE1(chx, 2) RW_ISSUE1(chx, 3) RW_ISSUE1(chx, 4) RW_ISSUE1(chx, 5) RW_ISSUE1(chx, 6) RW_ISSUE1(chx, 7) RW_ISSUE1(chx, 8) RW_ISSUE1(chx, 9) } while (0)
#define RW_CONV1(i_) { RW_DECODE(i_) \
            const f32x4 m4 = mureg[gi]; \
            f32x4 x = {bflo(rc[i_].x), bfhi(rc[i_].x), bflo(rc[i_].y), bfhi(rc[i_].y)}; \
            const f32x4 pn = {bflo(rp_[i_].x) + bflo(rn[i_].x), bfhi(rp_[i_].x) + bfhi(rn[i_].x), bflo(rp_[i_].y) + bflo(rn[i_].y), bfhi(rp_[i_].y) + bfhi(rn[i_].y)}; \
            x = x + (0.5f * pn - x) * m4; \
            if (gi < 3) { LAS float* dst = (gi == 0) ? XR : (gi == 1) ? XKD : XV; *(LAS f32x4*)(dst + t * 64 + c4) = x; } \
            else if (gi == 3) { \
                _Pragma("unroll") for (int j = 0; j < 4; ++j) { const float e = __expf(2.f * x[j]); x[j] = 1.f - 2.f * frcp(e + 1.f); } \
                u32x2 w; w.x = cvtpk(x[0], x[1]); w.y = cvtpk(x[2], x[3]); *(LAS u32x2*)(XWD + t * 72 + c4) = w; } \
            else { u32x2 w; w.x = cvtpk(x[0], x[1]); w.y = cvtpk(x[2], x[3]); *(LAS u32x2*)(XAD + t * 72 + c4) = w; } }
DI void rwkv_job(const KP& p, int l, int job, LAS unsigned char* lds, int tid) {
    int seq, h, dir, rpart; constexpr int nrows = 32;
    { int j = job; if (j < 32) { seq = 8 + (j >> 4); } else { j -= 32; seq = j >> 4; } h = (j >> 2) & 3; dir = (j >> 1) & 1; rpart = j & 1; }
    int start, len; seq_info(seq, start, len);
    const bf16_t* proj = (const bf16_t*)(p.ws + WS_R);
    bf16_t* mix = (bf16_t*)(p.ws + WS_X1);
    bf16_t* yb = (bf16_t*)(p.ws + WS_YB);
    float* cdot = (float*)(p.ws + WS_CDOT);
    const float* mu = p.in[4] + l * 1152;
    const int wave = tid >> 6, lane = tid & 63, r32 = lane & 31, hh = lane >> 5;
    LAS bf16_t* XWD = (LAS bf16_t*)(lds + RW_XWD); LAS bf16_t* XAD = (LAS bf16_t*)(lds + RW_XAD);
    LAS bf16_t* W2T = (LAS bf16_t*)(lds + RW_W2T); LAS bf16_t* A2T = (LAS bf16_t*)(lds + RW_A2T);
    { const float* w2 = p.in[6] + (size_t)((l * 2 + dir) * 64) * 256 + h * 64; const float* a2 = p.in[8] + (size_t)((l * 2 + dir) * 64) * 256 + h * 64;
#pragma unroll
      for (int i = 0; i < 8; ++i) { const int idx = tid + NTHR * i; const int mm = idx >> 6, c = idx & 63; W2T[c * 72 + mm] = f2bf(w2[mm * 256 + c]); A2T[c * 72 + mm] = f2bf(a2[mm * 256 + c]); } }
    const int nch = len >> 5;
    __syncthreads();
    if (tid < 256) {
        const int srow = tid >> 3, sj = (tid & 7) * 8;
        f32x4 Sa = {0.f, 0.f, 0.f, 0.f}, Sb = {0.f, 0.f, 0.f, 0.f};
        RW_BAR(); RW_BAR(); RW_BAR();
#define RW_LD(dst, arr, tt) const f32x4 dst##a = *(const LAS f32x4*)((arr) + (tt) * 64 + sj), dst##b = *(const LAS f32x4*)((arr) + (tt) * 64 + sj + 4)
        for (int ch = 0; ch < nch; ++ch) {
            LAS unsigned char* B = lds + (ch & 1) * RW_BUF;
            LAS float* XR = (LAS float*)(B + RW_XR); LAS float* XKD = (LAS float*)(B + RW_XKD); LAS float* XV = (LAS float*)(B + RW_XV);
            LAS float* WLW = (LAS float*)(B + RW_WLW); LAS float* ALB = (LAS float*)(B + RW_ALB); LAS float* KKN = (LAS float*)(B + RW_KKN);
            LAS float* YO = (LAS float*)(lds + RW_YO + (ch & 1) * 4096);
            f32x4 wa = *(const LAS f32x4*)(WLW + sj), wb = *(const LAS f32x4*)(WLW + sj + 4), ka = *(const LAS f32x4*)(KKN + sj), kb = *(const LAS f32x4*)(KKN + sj + 4);
            f32x4 ba = *(const LAS f32x4*)(ALB + sj), bb = *(const LAS f32x4*)(ALB + sj + 4), da = *(const LAS f32x4*)(XKD + sj), db = *(const LAS f32x4*)(XKD + sj + 4);
            f32x4 ra = *(const LAS f32x4*)(XR + sj), rb = *(const LAS f32x4*)(XR + sj + 4);
            float v = XV[rpart * 32 + srow];
#pragma unroll 2
            for (int t = 0; t < 32; ++t) {
                const int tn = (t < 31) ? t + 1 : 31;
                RW_LD(wn, WLW, tn); RW_LD(kn, KKN, tn); RW_LD(bn, ALB, tn); RW_LD(dn, XKD, tn); RW_LD(rn_, XR, tn);
                const float vn = XV[tn * 64 + rpart * 32 + srow];
                const f32x4 pa = Sa * ka + Sb * kb;
                float sa = (pa[0] + pa[1]) + (pa[2] + pa[3]);
                sa = -red8(sa);
                Sa = Sa * wa + sa * ba + v * da;
                Sb = Sb * wb + sa * bb + v * db;
                const f32x4 py = Sa * ra + Sb * rb;
                float y = (py[0] + py[1]) + (py[2] + py[3]);
                y = red8(y);
                if ((tid & 7) == 0) YO[t * 32 + srow] = y;
                wa = wna; wb = wnb; ka = kna; kb = knb; ba = bna; bb = bnb; da = dna; db = dnb; ra = rn_a; rb = rn_b; v = vn;
                if (t == 19 || t == 23) RW_BAR();
            }
            RW_BAR();
        }
    } else {
        const int ptid = tid - 256;
        const int cli = ptid & 15, cc4 = cli * 4;
        const f32x4 w0v = *(const f32x4*)(p.in[5] + (l * 2 + dir) * 256 + h * 64 + cc4);
        const f32x4 a0v = *(const f32x4*)(p.in[7] + (l * 2 + dir) * 256 + h * 64 + cc4);
        const f32x4 kkw = *(const f32x4*)(p.in[10] + l * 256 + h * 64 + cc4);
        const f32x4 kaw = *(const f32x4*)(p.in[11] + l * 256 + h * 64 + cc4);
        const f32x4 rkw = *(const f32x4*)(p.in[12] + l * 256 + h * 64 + cc4);
        u32x2 rc[10], rp_[10], rn[10];
        f32x4 mureg[5];
        { const int c4 = (ptid & 15) * 4;
          mureg[0] = *(const f32x4*)(mu + C_R + h * 64 + c4); mureg[1] = *(const f32x4*)(mu + C_K + h * 64 + c4); mureg[2] = *(const f32x4*)(mu + C_V + h * 64 + c4);
          mureg[3] = *(const f32x4*)(mu + C_WD + dir * 64 + c4); mureg[4] = *(const f32x4*)(mu + C_AD + dir * 64 + c4); }
        { int pt = ptid; RW_ISSUE(0); }
        for (int ch = -1; ch < nch; ++ch) {
            int pt = ptid; asm volatile("" : "+v"(pt));
            if (ch >= 1) {
                const int pc = ch - 1;
                LAS float* YO = (LAS float*)(lds + RW_YO + (pc & 1) * 4096); LAS float* CD = (LAS float*)(lds + RW_CD + (pc & 1) * 128);
                const int t = ptid >> 3, c4 = (ptid & 7) * 4;
                const int n = pc * 32 + t; const int pos = dir ? (len - 1 - n) : n; const int tok = start + pos;
                const f32x4 yv = *(const LAS f32x4*)(YO + t * 32 + c4);
                u32x2 w; w.x = cvtpk(yv[0], yv[1]); w.y = cvtpk(yv[2], yv[3]);
                if (c4 < nrows) { if (dir) *(u32x2*)(yb + (size_t)tok * 256 + h * 64 + rpart * nrows + c4) = w; else *(u32x2*)(mix + (size_t)tok * DM + h * 64 + rpart * nrows + c4) = w; }
                if (rpart == 0 && ptid < 32) { const int n2 = pc * 32 + ptid; const int pos2 = dir ? (len - 1 - n2) : n2; cdot[((size_t)(start + pos2) * 4 + h) * 2 + dir] = CD[ptid]; }
            }
            const int nc = ch + 1;
            const bool build = nc < nch;
            LAS unsigned char* B = lds + (nc & 1) * RW_BUF;
            LAS float* XR = (LAS float*)(B + RW_XR); LAS float* XKD = (LAS float*)(B + RW_XKD); LAS float* XV = (LAS float*)(B + RW_XV);
            LAS float* WLW = (LAS float*)(B + RW_WLW); LAS float* ALB = (LAS float*)(B + RW_ALB); LAS float* KKN = (LAS float*)(B + RW_KKN);
            LAS float* CDn = (LAS float*)(lds + RW_CD + (nc & 1) * 128);
            if (build) {
                RW_CONV1(0) RW_CONV1(1) RW_CONV1(2) RW_CONV1(3) RW_CONV1(4) RW_CONV1(5) RW_CONV1(6) RW_CONV1(7) RW_CONV1(8) RW_CONV1(9)
                if (nc + 1 < nch) RW_ISSUE(nc + 1);
            }
            RW_BAR();
            if (build) {
                const int mat = (wave - 4) >> 1, nb = (wave - 4) & 1;
                LAS bf16_t* Xs = mat ? XAD : XWD; LAS bf16_t* Ws = mat ? A2T : W2T;
                f32x16 acc = zero16();
#pragma unroll
                for (int ks = 0; ks < 4; ++ks) {
                    const bf16x8 a = *(const LAS bf16x8*)(Xs + r32 * 72 + ks * 16 + hh * 8);
                    const bf16x8 bb = *(const LAS bf16x8*)(Ws + (nb * 32 + r32) * 72 + ks * 16 + hh * 8);
                    acc = MFMA32(a, bb, acc);
                }
                LAS float* dst = mat ? ALB : WLW;
#pragma unroll
                for (int i = 0; i < 16; ++i) dst[crow(i, hh) * 64 + nb * 32 + r32] = acc[i];
            }
            RW_BAR();
            if (build) {
#pragma unroll
                for (int it = 0; it < 2; ++it) {
                    const int ct = (ptid >> 4) + 16 * it;
                    const f32x4 wl = *(const LAS f32x4*)(WLW + ct * 64 + cc4), al = *(const LAS f32x4*)(ALB + ct * 64 + cc4);
                    const f32x4 k4 = *(const LAS f32x4*)(XKD + ct * 64 + cc4), r4 = *(const LAS f32x4*)(XR + ct * 64 + cc4);
                    f32x4 w, a, kkr, kd;
                    float ssq = 0.f, cd = 0.f;
#pragma unroll
                    for (int j = 0; j < 4; ++j) {
                        const float sg = sigmoidf_(w0v[j] + wl[j]);
                        w[j] = __expf(-0.6065306597126334f * sg);
                        a[j] = sigmoidf_(a0v[j] + al[j]);
                        kkr[j] = k4[j] * kkw[j]; ssq += kkr[j] * kkr[j];
                        kd[j] = k4[j] * (1.f + (a[j] - 1.f) * kaw[j]);
                        cd += r4[j] * kd[j] * rkw[j];
                    }
                    ssq = red16(ssq); cd = red16(cd);
                    const float inv = __builtin_amdgcn_rsqf(fmaxf(ssq, 1e-24f));
                    f32x4 kkn, bv;
#pragma unroll
                    for (int j = 0; j < 4; ++j) { kkn[j] = kkr[j] * inv; bv[j] = kkn[j] * a[j]; }
                    *(LAS f32x4*)(WLW + ct * 64 + cc4) = w; *(LAS f32x4*)(ALB + ct * 64 + cc4) = bv; *(LAS f32x4*)(KKN + ct * 64 + cc4) = kkn; *(LAS f32x4*)(XKD + ct * 64 + cc4) = kd;
                    if (cli == 0) CDn[ct] = cd;
                }
            }
            RW_BAR();
        }
        {
            const int pc = nch - 1;
            LAS float* YO = (LAS float*)(lds + RW_YO + (pc & 1) * 4096); LAS float* CD = (LAS float*)(lds + RW_CD + (pc & 1) * 128);
            const int t = ptid >> 3, c4 = (ptid & 7) * 4;
            const int n = pc * 32 + t; const int pos = dir ? (len - 1 - n) : n; const int tok = start + pos;
            const f32x4 yv = *(const LAS f32x4*)(YO + t * 32 + c4);
            u32x2 w; w.x = cvtpk(yv[0], yv[1]); w.y = cvtpk(yv[2], yv[3]);
            if (c4 < nrows) { if (dir) *(u32x2*)(yb + (size_t)tok * 256 + h * 64 + rpart * nrows + c4) = w; else *(u32x2*)(mix + (size_t)tok * DM + h * 64 + rpart * nrows + c4) = w; }
            if (rpart == 0 && ptid < 32) { const int n2 = pc * 32 + ptid; const int pos2 = dir ? (len - 1 - n2) : n2; cdot[((size_t)(start + pos2) * 4 + h) * 2 + dir] = CD[ptid]; }
        }
    }
    __syncthreads();
}

constexpr int ML_QS = 0, ML_KS = 9216, ML_KT = 18432, ML_VT = 27648, ML_VWT = 36864, ML_PS = 46080, ML_CB = 55296, ML_WGT = 64512, ML_RR = 64768, ML_MROW = 65024,
              ML_SC = 65280, ML_EMT = 65536, ML_DENI = 65792, ML_NS = 66048, ML_A12 = 66304;
DI void mlstm_job(const KP& p, int l, int job, LAS unsigned char* lds, int tid) {
    int seq, hm, dir; seq_of_job(job, seq, hm, dir);
    int start, len; seq_info(seq, start, len);
    const bf16_t* proj = (const bf16_t*)(p.ws + WS_R);
    bf16_t* mix = (bf16_t*)(p.ws + WS_X1);
    bf16_t* hbp = (bf16_t*)(p.ws + WS_HBP);
    const float* cw = p.in[17] + l * 3 * 512;
    const float ibv = p.in[18][(l * 2 + dir) * 4 + hm], fbv = p.in[19][(l * 2 + dir) * 4 + hm];
    const int wave = tid >> 6, lane = tid & 63, r32 = lane & 31, hh = lane >> 5;
    LAS bf16_t* Qs = (LAS bf16_t*)(lds + ML_QS); LAS bf16_t* Ks = (LAS bf16_t*)(lds + ML_KS); LAS bf16_t* KT = (LAS bf16_t*)(lds + ML_KT);
    LAS bf16_t* VT = (LAS bf16_t*)(lds + ML_VT); LAS bf16_t* VWT = (LAS bf16_t*)(lds + ML_VWT); LAS bf16_t* Ps = (LAS bf16_t*)(lds + ML_PS); LAS bf16_t* CB = (LAS bf16_t*)(lds + ML_CB);
    LAS float* WGT = (LAS float*)(lds + ML_WGT); LAS float* RR = (LAS float*)(lds + ML_RR); LAS float* MROW = (LAS float*)(lds + ML_MROW); LAS float* SC = (LAS float*)(lds + ML_SC);
    LAS float* EMT = (LAS float*)(lds + ML_EMT); LAS float* DENI = (LAS float*)(lds + ML_DENI); LAS float* NS = (LAS float*)(lds + ML_NS); LAS float* A12 = (LAS float*)(lds + ML_A12);
    for (int i = tid; i < 64 * 72; i += NTHR) CB[i] = 0;
    if (tid < 64) NS[tid] = 0.f;
    f32x16 Creg = zero16();
    float Mst = 0.f;
    __syncthreads();
    const int nch = len >> 6;
    const int ll = tid >> 3, e8 = (tid & 7) * 8;
    for (int ch = 0; ch < nch; ++ch) {
        {
            const int n = ch * 64 + ll; const int pos = dir ? (len - 1 - n) : n; const int tok = start + pos;
#pragma unroll
            for (int which = 0; which < 2; ++which) {
                const int col = (which ? C_MK : C_MQ) + hm * 64 + e8; const int cwc = (which ? 256 : 0) + hm * 64 + e8;
                const bf16_t* bp = proj + (size_t)tok * NPROJ + col;
                const u32x4 cu = *(const u32x4*)bp; u32x4 pv = {0u, 0u, 0u, 0u}, nv = {0u, 0u, 0u, 0u};
                if (pos > 0) pv = *(const u32x4*)(bp - NPROJ);
                if (pos < len - 1) nv = *(const u32x4*)(bp + NPROJ);
                float o[8];
#pragma unroll
                for (int j = 0; j < 4; ++j) {
                    const f32x2 c0 = *(const f32x2*)(cw + cwc + 2 * j), c1 = *(const f32x2*)(cw + 512 + cwc + 2 * j), c2 = *(const f32x2*)(cw + 1024 + cwc + 2 * j);
                    const float v0 = c0.x * bflo(pv[j]) + c1.x * bflo(cu[j]) + c2.x * bflo(nv[j]);
                    const float v1 = c0.y * bfhi(pv[j]) + c1.y * bfhi(cu[j]) + c2.y * bfhi(nv[j]);
                    o[2 * j] = v0 * sigmoidf_(v0); o[2 * j + 1] = v1 * sigmoidf_(v1);
                }
                if (which) {
#pragma unroll
                    for (int j = 0; j < 8; ++j) o[j] *= 0.125f;
                }
                u32x4 w; w.x = cvtpk(o[0], o[1]); w.y = cvtpk(o[2], o[3]); w.z = cvtpk(o[4], o[5]); w.w = cvtpk(o[6], o[7]);
                if (!which) *(LAS u32x4*)(Qs + ll * 72 + e8) = w;
                else { *(LAS u32x4*)(Ks + ll * 72 + e8) = w;
#pragma unroll
                    for (int j = 0; j < 4; ++j) { KT[(e8 + 2 * j) * 72 + ll] = (bf16_t)(w[j] & 0xffffu); KT[(e8 + 2 * j + 1) * 72 + ll] = (bf16_t)(w[j] >> 16); } }
            }
        }
        if (wave == 0) {
            const int n = ch * 64 + lane; const int pos = dir ? (len - 1 - n) : n; const int tok = start + pos;
            const float igv = bf2f(proj[(size_t)tok * NPROJ + C_IG + dir * 4 + hm]) + ibv;
            const float fgv = bf2f(proj[(size_t)tok * NPROJ + C_FG + dir * 4 + hm]) + fbv;
            const float lf = (fgv > 0.f) ? -log1pf(__expf(-fgv)) : (fgv - log1pf(__expf(fgv)));
            float b = lf;
#pragma unroll
            for (int o = 1; o < 64; o <<= 1) { const float t2 = __shfl_up(b, o); if (lane >= o) b += t2; }
            const float bL = __shfl(b, 63);
            const float g = bL - b + igv;
            float mg = g;
#pragma unroll
            for (int o = 32; o >= 1; o >>= 1) mg = fmaxf(mg, __shfl_xor(mg, o));
            const float wgt = __expf(g - mg);
            const float r = igv - b;
            float cm = r;
#pragma unroll
            for (int o = 1; o < 64; o <<= 1) { const float t2 = __shfl_up(cm, o); if (lane >= o) cm = fmaxf(cm, t2); }
            const float mrow = fmaxf(cm, Mst);
            WGT[lane] = wgt; RR[lane] = r; MROW[lane] = mrow; SC[lane] = __expf(Mst - mrow); EMT[lane] = __expf(-(b + mrow));
            const float Mnew = fmaxf(bL + Mst, mg);
            if (lane == 0) { A12[0] = __expf(bL + Mst - Mnew); A12[1] = __expf(mg - Mnew); }
            Mst = Mnew;
        }
        __syncthreads();
        {
            const int n = ch * 64 + ll; const int pos = dir ? (len - 1 - n) : n; const int tok = start + pos;
            const u32x4 vv = *(const u32x4*)(proj + (size_t)tok * NPROJ + C_MV + hm * 64 + e8);
            const float wg = WGT[ll];
#pragma unroll
            for (int j = 0; j < 4; ++j) {
                VT[(e8 + 2 * j) * 72 + ll] = (bf16_t)(vv[j] & 0xffffu); VT[(e8 + 2 * j + 1) * 72 + ll] = (bf16_t)(vv[j] >> 16);
                const unsigned pw = cvtpk(bflo(vv[j]) * wg, bfhi(vv[j]) * wg);
                VWT[(e8 + 2 * j) * 72 + ll] = (bf16_t)(pw & 0xffffu); VWT[(e8 + 2 * j + 1) * 72 + ll] = (bf16_t)(pw >> 16);
            }
        }
        __syncthreads();
        if (wave < 4) {
            const int tb = wave >> 1, sb = wave & 1;
            f32x16 acc = zero16();
#pragma unroll
            for (int ks = 0; ks < 4; ++ks) {
                const bf16x8 a = *(const LAS bf16x8*)(Qs + (tb * 32 + r32) * 72 + ks * 16 + hh * 8);
                const bf16x8 b = *(const LAS bf16x8*)(Ks + (sb * 32 + r32) * 72 + ks * 16 + hh * 8);
                acc = MFMA32(a, b, acc);
            }
            const int s = sb * 32 + r32; const float rs_ = RR[s];
#pragma unroll
            for (int i = 0; i < 16; ++i) { const int t = tb * 32 + crow(i, hh); const float pvv = (s <= t) ? __expf(rs_ - MROW[t]) * acc[i] : 0.f; Ps[t * 72 + s] = f2bf(pvv); }
        } else {
            const int db = (wave - 4) >> 1, eb = (wave - 4) & 1;
            f32x16 kc = zero16();
#pragma unroll
            for (int ks = 0; ks < 4; ++ks) {
                const bf16x8 a = *(const LAS bf16x8*)(VWT + (db * 32 + r32) * 72 + ks * 16 + hh * 8);
                const bf16x8 b = *(const LAS bf16x8*)(KT + (eb * 32 + r32) * 72 + ks * 16 + hh * 8);
                kc = MFMA32(a, b, kc);
            }
            const float a1 = A12[0], a2 = A12[1];
#pragma unroll
            for (int i = 0; i < 16; ++i) Creg[i] = a1 * Creg[i] + a2 * kc[i];
        }
        __syncthreads();
        f32x16 acc = zero16();
        float ncv = 0.f;
        if (wave < 4) {
            const int tb = wave >> 1, db = wave & 1;
#pragma unroll
            for (int ks = 0; ks < 4; ++ks) {
                const bf16x8 a = *(const LAS bf16x8*)(Qs + (tb * 32 + r32) * 72 + ks * 16 + hh * 8);
                const bf16x8 b = *(const LAS bf16x8*)(CB + (db * 32 + r32) * 72 + ks * 16 + hh * 8);
                acc = MFMA32(a, b, acc);
            }
#pragma unroll
            for (int i = 0; i < 16; ++i) acc[i] *= SC[tb * 32 + crow(i, hh)];
#pragma unroll
            for (int ks = 0; ks < 4; ++ks) {
                const bf16x8 a = *(const LAS bf16x8*)(Ps + (tb * 32 + r32) * 72 + ks * 16 + hh * 8);
                const bf16x8 b = *(const LAS bf16x8*)(VT + (db * 32 + r32) * 72 + ks * 16 + hh * 8);
                acc = MFMA32(a, b, acc);
            }
        } else if (wave == 4) {
            float rsum = 0.f, qn = 0.f;
            for (int e = 0; e < 64; ++e) { rsum += bf2f(Ps[lane * 72 + e]); qn += bf2f(Qs[lane * 72 + e]) * NS[e]; }
            const float den = rsum + SC[lane] * qn;
            DENI[lane] = 1.f / fmaxf(fabsf(den), EMT[lane]);
        } else if (wave == 5) {
            for (int s = 0; s < 64; ++s) ncv += WGT[s] * bf2f(KT[lane * 72 + s]);
        }
        __syncthreads();
        if (wave < 4) {
            const int tb = wave >> 1, db = wave & 1;
#pragma unroll
            for (int i = 0; i < 16; ++i) {
                const int t = tb * 32 + crow(i, hh); const int n = ch * 64 + t; const int pos = dir ? (len - 1 - n) : n; const int tok = start + pos;
                const bf16_t o = f2bf(acc[i] * DENI[t]);
                if (dir) hbp[(size_t)tok * 256 + hm * 64 + db * 32 + r32] = o; else mix[(size_t)tok * DM + 768 + hm * 64 + db * 32 + r32] = o;
            }
        } else {
            const int db = (wave - 4) >> 1, eb = (wave - 4) & 1;
#pragma unroll
            for (int i = 0; i < 16; ++i) CB[(db * 32 + crow(i, hh)) * 72 + eb * 32 + r32] = f2bf(Creg[i]);
            if (wave == 5) NS[lane] = A12[0] * NS[lane] + A12[1] * ncv;
        }
        __syncthreads();
    }
}

DI void mixers_phase(const KP& p, int l, int cidx, LAS unsigned char* lds, int tid, int G, int bid) {
    unsigned* cnt = (unsigned*)(p.ws + WS_CNT) + cidx;
    LAS int* slot = (LAS int*)(lds + SLOT_OFF);
    for (;;) {
        if (tid == 0) *slot = (int)atomicAdd(cnt, 1u);
        __syncthreads();
        const int item = *slot;
        __syncthreads();
        if (item >= 240 + 1536) {
            if (l != 0 || item >= 240 + 1536 + 1344) break;
            const int t0 = 768 + (item - 1776) * 4;
            for (int q = 0; q < 4; ++q) convert_tile(p, t0 + q, (LAS float*)lds, tid);
            continue;
        }
        int kind, jb;
        if (item < 32) { kind = 0; jb = item; } else if (item < 48) { kind = 1; jb = item - 32; } else if (item < 176) { kind = 0; jb = item - 48 + 32; }
        else if (item < 240) { kind = 1; jb = item - 176 + 16; } else { kind = 2; jb = item - 240; }
        int t2 = tid; asm volatile("" : "+v"(t2));
#ifndef REP_R
#define REP_R 1
#endif
#ifndef REP_M
#define REP_M 1
#endif
#ifndef REP_T
#define REP_T 1
#endif
        if (kind == 0) { rwkv_job(p, l, jb, lds, t2); }
        else if (kind == 1) { for (int rep = 0; rep < REP_M; ++rep) { mlstm_job(p, l, jb, lds, t2); __syncthreads(); } }
        else { for (int rep = 0; rep < REP_T; ++rep) { attn_unit(p, l, jb, lds, t2); __syncthreads(); } }
        __syncthreads();
    }
}

constexpr int PO_G2T = 0, PO_AS = 69632, PO_GO = 87040;
DI void post_phase(const KP& p, int l, LAS unsigned char* lds, int tid, int G, int bid) {
    const bf16_t* proj = (const bf16_t*)(p.ws + WS_R);
    bf16_t* mix = (bf16_t*)(p.ws + WS_X1);
    const bf16_t* yb = (const bf16_t*)(p.ws + WS_YB);
    const bf16_t* hbp = (const bf16_t*)(p.ws + WS_HBP);
    const float* cdot = (const float*)(p.ws + WS_CDOT);
    const float* mu = p.in[4] + l * 1152;
    const float* lnw = p.in[13] + l * 256; const float* lnb = p.in[14] + l * 256; const float* nw = p.in[20] + l * 256;
    LAS bf16_t* G2T = (LAS bf16_t*)(lds + PO_G2T); LAS bf16_t* AS = (LAS bf16_t*)(lds + PO_AS); LAS bf16_t* GO = (LAS bf16_t*)(lds + PO_GO);
    const int wave = tid >> 6, lane = tid & 63, r32 = lane & 31, hh = lane >> 5;
    { const float* g2 = p.in[9] + (size_t)l * 128 * 256;
      for (int i = 0; i < 64; ++i) { const int idx = tid + NTHR * i; const int mm = idx >> 8, c = idx & 255; G2T[c * 136 + mm] = f2bf(g2[idx]); } }
    __syncthreads();
    for (int unit = bid; unit < T / 64; unit += G) {
        const int tok0 = unit * 64;
        int len; const int st = tok_seq_start(tok0, len);
#pragma unroll
        for (int i = 0; i < 4; ++i) {
            const int q = tid + NTHR * i; const int t = q >> 5, c4 = (q & 31) * 4; const int tok = tok0 + t; const int pos = tok - st;
            const bf16_t* bp = proj + (size_t)tok * NPROJ + C_GD + c4;
            const u32x2 cu = *(const u32x2*)bp; u32x2 pv = {0u, 0u}, nv = {0u, 0u};
            if (pos > 0) pv = *(const u32x2*)(bp - NPROJ);
            if (pos < len - 1) nv = *(const u32x2*)(bp + NPROJ);
            const f32x4 m4 = *(const f32x4*)(mu + C_GD + c4);
            float x[4] = {bflo(cu.x), bfhi(cu.x), bflo(cu.y), bfhi(cu.y)};
            const float pn[4] = {bflo(pv.x) + bflo(nv.x), bfhi(pv.x) + bfhi(nv.x), bflo(pv.y) + bflo(nv.y), bfhi(pv.y) + bfhi(nv.y)};
#pragma unroll
            for (int j = 0; j < 4; ++j) x[j] = sigmoidf_(x[j] + (0.5f * pn[j] - x[j]) * m4[j]);
            u32x2 w; w.x = cvtpk(x[0], x[1]); w.y = cvtpk(x[2], x[3]); *(LAS u32x2*)(AS + t * 136 + c4) = w;
        }
        __syncthreads();
        {
            const int hd = wave & 3, tb = wave >> 2;
            f32x16 a0 = zero16(), a1 = zero16();
#pragma unroll
            for (int ks = 0; ks < 8; ++ks) {
                const bf16x8 a = *(const LAS bf16x8*)(AS + (tb * 32 + r32) * 136 + ks * 16 + hh * 8);
                const bf16x8 b0 = *(const LAS bf16x8*)(G2T + (hd * 64 + r32) * 136 + ks * 16 + hh * 8);
                const bf16x8 b1 = *(const LAS bf16x8*)(G2T + (hd * 64 + 32 + r32) * 136 + ks * 16 + hh * 8);
                a0 = MFMA32(a, b0, a0); a1 = MFMA32(a, b1, a1);
            }
#pragma unroll
            for (int i = 0; i < 16; ++i) { const int t = tb * 32 + crow(i, hh); GO[t * 264 + hd * 64 + r32] = f2bf(a0[i]); GO[t * 264 + hd * 64 + 32 + r32] = f2bf(a1[i]); }
        }
        __syncthreads();
#pragma unroll 1
        for (int it = 0; it < 8; ++it) {
            const int task = tid + NTHR * it; const int grp = task >> 4, li = task & 15; const int t = grp >> 2, hd = grp & 3; const int c4 = li * 4;
            const int tok = tok0 + t; const int pos = tok - st;
            {
                const u32x2 yf = *(const u32x2*)(mix + (size_t)tok * DM + hd * 64 + c4), ybv = *(const u32x2*)(yb + (size_t)tok * 256 + hd * 64 + c4);
                float x[4] = {bflo(yf.x) + bflo(ybv.x), bfhi(yf.x) + bfhi(ybv.x), bflo(yf.y) + bflo(ybv.y), bfhi(yf.y) + bfhi(ybv.y)};
                const float mean = red16(x[0] + x[1] + x[2] + x[3]) * (1.f / 64.f);
                float vs = 0.f;
#pragma unroll
                for (int j = 0; j < 4; ++j) { x[j] -= mean; vs += x[j] * x[j]; }
                const float rstd = rsqrtf(red16(vs) * (1.f / 64.f) + 64e-5f);
                const bf16_t* bp = proj + (size_t)tok * NPROJ + C_V + hd * 64 + c4;
                const u32x2 cu = *(const u32x2*)bp; u32x2 pv = {0u, 0u}, nv = {0u, 0u};
                if (pos > 0) pv = *(const u32x2*)(bp - NPROJ);
                if (pos < len - 1) nv = *(const u32x2*)(bp + NPROJ);
                const f32x4 m4 = *(const f32x4*)(mu + C_V + hd * 64 + c4);
                float v[4] = {bflo(cu.x), bfhi(cu.x), bflo(cu.y), bfhi(cu.y)};
                const float pn[4] = {bflo(pv.x) + bflo(nv.x), bfhi(pv.x) + bfhi(nv.x), bflo(pv.y) + bflo(nv.y), bfhi(pv.y) + bfhi(nv.y)};
                const f32x2 cdv = *(const f32x2*)(cdot + ((size_t)tok * 4 + hd) * 2);
                const float cds = cdv.x + cdv.y;
                const f32x4 lw = *(const f32x4*)(lnw + hd * 64 + c4), lb = *(const f32x4*)(lnb + hd * 64 + c4);
                const u32x2 gv = *(const LAS u32x2*)(GO + t * 264 + hd * 64 + c4);
                const float g[4] = {bflo(gv.x), bfhi(gv.x), bflo(gv.y), bfhi(gv.y)};
                float o[4];
#pragma unroll
                for (int j = 0; j < 4; ++j) { const float vsft = v[j] + (0.5f * pn[j] - v[j]) * m4[j]; o[j] = (x[j] * rstd * lw[j] + lb[j] + cds * vsft) * g[j]; }
                u32x2 w; w.x = cvtpk(o[0], o[1]); w.y = cvtpk(o[2], o[3]); *(u32x2*)(mix + (size_t)tok * DM + hd * 64 + c4) = w;
            }
            {
                const u32x2 hf = *(const u32x2*)(mix + (size_t)tok * DM + 768 + hd * 64 + c4), hb = *(const u32x2*)(hbp + (size_t)tok * 256 + hd * 64 + c4);
                const float x[4] = {bflo(hf.x) + bflo(hb.x), bfhi(hf.x) + bfhi(hb.x), bflo(hf.y) + bflo(hb.y), bfhi(hf.y) + bfhi(hb.y)};
                const float ms = red16(x[0] * x[0] + x[1] * x[1] + x[2] * x[2] + x[3] * x[3]) * (1.f / 64.f);
                const float rinv = rsqrtf(ms + 1e-6f);
                const u32x2 ov = *(const u32x2*)(proj + (size_t)tok * NPROJ + C_MO + hd * 64 + c4);
                const float og[4] = {bflo(ov.x), bfhi(ov.x), bflo(ov.y), bfhi(ov.y)};
                const f32x4 nwv = *(const f32x4*)(nw + hd * 64 + c4);
                float o[4];
#pragma unroll
                for (int j = 0; j < 4; ++j) o[j] = sigmoidf_(og[j]) * x[j] * rinv * nwv[j];
                u32x2 w; w.x = cvtpk(o[0], o[1]); w.y = cvtpk(o[2], o[3]); *(u32x2*)(mix + (size_t)tok * DM + 768 + hd * 64 + c4) = w;
            }
        }
        __syncthreads();
    }
}

DI void final_phase(const KP& p, int tid, int G, int bid) {
    const float* ss = (const float*)(p.ws + WS_SS) + 4 * T;
    const float* g = p.in[25];
    const int wave = tid >> 6, lane = tid & 63;
    f32x4 gv[4];
#pragma unroll
    for (int j = 0; j < 4; ++j) gv[j] = *(const f32x4*)(g + (j * 64 + lane) * 4);
    for (int row = (bid * 8 + wave) * 4; row < T; row += G * 8 * 4) {
        f32x4 v[4][4]; float rs[4];
#pragma unroll
        for (int r = 0; r < 4; ++r) {
            rs[r] = rsqrtf(ss[row + r] * (1.f / 1024.f) + 1e-6f);
#pragma unroll
            for (int j = 0; j < 4; ++j) v[r][j] = *(const f32x4*)(p.out + (size_t)(row + r) * DM + (j * 64 + lane) * 4);
        }
#pragma unroll
        for (int r = 0; r < 4; ++r)
#pragma unroll
            for (int j = 0; j < 4; ++j) *(f32x4*)(p.out + (size_t)(row + r) * DM + (j * 64 + lane) * 4) = v[r][j] * rs[r] * gv[j];
    }
}

__global__ void __launch_bounds__(NTHR, 2) fwd_kernel(KP p) {
    extern __shared__ __attribute__((aligned(16))) unsigned char lds_raw[];
    LAS unsigned char* lds = (LAS unsigned char*)lds_raw;
    cg::grid_group grid = cg::this_grid();
    int tid = threadIdx.x; const int G = gridDim.x, bid = blockIdx.x;
#define LAUNDER() asm volatile("" : "+v"(tid))
    float* ss = (float*)(p.ws + WS_SS);
    bf16_t* X1 = (bf16_t*)(p.ws + WS_X1);
    bf16_t* PROJ = (bf16_t*)(p.ws + WS_R);
    bf16_t* HB = (bf16_t*)(p.ws + WS_R);
    bf16_t* HID = (bf16_t*)(p.ws + WS_HID);

        LAUNDER();
    volatile LAS unsigned* bst = (volatile LAS unsigned*)(lds + SLOT_OFF + 16);
    if (tid == 0) { bst[0] = 0u; bst[1] = 0u; }
    __syncthreads();
    const XcdBarrier xbar = xcd_barrier_post((unsigned*)(p.ws + WS_BAR), bst);
#define GSYNC() xcd_barrier(xbar)
    p0_phase(p, lds, tid, G, bid);
    grid.sync();
#ifdef PROBE_SYNC20
    for (int i = 0; i < 20; ++i) GSYNC();
#endif
#ifdef PROBE_P0X2
    LAUNDER(); p0_phase(p, lds, tid, G, bid);
    GSYNC();
#endif
#ifdef PROBE_SYNC10
    for (int i = 0; i < 10; ++i) GSYNC();
#endif
    for (int l = 0; l < 2; ++l) {
        {
            pg8::Gemm g{X1, (const bf16_t*)(p.ws + WS_WIN) + (size_t)l * NPROJ * 1024, T, NPROJ, 1024}; pg8::StaticOrder S; S.init(T, NPROJ, G, bid);
            EpiProj E{PROJ, ss + (2 * l) * T};
            pg8::gemm_phase<EpiProj, pg8::StaticOrder, true, true>(lds, g, S, E);
#ifdef PROBE_P1X2
            GSYNC();
            pg8::gemm_phase<EpiProj, pg8::StaticOrder, true, true>(lds, g, S, E);
#endif
        }
        GSYNC();
        LAUNDER();
        prep_phase(p, l, lds, tid, G, bid);
        GSYNC();
        LAUNDER();
        mixers_phase(p, l, l, lds, tid, G, bid);
#ifdef PROBE_MIX2
        GSYNC(); LAUNDER();
        mixers_phase(p, l, l + 2, lds, tid, G, bid);
#endif
        GSYNC();
        LAUNDER();
        post_phase(p, l, lds, tid, G, bid);
        GSYNC();
        {
            pg8::Gemm g{X1, (const bf16_t*)(p.ws + WS_WOUT) + (size_t)l * 1024 * 1024, T, DM, 1024}; pg8::StaticOrder S; S.init(T, DM, G, bid);
            if (l == 0) { EpiRes<true, true, true> E{p.out, HB, ss + (2 * l + 1) * T, p.in[0], p.in[1]}; pg8::gemm_phase<EpiRes<true, true, true>, pg8::StaticOrder, true, true>(lds, g, S, E); }
            else { EpiRes<true, true> E{p.out, HB, ss + (2 * l + 1) * T, nullptr, nullptr}; pg8::gemm_phase<EpiRes<true, true>, pg8::StaticOrder, true, true>(lds, g, S, E); }
        }
        GSYNC();
        for (int hf = 0; hf < 2; ++hf) {
            {
                pg8::Gemm g{HB, (const bf16_t*)(p.ws + WS_W1) + (size_t)l * 4096 * 1024 + (size_t)hf * HFF * 1024, T, HFF, 1024}; pg8::StaticOrder S; S.init(T, HFF, G, bid);
                EpiRelu2 E{HID, ss + (2 * l + 1) * T};
                pg8::gemm_phase<EpiRelu2, pg8::StaticOrder, true, true>(lds, g, S, E);
            }
            GSYNC();
            {
                pg8::Gemm g{HID, (const bf16_t*)(p.ws + WS_W2) + (size_t)l * 2 * 1024 * 2048 + (size_t)hf * 1024 * 2048, T, DM, HFF}; pg8::StaticOrder S; S.init(T, DM, G, bid);
                if (hf == 0) { EpiPart E{X1}; pg8::gemm_phase<EpiPart, pg8::StaticOrder, true, true>(lds, g, S, E); }
                else { EpiRes<true, true, false, true> E{p.out, X1, ss + (2 * l + 2) * T, nullptr, nullptr}; pg8::gemm_phase<EpiRes<true, true, false, true>, pg8::StaticOrder, true, true>(lds, g, S, E); }
            }
            GSYNC();
        }
    }
        LAUNDER();
    final_phase(p, tid, G, bid);
}

extern "C" void kernel_launch(void* const* d_in, const int* in_sizes, int n_in, void* d_out, int out_size, void* d_ws, size_t ws_size, hipStream_t stream) {
    static int grid_blocks = 0;
    if (grid_blocks == 0) {
        if (n_in != 26 || out_size != T * DM || ws_size < WS_END) { fprintf(stderr, "kernel_launch: unexpected shapes (n_in %d out %d ws %zu)\n", n_in, out_size, ws_size); grid_blocks = -1; return; }
        int dev = 0, cus = 0, per_cu = 0;
        hipGetDevice(&dev);
        hipDeviceGetAttribute(&cus, hipDeviceAttributeMultiprocessorCount, dev);
        hipFuncSetAttribute((const void*)fwd_kernel, hipFuncAttributeMaxDynamicSharedMemorySize, LDS_BYTES);
        hipOccupancyMaxActiveBlocksPerMultiprocessor(&per_cu, (const void*)fwd_kernel, NTHR, LDS_BYTES);
        if (per_cu < 1) per_cu = 1;
        grid_blocks = cus * per_cu;
        (void)hipGetLastError();
    }
    if (grid_blocks < 0) return;
    KP p{};
    for (int i = 0; i < 26; ++i) p.in[i] = (const float*)d_in[i];
    p.out = (float*)d_out; p.ws = (unsigned char*)d_ws;
    (void)hipMemsetAsync((char*)d_ws + WS_BAR, 0, 16384, stream);
    void* args[] = {&p};
    hipError_t e = hipLaunchCooperativeKernel((const void*)fwd_kernel, dim3(grid_blocks), dim3(NTHR), args, LDS_BYTES, stream);
    if (e != hipSuccess) fprintf(stderr, "cooperative launch failed: %s (grid %d)\n", hipGetErrorString(e), grid_blocks);
}
```

```cpp
#include <hip/hip_runtime.h>
#include <hip/hip_cooperative_groups.h>
#include <cstdio>
#include <cstdint>
namespace cg = cooperative_groups;
namespace pg8 {
#define PG8_LAS __attribute__((address_space(3)))
typedef unsigned short bf16_t;
typedef short bf16x8 __attribute__((ext_vector_type(8)));
typedef float f32x4 __attribute__((ext_vector_type(4)));
typedef unsigned u32x4 __attribute__((ext_vector_type(4)));
constexpr int BM = 256, BK = 64, HALF = 128, HTB = HALF * BK * 2  , STAGE_BYTES = 8 * HTB, NXCD = 8, WGM = 8;

__host__ __device__ __forceinline__ int lds_byte(int r, int c) { const int st = (r >> 4) * 2 + (c >> 5), rr = r & 15, cc = c & 31, ob = rr * 64 + cc * 2; return st * 1024 + (ob ^ (((ob >> 9) & 1) << 5)); }
__host__ __device__ __forceinline__ void stage_rc(int b, int& R, int& C) { const int st = b / 1024, sb = b % 1024, swz = sb ^ (((sb >> 9) & 1) << 5); R = (st >> 1) * 16 + swz / 64; C = (st & 1) * 32 + (swz % 64) / 2; }
__host__ __device__ __forceinline__ int perm32(int rho) { const int n = rho >> 4, i = rho & 15; return 8 * (i >> 2) + 4 * n + (i & 3); }

struct Unit { int pm, pn; };
struct Gemm { const bf16_t* A; const bf16_t* Bt; int M, N, K; };

struct StaticOrder {
    int nM, nN, nwg, G, c;
    __host__ __device__ void init(int M, int N, int G_, int c_) { nM = M / BM; nN = N / BM; nwg = nM * nN; G = G_; c = c_; }
    __host__ __device__ bool next(int i, Unit& u) const {
        const long L = (long)i * G + c; if (L >= nwg) return false;
        int wgid = (int)L; { const int q = nwg / NXCD, r = nwg % NXCD, xcd = wgid % NXCD, off = wgid / NXCD; wgid = (xcd < r ? xcd * (q + 1) : r * (q + 1) + (xcd - r) * q) + off; }
        const int nig = WGM * nN, gid = wgid / nig, fm = gid * WGM, gsz = (nM - fm) < WGM ? (nM - fm) : WGM;
        u.pm = fm + ((wgid % nig) % gsz); u.pn = (wgid % nig) / gsz; return true;
    }
    __device__ __forceinline__ void a_ready(const Unit&) const {}
    __device__ __forceinline__ void done(const Unit&) const {}
};

template <class Epi, class Sched, bool ALIGN_EPI = false, bool SP2 = false>
__device__ __forceinline__ void gemm_phase(PG8_LAS unsigned char* lds, const Gemm g, const Sched& S, const Epi& E) {
    int tid_l = threadIdx.x; asm volatile("" : "+v"(tid_l));
    const int tid = tid_l, wid = __builtin_amdgcn_readfirstlane(tid >> 6), lane = tid & 63, wr = wid >> 2, wc = wid & 3, fr = lane & 15, fq = lane >> 4;
    const int K = g.K, nt = K / BK;
    unsigned voffA[2], voffB[2];
#pragma unroll
    for (int i = 0; i < 2; ++i) { int R, C; stage_rc(tid * 16 + i * 8192, R, C); const int Rb = Epi::PERM ? ((R & ~31) + perm32(R & 31)) : R;
        voffA[i] = (unsigned)(R * K + C) * 2u; voffB[i] = (unsigned)(Rb * K + C) * 2u; }
    const size_t kstep = (size_t)(BK * 2);
    const size_t hstep = (size_t)HALF * K * 2;
    const size_t tstep = 2 * hstep;
    const unsigned ldsw = (unsigned)wid * 1024u;
    const int aoff = lds_byte(wr * 64 + fr, fq * 8), boff = lds_byte(wc * 32 + fr, fq * 8);
#define PG8_SA(b, h) (((b) * 2 + (h)) * HTB)
#define PG8_SB(b, h) ((4 + (b) * 2 + (h)) * HTB)
#define PG8_STAGE(bufoff, gbase, voff) do { _Pragma("unroll") for (int _i = 0; _i < 2; ++_i) \
        __builtin_amdgcn_global_load_lds((const unsigned*)((const char*)(gbase) + (voff)[_i]), (PG8_LAS unsigned*)(lds + (bufoff) + ldsw + _i * 8192), 16, 0, 0); } while (0)
#define PG8_LDA(dst, b, h) do { _Pragma("unroll") for (int m = 0; m < 4; ++m) _Pragma("unroll") for (int k = 0; k < 2; ++k) dst[m][k] = *(const PG8_LAS bf16x8*)(lds + PG8_SA(b, h) + aoff + m * 2048 + k * 1024); } while (0)
#define PG8_LDB(dst, b, h) do { _Pragma("unroll") for (int n = 0; n < 2; ++n) _Pragma("unroll") for (int k = 0; k < 2; ++k) dst[n][k] = *(const PG8_LAS bf16x8*)(lds + PG8_SB(b, h) + boff + n * 2048 + k * 1024); } while (0)
#define PG8_MMA(ai, bj, At, Bt) do { __builtin_amdgcn_s_setprio(1); _Pragma("unroll") for (int m = 0; m < 4; ++m) _Pragma("unroll") for (int n = 0; n < 2; ++n) _Pragma("unroll") for (int k = 0; k < 2; ++k) \
        acc[ai][bj][m][n] = __builtin_amdgcn_mfma_f32_16x16x32_bf16(Bt[n][k], At[m][k], acc[ai][bj][m][n], 0, 0, 0); __builtin_amdgcn_s_setprio(0); } while (0)
#define PG8_WAIT_V(n) asm volatile("s_waitcnt vmcnt(" #n ")" ::: "memory")
#define PG8_WAIT_L(n) asm volatile("s_waitcnt lgkmcnt(" #n ")" ::: "memory")
#define PG8_BAR __builtin_amdgcn_s_barrier()
#define PG8_SCHED __builtin_amdgcn_sched_barrier(0)
    Unit cur, nxt; int ui = 0;
    if (!S.next(0, cur)) return;
    f32x4 acc[2][2][4][2];
#pragma unroll
    for (int a = 0; a < 2; ++a)
#pragma unroll
        for (int b = 0; b < 2; ++b)
#pragma unroll
            for (int m = 0; m < 4; ++m)
#pragma unroll
                for (int n = 0; n < 2; ++n) acc[a][b][m][n] = (f32x4){0.f, 0.f, 0.f, 0.f};
    bf16x8 At[4][2], B0[2][2], B1[2][2];
    const char* cA = (const char*)g.A + (size_t)cur.pm * tstep; const char* cB = (const char*)g.Bt + (size_t)cur.pn * tstep;
    S.a_ready(cur);
    if constexpr (SP2) {
        PG8_STAGE(PG8_SB(0, 0), cB, voffB); PG8_STAGE(PG8_SB(0, 1), cB + hstep, voffB); PG8_STAGE(PG8_SA(0, 0), cA, voffA); PG8_STAGE(PG8_SA(0, 1), cA + hstep, voffA);
        if (wr == 1) PG8_BAR;
        PG8_WAIT_V(2); PG8_BAR;
        PG8_STAGE(PG8_SB(1, 0), cB + kstep, voffB); PG8_STAGE(PG8_SA(1, 0), cA + kstep, voffA); PG8_STAGE(PG8_SB(1, 1), cB + hstep + kstep, voffB);
        PG8_WAIT_V(6); PG8_BAR;
    } else {
        PG8_STAGE(PG8_SB(0, 0), cB, voffB); PG8_STAGE(PG8_SA(0, 0), cA, voffA); PG8_STAGE(PG8_SB(0, 1), cB + hstep, voffB); PG8_STAGE(PG8_SA(0, 1), cA + hstep, voffA);
        if (wr == 1) PG8_BAR;
        PG8_WAIT_V(4); PG8_BAR;
        PG8_STAGE(PG8_SB(1, 0), cB + kstep, voffB); PG8_STAGE(PG8_SA(1, 0), cA + kstep, voffA); PG8_STAGE(PG8_SB(1, 1), cB + hstep + kstep, voffB);
        PG8_WAIT_V(6); PG8_BAR;
    }
    for (;;) {
        const bool has_next = S.next(ui + 1, nxt);
        const char* nA = has_next ? (const char*)g.A + (size_t)nxt.pm * tstep : cA; const char* nB = has_next ? (const char*)g.Bt + (size_t)nxt.pn * tstep : cB;
        for (int t = 0; t < nt; t += 2) {
            const bool last = (t == nt - 2);
            const char* a1 = cA + (size_t)(t + 1) * kstep;
            const char* a2 = last ? nA : cA + (size_t)(t + 2) * kstep; const char* b2 = last ? nB : cB + (size_t)(t + 2) * kstep;
            const char* a3 = a2 + kstep; const char* b3 = b2 + kstep;
            if (last && has_next) S.a_ready(nxt);
            if constexpr (SP2) {
            PG8_LDB(B0, 0, 0); PG8_LDB(B1, 0, 1); PG8_SCHED; PG8_LDA(At, 0, 0); PG8_STAGE(PG8_SA(1, 1), a1 + hstep, voffA);
            PG8_WAIT_V(8); PG8_WAIT_L(0); PG8_BAR; PG8_MMA(0, 0, At, B0); PG8_MMA(0, 1, At, B1); PG8_BAR; PG8_SCHED;
            PG8_LDA(At, 0, 1); PG8_STAGE(PG8_SB(0, 0), b2, voffB); PG8_STAGE(PG8_SB(0, 1), b2 + hstep, voffB); PG8_STAGE(PG8_SA(0, 0), a2, voffA);
            PG8_WAIT_V(8); PG8_WAIT_L(0); PG8_BAR; PG8_MMA(1, 0, At, B0); PG8_MMA(1, 1, At, B1); PG8_BAR; PG8_SCHED;
            PG8_LDB(B0, 1, 0); PG8_LDB(B1, 1, 1); PG8_SCHED; PG8_LDA(At, 1, 0); PG8_STAGE(PG8_SA(0, 1), a2 + hstep, voffA);
            PG8_WAIT_V(8); PG8_WAIT_L(0); PG8_BAR; PG8_MMA(0, 0, At, B0); PG8_MMA(0, 1, At, B1); PG8_BAR; PG8_SCHED;
            PG8_LDA(At, 1, 1); PG8_STAGE(PG8_SB(1, 0), b3, voffB); PG8_STAGE(PG8_SB(1, 1), b3 + hstep, voffB); PG8_STAGE(PG8_SA(1, 0), a3, voffA);
            PG8_WAIT_V(8); PG8_WAIT_L(0); PG8_BAR; PG8_MMA(1, 0, At, B0); PG8_MMA(1, 1, At, B1); PG8_BAR; PG8_SCHED;
            } else {
            PG8_LDB(B0, 0, 0); PG8_SCHED; PG8_LDA(At, 0, 0); PG8_STAGE(PG8_SA(1, 1), a1 + hstep, voffA);
            PG8_WAIT_L(8); PG8_BAR; PG8_WAIT_L(0); PG8_MMA(0, 0, At, B0); PG8_BAR; PG8_SCHED;
            PG8_LDB(B1, 0, 1); PG8_STAGE(PG8_SB(0, 0), b2, voffB);
            PG8_BAR; PG8_WAIT_L(0); PG8_MMA(0, 1, At, B1); PG8_BAR;
            PG8_LDA(At, 0, 1); PG8_STAGE(PG8_SA(0, 0), a2, voffA);
            PG8_BAR; PG8_WAIT_L(0); PG8_MMA(1, 0, At, B0); PG8_BAR; PG8_SCHED;
            PG8_STAGE(PG8_SB(0, 1), b2 + hstep, voffB);
            PG8_WAIT_V(6); PG8_BAR; PG8_MMA(1, 1, At, B1); PG8_BAR;
            PG8_LDB(B0, 1, 0); PG8_SCHED; PG8_LDA(At, 1, 0); PG8_STAGE(PG8_SA(0, 1), a2 + hstep, voffA);
            PG8_WAIT_L(8); PG8_BAR; PG8_WAIT_L(0); PG8_MMA(0, 0, At, B0); PG8_BAR; PG8_SCHED;
            PG8_LDB(B1, 1, 1); PG8_STAGE(PG8_SB(1, 0), b3, voffB);
            PG8_BAR; PG8_WAIT_L(0); PG8_MMA(0, 1, At, B1); PG8_BAR;
            PG8_LDA(At, 1, 1); PG8_STAGE(PG8_SA(1, 0), a3, voffA);
            PG8_BAR; PG8_WAIT_L(0); PG8_MMA(1, 0, At, B0); PG8_BAR; PG8_SCHED;
            PG8_STAGE(PG8_SB(1, 1), b3 + hstep, voffB);
            PG8_WAIT_V(6); PG8_BAR; PG8_MMA(1, 1, At, B1); PG8_BAR;
            }
        }
        if constexpr (ALIGN_EPI) { if (wr == 0) PG8_BAR; }
        if constexpr (!Epi::AFTER_DRAIN) { E(acc, cur, wr, wc, fr, fq); S.done(cur); }
        if (!has_next) break;
#pragma unroll
        for (int a = 0; a < 2; ++a)
#pragma unroll
            for (int b = 0; b < 2; ++b)
#pragma unroll
                for (int m = 0; m < 4; ++m)
#pragma unroll
                    for (int n = 0; n < 2; ++n) acc[a][b][m][n] = (f32x4){0.f, 0.f, 0.f, 0.f};
        cur = nxt; cA = nA; cB = nB; ++ui;
        if constexpr (ALIGN_EPI) { if (wr == 1) PG8_BAR; }
    }
    PG8_WAIT_V(0);
    if constexpr (!ALIGN_EPI) { if (wr == 0) PG8_BAR; }
    PG8_BAR;
    if constexpr (Epi::AFTER_DRAIN) { E.fused(acc, cur, wr, wc, fr, fq, lds, wid, lane); S.done(cur); }
#undef PG8_SA
#undef PG8_SB
#undef PG8_STAGE
#undef PG8_LDA
#undef PG8_LDB
#undef PG8_MMA
#undef PG8_WAIT_V
#undef PG8_WAIT_L
#undef PG8_BAR
#undef PG8_SCHED
}
}

#define DI __device__ __forceinline__
#define LAS __attribute__((address_space(3)))
typedef unsigned short bf16_t;
typedef short bf16x8 __attribute__((ext_vector_type(8)));
typedef short s16x4 __attribute__((ext_vector_type(4)));
typedef float f32x4 __attribute__((ext_vector_type(4)));
typedef float f32x2 __attribute__((ext_vector_type(2)));
typedef float f32x16 __attribute__((ext_vector_type(16)));
typedef unsigned u32x4 __attribute__((ext_vector_type(4)));
typedef unsigned u32x2 __attribute__((ext_vector_type(2)));
typedef __bf16 bf16x2_t __attribute__((ext_vector_type(2)));
#define MFMA32(a, b, c) __builtin_amdgcn_mfma_f32_32x32x16_bf16((a), (b), (c), 0, 0, 0)

constexpr int T = 49152, DM = 1024, NPROJ = 3072, NIN = 2960, DFF = 4096, HFF = 2048;
constexpr int C_R = 0, C_K = 256, C_V = 512, C_WD = 768, C_AD = 896, C_GD = 1024;
constexpr int C_AQ = 1152, C_AK = 1664, C_AV = 1792;
constexpr int C_MQ = 1920, C_MK = 2176, C_MV = 2432, C_MO = 2688, C_IG = 2944, C_FG = 2952;
constexpr size_t MiB = 1u << 20;
constexpr size_t WS_SS = 0, WS_CNT = MiB - 4096, WS_CDOT = 1 * MiB, WS_TAB = 2 * MiB + 512 * 1024, WS_BAR = 2 * MiB + 768 * 1024, WS_WIN = 3 * MiB, WS_WOUT = 15 * MiB,
                 WS_W1 = 19 * MiB, WS_W2 = 35 * MiB, WS_VT = 51 * MiB, WS_YB = 63 * MiB, WS_HBP = 87 * MiB, WS_X1 = 111 * MiB, WS_R = 207 * MiB,
                 WS_HID = WS_R + 96 * MiB, WS_END = 495 * MiB;
constexpr int LDS_BYTES = 134400 + 256;
constexpr int NTHR = 512;

struct KP { const float* in[26]; float* out; unsigned char* ws; };

DI unsigned cvtpk(float lo, float hi) { f32x2 v = {lo, hi}; bf16x2_t b = __builtin_convertvector(v, bf16x2_t); return __builtin_bit_cast(unsigned, b); }
DI unsigned short f2bf(float f) { return (unsigned short)(cvtpk(f, 0.f) & 0xffffu); }
DI float bf2f(unsigned h) { return __builtin_bit_cast(float, h << 16); }
DI float bflo(unsigned w) { return __builtin_bit_cast(float, w << 16); }
DI float bfhi(unsigned w) { return __builtin_bit_cast(float, w & 0xffff0000u); }
DI int crow(int reg, int h) { return (reg & 3) + 8 * (reg >> 2) + 4 * h; }
template <int CTRL> DI float dppf(float v) { return __builtin_bit_cast(float, __builtin_amdgcn_update_dpp(0, __builtin_bit_cast(int, v), CTRL, 0xf, 0xf, true)); }
DI float red8(float v) { v += dppf<0xB1>(v); v += dppf<0x4E>(v); v += dppf<0x141>(v); return v; }
DI float red16(float v) { v = red8(v); v += dppf<0x128>(v); return v; }
DI float frcp(float x) { return __builtin_amdgcn_rcpf(x); }
DI float sigmoidf_(float x) { return frcp(1.f + __expf(-x)); }
DI f32x16 zero16() { f32x16 z; for (int i = 0; i < 16; ++i) z[i] = 0.f; return z; }
DI void seq_of_job(int j, int& seq, int& h, int& dir) { if (j < 16) { seq = 8 + (j >> 3); } else { j -= 16; seq = j >> 3; } h = (j >> 1) & 3; dir = j & 1; }
DI void seq_info(int s, int& start, int& len) { if (s < 8) { start = s * 4096; len = 4096; } else { start = 32768 + (s - 8) * 8192; len = 8192; } }
DI int tok_seq_start(int tok, int& len) { if (tok < 32768) { len = 4096; return tok & ~4095; } len = 8192; return 32768 + ((tok - 32768) & ~8191); }

#define XB_TMO      128
#define XB_XCNT(j)  (256  + 64 * (j))
#define XB_XSUB(j)  (1280 + 64 * (j))
#define XB_XGEN(j)  (2304 + 64 * (j))
#define XB_TOP      3328
#define XB_TOPGEN   3392
#define XCD_BAR_WORDS 3456
#define XB_SPIN_CAP (1u << 18)

__device__ __forceinline__ unsigned xb_ld(unsigned* p)              { return __hip_atomic_load(p, __ATOMIC_RELAXED, __HIP_MEMORY_SCOPE_AGENT); }
__device__ __forceinline__ unsigned xb_add(unsigned* p, unsigned v) { return __hip_atomic_fetch_add(p, v, __ATOMIC_RELAXED, __HIP_MEMORY_SCOPE_AGENT); }
__device__ __forceinline__ unsigned xb_xcc_id() { return (unsigned)__builtin_amdgcn_s_getreg((3 << 11) | 20) & 0xFu; }
#define XB_SPIN(cond, bar) do { unsigned _sp = 0; while (cond) { __builtin_amdgcn_s_sleep(1); \
    if ((++_sp & 255u) == 0u) { if (xb_ld(&(bar)[XB_TMO])) break; if (_sp > XB_SPIN_CAP) { atomicAdd(&(bar)[XB_TMO], 1u); break; } } } } while (0)

struct XcdBarrier {
    unsigned* bar; unsigned x;
    volatile LAS unsigned* st;
};

__device__ __forceinline__ XcdBarrier xcd_barrier_post(unsigned* bar, volatile LAS unsigned* st) {
    XcdBarrier b; b.bar = bar; b.x = xb_xcc_id(); b.st = st;
    if (threadIdx.x == 0) (void)xb_add(&bar[XB_XCNT(b.x)], 1u);
    return b;
}
__device__ __forceinline__ void xcd_barrier_complete(unsigned* bar, unsigned x, unsigned& nloc, unsigned& nx) {
    const unsigned G = gridDim.x * gridDim.y * gridDim.z;
    unsigned sum, cnt, mine, sp = 0u;
    for (;;) {
        sum = 0u; cnt = 0u; mine = 0u;
#pragma unroll
        for (unsigned j = 0; j < 16; ++j) { const unsigned c = xb_ld(&bar[XB_XCNT(j)]); sum += c; cnt += (c > 0u) ? 1u : 0u; mine = (j == x) ? c : mine; }
        if (sum == G) break;
        __builtin_amdgcn_s_sleep(1);
        if ((++sp & 255u) == 0u) { if (xb_ld(&bar[XB_TMO])) break; if (sp > XB_SPIN_CAP) { atomicAdd(&bar[XB_TMO], 1u); break; } }
    }
    nloc = mine > 0u ? mine : 1u; nx = cnt > 0u ? cnt : 1u;
}

__device__ __forceinline__ void xcd_barrier(const XcdBarrier& b) {
    asm volatile("s_waitcnt vmcnt(0)" ::: "memory");
    __syncthreads();
    if (threadIdx.x == 0) {
        unsigned* bar = b.bar;
        __builtin_amdgcn_s_waitcnt(0);
        unsigned nloc = b.st[0], nx = b.st[1];
        if (nloc == 0u) { xcd_barrier_complete(bar, b.x, nloc, nx); b.st[0] = nloc; b.st[1] = nx; }
        const unsigned old = xb_add(&bar[XB_XSUB(b.x)], 1u);
        const unsigned gen = old / nloc;
        if (old + 1u == (gen + 1u) * nloc) {
            __builtin_amdgcn_fence(__ATOMIC_RELEASE, "agent");
            asm volatile("s_waitcnt vmcnt(0)" ::: "memory");
            const unsigned og = xb_add(&bar[XB_TOP], 1u);
            const unsigned tg = og / nx;
            if (og + 1u == (tg + 1u) * nx) xb_add(&bar[XB_TOPGEN], 1u);
            else XB_SPIN(xb_ld(&bar[XB_TOPGEN]) == tg, bar);
            __builtin_amdgcn_fence(__ATOMIC_ACQUIRE, "agent");
            xb_add(&bar[XB_XGEN(b.x)], 1u);
            asm volatile("s_waitcnt vmcnt(0)" ::: "memory");
        } else {
            XB_SPIN(xb_ld(&bar[XB_XGEN(b.x)]) == gen, bar);
            __builtin_amdgcn_fence(__ATOMIC_ACQUIRE, "agent");
            asm volatile("s_waitcnt vmcnt(0)" ::: "memory");
        }
    }
    __syncthreads();
}

struct EpiProj {
    static constexpr bool PERM = true, AFTER_DRAIN = false;
    bf16_t* O; const float* ss;
    DI void operator()(const pg8::f32x4 (&acc)[2][2][4][2], const pg8::Unit& u, int wr, int wc, int fr, int fq) const {
        const int row0 = u.pm * 256 + wr * 64 + fr, col0 = u.pn * 256 + wc * 32 + 8 * fq;
#pragma unroll
        for (int ai = 0; ai < 2; ++ai)
#pragma unroll
            for (int m = 0; m < 4; ++m) {
                const int row = row0 + ai * 128 + m * 16;
                const float rs = rsqrtf(ss[row] * (1.f / 1024.f) + 1e-6f);
                bf16_t* rp = O + (size_t)row * NPROJ + col0;
#pragma unroll
                for (int bj = 0; bj < 2; ++bj) {
                    pg8::f32x4 v0 = acc[ai][bj][m][0] * rs, v1 = acc[ai][bj][m][1] * rs;
                    u32x4 w; w.x = cvtpk(v0[0], v0[1]); w.y = cvtpk(v0[2], v0[3]); w.z = cvtpk(v1[0], v1[1]); w.w = cvtpk(v1[2], v1[3]);
                    *(u32x4*)(rp + bj * 128) = w;
                }
            }
    }
};
struct EpiRelu2 {
    static constexpr bool PERM = true, AFTER_DRAIN = false;
    bf16_t* O; const float* ss;
    DI void operator()(const pg8::f32x4 (&acc)[2][2][4][2], const pg8::Unit& u, int wr, int wc, int fr, int fq) const {
        const int row0 = u.pm * 256 + wr * 64 + fr, col0 = u.pn * 256 + wc * 32 + 8 * fq;
#pragma unroll
        for (int ai = 0; ai < 2; ++ai)
#pragma unroll
            for (int m = 0; m < 4; ++m) {
                const int row = row0 + ai * 128 + m * 16;
                const float rs = rsqrtf(ss[row] * (1.f / 1024.f) + 1e-6f);
                bf16_t* rp = O + (size_t)row * HFF + col0;
#pragma unroll
                for (int bj = 0; bj < 2; ++bj) {
                    pg8::f32x4 v0 = acc[ai][bj][m][0] * rs, v1 = acc[ai][bj][m][1] * rs;
#pragma unroll
                    for (int j = 0; j < 4; ++j) { float a = fmaxf(v0[j], 0.f); v0[j] = a * a; float b = fmaxf(v1[j], 0.f); v1[j] = b * b; }
                    u32x4 w; w.x = cvtpk(v0[0], v0[1]); w.y = cvtpk(v0[2], v0[3]); w.z = cvtpk(v1[0], v1[1]); w.w = cvtpk(v1[2], v1[3]);
                    *(u32x4*)(rp + bj * 128) = w;
                }
            }
    }
};
struct EpiPart {
    static constexpr bool PERM = true, AFTER_DRAIN = false;
    bf16_t* O;
    DI void operator()(const pg8::f32x4 (&acc)[2][2][4][2], const pg8::Unit& u, int wr, int wc, int fr, int fq) const {
        const int row0 = u.pm * 256 + wr * 64 + fr, col0 = u.pn * 256 + wc * 32 + 8 * fq;
#pragma unroll
        for (int ai = 0; ai < 2; ++ai)
#pragma unroll
            for (int m = 0; m < 4; ++m) {
                bf16_t* rp = O + (size_t)(row0 + ai * 128 + m * 16) * DM + col0;
#pragma unroll
                for (int bj = 0; bj < 2; ++bj) {
                    const pg8::f32x4 v0 = acc[ai][bj][m][0], v1 = acc[ai][bj][m][1];
                    u32x4 w; w.x = cvtpk(v0[0], v0[1]); w.y = cvtpk(v0[2], v0[3]); w.z = cvtpk(v1[0], v1[1]); w.w = cvtpk(v1[2], v1[3]);
                    *(u32x4*)(rp + bj * 128) = w;
                }
            }
    }
};
template <bool WRITE_HB, bool DO_SS, bool FIRST = false, bool PART = false> struct EpiRes {
    static constexpr bool PERM = true, AFTER_DRAIN = false;
    float* X; bf16_t* HB; float* ss; const float* xin0; const float* xin1;
    DI void operator()(const pg8::f32x4 (&acc)[2][2][4][2], const pg8::Unit& u, int wr, int wc, int fr, int fq) const {
        const int row0 = u.pm * 256 + wr * 64 + fr, col0 = u.pn * 256 + wc * 32 + 8 * fq;
#pragma unroll
        for (int ai = 0; ai < 2; ++ai)
#pragma unroll
            for (int m = 0; m < 4; ++m) {
                const int row = row0 + ai * 128 + m * 16;
                float* xp = X + (size_t)row * DM + col0;
                const float* rp = FIRST ? ((row < 32768 ? xin0 + (size_t)row * DM : xin1 + (size_t)(row - 32768) * DM) + col0) : xp;
                float sq = 0.f;
#pragma unroll
                for (int bj = 0; bj < 2; ++bj) {
                    pg8::f32x4 a0 = *(const pg8::f32x4*)(rp + bj * 128), a1 = *(const pg8::f32x4*)(rp + bj * 128 + 4);
                    a0 += acc[ai][bj][m][0]; a1 += acc[ai][bj][m][1];
                    if (PART) { const u32x4 pw = *(const u32x4*)(HB + (size_t)row * DM + col0 + bj * 128);
                        a0[0] += bflo(pw.x); a0[1] += bfhi(pw.x); a0[2] += bflo(pw.y); a0[3] += bfhi(pw.y); a1[0] += bflo(pw.z); a1[1] += bfhi(pw.z); a1[2] += bflo(pw.w); a1[3] += bfhi(pw.w); }
                    *(pg8::f32x4*)(xp + bj * 128) = a0; *(pg8::f32x4*)(xp + bj * 128 + 4) = a1;
                    if (WRITE_HB) { u32x4 w; w.x = cvtpk(a0[0], a0[1]); w.y = cvtpk(a0[2], a0[3]); w.z = cvtpk(a1[0], a1[1]); w.w = cvtpk(a1[2], a1[3]);
                        *(u32x4*)(HB + (size_t)row * DM + col0 + bj * 128) = w; }
                    if (DO_SS) sq += a0[0] * a0[0] + a0[1] * a0[1] + a0[2] * a0[2] + a0[3] * a0[3] + a1[0] * a1[0] + a1[1] * a1[1] + a1[2] * a1[2] + a1[3] * a1[3];
                }
                if (DO_SS) { sq += __shfl_xor(sq, 16); sq += __shfl_xor(sq, 32); if (fq == 0) atomicAdd(ss + row, sq); }
            }
    }
};

DI void transpose_tile(const float* src, int N, int nvalid, const float* gain, bf16_t* dst, int K, int kt, int nt, LAS float* tile, int tid) {
    const int a = tid & 63, b8 = tid >> 6;
#pragma unroll
    for (int i = 0; i < 8; ++i) { const int k = b8 + 8 * i, n = nt * 64 + a; float v = (n < nvalid) ? src[(size_t)(kt * 64 + k) * N + n] : 0.f; if (gain) v *= gain[kt * 64 + k]; tile[k * 65 + a] = v; }
    __syncthreads();
#pragma unroll
    for (int i = 0; i < 8; ++i) { const int n = b8 + 8 * i; dst[(size_t)(nt * 64 + n) * K + kt * 64 + a] = f2bf(tile[a * 65 + n]); }
    __syncthreads();
}
DI void convert_tile(const KP& p, int it, LAS float* tile, int tid) {
    {
        const int l = it / 3072; int r = it % 3072;
        const float* src; const float* gain; bf16_t* dst; int N, nvalid, K, kt, nt;
        if (r < 768) { src = p.in[3] + (size_t)l * 1024 * NIN; N = NIN; nvalid = NIN; K = 1024; gain = p.in[2] + l * 1024; dst = (bf16_t*)(p.ws + WS_WIN) + (size_t)l * NPROJ * 1024; kt = r / 48; nt = r % 48; }
        else if (r < 1024) { r -= 768; src = p.in[21] + (size_t)l * 1024 * 1024; N = 1024; nvalid = 1024; K = 1024; gain = nullptr; dst = (bf16_t*)(p.ws + WS_WOUT) + (size_t)l * 1024 * 1024; kt = r / 16; nt = r % 16; }
        else if (r < 2048) { r -= 1024; src = p.in[23] + (size_t)l * 1024 * 4096; N = 4096; nvalid = 4096; K = 1024; gain = p.in[22] + l * 1024; dst = (bf16_t*)(p.ws + WS_W1) + (size_t)l * 4096 * 1024; kt = r / 64; nt = r % 64; }
        else { r -= 2048; const int h = r / 512; r %= 512; src = p.in[24] + (size_t)l * 4096 * 1024 + (size_t)h * 2048 * 1024; N = 1024; nvalid = 1024; K = 2048; gain = nullptr;
               dst = (bf16_t*)(p.ws + WS_W2) + (size_t)l * 2 * 1024 * 2048 + (size_t)h * 1024 * 2048; kt = r / 16; nt = r % 16; }
        transpose_tile(src, N, nvalid, gain, dst, K, kt, nt, tile, tid);
    }
}
DI void p0_phase(const KP& p, LAS unsigned char* lds, int tid, int G, int bid) {
    LAS float* tile = (LAS float*)lds;
    for (int it = bid; it < 768; it += G) convert_tile(p, it, tile, tid);
    const int wave = tid >> 6, lane = tid & 63;
    float* ss = (float*)(p.ws + WS_SS);
    bf16_t* xb = (bf16_t*)(p.ws + WS_X1);
    for (int row0 = (bid * 8 + wave) * 2; row0 < T; row0 += G * 8 * 2) {
        f32x4 v[2][4];
#pragma unroll
        for (int r = 0; r < 2; ++r) {
            const int row = row0 + r;
            const float* xs = (row < 32768) ? p.in[0] + (size_t)row * DM : p.in[1] + (size_t)(row - 32768) * DM;
#pragma unroll
            for (int j = 0; j < 4; ++j) v[r][j] = *(const f32x4*)(xs + (j * 64 + lane) * 4);
        }
#pragma unroll
        for (int r = 0; r < 2; ++r) {
            const int row = row0 + r;
            float sq = 0.f;
#pragma unroll
            for (int j = 0; j < 4; ++j) {
                const f32x4 x = v[r][j];
                u32x2 w; w.x = cvtpk(x[0], x[1]); w.y = cvtpk(x[2], x[3]);
                *(u32x2*)(xb + (size_t)row * DM + (j * 64 + lane) * 4) = w;
                sq += x[0] * x[0] + x[1] * x[1] + x[2] * x[2] + x[3] * x[3];
            }
#pragma unroll
            for (int o = 32; o >= 1; o >>= 1) sq += __shfl_xor(sq, o);
            if (lane == 0) ss[row] = sq;
        }
    }
    for (int i = bid * NTHR + tid; i < 4 * T; i += G * NTHR) ss[T + i] = 0.f;
    if (bid == 0) {
        if (tid < 64) ((unsigned*)(p.ws + WS_CNT))[tid] = 0u;
        float2* tab = (float2*)(p.ws + WS_TAB);
        for (int idx = tid; idx < 2048; idx += NTHR) { const int pos = idx >> 4, f = idx & 15; const float inv = powf(10000.f, -(float)f / 16.f); const float ang = (float)pos * inv; tab[idx] = make_float2(cosf(ang), sinf(ang)); }
    }
}

DI void prep_phase(const KP& p, int l, LAS unsigned char* lds, int tid, int G, int bid) {
    bf16_t* proj = (bf16_t*)(p.ws + WS_R);
    bf16_t* vT = (bf16_t*)(p.ws + WS_VT);
    const float2* tab = (const float2*)(p.ws + WS_TAB);
    const float* qn = p.in[15] + l * 64; const float* kn = p.in[16] + l * 64;
    const int wave = tid >> 6, lane = tid & 63, g = lane >> 4, li = lane & 15;
    LAS bf16_t* vts = (LAS bf16_t*)lds;
    for (int unit = bid; unit < T / 64; unit += G) {
        const int tok0 = unit * 64;
        u32x2 raw[8][3];
#pragma unroll
        for (int i = 0; i < 8; ++i) {
            const int tok = tok0 + wave * 8 + i;
#pragma unroll
            for (int it = 0; it < 3; ++it) {
                const int colbase = (it < 2) ? C_AQ + (it * 4 + g) * 64 : C_AK + (g & 1) * 64;
                raw[i][it] = *(const u32x2*)(proj + (size_t)tok * NPROJ + colbase + li * 4);
            }
        }
#pragma unroll
        for (int i = 0; i < 8; ++i) {
            const int tok = tok0 + wave * 8 + i; int len; const int st = tok_seq_start(tok, len); const int pos = tok - st; const int prow = pos >> 6, pcol = pos & 63;
#pragma unroll
            for (int it = 0; it < 3; ++it) {
                const bool act = (it < 2) || (g < 2);
                const int colbase = (it < 2) ? C_AQ + (it * 4 + g) * 64 : C_AK + (g & 1) * 64;
                const float* wn = (it < 2) ? qn : kn;
                bf16_t* ptr = proj + (size_t)tok * NPROJ + colbase + li * 4;
                const u32x2 rw = raw[i][it];
                float x[4] = {bflo(rw.x), bfhi(rw.x), bflo(rw.y), bfhi(rw.y)};
                float sq = x[0] * x[0] + x[1] * x[1] + x[2] * x[2] + x[3] * x[3];
                sq = red16(sq);
                const float rinv = rsqrtf(sq * (1.f / 64.f) + 1e-6f);
                const f32x4 w4 = *(const f32x4*)(wn + li * 4);
                const int idx = (li >> 3) ? pcol : prow; const bool second = (li >> 2) & 1;
                const float scale = (it < 2) ? 0.125f * 1.4426950408889634f : 1.f;
                float o[4];
#pragma unroll
                for (int j = 0; j < 4; ++j) {
                    const float y = x[j] * rinv * w4[j];
                    const float pr = __shfl_xor(y, 4);
                    const int f = (li * 4 + j) & 15;
                    const float2 cs = tab[idx * 16 + f];
                    o[j] = (second ? (y * cs.x + pr * cs.y) : (y * cs.x - pr * cs.y)) * scale;
                }
                if (act) { u32x2 w; w.x = cvtpk(o[0], o[1]); w.y = cvtpk(o[2], o[3]); *(u32x2*)ptr = w; }
            }
        }
#pragma unroll
        for (int i = 0; i < 2; ++i) { const int idx = tid + NTHR * i; const int tl = idx >> 4, c8 = (idx & 15) * 8;
            const u32x4 v = *(const u32x4*)(proj + (size_t)(tok0 + tl) * NPROJ + C_AV + c8); *(LAS u32x4*)(vts + tl * 136 + c8) = v; }
        __syncthreads();
        { const int c = tid >> 2, tq = tid & 3; unsigned w[8];
#pragma unroll
          for (int j = 0; j < 8; ++j) { const unsigned lo = vts[(tq * 16 + 2 * j) * 136 + c], hi = vts[(tq * 16 + 2 * j + 1) * 136 + c]; w[j] = lo | (hi << 16); }
          u32x4 a = {w[0], w[1], w[2], w[3]}, b = {w[4], w[5], w[6], w[7]};
          bf16_t* dp = vT + (size_t)c * T + tok0 + tq * 16; *(u32x4*)dp = a; *(u32x4*)(dp + 8) = b; }
        __syncthreads();
    }
}

DI void attn_unit(const KP& p, int l, int unit, LAS unsigned char* lds, int tid) {
    const float* qnw = p.in[15] + l * 64; const float* knw = p.in[16] + l * 64;
    const bf16_t* proj = (const bf16_t*)(p.ws + WS_R);
    const bf16_t* vT = (const bf16_t*)(p.ws + WS_VT);
    bf16_t* mix = (bf16_t*)(p.ws + WS_X1);
    int seq, kvh, qt;
    if (unit < 512) { seq = 8 + (unit >> 8); const int r = unit & 255; kvh = r >> 7; qt = r & 127; }
    else { const int u2 = unit - 512; seq = u2 >> 7; const int r = u2 & 127; kvh = r >> 6; qt = r & 63; }
    int start, len; seq_info(seq, start, len);
    const int nk = len >> 6;
    const int wave = tid >> 6, lane = tid & 63, r32 = lane & 31, hh = lane >> 5;
    const int head = kvh * 4 + (wave >> 1);
    const int q0 = start + qt * 64 + (wave & 1) * 32;
    bf16x8 qf[4];
    { const bf16_t* qp = proj + (size_t)(q0 + r32) * NPROJ + C_AQ + head * 64 + hh * 8;
#pragma unroll
      for (int ks = 0; ks < 4; ++ks) qf[ks] = *(const bf16x8*)(qp + ks * 16); }
    f32x16 o0 = zero16(), o1 = zero16();
    float lsum = 0.f;
    f32x16 sinit;
    { float mq = fabsf(qnw[lane]), mk = fabsf(knw[lane]);
#pragma unroll
      for (int o = 32; o >= 1; o >>= 1) { mq = fmaxf(mq, __shfl_xor(mq, o)); mk = fmaxf(mk, __shfl_xor(mk, o)); }
      const float bnd = 64.f * 0.125f * 1.4426950408889634f * 1.01f * mq * mk;
#pragma unroll
      for (int i = 0; i < 16; ++i) sinit[i] = -bnd; }
    const int lrow = tid >> 3, lseg = tid & 7;
    const bf16_t* kptr = proj + (size_t)(start + lrow) * NPROJ + C_AK + kvh * 64 + lseg * 8;
    const bf16_t* vptr = vT + (size_t)(kvh * 64 + lrow) * T + start + lseg * 8;
    const int lds_off = lrow * 144 + lseg * 16;
    u32x4 kreg = *(const u32x4*)kptr, vreg = *(const u32x4*)vptr;
    *(LAS u32x4*)(lds + lds_off) = kreg; *(LAS u32x4*)(lds + 9216 + lds_off) = vreg;
    kreg = *(const u32x4*)(kptr + (size_t)64 * NPROJ); vreg = *(const u32x4*)(vptr + 64);
    u32x4 kreg2 = kreg, vreg2 = vreg;
    __syncthreads();
    for (int j = 0; j < nk; ++j) {
        const bool more = (j + 1 < nk);
        if (j + 2 < nk) { kreg2 = *(const u32x4*)(kptr + (size_t)(j + 2) * 64 * NPROJ); vreg2 = *(const u32x4*)(vptr + (j + 2) * 64); }
        LAS unsigned char* Ks = lds + (j & 1) * 18432; LAS unsigned char* Vs = Ks + 9216;
        f32x16 s0 = sinit, s1 = sinit;
#pragma unroll
        for (int ks = 0; ks < 4; ++ks) {
            const bf16x8 a0 = *(const LAS bf16x8*)(Ks + r32 * 144 + (ks * 16 + hh * 8) * 2);
            const bf16x8 a1 = *(const LAS bf16x8*)(Ks + (32 + r32) * 144 + (ks * 16 + hh * 8) * 2);
            s0 = MFMA32(a0, qf[ks], s0); s1 = MFMA32(a1, qf[ks], s1);
        }
        float rs = 0.f;
#pragma unroll
        for (int i = 0; i < 16; ++i) { s0[i] = __builtin_amdgcn_exp2f(s0[i]); rs += s0[i]; }
#pragma unroll
        for (int i = 0; i < 16; ++i) { s1[i] = __builtin_amdgcn_exp2f(s1[i]); rs += s1[i]; }
        lsum += rs;
#pragma unroll
        for (int mb = 0; mb < 2; ++mb)
#pragma unroll
            for (int s = 0; s < 2; ++s) {
                u32x4 pk;
                if (mb == 0) { pk.x = cvtpk(s0[8 * s], s0[8 * s + 1]); pk.y = cvtpk(s0[8 * s + 2], s0[8 * s + 3]); pk.z = cvtpk(s0[8 * s + 4], s0[8 * s + 5]); pk.w = cvtpk(s0[8 * s + 6], s0[8 * s + 7]); }
                else         { pk.x = cvtpk(s1[8 * s], s1[8 * s + 1]); pk.y = cvtpk(s1[8 * s + 2], s1[8 * s + 3]); pk.z = cvtpk(s1[8 * s + 4], s1[8 * s + 5]); pk.w = cvtpk(s1[8 * s + 6], s1[8 * s + 7]); }
                const bf16x8 pb = __builtin_bit_cast(bf16x8, pk);
                const int keyoff = 32 * mb + 16 * s + 4 * hh;
                { const s16x4 lo = *(const LAS s16x4*)(Vs + r32 * 144 + keyoff * 2), hi = *(const LAS s16x4*)(Vs + r32 * 144 + (keyoff + 8) * 2);
                  const bf16x8 va = __builtin_shufflevector(lo, hi, 0, 1, 2, 3, 4, 5, 6, 7); o0 = MFMA32(va, pb, o0); }
                { const s16x4 lo = *(const LAS s16x4*)(Vs + (32 + r32) * 144 + keyoff * 2), hi = *(const LAS s16x4*)(Vs + (32 + r32) * 144 + (keyoff + 8) * 2);
                  const bf16x8 va = __builtin_shufflevector(lo, hi, 0, 1, 2, 3, 4, 5, 6, 7); o1 = MFMA32(va, pb, o1); }
            }
        if (more) { LAS unsigned char* Kn = lds + ((j + 1) & 1) * 18432; *(LAS u32x4*)(Kn + lds_off) = kreg; *(LAS u32x4*)(Kn + 9216 + lds_off) = vreg; }
        asm volatile("s_waitcnt lgkmcnt(0)\n\ts_barrier" ::: "memory");
        kreg = kreg2; vreg = vreg2;
    }
    lsum += __shfl_xor(lsum, 32);
    const float inv = 1.f / lsum;
    bf16_t* op = mix + (size_t)(q0 + r32) * DM + 256 + head * 64;
#pragma unroll
    for (int g4 = 0; g4 < 4; ++g4) {
        u32x2 w0; w0.x = cvtpk(o0[4 * g4] * inv, o0[4 * g4 + 1] * inv); w0.y = cvtpk(o0[4 * g4 + 2] * inv, o0[4 * g4 + 3] * inv);
        *(u32x2*)(op + 8 * g4 + 4 * hh) = w0;
        u32x2 w1; w1.x = cvtpk(o1[4 * g4] * inv, o1[4 * g4 + 1] * inv); w1.y = cvtpk(o1[4 * g4 + 2] * inv, o1[4 * g4 + 3] * inv);
        *(u32x2*)(op + 32 + 8 * g4 + 4 * hh) = w1;
    }
}

constexpr int RW_BUF = 49152, RW_XR = 0, RW_XKD = 8192, RW_XV = 16384, RW_WLW = 24576, RW_ALB = 32768, RW_KKN = 40960, RW_YO = 98304, RW_XWD = 106496, RW_XAD = 111104,
              RW_W2T = 115712, RW_A2T = 124928, RW_CD = 134144, SLOT_OFF = 134400;
#define RW_BAR() asm volatile("s_waitcnt lgkmcnt(0)\n\ts_barrier" ::: "memory")
#define RW_DECODE(i_) const int t = (pt >> 4) + 16 * ((i_) / 5), c4 = (pt & 15) * 4; constexpr int gi = (i_) % 5; \
            const int col = (gi == 0) ? C_R + h * 64 + c4 : (gi == 1) ? C_K + h * 64 + c4 : (gi == 2) ? C_V + h * 64 + c4 : (gi == 3) ? C_WD + dir * 64 + c4 : C_AD + dir * 64 + c4;
#define RW_ISSUE1(chx, i_) { const int t = (pt >> 4) + 16 * ((i_) / 5); \
            const int n = (chx) * 32 + t; const int pos = dir ? (len - 1 - n) : n; \
            const bf16_t* bp = bq[i_]; bq[i_] = bp + bstep; \
            rc[i_] = *(const u32x2*)bp; rp_[i_] = (u32x2){0u, 0u}; rn[i_] = (u32x2){0u, 0u}; \
            if (pos > 0) rp_[i_] = *(const u32x2*)(bp - NPROJ); \
            if (pos < len - 1) rn[i_] = *(const u32x2*)(bp + NPROJ); }
#define RW_ISSUE(chx) do { RW_ISSUE1(chx, 0) RW_ISSUE1(chx, 1) RW_ISSUE1(chx, 2) RW_ISSUE1(chx, 3) RW_ISSUE1(chx, 4) RW_ISSUE1(chx, 5) RW_ISSUE1(chx, 6) RW_ISSUE1(chx, 7) RW_ISSUE1(chx, 8) RW_ISSUE1(chx, 9) } while (0)
#define RW_ISSUEM1(i_) { const bf16_t* bp = bq[i_]; bq[i_] = bp + bstep; \
            rc[i_] = *(const u32x2*)bp; rp_[i_] = *(const u32x2*)(bp - NPROJ); rn[i_] = *(const u32x2*)(bp + NPROJ); }
#define RW_ISSUE_MID() do { RW_ISSUEM1(0) RW_ISSUEM1(1) RW_ISSUEM1(2) RW_ISSUEM1(3) RW_ISSUEM1(4) RW_ISSUEM1(5) RW_ISSUEM1(6) RW_ISSUEM1(7) RW_ISSUEM1(8) RW_ISSUEM1(9) } while (0)
#define RW_CONV1(i_) { RW_DECODE(i_) \
            const f32x4 m4 = mureg[gi]; \
            f32x4 x = {bflo(rc[i_].x), bfhi(rc[i_].x), bflo(rc[i_].y), bfhi(rc[i_].y)}; \
            const f32x4 pn = {bflo(rp_[i_].x) + bflo(rn[i_].x), bfhi(rp_[i_].x) + bfhi(rn[i_].x), bflo(rp_[i_].y) + bflo(rn[i_].y), bfhi(rp_[i_].y) + bfhi(rn[i_].y)}; \
            x = x + (0.5f * pn - x) * m4; \
            if (gi < 3) { LAS float* dst = (gi == 0) ? XR : (gi == 1) ? XKD : XV; *(LAS f32x4*)(dst + t * 64 + c4) = x; } \
            else if (gi == 3) { \
                _Pragma("unroll") for (int j = 0; j < 4; ++j) { const float e = __expf(2.f * x[j]); x[j] = 1.f - 2.f * frcp(e + 1.f); } \
                u32x2 w; w.x = cvtpk(x[0], x[1]); w.y = cvtpk(x[2], x[3]); *(LAS u32x2*)(XWD + t * 72 + c4) = w; } \
            else { u32x2 w; w.x = cvtpk(x[0], x[1]); w.y = cvtpk(x[2], x[3]); *(LAS u32x2*)(XAD + t * 72 + c4) = w; } }
DI void rwkv_job(const KP& p, int l, int job, LAS unsigned char* lds, int tid) {
    int seq, h, dir, rpart; constexpr int nrows = 32;
    { int j = job; if (j < 32) { seq = 8 + (j >> 4); } else { j -= 32; seq = j >> 4; } h = (j >> 2) & 3; dir = (j >> 1) & 1; rpart = j & 1; }
    int start, len; seq_info(seq, start, len);
    const bf16_t* proj = (const bf16_t*)(p.ws + WS_R);
    bf16_t* mix = (bf16_t*)(p.ws + WS_X1);
    bf16_t* yb = (bf16_t*)(p.ws + WS_YB);
    float* cdot = (float*)(p.ws + WS_CDOT);
    const float* mu = p.in[4] + l * 1152;
    const int wave = tid >> 6, lane = tid & 63, r32 = lane & 31, hh = lane >> 5;
    LAS bf16_t* XWD = (LAS bf16_t*)(lds + RW_XWD); LAS bf16_t* XAD = (LAS bf16_t*)(lds + RW_XAD);
    LAS bf16_t* W2T = (LAS bf16_t*)(lds + RW_W2T); LAS bf16_t* A2T = (LAS bf16_t*)(lds + RW_A2T);
    { const float* w2 = p.in[6] + (size_t)((l * 2 + dir) * 64) * 256 + h * 64; const float* a2 = p.in[8] + (size_t)((l * 2 + dir) * 64) * 256 + h * 64;
#pragma unroll
      for (int i = 0; i < 8; ++i) { const int idx = tid + NTHR * i; const int mm = idx >> 6, c = idx & 63; W2T[c * 72 + mm] = f2bf(w2[mm * 256 + c]); A2T[c * 72 + mm] = f2bf(a2[mm * 256 + c]); } }
    const int nch = len >> 5;
    __syncthreads();
    if (tid < 256) {
        const int srow = tid >> 3, sj = (tid & 7) * 8;
        f32x4 Sa = {0.f, 0.f, 0.f, 0.f}, Sb = {0.f, 0.f, 0.f, 0.f};
        RW_BAR(); RW_BAR(); RW_BAR();
#define RW_LD(dst, arr, tt) const f32x4 dst##a = *(const LAS f32x4*)((arr) + (tt) * 64 + sj), dst##b = *(const LAS f32x4*)((arr) + (tt) * 64 + sj + 4)
        for (int ch = 0; ch < nch; ++ch) {
            LAS unsigned char* B = lds + (ch & 1) * RW_BUF;
            LAS float* XR = (LAS float*)(B + RW_XR); LAS float* XKD = (LAS float*)(B + RW_XKD); LAS float* XV = (LAS float*)(B + RW_XV);
            LAS float* WLW = (LAS float*)(B + RW_WLW); LAS float* ALB = (LAS float*)(B + RW_ALB); LAS float* KKN = (LAS float*)(B + RW_KKN);
            LAS float* YO = (LAS float*)(lds + RW_YO + (ch & 1) * 4096);
            f32x4 wa = *(const LAS f32x4*)(WLW + sj), wb = *(const LAS f32x4*)(WLW + sj + 4), ka = *(const LAS f32x4*)(KKN + sj), kb = *(const LAS f32x4*)(KKN + sj + 4);
            f32x4 ba = *(const LAS f32x4*)(ALB + sj), bb = *(const LAS f32x4*)(ALB + sj + 4), da = *(const LAS f32x4*)(XKD + sj), db = *(const LAS f32x4*)(XKD + sj + 4);
            f32x4 ra = *(const LAS f32x4*)(XR + sj), rb = *(const LAS f32x4*)(XR + sj + 4);
            float v = XV[rpart * 32 + srow];
#pragma unroll 2
            for (int t = 0; t < 32; ++t) {
                const int tn = (t < 31) ? t + 1 : 31;
                RW_LD(wn, WLW, tn); RW_LD(kn, KKN, tn); RW_LD(bn, ALB, tn); RW_LD(dn, XKD, tn); RW_LD(rn_, XR, tn);
                const float vn = XV[tn * 64 + rpart * 32 + srow];
                const f32x4 pa = Sa * ka + Sb * kb;
                float sa = (pa[0] + pa[1]) + (pa[2] + pa[3]);
                sa = -red8(sa);
                Sa = Sa * wa + sa * ba + v * da;
                Sb = Sb * wb + sa * bb + v * db;
                const f32x4 py = Sa * ra + Sb * rb;
                float y = (py[0] + py[1]) + (py[2] + py[3]);
                y = red8(y);
                if ((tid & 7) == 0) YO[t * 32 + srow] = y;
                wa = wna; wb = wnb; ka = kna; kb = knb; ba = bna; bb = bnb; da = dna; db = dnb; ra = rn_a; rb = rn_b; v = vn;
                if (t == 19 || t == 23) RW_BAR();
            }
            RW_BAR();
        }
    } else {
        const int ptid = tid - 256;
        const int cli = ptid & 15, cc4 = cli * 4;
        const f32x4 w0v = *(const f32x4*)(p.in[5] + (l * 2 + dir) * 256 + h * 64 + cc4);
        const f32x4 a0v = *(const f32x4*)(p.in[7] + (l * 2 + dir) * 256 + h * 64 + cc4);
        const f32x4 kkw = *(const f32x4*)(p.in[10] + l * 256 + h * 64 + cc4);
        const f32x4 kaw = *(const f32x4*)(p.in[11] + l * 256 + h * 64 + cc4);
        const f32x4 rkw = *(const f32x4*)(p.in[12] + l * 256 + h * 64 + cc4);
        u32x2 rc[10], rp_[10], rn[10];
        const bf16_t* bq[10];
        const long bstep = dir ? -(long)32 * NPROJ : (long)32 * NPROJ;
#define RW_BQ(i_) { const int pt = ptid; RW_DECODE(i_) const int pos = dir ? (len - 1 - t) : t; bq[i_] = proj + (size_t)(start + pos) * NPROJ + col; }
        RW_BQ(0) RW_BQ(1) RW_BQ(2) RW_BQ(3) RW_BQ(4) RW_BQ(5) RW_BQ(6) RW_BQ(7) RW_BQ(8) RW_BQ(9)
        f32x4 mureg[5];
        { const int c4 = (ptid & 15) * 4;
          mureg[0] = *(const f32x4*)(mu + C_R + h * 64 + c4); mureg[1] = *(const f32x4*)(mu + C_K + h * 64 + c4); mureg[2] = *(const f32x4*)(mu + C_V + h * 64 + c4);
          mureg[3] = *(const f32x4*)(mu + C_WD + dir * 64 + c4); mureg[4] = *(const f32x4*)(mu + C_AD + dir * 64 + c4); }
        { int pt = ptid; RW_ISSUE(0); }
        for (int ch = -1; ch < nch; ++ch) {
            int pt = ptid; asm volatile("" : "+v"(pt));
            if (ch >= 1) {
                const int pc = ch - 1;
                LAS float* YO = (LAS float*)(lds + RW_YO + (pc & 1) * 4096); LAS float* CD = (LAS float*)(lds + RW_CD + (pc & 1) * 128);
                const int t = ptid >> 3, c4 = (ptid & 7) * 4;
                const int n = pc * 32 + t; const int pos = dir ? (len - 1 - n) : n; const int tok = start + pos;
                const f32x4 yv = *(const LAS f32x4*)(YO + t * 32 + c4);
                u32x2 w; w.x = cvtpk(yv[0], yv[1]); w.y = cvtpk(yv[2], yv[3]);
                if (c4 < nrows) { if (dir) *(u32x2*)(yb + (size_t)tok * 256 + h * 64 + rpart * nrows + c4) = w; else *(u32x2*)(mix + (size_t)tok * DM + h * 64 + rpart * nrows + c4) = w; }
                if (rpart == 0 && ptid < 32) { const int n2 = pc * 32 + ptid; const int pos2 = dir ? (len - 1 - n2) : n2; cdot[((size_t)(start + pos2) * 4 + h) * 2 + dir] = CD[ptid]; }
            }
            const int nc = ch + 1;
            const bool build = nc < nch;
            LAS unsigned char* B = lds + (nc & 1) * RW_BUF;
            LAS float* XR = (LAS float*)(B + RW_XR); LAS float* XKD = (LAS float*)(B + RW_XKD); LAS float* XV = (LAS float*)(B + RW_XV);
            LAS float* WLW = (LAS float*)(B + RW_WLW); LAS float* ALB = (LAS float*)(B + RW_ALB); LAS float* KKN = (LAS float*)(B + RW_KKN);
            LAS float* CDn = (LAS float*)(lds + RW_CD + (nc & 1) * 128);
            if (build) {
                RW_CONV1(0) RW_CONV1(1) RW_CONV1(2) RW_CONV1(3) RW_CONV1(4) RW_CONV1(5) RW_CONV1(6) RW_CONV1(7) RW_CONV1(8) RW_CONV1(9)
                if (nc + 1 < nch - 1) RW_ISSUE_MID(); else if (nc + 1 < nch) RW_ISSUE(nc + 1);
            }
            RW_BAR();
            if (build) {
                const int mat = (wave - 4) >> 1, nb = (wave - 4) & 1;
                LAS bf16_t* Xs = mat ? XAD : XWD; LAS bf16_t* Ws = mat ? A2T : W2T;
                f32x16 acc = zero16();
#pragma unroll
                for (int ks = 0; ks < 4; ++ks) {
                    const bf16x8 a = *(const LAS bf16x8*)(Xs + r32 * 72 + ks * 16 + hh * 8);
                    const bf16x8 bb = *(const LAS bf16x8*)(Ws + (nb * 32 + r32) * 72 + ks * 16 + hh * 8);
                    acc = MFMA32(a, bb, acc);
                }
                LAS float* dst = mat ? ALB : WLW;
#pragma unroll
                for (int i = 0; i < 16; ++i) dst[crow(i, hh) * 64 + nb * 32 + r32] = acc[i];
            }
            RW_BAR();
            if (build) {
#pragma unroll
                for (int it = 0; it < 2; ++it) {
                    const int ct = (ptid >> 4) + 16 * it;
                    const f32x4 wl = *(const LAS f32x4*)(WLW + ct * 64 + cc4), al = *(const LAS f32x4*)(ALB + ct * 64 + cc4);
                    const f32x4 k4 = *(const LAS f32x4*)(XKD + ct * 64 + cc4), r4 = *(const LAS f32x4*)(XR + ct * 64 + cc4);
                    f32x4 w, a, kkr, kd;
                    float ssq = 0.f, cd = 0.f;
#pragma unroll
                    for (int j = 0; j < 4; ++j) {
                        const float sg = sigmoidf_(w0v[j] + wl[j]);
                        w[j] = __expf(-0.6065306597126334f * sg);
                        a[j] = sigmoidf_(a0v[j] + al[j]);
                        kkr[j] = k4[j] * kkw[j]; ssq += kkr[j] * kkr[j];
                        kd[j] = k4[j] * (1.f + (a[j] - 1.f) * kaw[j]);
                        cd += r4[j] * kd[j] * rkw[j];
                    }
                    ssq = red16(ssq); cd = red16(cd);
                    const float inv = __builtin_amdgcn_rsqf(fmaxf(ssq, 1e-24f));
                    f32x4 kkn, bv;
#pragma unroll
                    for (int j = 0; j < 4; ++j) { kkn[j] = kkr[j] * inv; bv[j] = kkn[j] * a[j]; }
                    *(LAS f32x4*)(WLW + ct * 64 + cc4) = w; *(LAS f32x4*)(ALB + ct * 64 + cc4) = bv; *(LAS f32x4*)(KKN + ct * 64 + cc4) = kkn; *(LAS f32x4*)(XKD + ct * 64 + cc4) = kd;
                    if (cli == 0) CDn[ct] = cd;
                }
            }
            RW_BAR();
        }
        {
            const int pc = nch - 1;
            LAS float* YO = (LAS float*)(lds + RW_YO + (pc & 1) * 4096); LAS float* CD = (LAS float*)(lds + RW_CD + (pc & 1) * 128);
            const int t = ptid >> 3, c4 = (ptid & 7) * 4;
            const int n = pc * 32 + t; const int pos = dir ? (len - 1 - n) : n; const int tok = start + pos;
            const f32x4 yv = *(const LAS f32x4*)(YO + t * 32 + c4);
            u32x2 w; w.x = cvtpk(yv[0], yv[1]); w.y = cvtpk(yv[2], yv[3]);
            if (c4 < nrows) { if (dir) *(u32x2*)(yb + (size_t)tok * 256 + h * 64 + rpart * nrows + c4) = w; else *(u32x2*)(mix + (size_t)tok * DM + h * 64 + rpart * nrows + c4) = w; }
            if (rpart == 0 && ptid < 32) { const int n2 = pc * 32 + ptid; const int pos2 = dir ? (len - 1 - n2) : n2; cdot[((size_t)(start + pos2) * 4 + h) * 2 + dir] = CD[ptid]; }
        }
    }
    __syncthreads();
}

constexpr int ML_QS = 0, ML_KS = 9216, ML_KT = 18432, ML_VT = 27648, ML_VWT = 36864, ML_PS = 46080, ML_CB = 55296, ML_WGT = 64512, ML_RR = 64768, ML_MROW = 65024,
              ML_SC = 65280, ML_EMT = 65536, ML_DENI = 65792, ML_NS = 66048, ML_A12 = 66304;
DI void mlstm_job(const KP& p, int l, int job, LAS unsigned char* lds, int tid) {
    int seq, hm, dir; seq_of_job(job, seq, hm, dir);
    int start, len; seq_info(seq, start, len);
    const bf16_t* proj = (const bf16_t*)(p.ws + WS_R);
    bf16_t* mix = (bf16_t*)(p.ws + WS_X1);
    bf16_t* hbp = (bf16_t*)(p.ws + WS_HBP);
    const float* cw = p.in[17] + l * 3 * 512;
    const float ibv = p.in[18][(l * 2 + dir) * 4 + hm], fbv = p.in[19][(l * 2 + dir) * 4 + hm];
    const int wave = tid >> 6, lane = tid & 63, r32 = lane & 31, hh = lane >> 5;
    LAS bf16_t* Qs = (LAS bf16_t*)(lds + ML_QS); LAS bf16_t* Ks = (LAS bf16_t*)(lds + ML_KS); LAS bf16_t* KT = (LAS bf16_t*)(lds + ML_KT);
    LAS bf16_t* VT = (LAS bf16_t*)(lds + ML_VT); LAS bf16_t* VWT = (LAS bf16_t*)(lds + ML_VWT); LAS bf16_t* Ps = (LAS bf16_t*)(lds + ML_PS); LAS bf16_t* CB = (LAS bf16_t*)(lds + ML_CB);
    LAS float* WGT = (LAS float*)(lds + ML_WGT); LAS float* RR = (LAS float*)(lds + ML_RR); LAS float* MROW = (LAS float*)(lds + ML_MROW); LAS float* SC = (LAS float*)(lds + ML_SC);
    LAS float* EMT = (LAS float*)(lds + ML_EMT); LAS float* DENI = (LAS float*)(lds + ML_DENI); LAS float* NS = (LAS float*)(lds + ML_NS); LAS float* A12 = (LAS float*)(lds + ML_A12);
    for (int i = tid; i < 64 * 72; i += NTHR) CB[i] = 0;
    if (tid < 64) NS[tid] = 0.f;
    f32x16 Creg = zero16();
    float Mst = 0.f;
    __syncthreads();
    const int nch = len >> 6;
    const int ll = tid >> 3, e8 = (tid & 7) * 8;
    for (int ch = 0; ch < nch; ++ch) {
        {
            const int n = ch * 64 + ll; const int pos = dir ? (len - 1 - n) : n; const int tok = start + pos;
#pragma unroll
            for (int which = 0; which < 2; ++which) {
                const int col = (which ? C_MK : C_MQ) + hm * 64 + e8; const int cwc = (which ? 256 : 0) + hm * 64 + e8;
                const bf16_t* bp = proj + (size_t)tok * NPROJ + col;
                const u32x4 cu = *(const u32x4*)bp; u32x4 pv = {0u, 0u, 0u, 0u}, nv = {0u, 0u, 0u, 0u};
                if (pos > 0) pv = *(const u32x4*)(bp - NPROJ);
                if (pos < len - 1) nv = *(const u32x4*)(bp + NPROJ);
                float o[8];
#pragma unroll
                for (int j = 0; j < 4; ++j) {
                    const f32x2 c0 = *(const f32x2*)(cw + cwc + 2 * j), c1 = *(const f32x2*)(cw + 512 + cwc + 2 * j), c2 = *(const f32x2*)(cw + 1024 + cwc + 2 * j);
                    const float v0 = c0.x * bflo(pv[j]) + c1.x * bflo(cu[j]) + c2.x * bflo(nv[j]);
                    const float v1 = c0.y * bfhi(pv[j]) + c1.y * bfhi(cu[j]) + c2.y * bfhi(nv[j]);
                    o[2 * j] = v0 * sigmoidf_(v0); o[2 * j + 1] = v1 * sigmoidf_(v1);
                }
                if (which) {
#pragma unroll
                    for (int j = 0; j < 8; ++j) o[j] *= 0.125f;
                }
                u32x4 w; w.x = cvtpk(o[0], o[1]); w.y = cvtpk(o[2], o[3]); w.z = cvtpk(o[4], o[5]); w.w = cvtpk(o[6], o[7]);
                if (!which) *(LAS u32x4*)(Qs + ll * 72 + e8) = w;
                else { *(LAS u32x4*)(Ks + ll * 72 + e8) = w;
#pragma unroll
                    for (int j = 0; j < 4; ++j) { KT[(e8 + 2 * j) * 72 + ll] = (bf16_t)(w[j] & 0xffffu); KT[(e8 + 2 * j + 1) * 72 + ll] = (bf16_t)(w[j] >> 16); } }
            }
        }
        if (wave == 0) {
            const int n = ch * 64 + lane; const int pos = dir ? (len - 1 - n) : n; const int tok = start + pos;
            const float igv = bf2f(proj[(size_t)tok * NPROJ + C_IG + dir * 4 + hm]) + ibv;
            const float fgv = bf2f(proj[(size_t)tok * NPROJ + C_FG + dir * 4 + hm]) + fbv;
            const float lf = (fgv > 0.f) ? -log1pf(__expf(-fgv)) : (fgv - log1pf(__expf(fgv)));
            float b = lf;
#pragma unroll
            for (int o = 1; o < 64; o <<= 1) { const float t2 = __shfl_up(b, o); if (lane >= o) b += t2; }
            const float bL = __shfl(b, 63);
            const float g = bL - b + igv;
            float mg = g;
#pragma unroll
            for (int o = 32; o >= 1; o >>= 1) mg = fmaxf(mg, __shfl_xor(mg, o));
            const float wgt = __expf(g - mg);
            const float r = igv - b;
            float cm = r;
#pragma unroll
            for (int o = 1; o < 64; o <<= 1) { const float t2 = __shfl_up(cm, o); if (lane >= o) cm = fmaxf(cm, t2); }
            const float mrow = fmaxf(cm, Mst);
            WGT[lane] = wgt; RR[lane] = r; MROW[lane] = mrow; SC[lane] = __expf(Mst - mrow); EMT[lane] = __expf(-(b + mrow));
            const float Mnew = fmaxf(bL + Mst, mg);
            if (lane == 0) { A12[0] = __expf(bL + Mst - Mnew); A12[1] = __expf(mg - Mnew); }
            Mst = Mnew;
        }
        __syncthreads();
        {
            const int n = ch * 64 + ll; const int pos = dir ? (len - 1 - n) : n; const int tok = start + pos;
            const u32x4 vv = *(const u32x4*)(proj + (size_t)tok * NPROJ + C_MV + hm * 64 + e8);
            const float wg = WGT[ll];
#pragma unroll
            for (int j = 0; j < 4; ++j) {
                VT[(e8 + 2 * j) * 72 + ll] = (bf16_t)(vv[j] & 0xffffu); VT[(e8 + 2 * j + 1) * 72 + ll] = (bf16_t)(vv[j] >> 16);
                const unsigned pw = cvtpk(bflo(vv[j]) * wg, bfhi(vv[j]) * wg);
                VWT[(e8 + 2 * j) * 72 + ll] = (bf16_t)(pw & 0xffffu); VWT[(e8 + 2 * j + 1) * 72 + ll] = (bf16_t)(pw >> 16);
            }
        }
        __syncthreads();
        if (wave < 4) {
            const int tb = wave >> 1, sb = wave & 1;
            f32x16 acc = zero16();
#pragma unroll
            for (int ks = 0; ks < 4; ++ks) {
                const bf16x8 a = *(const LAS bf16x8*)(Qs + (tb * 32 + r32) * 72 + ks * 16 + hh * 8);
                const bf16x8 b = *(const LAS bf16x8*)(Ks + (sb * 32 + r32) * 72 + ks * 16 + hh * 8);
                acc = MFMA32(a, b, acc);
            }
            const int s = sb * 32 + r32; const float rs_ = RR[s];
#pragma unroll
            for (int i = 0; i < 16; ++i) { const int t = tb * 32 + crow(i, hh); const float pvv = (s <= t) ? __expf(rs_ - MROW[t]) * acc[i] : 0.f; Ps[t * 72 + s] = f2bf(pvv); }
        } else {
            const int db = (wave - 4) >> 1, eb = (wave - 4) & 1;
            f32x16 kc = zero16();
#pragma unroll
            for (int ks = 0; ks < 4; ++ks) {
                const bf16x8 a = *(const LAS bf16x8*)(VWT + (db * 32 + r32) * 72 + ks * 16 + hh * 8);
                const bf16x8 b = *(const LAS bf16x8*)(KT + (eb * 32 + r32) * 72 + ks * 16 + hh * 8);
                kc = MFMA32(a, b, kc);
            }
            const float a1 = A12[0], a2 = A12[1];
#pragma unroll
            for (int i = 0; i < 16; ++i) Creg[i] = a1 * Creg[i] + a2 * kc[i];
        }
        __syncthreads();
        f32x16 acc = zero16();
        float ncv = 0.f;
        if (wave < 4) {
            const int tb = wave >> 1, db = wave & 1;
#pragma unroll
            for (int ks = 0; ks < 4; ++ks) {
                const bf16x8 a = *(const LAS bf16x8*)(Qs + (tb * 32 + r32) * 72 + ks * 16 + hh * 8);
                const bf16x8 b = *(const LAS bf16x8*)(CB + (db * 32 + r32) * 72 + ks * 16 + hh * 8);
                acc = MFMA32(a, b, acc);
            }
#pragma unroll
            for (int i = 0; i < 16; ++i) acc[i] *= SC[tb * 32 + crow(i, hh)];
#pragma unroll
            for (int ks = 0; ks < 4; ++ks) {
                const bf16x8 a = *(const LAS bf16x8*)(Ps + (tb * 32 + r32) * 72 + ks * 16 + hh * 8);
                const bf16x8 b = *(const LAS bf16x8*)(VT + (db * 32 + r32) * 72 + ks * 16 + hh * 8);
                acc = MFMA32(a, b, acc);
            }
        } else if (wave == 4) {
            float rsum = 0.f, qn = 0.f;
            for (int e = 0; e < 64; ++e) { rsum += bf2f(Ps[lane * 72 + e]); qn += bf2f(Qs[lane * 72 + e]) * NS[e]; }
            const float den = rsum + SC[lane] * qn;
            DENI[lane] = 1.f / fmaxf(fabsf(den), EMT[lane]);
        } else if (wave == 5) {
            for (int s = 0; s < 64; ++s) ncv += WGT[s] * bf2f(KT[lane * 72 + s]);
        }
        __syncthreads();
        if (wave < 4) {
            const int tb = wave >> 1, db = wave & 1;
#pragma unroll
            for (int i = 0; i < 16; ++i) {
                const int t = tb * 32 + crow(i, hh); const int n = ch * 64 + t; const int pos = dir ? (len - 1 - n) : n; const int tok = start + pos;
                const bf16_t o = f2bf(acc[i] * DENI[t]);
                if (dir) hbp[(size_t)tok * 256 + hm * 64 + db * 32 + r32] = o; else mix[(size_t)tok * DM + 768 + hm * 64 + db * 32 + r32] = o;
            }
        } else {
            const int db = (wave - 4) >> 1, eb = (wave - 4) & 1;
#pragma unroll
            for (int i = 0; i < 16; ++i) CB[(db * 32 + crow(i, hh)) * 72 + eb * 32 + r32] = f2bf(Creg[i]);
            if (wave == 5) NS[lane] = A12[0] * NS[lane] + A12[1] * ncv;
        }
        __syncthreads();
    }
}

DI void mixers_phase(const KP& p, int l, int cidx, LAS unsigned char* lds, int tid, int G, int bid) {
    unsigned* cnt = (unsigned*)(p.ws + WS_CNT) + cidx;
    LAS int* slot = (LAS int*)(lds + SLOT_OFF);
    for (;;) {
        if (tid == 0) *slot = (int)atomicAdd(cnt, 1u);
        __syncthreads();
        const int item = *slot;
        __syncthreads();
        if (item >= 240 + 1536) {
            if (l != 0 || item >= 240 + 1536 + 1344) break;
            const int t0 = 768 + (item - 1776) * 4;
            for (int q = 0; q < 4; ++q) convert_tile(p, t0 + q, (LAS float*)lds, tid);
            continue;
        }
        int kind, jb;
        if (item < 32) { kind = 0; jb = item; } else if (item < 48) { kind = 1; jb = item - 32; } else if (item < 176) { kind = 0; jb = item - 48 + 32; }
        else if (item < 240) { kind = 1; jb = item - 176 + 16; } else { kind = 2; jb = item - 240; }
        int t2 = tid; asm volatile("" : "+v"(t2));
#ifndef REP_R
#define REP_R 1
#endif
#ifndef REP_M
#define REP_M 1
#endif
#ifndef REP_T
#define REP_T 1
#endif
        if (kind == 0) { rwkv_job(p, l, jb, lds, t2); }
        else if (kind == 1) { for (int rep = 0; rep < REP_M; ++rep) { mlstm_job(p, l, jb, lds, t2); __syncthreads(); } }
        else { for (int rep = 0; rep < REP_T; ++rep) { attn_unit(p, l, jb, lds, t2); __syncthreads(); } }
        __syncthreads();
    }
}

constexpr int PO_G2T = 0, PO_AS = 69632, PO_GO = 87040;
DI void post_phase(const KP& p, int l, LAS unsigned char* lds, int tid, int G, int bid) {
    const bf16_t* proj = (const bf16_t*)(p.ws + WS_R);
    bf16_t* mix = (bf16_t*)(p.ws + WS_X1);
    const bf16_t* yb = (const bf16_t*)(p.ws + WS_YB);
    const bf16_t* hbp = (const bf16_t*)(p.ws + WS_HBP);
    const float* cdot = (const float*)(p.ws + WS_CDOT);
    const float* mu = p.in[4] + l * 1152;
    const float* lnw = p.in[13] + l * 256; const float* lnb = p.in[14] + l * 256; const float* nw = p.in[20] + l * 256;
    LAS bf16_t* G2T = (LAS bf16_t*)(lds + PO_G2T); LAS bf16_t* AS = (LAS bf16_t*)(lds + PO_AS); LAS bf16_t* GO = (LAS bf16_t*)(lds + PO_GO);
    const int wave = tid >> 6, lane = tid & 63, r32 = lane & 31, hh = lane >> 5;
    { const float* g2 = p.in[9] + (size_t)l * 128 * 256;
      for (int i = 0; i < 64; ++i) { const int idx = tid + NTHR * i; const int mm = idx >> 8, c = idx & 255; G2T[c * 136 + mm] = f2bf(g2[idx]); } }
    __syncthreads();
    for (int unit = bid; unit < T / 64; unit += G) {
        const int tok0 = unit * 64;
        int len; const int st = tok_seq_start(tok0, len);
#pragma unroll
        for (int i = 0; i < 4; ++i) {
            const int q = tid + NTHR * i; const int t = q >> 5, c4 = (q & 31) * 4; const int tok = tok0 + t; const int pos = tok - st;
            const bf16_t* bp = proj + (size_t)tok * NPROJ + C_GD + c4;
            const u32x2 cu = *(const u32x2*)bp; u32x2 pv = {0u, 0u}, nv = {0u, 0u};
            if (pos > 0) pv = *(const u32x2*)(bp - NPROJ);
            if (pos < len - 1) nv = *(const u32x2*)(bp + NPROJ);
            const f32x4 m4 = *(const f32x4*)(mu + C_GD + c4);
            float x[4] = {bflo(cu.x), bfhi(cu.x), bflo(cu.y), bfhi(cu.y)};
            const float pn[4] = {bflo(pv.x) + bflo(nv.x), bfhi(pv.x) + bfhi(nv.x), bflo(pv.y) + bflo(nv.y), bfhi(pv.y) + bfhi(nv.y)};
#pragma unroll
            for (int j = 0; j < 4; ++j) x[j] = sigmoidf_(x[j] + (0.5f * pn[j] - x[j]) * m4[j]);
            u32x2 w; w.x = cvtpk(x[0], x[1]); w.y = cvtpk(x[2], x[3]); *(LAS u32x2*)(AS + t * 136 + c4) = w;
        }
        __syncthreads();
        {
            const int hd = wave & 3, tb = wave >> 2;
            f32x16 a0 = zero16(), a1 = zero16();
#pragma unroll
            for (int ks = 0; ks < 8; ++ks) {
                const bf16x8 a = *(const LAS bf16x8*)(AS + (tb * 32 + r32) * 136 + ks * 16 + hh * 8);
                const bf16x8 b0 = *(const LAS bf16x8*)(G2T + (hd * 64 + r32) * 136 + ks * 16 + hh * 8);
                const bf16x8 b1 = *(const LAS bf16x8*)(G2T + (hd * 64 + 32 + r32) * 136 + ks * 16 + hh * 8);
                a0 = MFMA32(a, b0, a0); a1 = MFMA32(a, b1, a1);
            }
#pragma unroll
            for (int i = 0; i < 16; ++i) { const int t = tb * 32 + crow(i, hh); GO[t * 264 + hd * 64 + r32] = f2bf(a0[i]); GO[t * 264 + hd * 64 + 32 + r32] = f2bf(a1[i]); }
        }
        __syncthreads();
#pragma unroll 1
        for (int it = 0; it < 8; ++it) {
            const int task = tid + NTHR * it; const int grp = task >> 4, li = task & 15; const int t = grp >> 2, hd = grp & 3; const int c4 = li * 4;
            const int tok = tok0 + t; const int pos = tok - st;
            {
                const u32x2 yf = *(const u32x2*)(mix + (size_t)tok * DM + hd * 64 + c4), ybv = *(const u32x2*)(yb + (size_t)tok * 256 + hd * 64 + c4);
                float x[4] = {bflo(yf.x) + bflo(ybv.x), bfhi(yf.x) + bfhi(ybv.x), bflo(yf.y) + bflo(ybv.y), bfhi(yf.y) + bfhi(ybv.y)};
                const float mean = red16(x[0] + x[1] + x[2] + x[3]) * (1.f / 64.f);
                float vs = 0.f;
#pragma unroll
                for (int j = 0; j < 4; ++j) { x[j] -= mean; vs += x[j] * x[j]; }
                const float rstd = rsqrtf(red16(vs) * (1.f / 64.f) + 64e-5f);
                const bf16_t* bp = proj + (size_t)tok * NPROJ + C_V + hd * 64 + c4;
                const u32x2 cu = *(const u32x2*)bp; u32x2 pv = {0u, 0u}, nv = {0u, 0u};
                if (pos > 0) pv = *(const u32x2*)(bp - NPROJ);
                if (pos < len - 1) nv = *(const u32x2*)(bp + NPROJ);
                const f32x4 m4 = *(const f32x4*)(mu + C_V + hd * 64 + c4);
                float v[4] = {bflo(cu.x), bfhi(cu.x), bflo(cu.y), bfhi(cu.y)};
                const float pn[4] = {bflo(pv.x) + bflo(nv.x), bfhi(pv.x) + bfhi(nv.x), bflo(pv.y) + bflo(nv.y), bfhi(pv.y) + bfhi(nv.y)};
                const f32x2 cdv = *(const f32x2*)(cdot + ((size_t)tok * 4 + hd) * 2);
                const float cds = cdv.x + cdv.y;
                const f32x4 lw = *(const f32x4*)(lnw + hd * 64 + c4), lb = *(const f32x4*)(lnb + hd * 64 + c4);
                const u32x2 gv = *(const LAS u32x2*)(GO + t * 264 + hd * 64 + c4);
                const float g[4] = {bflo(gv.x), bfhi(gv.x), bflo(gv.y), bfhi(gv.y)};
                float o[4];
#pragma unroll
                for (int j = 0; j < 4; ++j) { const float vsft = v[j] + (0.5f * pn[j] - v[j]) * m4[j]; o[j] = (x[j] * rstd * lw[j] + lb[j] + cds * vsft) * g[j]; }
                u32x2 w; w.x = cvtpk(o[0], o[1]); w.y = cvtpk(o[2], o[3]); *(u32x2*)(mix + (size_t)tok * DM + hd * 64 + c4) = w;
            }
            {
                const u32x2 hf = *(const u32x2*)(mix + (size_t)tok * DM + 768 + hd * 64 + c4), hb = *(const u32x2*)(hbp + (size_t)tok * 256 + hd * 64 + c4);
                const float x[4] = {bflo(hf.x) + bflo(hb.x), bfhi(hf.x) + bfhi(hb.x), bflo(hf.y) + bflo(hb.y), bfhi(hf.y) + bfhi(hb.y)};
                const float ms = red16(x[0] * x[0] + x[1] * x[1] + x[2] * x[2] + x[3] * x[3]) * (1.f / 64.f);
                const float rinv = rsqrtf(ms + 1e-6f);
                const u32x2 ov = *(const u32x2*)(proj + (size_t)tok * NPROJ + C_MO + hd * 64 + c4);
                const float og[4] = {bflo(ov.x), bfhi(ov.x), bflo(ov.y), bfhi(ov.y)};
                const f32x4 nwv = *(const f32x4*)(nw + hd * 64 + c4);
                float o[4];
#pragma unroll
                for (int j = 0; j < 4; ++j) o[j] = sigmoidf_(og[j]) * x[j] * rinv * nwv[j];
                u32x2 w; w.x = cvtpk(o[0], o[1]); w.y = cvtpk(o[2], o[3]); *(u32x2*)(mix + (size_t)tok * DM + 768 + hd * 64 + c4) = w;
            }
        }
        __syncthreads();
    }
}

DI void final_phase(const KP& p, int tid, int G, int bid) {
    const float* ss = (const float*)(p.ws + WS_SS) + 4 * T;
    const float* g = p.in[25];
    const int wave = tid >> 6, lane = tid & 63;
    f32x4 gv[4];
#pragma unroll
    for (int j = 0; j < 4; ++j) gv[j] = *(const f32x4*)(g + (j * 64 + lane) * 4);
    for (int row = (bid * 8 + wave) * 4; row < T; row += G * 8 * 4) {
        f32x4 v[4][4]; float rs[4];
#pragma unroll
        for (int r = 0; r < 4; ++r) {
            rs[r] = rsqrtf(ss[row + r] * (1.f / 1024.f) + 1e-6f);
#pragma unroll
            for (int j = 0; j < 4; ++j) v[r][j] = *(const f32x4*)(p.out + (size_t)(row + r) * DM + (j * 64 + lane) * 4);
        }
#pragma unroll
        for (int r = 0; r < 4; ++r)
#pragma unroll
            for (int j = 0; j < 4; ++j) *(f32x4*)(p.out + (size_t)(row + r) * DM + (j * 64 + lane) * 4) = v[r][j] * rs[r] * gv[j];
    }
}

__global__ void __launch_bounds__(NTHR, 2) fwd_kernel(KP p) {
    extern __shared__ __attribute__((aligned(16))) unsigned char lds_raw[];
    LAS unsigned char* lds = (LAS unsigned char*)lds_raw;
    cg::grid_group grid = cg::this_grid();
    int tid = threadIdx.x; const int G = gridDim.x, bid = blockIdx.x;
#define LAUNDER() asm volatile("" : "+v"(tid))
    float* ss = (float*)(p.ws + WS_SS);
    bf16_t* X1 = (bf16_t*)(p.ws + WS_X1);
    bf16_t* PROJ = (bf16_t*)(p.ws + WS_R);
    bf16_t* HB = (bf16_t*)(p.ws + WS_R);
    bf16_t* HID = (bf16_t*)(p.ws + WS_HID);

        LAUNDER();
    volatile LAS unsigned* bst = (volatile LAS unsigned*)(lds + SLOT_OFF + 16);
    if (tid == 0) { bst[0] = 0u; bst[1] = 0u; }
    __syncthreads();
    const XcdBarrier xbar = xcd_barrier_post((unsigned*)(p.ws + WS_BAR), bst);
#define GSYNC() xcd_barrier(xbar)
    p0_phase(p, lds, tid, G, bid);
    grid.sync();
#ifdef PROBE_SYNC20
    for (int i = 0; i < 20; ++i) GSYNC();
#endif
#ifdef PROBE_P0X2
    LAUNDER(); p0_phase(p, lds, tid, G, bid);
    GSYNC();
#endif
#ifdef PROBE_SYNC10
    for (int i = 0; i < 10; ++i) GSYNC();
#endif
    for (int l = 0; l < 2; ++l) {
        {
            pg8::Gemm g{X1, (const bf16_t*)(p.ws + WS_WIN) + (size_t)l * NPROJ * 1024, T, NPROJ, 1024}; pg8::StaticOrder S; S.init(T, NPROJ, G, bid);
            EpiProj E{PROJ, ss + (2 * l) * T};
            pg8::gemm_phase<EpiProj, pg8::StaticOrder, true, true>(lds, g, S, E);
#ifdef PROBE_P1X2
            GSYNC();
            pg8::gemm_phase<EpiProj, pg8::StaticOrder, true, true>(lds, g, S, E);
#endif
        }
        GSYNC();
        LAUNDER();
        prep_phase(p, l, lds, tid, G, bid);
        GSYNC();
        LAUNDER();
        mixers_phase(p, l, l, lds, tid, G, bid);
#ifdef PROBE_MIX2
        GSYNC(); LAUNDER();
        mixers_phase(p, l, l + 2, lds, tid, G, bid);
#endif
        GSYNC();
        LAUNDER();
        post_phase(p, l, lds, tid, G, bid);
        GSYNC();
        {
            pg8::Gemm g{X1, (const bf16_t*)(p.ws + WS_WOUT) + (size_t)l * 1024 * 1024, T, DM, 1024}; pg8::StaticOrder S; S.init(T, DM, G, bid);
            if (l == 0) { EpiRes<true, true, true> E{p.out, HB, ss + (2 * l + 1) * T, p.in[0], p.in[1]}; pg8::gemm_phase<EpiRes<true, true, true>, pg8::StaticOrder, true, true>(lds, g, S, E); }
            else { EpiRes<true, true> E{p.out, HB, ss + (2 * l + 1) * T, nullptr, nullptr}; pg8::gemm_phase<EpiRes<true, true>, pg8::StaticOrder, true, true>(lds, g, S, E); }
        }
        GSYNC();
        for (int hf = 0; hf < 2; ++hf) {
            {
                pg8::Gemm g{HB, (const bf16_t*)(p.ws + WS_W1) + (size_t)l * 4096 * 1024 + (size_t)hf * HFF * 1024, T, HFF, 1024}; pg8::StaticOrder S; S.init(T, HFF, G, bid);
                EpiRelu2 E{HID, ss + (2 * l + 1) * T};
                pg8::gemm_phase<EpiRelu2, pg8::StaticOrder, true, true>(lds, g, S, E);
            }
            GSYNC();
            {
                pg8::Gemm g{HID, (const bf16_t*)(p.ws + WS_W2) + (size_t)l * 2 * 1024 * 2048 + (size_t)hf * 1024 * 2048, T, DM, HFF}; pg8::StaticOrder S; S.init(T, DM, G, bid);
                if (hf == 0) { EpiPart E{X1}; pg8::gemm_phase<EpiPart, pg8::StaticOrder, true, true>(lds, g, S, E); }
                else { EpiRes<true, true, false, true> E{p.out, X1, ss + (2 * l + 2) * T, nullptr, nullptr}; pg8::gemm_phase<EpiRes<true, true, false, true>, pg8::StaticOrder, true, true>(lds, g, S, E); }
            }
            GSYNC();
        }
    }
        LAUNDER();
    final_phase(p, tid, G, bid);
}

extern "C" void kernel_launch(void* const* d_in, const int* in_sizes, int n_in, void* d_out, int out_size, void* d_ws, size_t ws_size, hipStream_t stream) {
    static int grid_blocks = 0;
    if (grid_blocks == 0) {
        if (n_in != 26 || out_size != T * DM || ws_size < WS_END) { fprintf(stderr, "kernel_launch: unexpected shapes (n_in %d out %d ws %zu)\n", n_in, out_size, ws_size); grid_blocks = -1; return; }
        int dev = 0, cus = 0, per_cu = 0;
        hipGetDevice(&dev);
        hipDeviceGetAttribute(&cus, hipDeviceAttributeMultiprocessorCount, dev);
        hipFuncSetAttribute((const void*)fwd_kernel, hipFuncAttributeMaxDynamicSharedMemorySize, LDS_BYTES);
        hipOccupancyMaxActiveBlocksPerMultiprocessor(&per_cu, (const void*)fwd_kernel, NTHR, LDS_BYTES);
        if (per_cu < 1) per_cu = 1;
        grid_blocks = cus * per_cu;
        (void)hipGetLastError();
    }
    if (grid_blocks < 0) return;
    KP p{};
    for (int i = 0; i < 26; ++i) p.in[i] = (const float*)d_in[i];
    p.out = (float*)d_out; p.ws = (unsigned char*)d_ws;
    (void)hipMemsetAsync((char*)d_ws + WS_BAR, 0, 16384, stream);
    void* args[] = {&p};
    hipError_t e = hipLaunchCooperativeKernel((const void*)fwd_kernel, dim3(grid_blocks), dim3(NTHR), args, LDS_BYTES, stream);
    if (e != hipSuccess) fprintf(stderr, "cooperative launch failed: %s (grid %d)\n", hipGetErrorString(e), grid_blocks);
}
```

```cpp
#include <hip/hip_runtime.h>
#include <hip/hip_cooperative_groups.h>
#include <cstdio>
#include <cstdint>
namespace cg = cooperative_groups;
namespace pg8 {
#define PG8_LAS __attribute__((address_space(3)))
typedef unsigned short bf16_t;
typedef short bf16x8 __attribute__((ext_vector_type(8)));
typedef float f32x4 __attribute__((ext_vector_type(4)));
typedef unsigned u32x4 __attribute__((ext_vector_type(4)));
constexpr int BM = 256, BK = 64, HALF = 128, HTB = HALF * BK * 2  , STAGE_BYTES = 8 * HTB, NXCD = 8, WGM = 8;

__host__ __device__ __forceinline__ int lds_byte(int r, int c) { const int st = (r >> 4) * 2 + (c >> 5), rr = r & 15, cc = c & 31, ob = rr * 64 + cc * 2; return st * 1024 + (ob ^ (((ob >> 9) & 1) << 5)); }
__host__ __device__ __forceinline__ void stage_rc(int b, int& R, int& C) { const int st = b / 1024, sb = b % 1024, swz = sb ^ (((sb >> 9) & 1) << 5); R = (st >> 1) * 16 + swz / 64; C = (st & 1) * 32 + (swz % 64) / 2; }
__host__ __device__ __forceinline__ int perm32(int rho) { const int n = rho >> 4, i = rho & 15; return 8 * (i >> 2) + 4 * n + (i & 3); }

struct Unit { int pm, pn; };
struct Gemm { const bf16_t* A; const bf16_t* Bt; int M, N, K; };

struct StaticOrder {
    int nM, nN, nwg, G, c;
    __host__ __device__ void init(int M, int N, int G_, int c_) { nM = M / BM; nN = N / BM; nwg = nM * nN; G = G_; c = c_; }
    __host__ __device__ bool next(int i, Unit& u) const {
        const long L = (long)i * G + c; if (L >= nwg) return false;
        int wgid = (int)L; { const int q = nwg / NXCD, r = nwg % NXCD, xcd = wgid % NXCD, off = wgid / NXCD; wgid = (xcd < r ? xcd * (q + 1) : r * (q + 1) + (xcd - r) * q) + off; }
        const int nig = WGM * nN, gid = wgid / nig, fm = gid * WGM, gsz = (nM - fm) < WGM ? (nM - fm) : WGM;
        u.pm = fm + ((wgid % nig) % gsz); u.pn = (wgid % nig) / gsz; return true;
    }
    __device__ __forceinline__ void a_ready(const Unit&) const {}
    __device__ __forceinline__ void done(const Unit&) const {}
};

template <class Epi, class Sched, bool ALIGN_EPI = false, bool SP2 = false>
__device__ __forceinline__ void gemm_phase(PG8_LAS unsigned char* lds, const Gemm g, const Sched& S, const Epi& E) {
    int tid_l = threadIdx.x; asm volatile("" : "+v"(tid_l));
    const int tid = tid_l, wid = __builtin_amdgcn_readfirstlane(tid >> 6), lane = tid & 63, wr = wid >> 2, wc = wid & 3, fr = lane & 15, fq = lane >> 4;
    const int K = g.K, nt = K / BK;
    unsigned voffA[2], voffB[2];
#pragma unroll
    for (int i = 0; i < 2; ++i) { int R, C; stage_rc(tid * 16 + i * 8192, R, C); const int Rb = Epi::PERM ? ((R & ~31) + perm32(R & 31)) : R;
        voffA[i] = (unsigned)(R * K + C) * 2u; voffB[i] = (unsigned)(Rb * K + C) * 2u; }
    const size_t kstep = (size_t)(BK * 2);
    const size_t hstep = (size_t)HALF * K * 2;
    const size_t tstep = 2 * hstep;
    const unsigned ldsw = (unsigned)wid * 1024u;
    const int aoff = lds_byte(wr * 64 + fr, fq * 8), boff = lds_byte(wc * 32 + fr, fq * 8);
#define PG8_SA(b, h) (((b) * 2 + (h)) * HTB)
#define PG8_SB(b, h) ((4 + (b) * 2 + (h)) * HTB)
#define PG8_STAGE(bufoff, gbase, voff) do { _Pragma("unroll") for (int _i = 0; _i < 2; ++_i) \
        __builtin_amdgcn_global_load_lds((const unsigned*)((const char*)(gbase) + (voff)[_i]), (PG8_LAS unsigned*)(lds + (bufoff) + ldsw + _i * 8192), 16, 0, 0); } while (0)
#define PG8_LDA(dst, b, h) do { _Pragma("unroll") for (int m = 0; m < 4; ++m) _Pragma("unroll") for (int k = 0; k < 2; ++k) dst[m][k] = *(const PG8_LAS bf16x8*)(lds + PG8_SA(b, h) + aoff + m * 2048 + k * 1024); } while (0)
#define PG8_LDB(dst, b, h) do { _Pragma("unroll") for (int n = 0; n < 2; ++n) _Pragma("unroll") for (int k = 0; k < 2; ++k) dst[n][k] = *(const PG8_LAS bf16x8*)(lds + PG8_SB(b, h) + boff + n * 2048 + k * 1024); } while (0)
#define PG8_MMA(ai, bj, At, Bt) do { __builtin_amdgcn_s_setprio(1); _Pragma("unroll") for (int m = 0; m < 4; ++m) _Pragma("unroll") for (int n = 0; n < 2; ++n) _Pragma("unroll") for (int k = 0; k < 2; ++k) \
        acc[ai][bj][m][n] = __builtin_amdgcn_mfma_f32_16x16x32_bf16(Bt[n][k], At[m][k], acc[ai][bj][m][n], 0, 0, 0); __builtin_amdgcn_s_setprio(0); } while (0)
#define PG8_WAIT_V(n) asm volatile("s_waitcnt vmcnt(" #n ")" ::: "memory")
#define PG8_WAIT_L(n) asm volatile("s_waitcnt lgkmcnt(" #n ")" ::: "memory")
#define PG8_BAR __builtin_amdgcn_s_barrier()
#define PG8_SCHED __builtin_amdgcn_sched_barrier(0)
    Unit cur, nxt; int ui = 0;
    if (!S.next(0, cur)) return;
    f32x4 acc[2][2][4][2];
#pragma unroll
    for (int a = 0; a < 2; ++a)
#pragma unroll
        for (int b = 0; b < 2; ++b)
#pragma unroll
            for (int m = 0; m < 4; ++m)
#pragma unroll
                for (int n = 0; n < 2; ++n) acc[a][b][m][n] = (f32x4){0.f, 0.f, 0.f, 0.f};
    bf16x8 At[4][2], B0[2][2], B1[2][2];
    const char* cA = (const char*)g.A + (size_t)cur.pm * tstep; const char* cB = (const char*)g.Bt + (size_t)cur.pn * tstep;
    S.a_ready(cur);
    if constexpr (SP2) {
        PG8_STAGE(PG8_SB(0, 0), cB, voffB); PG8_STAGE(PG8_SB(0, 1), cB + hstep, voffB); PG8_STAGE(PG8_SA(0, 0), cA, voffA); PG8_STAGE(PG8_SA(0, 1), cA + hstep, voffA);
        if (wr == 1) PG8_BAR;
        PG8_WAIT_V(2); PG8_BAR;
        PG8_STAGE(PG8_SB(1, 0), cB + kstep, voffB); PG8_STAGE(PG8_SA(1, 0), cA + kstep, voffA); PG8_STAGE(PG8_SB(1, 1), cB + hstep + kstep, voffB);
        PG8_WAIT_V(6); PG8_BAR;
    } else {
        PG8_STAGE(PG8_SB(0, 0), cB, voffB); PG8_STAGE(PG8_SA(0, 0), cA, voffA); PG8_STAGE(PG8_SB(0, 1), cB + hstep, voffB); PG8_STAGE(PG8_SA(0, 1), cA + hstep, voffA);
        if (wr == 1) PG8_BAR;
        PG8_WAIT_V(4); PG8_BAR;
        PG8_STAGE(PG8_SB(1, 0), cB + kstep, voffB); PG8_STAGE(PG8_SA(1, 0), cA + kstep, voffA); PG8_STAGE(PG8_SB(1, 1), cB + hstep + kstep, voffB);
        PG8_WAIT_V(6); PG8_BAR;
    }
    for (;;) {
        const bool has_next = S.next(ui + 1, nxt);
        const char* nA = has_next ? (const char*)g.A + (size_t)nxt.pm * tstep : cA; const char* nB = has_next ? (const char*)g.Bt + (size_t)nxt.pn * tstep : cB;
        for (int t = 0; t < nt; t += 2) {
            const bool last = (t == nt - 2);
            const char* a1 = cA + (size_t)(t + 1) * kstep;
            const char* a2 = last ? nA : cA + (size_t)(t + 2) * kstep; const char* b2 = last ? nB : cB + (size_t)(t + 2) * kstep;
            const char* a3 = a2 + kstep; const char* b3 = b2 + kstep;
            if (last && has_next) S.a_ready(nxt);
            if constexpr (SP2) {
            PG8_LDB(B0, 0, 0); PG8_LDB(B1, 0, 1); PG8_SCHED; PG8_LDA(At, 0, 0); PG8_STAGE(PG8_SA(1, 1), a1 + hstep, voffA);
            PG8_WAIT_V(8); PG8_WAIT_L(0); PG8_BAR; PG8_MMA(0, 0, At, B0); PG8_MMA(0, 1, At, B1); PG8_BAR; PG8_SCHED;
            PG8_LDA(At, 0, 1); PG8_STAGE(PG8_SB(0, 0), b2, voffB); PG8_STAGE(PG8_SB(0, 1), b2 + hstep, voffB); PG8_STAGE(PG8_SA(0, 0), a2, voffA);
            PG8_WAIT_V(8); PG8_WAIT_L(0); PG8_BAR; PG8_MMA(1, 0, At, B0); PG8_MMA(1, 1, At, B1); PG8_BAR; PG8_SCHED;
            PG8_LDB(B0, 1, 0); PG8_LDB(B1, 1, 1); PG8_SCHED; PG8_LDA(At, 1, 0); PG8_STAGE(PG8_SA(0, 1), a2 + hstep, voffA);
            PG8_WAIT_V(8); PG8_WAIT_L(0); PG8_BAR; PG8_MMA(0, 0, At, B0); PG8_MMA(0, 1, At, B1); PG8_BAR; PG8_SCHED;
            PG8_LDA(At, 1, 1); PG8_STAGE(PG8_SB(1, 0), b3, voffB); PG8_STAGE(PG8_SB(1, 1), b3 + hstep, voffB); PG8_STAGE(PG8_SA(1, 0), a3, voffA);
            PG8_WAIT_V(8); PG8_WAIT_L(0); PG8_BAR; PG8_MMA(1, 0, At, B0); PG8_MMA(1, 1, At, B1); PG8_BAR; PG8_SCHED;
            } else {
            PG8_LDB(B0, 0, 0); PG8_SCHED; PG8_LDA(At, 0, 0); PG8_STAGE(PG8_SA(1, 1), a1 + hstep, voffA);
            PG8_WAIT_L(8); PG8_BAR; PG8_WAIT_L(0); PG8_MMA(0, 0, At, B0); PG8_BAR; PG8_SCHED;
            PG8_LDB(B1, 0, 1); PG8_STAGE(PG8_SB(0, 0), b2, voffB);
            PG8_BAR; PG8_WAIT_L(0); PG8_MMA(0, 1, At, B1); PG8_BAR;
            PG8_LDA(At, 0, 1); PG8_STAGE(PG8_SA(0, 0), a2, voffA);
            PG8_BAR; PG8_WAIT_L(0); PG8_MMA(1, 0, At, B0); PG8_BAR; PG8_SCHED;
            PG8_STAGE(PG8_SB(0, 1), b2 + hstep, voffB);
            PG8_WAIT_V(6); PG8_BAR; PG8_MMA(1, 1, At, B1); PG8_BAR;
            PG8_LDB(B0, 1, 0); PG8_SCHED; PG8_LDA(At, 1, 0); PG8_STAGE(PG8_SA(0, 1), a2 + hstep, voffA);
            PG8_WAIT_L(8); PG8_BAR; PG8_WAIT_L(0); PG8_MMA(0, 0, At, B0); PG8_BAR; PG8_SCHED;
            PG8_LDB(B1, 1, 1); PG8_STAGE(PG8_SB(1, 0), b3, voffB);
            PG8_BAR; PG8_WAIT_L(0); PG8_MMA(0, 1, At, B1); PG8_BAR;
            PG8_LDA(At, 1, 1); PG8_STAGE(PG8_SA(1, 0), a3, voffA);
            PG8_BAR; PG8_WAIT_L(0); PG8_MMA(1, 0, At, B0); PG8_BAR; PG8_SCHED;
            PG8_STAGE(PG8_SB(1, 1), b3 + hstep, voffB);
            PG8_WAIT_V(6); PG8_BAR; PG8_MMA(1, 1, At, B1); PG8_BAR;
            }
        }
        if constexpr (ALIGN_EPI) { if (wr == 0) PG8_BAR; }
        if constexpr (!Epi::AFTER_DRAIN) { E(acc, cur, wr, wc, fr, fq); S.done(cur); }
        if (!has_next) break;
#pragma unroll
        for (int a = 0; a < 2; ++a)
#pragma unroll
            for (int b = 0; b < 2; ++b)
#pragma unroll
                for (int m = 0; m < 4; ++m)
#pragma unroll
                    for (int n = 0; n < 2; ++n) acc[a][b][m][n] = (f32x4){0.f, 0.f, 0.f, 0.f};
        cur = nxt; cA = nA; cB = nB; ++ui;
        if constexpr (ALIGN_EPI) { if (wr == 1) PG8_BAR; }
    }
    PG8_WAIT_V(0);
    if constexpr (!ALIGN_EPI) { if (wr == 0) PG8_BAR; }
    PG8_BAR;
    if constexpr (Epi::AFTER_DRAIN) { E.fused(acc, cur, wr, wc, fr, fq, lds, wid, lane); S.done(cur); }
#undef PG8_SA
#undef PG8_SB
#undef PG8_STAGE
#undef PG8_LDA
#undef PG8_LDB
#undef PG8_MMA
#undef PG8_WAIT_V
#undef PG8_WAIT_L
#undef PG8_BAR
#undef PG8_SCHED
}
}

#define DI __device__ __forceinline__
#define LAS __attribute__((address_space(3)))
typedef unsigned short bf16_t;
typedef short bf16x8 __attribute__((ext_vector_type(8)));
typedef short s16x4 __attribute__((ext_vector_type(4)));
typedef float f32x4 __attribute__((ext_vector_type(4)));
typedef float f32x2 __attribute__((ext_vector_type(2)));
typedef float f32x16 __attribute__((ext_vector_type(16)));
typedef unsigned u32x4 __attribute__((ext_vector_type(4)));
typedef unsigned u32x2 __attribute__((ext_vector_type(2)));
typedef __bf16 bf16x2_t __attribute__((ext_vector_type(2)));
#define MFMA32(a, b, c) __builtin_amdgcn_mfma_f32_32x32x16_bf16((a), (b), (c), 0, 0, 0)

constexpr int T = 49152, DM = 1024, NPROJ = 3072, NIN = 2960, DFF = 4096, HFF = 2048;
constexpr int C_R = 0, C_K = 256, C_V = 512, C_WD = 768, C_AD = 896, C_GD = 1024;
constexpr int C_AQ = 1152, C_AK = 1664, C_AV = 1792;
constexpr int C_MQ = 1920, C_MK = 2176, C_MV = 2432, C_MO = 2688, C_IG = 2944, C_FG = 2952;
constexpr size_t MiB = 1u << 20;
constexpr size_t WS_SS = 0, WS_CNT = MiB - 4096, WS_CDOT = 1 * MiB, WS_TAB = 2 * MiB + 512 * 1024, WS_BAR = 2 * MiB + 768 * 1024, WS_WIN = 3 * MiB, WS_WOUT = 15 * MiB,
                 WS_W1 = 19 * MiB, WS_W2 = 35 * MiB, WS_VT = 51 * MiB, WS_YB = 63 * MiB, WS_HBP = 87 * MiB, WS_X1 = 111 * MiB, WS_R = 207 * MiB,
                 WS_HID = WS_R + 96 * MiB, WS_END = 495 * MiB;
constexpr int LDS_BYTES = 134400 + 256;
constexpr int NTHR = 512;

struct KP { const float* in[26]; float* out; unsigned char* ws; };

DI unsigned cvtpk(float lo, float hi) { f32x2 v = {lo, hi}; bf16x2_t b = __builtin_convertvector(v, bf16x2_t); return __builtin_bit_cast(unsigned, b); }
DI unsigned short f2bf(float f) { return (unsigned short)(cvtpk(f, 0.f) & 0xffffu); }
DI float bf2f(unsigned h) { return __builtin_bit_cast(float, h << 16); }
DI float bflo(unsigned w) { return __builtin_bit_cast(float, w << 16); }
DI float bfhi(unsigned w) { return __builtin_bit_cast(float, w & 0xffff0000u); }
DI int crow(int reg, int h) { return (reg & 3) + 8 * (reg >> 2) + 4 * h; }
template <int CTRL> DI float dppf(float v) { return __builtin_bit_cast(float, __builtin_amdgcn_update_dpp(0, __builtin_bit_cast(int, v), CTRL, 0xf, 0xf, true)); }
DI float red8(float v) { v += dppf<0xB1>(v); v += dppf<0x4E>(v); v += dppf<0x141>(v); return v; }
DI float red16(float v) { v = red8(v); v += dppf<0x128>(v); return v; }
DI float frcp(float x) { return __builtin_amdgcn_rcpf(x); }
DI float sigmoidf_(float x) { return frcp(1.f + __expf(-x)); }
DI f32x16 zero16() { f32x16 z; for (int i = 0; i < 16; ++i) z[i] = 0.f; return z; }
DI void seq_of_job(int j, int& seq, int& h, int& dir) { if (j < 16) { seq = 8 + (j >> 3); } else { j -= 16; seq = j >> 3; } h = (j >> 1) & 3; dir = j & 1; }
DI void seq_info(int s, int& start, int& len) { if (s < 8) { start = s * 4096; len = 4096; } else { start = 32768 + (s - 8) * 8192; len = 8192; } }
DI int tok_seq_start(int tok, int& len) { if (tok < 32768) { len = 4096; return tok & ~4095; } len = 8192; return 32768 + ((tok - 32768) & ~8191); }

#define XB_TMO      128
#define XB_XCNT(j)  (256  + 64 * (j))
#define XB_XSUB(j)  (1280 + 64 * (j))
#define XB_XGEN(j)  (2304 + 64 * (j))
#define XB_TOP      3328
#define XB_TOPGEN   3392
#define XCD_BAR_WORDS 3456
#define XB_SPIN_CAP (1u << 18)

__device__ __forceinline__ unsigned xb_ld(unsigned* p)              { return __hip_atomic_load(p, __ATOMIC_RELAXED, __HIP_MEMORY_SCOPE_AGENT); }
__device__ __forceinline__ unsigned xb_add(unsigned* p, unsigned v) { return __hip_atomic_fetch_add(p, v, __ATOMIC_RELAXED, __HIP_MEMORY_SCOPE_AGENT); }
__device__ __forceinline__ unsigned xb_xcc_id() { return (unsigned)__builtin_amdgcn_s_getreg((3 << 11) | 20) & 0xFu; }
#define XB_SPIN(cond, bar) do { unsigned _sp = 0; while (cond) { __builtin_amdgcn_s_sleep(1); \
    if ((++_sp & 255u) == 0u) { if (xb_ld(&(bar)[XB_TMO])) break; if (_sp > XB_SPIN_CAP) { atomicAdd(&(bar)[XB_TMO], 1u); break; } } } } while (0)

struct XcdBarrier {
    unsigned* bar; unsigned x;
    volatile LAS unsigned* st;
};

__device__ __forceinline__ XcdBarrier xcd_barrier_post(unsigned* bar, volatile LAS unsigned* st) {
    XcdBarrier b; b.bar = bar; b.x = xb_xcc_id(); b.st = st;
    if (threadIdx.x == 0) (void)xb_add(&bar[XB_XCNT(b.x)], 1u);
    return b;
}
__device__ __forceinline__ void xcd_barrier_complete(unsigned* bar, unsigned x, unsigned& nloc, unsigned& nx) {
    const unsigned G = gridDim.x * gridDim.y * gridDim.z;
    unsigned sum, cnt, mine, sp = 0u;
    for (;;) {
        sum = 0u; cnt = 0u; mine = 0u;
#pragma unroll
        for (unsigned j = 0; j < 16; ++j) { const unsigned c = xb_ld(&bar[XB_XCNT(j)]); sum += c; cnt += (c > 0u) ? 1u : 0u; mine = (j == x) ? c : mine; }
        if (sum == G) break;
        __builtin_amdgcn_s_sleep(1);
        if ((++sp & 255u) == 0u) { if (xb_ld(&bar[XB_TMO])) break; if (sp > XB_SPIN_CAP) { atomicAdd(&bar[XB_TMO], 1u); break; } }
    }
    nloc = mine > 0u ? mine : 1u; nx = cnt > 0u ? cnt : 1u;
}

__device__ __forceinline__ void xcd_barrier(const XcdBarrier& b) {
    asm volatile("s_waitcnt vmcnt(0)" ::: "memory");
    __syncthreads();
    if (threadIdx.x == 0) {
        unsigned* bar = b.bar;
        __builtin_amdgcn_s_waitcnt(0);
        unsigned nloc = b.st[0], nx = b.st[1];
        if (nloc == 0u) { xcd_barrier_complete(bar, b.x, nloc, nx); b.st[0] = nloc; b.st[1] = nx; }
        const unsigned old = xb_add(&bar[XB_XSUB(b.x)], 1u);
        const unsigned gen = old / nloc;
        if (old + 1u == (gen + 1u) * nloc) {
            __builtin_amdgcn_fence(__ATOMIC_RELEASE, "agent");
            asm volatile("s_waitcnt vmcnt(0)" ::: "memory");
            const unsigned og = xb_add(&bar[XB_TOP], 1u);
            const unsigned tg = og / nx;
            if (og + 1u == (tg + 1u) * nx) xb_add(&bar[XB_TOPGEN], 1u);
            else XB_SPIN(xb_ld(&bar[XB_TOPGEN]) == tg, bar);
            __builtin_amdgcn_fence(__ATOMIC_ACQUIRE, "agent");
            xb_add(&bar[XB_XGEN(b.x)], 1u);
            asm volatile("s_waitcnt vmcnt(0)" ::: "memory");
        } else {
            XB_SPIN(xb_ld(&bar[XB_XGEN(b.x)]) == gen, bar);
            __builtin_amdgcn_fence(__ATOMIC_ACQUIRE, "agent");
            asm volatile("s_waitcnt vmcnt(0)" ::: "memory");
        }
    }
    __syncthreads();
}

struct EpiProj {
    static constexpr bool PERM = true, AFTER_DRAIN = false;
    bf16_t* O; const float* ss;
    DI void operator()(const pg8::f32x4 (&acc)[2][2][4][2], const pg8::Unit& u, int wr, int wc, int fr, int fq) const {
        const int row0 = u.pm * 256 + wr * 64 + fr, col0 = u.pn * 256 + wc * 32 + 8 * fq;
#pragma unroll
        for (int ai = 0; ai < 2; ++ai)
#pragma unroll
            for (int m = 0; m < 4; ++m) {
                const int row = row0 + ai * 128 + m * 16;
                const float rs = rsqrtf(ss[row] * (1.f / 1024.f) + 1e-6f);
                bf16_t* rp = O + (size_t)row * NPROJ + col0;
#pragma unroll
                for (int bj = 0; bj < 2; ++bj) {
                    pg8::f32x4 v0 = acc[ai][bj][m][0] * rs, v1 = acc[ai][bj][m][1] * rs;
                    u32x4 w; w.x = cvtpk(v0[0], v0[1]); w.y = cvtpk(v0[2], v0[3]); w.z = cvtpk(v1[0], v1[1]); w.w = cvtpk(v1[2], v1[3]);
                    *(u32x4*)(rp + bj * 128) = w;
                }
            }
    }
};
struct EpiRelu2 {
    static constexpr bool PERM = true, AFTER_DRAIN = false;
    bf16_t* O; const float* ss;
    DI void operator()(const pg8::f32x4 (&acc)[2][2][4][2], const pg8::Unit& u, int wr, int wc, int fr, int fq) const {
        const int row0 = u.pm * 256 + wr * 64 + fr, col0 = u.pn * 256 + wc * 32 + 8 * fq;
#pragma unroll
        for (int ai = 0; ai < 2; ++ai)
#pragma unroll
            for (int m = 0; m < 4; ++m) {
                const int row = row0 + ai * 128 + m * 16;
                const float rs = rsqrtf(ss[row] * (1.f / 1024.f) + 1e-6f);
                bf16_t* rp = O + (size_t)row * HFF + col0;
#pragma unroll
                for (int bj = 0; bj < 2; ++bj) {
                    pg8::f32x4 v0 = acc[ai][bj][m][0] * rs, v1 = acc[ai][bj][m][1] * rs;
#pragma unroll
                    for (int j = 0; j < 4; ++j) { float a = fmaxf(v0[j], 0.f); v0[j] = a * a; float b = fmaxf(v1[j], 0.f); v1[j] = b * b; }
                    u32x4 w; w.x = cvtpk(v0[0], v0[1]); w.y = cvtpk(v0[2], v0[3]); w.z = cvtpk(v1[0], v1[1]); w.w = cvtpk(v1[2], v1[3]);
                    *(u32x4*)(rp + bj * 128) = w;
                }
            }
    }
};
struct EpiPart {
    static constexpr bool PERM = true, AFTER_DRAIN = false;
    bf16_t* O;
    DI void operator()(const pg8::f32x4 (&acc)[2][2][4][2], const pg8::Unit& u, int wr, int wc, int fr, int fq) const {
        const int row0 = u.pm * 256 + wr * 64 + fr, col0 = u.pn * 256 + wc * 32 + 8 * fq;
#pragma unroll
        for (int ai = 0; ai < 2; ++ai)
#pragma unroll
            for (int m = 0; m < 4; ++m) {
                bf16_t* rp = O + (size_t)(row0 + ai * 128 + m * 16) * DM + col0;
#pragma unroll
                for (int bj = 0; bj < 2; ++bj) {
                    const pg8::f32x4 v0 = acc[ai][bj][m][0], v1 = acc[ai][bj][m][1];
                    u32x4 w; w.x = cvtpk(v0[0], v0[1]); w.y = cvtpk(v0[2], v0[3]); w.z = cvtpk(v1[0], v1[1]); w.w = cvtpk(v1[2], v1[3]);
                    *(u32x4*)(rp + bj * 128) = w;
                }
            }
    }
};
template <bool WRITE_HB, bool DO_SS, bool FIRST = false, bool PART = false> struct EpiRes {
    static constexpr bool PERM = true, AFTER_DRAIN = false;
    float* X; bf16_t* HB; float* ss; const float* xin0; const float* xin1;
    DI void operator()(const pg8::f32x4 (&acc)[2][2][4][2], const pg8::Unit& u, int wr, int wc, int fr, int fq) const {
        const int row0 = u.pm * 256 + wr * 64 + fr, col0 = u.pn * 256 + wc * 32 + 8 * fq;
#pragma unroll
        for (int ai = 0; ai < 2; ++ai)
#pragma unroll
            for (int m = 0; m < 4; ++m) {
                const int row = row0 + ai * 128 + m * 16;
                float* xp = X + (size_t)row * DM + col0;
                const float* rp = FIRST ? ((row < 32768 ? xin0 + (size_t)row * DM : xin1 + (size_t)(row - 32768) * DM) + col0) : xp;
                float sq = 0.f;
#pragma unroll
                for (int bj = 0; bj < 2; ++bj) {
                    pg8::f32x4 a0 = *(const pg8::f32x4*)(rp + bj * 128), a1 = *(const pg8::f32x4*)(rp + bj * 128 + 4);
                    a0 += acc[ai][bj][m][0]; a1 += acc[ai][bj][m][1];
                    if (PART) { const u32x4 pw = *(const u32x4*)(HB + (size_t)row * DM + col0 + bj * 128);
                        a0[0] += bflo(pw.x); a0[1] += bfhi(pw.x); a0[2] += bflo(pw.y); a0[3] += bfhi(pw.y); a1[0] += bflo(pw.z); a1[1] += bfhi(pw.z); a1[2] += bflo(pw.w); a1[3] += bfhi(pw.w); }
                    *(pg8::f32x4*)(xp + bj * 128) = a0; *(pg8::f32x4*)(xp + bj * 128 + 4) = a1;
                    if (WRITE_HB) { u32x4 w; w.x = cvtpk(a0[0], a0[1]); w.y = cvtpk(a0[2], a0[3]); w.z = cvtpk(a1[0], a1[1]); w.w = cvtpk(a1[2], a1[3]);
                        *(u32x4*)(HB + (size_t)row * DM + col0 + bj * 128) = w; }
                    if (DO_SS) sq += a0[0] * a0[0] + a0[1] * a0[1] + a0[2] * a0[2] + a0[3] * a0[3] + a1[0] * a1[0] + a1[1] * a1[1] + a1[2] * a1[2] + a1[3] * a1[3];
                }
                if (DO_SS) { sq += __shfl_xor(sq, 16); sq += __shfl_xor(sq, 32); if (fq == 0) atomicAdd(ss + row, sq); }
            }
    }
};

DI void transpose_tile(const float* src, int N, int nvalid, const float* gain, bf16_t* dst, int K, int kt, int nt, LAS float* tile, int tid) {
    const int a = tid & 63, b8 = tid >> 6;
#pragma unroll
    for (int i = 0; i < 8; ++i) { const int k = b8 + 8 * i, n = nt * 64 + a; float v = (n < nvalid) ? src[(size_t)(kt * 64 + k) * N + n] : 0.f; if (gain) v *= gain[kt * 64 + k]; tile[k * 65 + a] = v; }
    __syncthreads();
#pragma unroll
    for (int i = 0; i < 8; ++i) { const int n = b8 + 8 * i; dst[(size_t)(nt * 64 + n) * K + kt * 64 + a] = f2bf(tile[a * 65 + n]); }
    __syncthreads();
}
DI void convert_tile(const KP& p, int it, LAS float* tile, int tid) {
    {
        const int l = it / 3072; int r = it % 3072;
        const float* src; const float* gain; bf16_t* dst; int N, nvalid, K, kt, nt;
        if (r < 768) { src = p.in[3] + (size_t)l * 1024 * NIN; N = NIN; nvalid = NIN; K = 1024; gain = p.in[2] + l * 1024; dst = (bf16_t*)(p.ws + WS_WIN) + (size_t)l * NPROJ * 1024; kt = r / 48; nt = r % 48; }
        else if (r < 1024) { r -= 768; src = p.in[21] + (size_t)l * 1024 * 1024; N = 1024; nvalid = 1024; K = 1024; gain = nullptr; dst = (bf16_t*)(p.ws + WS_WOUT) + (size_t)l * 1024 * 1024; kt = r / 16; nt = r % 16; }
        else if (r < 2048) { r -= 1024; src = p.in[23] + (size_t)l * 1024 * 4096; N = 4096; nvalid = 4096; K = 1024; gain = p.in[22] + l * 1024; dst = (bf16_t*)(p.ws + WS_W1) + (size_t)l * 4096 * 1024; kt = r / 64; nt = r % 64; }
        else { r -= 2048; const int h = r / 512; r %= 512; src = p.in[24] + (size_t)l * 4096 * 1024 + (size_t)h * 2048 * 1024; N = 1024; nvalid = 1024; K = 2048; gain = nullptr;
               dst = (bf16_t*)(p.ws + WS_W2) + (size_t)l * 2 * 1024 * 2048 + (size_t)h * 1024 * 2048; kt = r / 16; nt = r % 16; }
        transpose_tile(src, N, nvalid, gain, dst, K, kt, nt, tile, tid);
    }
}
DI void p0_phase(const KP& p, LAS unsigned char* lds, int tid, int G, int bid) {
    LAS float* tile = (LAS float*)lds;
    for (int it = bid; it < 768; it += G) convert_tile(p, it, tile, tid);
    const int wave = tid >> 6, lane = tid & 63;
    float* ss = (float*)(p.ws + WS_SS);
    bf16_t* xb = (bf16_t*)(p.ws + WS_X1);
    for (int row0 = (bid * 8 + wave) * 2; row0 < T; row0 += G * 8 * 2) {
        f32x4 v[2][4];
#pragma unroll
        for (int r = 0; r < 2; ++r) {
            const int row = row0 + r;
            const float* xs = (row < 32768) ? p.in[0] + (size_t)row * DM : p.in[1] + (size_t)(row - 32768) * DM;
#pragma unroll
            for (int j = 0; j < 4; ++j) v[r][j] = *(const f32x4*)(xs + (j * 64 + lane) * 4);
        }
#pragma unroll
        for (int r = 0; r < 2; ++r) {
            const int row = row0 + r;
            float sq = 0.f;
#pragma unroll
            for (int j = 0; j < 4; ++j) {
                const f32x4 x = v[r][j];
                u32x2 w; w.x = cvtpk(x[0], x[1]); w.y = cvtpk(x[2], x[3]);
                *(u32x2*)(xb + (size_t)row * DM + (j * 64 + lane) * 4) = w;
                sq += x[0] * x[0] + x[1] * x[1] + x[2] * x[2] + x[3] * x[3];
            }
#pragma unroll
            for (int o = 32; o >= 1; o >>= 1) sq += __shfl_xor(sq, o);
            if (lane == 0) ss[row] = sq;
        }
    }
    for (int i = bid * NTHR + tid; i < 4 * T; i += G * NTHR) ss[T + i] = 0.f;
    if (bid == 0) {
        if (tid < 64) ((unsigned*)(p.ws + WS_CNT))[tid] = 0u;
        float2* tab = (float2*)(p.ws + WS_TAB);
        for (int idx = tid; idx < 2048; idx += NTHR) { const int pos = idx >> 4, f = idx & 15; const float inv = powf(10000.f, -(float)f / 16.f); const float ang = (float)pos * inv; tab[idx] = make_float2(cosf(ang), sinf(ang)); }
    }
}

DI void prep_phase(const KP& p, int l, LAS unsigned char* lds, int tid, int G, int bid) {
    bf16_t* proj = (bf16_t*)(p.ws + WS_R);
    bf16_t* vT = (bf16_t*)(p.ws + WS_VT);
    const float2* tab = (const float2*)(p.ws + WS_TAB);
    const float* qn = p.in[15] + l * 64; const float* kn = p.in[16] + l * 64;
    const int wave = tid >> 6, lane = tid & 63, g = lane >> 4, li = lane & 15;
    LAS bf16_t* vts = (LAS bf16_t*)lds;
    for (int unit = bid; unit < T / 64; unit += G) {
        const int tok0 = unit * 64;
        u32x2 raw[8][3];
#pragma unroll
        for (int i = 0; i < 8; ++i) {
            const int tok = tok0 + wave * 8 + i;
#pragma unroll
            for (int it = 0; it < 3; ++it) {
                const int colbase = (it < 2) ? C_AQ + (it * 4 + g) * 64 : C_AK + (g & 1) * 64;
                raw[i][it] = *(const u32x2*)(proj + (size_t)tok * NPROJ + colbase + li * 4);
            }
        }
#pragma unroll
        for (int i = 0; i < 8; ++i) {
            const int tok = tok0 + wave * 8 + i; int len; const int st = tok_seq_start(tok, len); const int pos = tok - st; const int prow = pos >> 6, pcol = pos & 63;
#pragma unroll
            for (int it = 0; it < 3; ++it) {
                const bool act = (it < 2) || (g < 2);
                const int colbase = (it < 2) ? C_AQ + (it * 4 + g) * 64 : C_AK + (g & 1) * 64;
                const float* wn = (it < 2) ? qn : kn;
                bf16_t* ptr = proj + (size_t)tok * NPROJ + colbase + li * 4;
                const u32x2 rw = raw[i][it];
                float x[4] = {bflo(rw.x), bfhi(rw.x), bflo(rw.y), bfhi(rw.y)};
                float sq = x[0] * x[0] + x[1] * x[1] + x[2] * x[2] + x[3] * x[3];
                sq = red16(sq);
                const float rinv = rsqrtf(sq * (1.f / 64.f) + 1e-6f);
                const f32x4 w4 = *(const f32x4*)(wn + li * 4);
                const int idx = (li >> 3) ? pcol : prow; const bool second = (li >> 2) & 1;
                const float scale = (it < 2) ? 0.125f * 1.4426950408889634f : 1.f;
                float o[4];
#pragma unroll
                for (int j = 0; j < 4; ++j) {
                    const float y = x[j] * rinv * w4[j];
                    const float pr = __shfl_xor(y, 4);
                    const int f = (li * 4 + j) & 15;
                    const float2 cs = tab[idx * 16 + f];
                    o[j] = (second ? (y * cs.x + pr * cs.y) : (y * cs.x - pr * cs.y)) * scale;
                }
                if (act) { u32x2 w; w.x = cvtpk(o[0], o[1]); w.y = cvtpk(o[2], o[3]); *(u32x2*)ptr = w; }
            }
        }
#pragma unroll
        for (int i = 0; i < 2; ++i) { const int idx = tid + NTHR * i; const int tl = idx >> 4, c8 = (idx & 15) * 8;
            const u32x4 v = *(const u32x4*)(proj + (size_t)(tok0 + tl) * NPROJ + C_AV + c8); *(LAS u32x4*)(vts + tl * 136 + c8) = v; }
        __syncthreads();
        { const int c = tid >> 2, tq = tid & 3; unsigned w[8];
#pragma unroll
          for (int j = 0; j < 8; ++j) { const unsigned lo = vts[(tq * 16 + 2 * j) * 136 + c], hi = vts[(tq * 16 + 2 * j + 1) * 136 + c]; w[j] = lo | (hi << 16); }
          u32x4 a = {w[0], w[1], w[2], w[3]}, b = {w[4], w[5], w[6], w[7]};
          bf16_t* dp = vT + (size_t)c * T + tok0 + tq * 16; *(u32x4*)dp = a; *(u32x4*)(dp + 8) = b; }
        __syncthreads();
    }
}

DI void attn_unit(const KP& p, int l, int unit, LAS unsigned char* lds, int tid) {
    const float* qnw = p.in[15] + l * 64; const float* knw = p.in[16] + l * 64;
    const bf16_t* proj = (const bf16_t*)(p.ws + WS_R);
    const bf16_t* vT = (const bf16_t*)(p.ws + WS_VT);
    bf16_t* mix = (bf16_t*)(p.ws + WS_X1);
    int seq, kvh, qt;
    if (unit < 512) { seq = 8 + (unit >> 8); const int r = unit & 255; kvh = r >> 7; qt = r & 127; }
    else { const int u2 = unit - 512; seq = u2 >> 7; const int r = u2 & 127; kvh = r >> 6; qt = r & 63; }
    int start, len; seq_info(seq, start, len);
    const int nk = len >> 6;
    const int wave = tid >> 6, lane = tid & 63, r32 = lane & 31, hh = lane >> 5;
    const int head = kvh * 4 + (wave >> 1);
    const int q0 = start + qt * 64 + (wave & 1) * 32;
    bf16x8 qf[4];
    { const bf16_t* qp = proj + (size_t)(q0 + r32) * NPROJ + C_AQ + head * 64 + hh * 8;
#pragma unroll
      for (int ks = 0; ks < 4; ++ks) qf[ks] = *(const bf16x8*)(qp + ks * 16); }
    f32x16 o0 = zero16(), o1 = zero16();
    float lsum = 0.f;
    f32x16 sinit;
    { float mq = fabsf(qnw[lane]), mk = fabsf(knw[lane]);
#pragma unroll
      for (int o = 32; o >= 1; o >>= 1) { mq = fmaxf(mq, __shfl_xor(mq, o)); mk = fmaxf(mk, __shfl_xor(mk, o)); }
      const float bnd = 64.f * 0.125f * 1.4426950408889634f * 1.01f * mq * mk;
#pragma unroll
      for (int i = 0; i < 16; ++i) sinit[i] = -bnd; }
    const int lrow = tid >> 3, lseg = tid & 7;
    const bf16_t* kptr = proj + (size_t)(start + lrow) * NPROJ + C_AK + kvh * 64 + lseg * 8;
    const bf16_t* vptr = vT + (size_t)(kvh * 64 + lrow) * T + start + lseg * 8;
    const int lds_off = lrow * 144 + lseg * 16;
    u32x4 kreg = *(const u32x4*)kptr, vreg = *(const u32x4*)vptr;
    *(LAS u32x4*)(lds + lds_off) = kreg; *(LAS u32x4*)(lds + 9216 + lds_off) = vreg;
    kreg = *(const u32x4*)(kptr + (size_t)64 * NPROJ); vreg = *(const u32x4*)(vptr + 64);
    u32x4 kreg2 = kreg, vreg2 = vreg;
    __syncthreads();
    for (int j = 0; j < nk; ++j) {
        const bool more = (j + 1 < nk);
        if (j + 2 < nk) { kreg2 = *(const u32x4*)(kptr + (size_t)(j + 2) * 64 * NPROJ); vreg2 = *(const u32x4*)(vptr + (j + 2) * 64); }
        LAS unsigned char* Ks = lds + (j & 1) * 18432; LAS unsigned char* Vs = Ks + 9216;
        f32x16 s0 = sinit, s1 = sinit;
#pragma unroll
        for (int ks = 0; ks < 4; ++ks) {
            const bf16x8 a0 = *(const LAS bf16x8*)(Ks + r32 * 144 + (ks * 16 + hh * 8) * 2);
            const bf16x8 a1 = *(const LAS bf16x8*)(Ks + (32 + r32) * 144 + (ks * 16 + hh * 8) * 2);
            s0 = MFMA32(a0, qf[ks], s0); s1 = MFMA32(a1, qf[ks], s1);
        }
        float rs = 0.f;
#pragma unroll
        for (int i = 0; i < 16; ++i) { s0[i] = __builtin_amdgcn_exp2f(s0[i]); rs += s0[i]; }
#pragma unroll
        for (int i = 0; i < 16; ++i) { s1[i] = __builtin_amdgcn_exp2f(s1[i]); rs += s1[i]; }
        lsum += rs;
#pragma unroll
        for (int mb = 0; mb < 2; ++mb)
#pragma unroll
            for (int s = 0; s < 2; ++s) {
                u32x4 pk;
                if (mb == 0) { pk.x = cvtpk(s0[8 * s], s0[8 * s + 1]); pk.y = cvtpk(s0[8 * s + 2], s0[8 * s + 3]); pk.z = cvtpk(s0[8 * s + 4], s0[8 * s + 5]); pk.w = cvtpk(s0[8 * s + 6], s0[8 * s + 7]); }
                else         { pk.x = cvtpk(s1[8 * s], s1[8 * s + 1]); pk.y = cvtpk(s1[8 * s + 2], s1[8 * s + 3]); pk.z = cvtpk(s1[8 * s + 4], s1[8 * s + 5]); pk.w = cvtpk(s1[8 * s + 6], s1[8 * s + 7]); }
                const bf16x8 pb = __builtin_bit_cast(bf16x8, pk);
                const int keyoff = 32 * mb + 16 * s + 4 * hh;
                { const s16x4 lo = *(const LAS s16x4*)(Vs + r32 * 144 + keyoff * 2), hi = *(const LAS s16x4*)(Vs + r32 * 144 + (keyoff + 8) * 2);
                  const bf16x8 va = __builtin_shufflevector(lo, hi, 0, 1, 2, 3, 4, 5, 6, 7); o0 = MFMA32(va, pb, o0); }
                { const s16x4 lo = *(const LAS s16x4*)(Vs + (32 + r32) * 144 + keyoff * 2), hi = *(const LAS s16x4*)(Vs + (32 + r32) * 144 + (keyoff + 8) * 2);
                  const bf16x8 va = __builtin_shufflevector(lo, hi, 0, 1, 2, 3, 4, 5, 6, 7); o1 = MFMA32(va, pb, o1); }
            }
        if (more) { LAS unsigned char* Kn = lds + ((j + 1) & 1) * 18432; *(LAS u32x4*)(Kn + lds_off) = kreg; *(LAS u32x4*)(Kn + 9216 + lds_off) = vreg; }
        asm volatile("s_waitcnt lgkmcnt(0)\n\ts_barrier" ::: "memory");
        kreg = kreg2; vreg = vreg2;
    }
    lsum += __shfl_xor(lsum, 32);
    const float inv = 1.f / lsum;
    bf16_t* op = mix + (size_t)(q0 + r32) * DM + 256 + head * 64;
#pragma unroll
    for (int g4 = 0; g4 < 4; ++g4) {
        u32x2 w0; w0.x = cvtpk(o0[4 * g4] * inv, o0[4 * g4 + 1] * inv); w0.y = cvtpk(o0[4 * g4 + 2] * inv, o0[4 * g4 + 3] * inv);
        *(u32x2*)(op + 8 * g4 + 4 * hh) = w0;
        u32x2 w1; w1.x = cvtpk(o1[4 * g4] * inv, o1[4 * g4 + 1] * inv); w1.y = cvtpk(o1[4 * g4 + 2] * inv, o1[4 * g4 + 3] * inv);
        *(u32x2*)(op + 32 + 8 * g4 + 4 * hh) = w1;
    }
}

constexpr int RW_BUF = 49152, RW_XR = 0, RW_XKD = 8192, RW_XV = 16384, RW_WLW = 24576, RW_ALB = 32768, RW_KKN = 40960, RW_YO = 98304, RW_XWD = 106496, RW_XAD = 111104,
              RW_W2T = 115712, RW_A2T = 124928, RW_CD = 134144, SLOT_OFF = 134400;
#define RW_BAR() asm volatile("s_waitcnt lgkmcnt(0)\n\ts_barrier" ::: "memory")
#define RW_DECODE(i_) const int t = (pt >> 4) + 16 * ((i_) / 5), c4 = (pt & 15) * 4; constexpr int gi = (i_) % 5; \
            const int col = (gi == 0) ? C_R + h * 64 + c4 : (gi == 1) ? C_K + h * 64 + c4 : (gi == 2) ? C_V + h * 64 + c4 : (gi == 3) ? C_WD + dir * 64 + c4 : C_AD + dir * 64 + c4;
#define RW_ISSUE1(chx, i_) { const int t = (pt >> 4) + 16 * ((i_) / 5); \
            const int n = (chx) * 32 + t; const int pos = dir ? (len - 1 - n) : n; \
            const bf16_t* bp = bq[i_]; bq[i_] = bp + bstep; \
            rc[i_] = *(const u32x2*)bp; rp_[i_] = (u32x2){0u, 0u}; rn[i_] = (u32x2){0u, 0u}; \
            if (pos > 0) rp_[i_] = *(const u32x2*)(bp - NPROJ); \
            if (pos < len - 1) rn[i_] = *(const u32x2*)(bp + NPROJ); }
#define RW_ISSUE(chx) do { RW_ISSUE1(chx, 0) RW_ISSUE1(chx, 1) RW_ISSUE1(chx, 2) RW_ISSUE1(chx, 3) RW_ISSUE1(chx, 4) RW_ISSUE1(chx, 5) RW_ISSUE1(chx, 6) RW_ISSUE1(chx, 7) RW_ISSUE1(chx, 8) RW_ISSUE1(chx, 9) } while (0)
#define RW_ISSUEM1(i_) { const bf16_t* bp = bq[i_]; bq[i_] = bp + bstep; \
            rc[i_] = *(const u32x2*)bp; rp_[i_] = *(const u32x2*)(bp - NPROJ); rn[i_] = *(const u32x2*)(bp + NPROJ); }
#define RW_ISSUE_MID() do { RW_ISSUEM1(0) RW_ISSUEM1(1) RW_ISSUEM1(2) RW_ISSUEM1(3) RW_ISSUEM1(4) RW_ISSUEM1(5) RW_ISSUEM1(6) RW_ISSUEM1(7) RW_ISSUEM1(8) RW_ISSUEM1(9) } while (0)
#define RW_CONV1(i_) { RW_DECODE(i_) \
            const f32x4 m4 = mureg[gi]; \
            f32x4 x = {bflo(rc[i_].x), bfhi(rc[i_].x), bflo(rc[i_].y), bfhi(rc[i_].y)}; \
            const f32x4 pn = {bflo(rp_[i_].x) + bflo(rn[i_].x), bfhi(rp_[i_].x) + bfhi(rn[i_].x), bflo(rp_[i_].y) + bflo(rn[i_].y), bfhi(rp_[i_].y) + bfhi(rn[i_].y)}; \
            x = x + (0.5f * pn - x) * m4; \
            if (gi < 3) { LAS float* dst = (gi == 0) ? XR : (gi == 1) ? XKD : XV; *(LAS f32x4*)(dst + t * 64 + c4) = x; } \
            else if (gi == 3) { \
                _Pragma("unroll") for (int j = 0; j < 4; ++j) { const float e = __expf(2.f * x[j]); x[j] = 1.f - 2.f * frcp(e + 1.f); } \
                u32x2 w; w.x = cvtpk(x[0], x[1]); w.y = cvtpk(x[2], x[3]); *(LAS u32x2*)(XWD + t * 72 + c4) = w; } \
            else { u32x2 w; w.x = cvtpk(x[0], x[1]); w.y = cvtpk(x[2], x[3]); *(LAS u32x2*)(XAD + t * 72 + c4) = w; } }
DI void rwkv_job(const KP& p, int l, int job, LAS unsigned char* lds, int tid) {
    int seq, h, dir, rpart; constexpr int nrows = 32;
    { int j = job; if (j < 32) { seq = 8 + (j >> 4); } else { j -= 32; seq = j >> 4; } h = (j >> 2) & 3; dir = (j >> 1) & 1; rpart = j & 1; }
    int start, len; seq_info(seq, start, len);
    const bf16_t* proj = (const bf16_t*)(p.ws + WS_R);
    bf16_t* mix = (bf16_t*)(p.ws + WS_X1);
    bf16_t* yb = (bf16_t*)(p.ws + WS_YB);
    float* cdot = (float*)(p.ws + WS_CDOT);
    const float* mu = p.in[4] + l * 1152;
    const int wave = tid >> 6, lane = tid & 63, r32 = lane & 31, hh = lane >> 5;
    LAS bf16_t* XWD = (LAS bf16_t*)(lds + RW_XWD); LAS bf16_t* XAD = (LAS bf16_t*)(lds + RW_XAD);
    LAS bf16_t* W2T = (LAS bf16_t*)(lds + RW_W2T); LAS bf16_t* A2T = (LAS bf16_t*)(lds + RW_A2T);
    { const float* w2 = p.in[6] + (size_t)((l * 2 + dir) * 64) * 256 + h * 64; const float* a2 = p.in[8] + (size_t)((l * 2 + dir) * 64) * 256 + h * 64;
#pragma unroll
      for (int i = 0; i < 8; ++i) { const int idx = tid + NTHR * i; const int mm = idx >> 6, c = idx & 63; W2T[c * 72 + mm] = f2bf(w2[mm * 256 + c]); A2T[c * 72 + mm] = f2bf(a2[mm * 256 + c]); } }
    const int nch = len >> 5;
    __syncthreads();
    if (tid < 256) {
        const int srow = tid >> 3, sj = (tid & 7) * 8;
        f32x4 Sa = {0.f, 0.f, 0.f, 0.f}, Sb = {0.f, 0.f, 0.f, 0.f};
        RW_BAR(); RW_BAR(); RW_BAR();
#define RW_LD(dst, arr, tt) const f32x4 dst##a = *(const LAS f32x4*)((arr) + (tt) * 64 + sj), dst##b = *(const LAS f32x4*)((arr) + (tt) * 64 + sj + 4)
        for (int ch = 0; ch < nch; ++ch) {
            LAS unsigned char* B = lds + (ch & 1) * RW_BUF;
            LAS float* XR = (LAS float*)(B + RW_XR); LAS float* XKD = (LAS float*)(B + RW_XKD); LAS float* XV = (LAS float*)(B + RW_XV);
            LAS float* WLW = (LAS float*)(B + RW_WLW); LAS float* ALB = (LAS float*)(B + RW_ALB); LAS float* KKN = (LAS float*)(B + RW_KKN);
            LAS float* YO = (LAS float*)(lds + RW_YO + (ch & 1) * 4096);
            f32x4 wa = *(const LAS f32x4*)(WLW + sj), wb = *(const LAS f32x4*)(WLW + sj + 4), ka = *(const LAS f32x4*)(KKN + sj), kb = *(const LAS f32x4*)(KKN + sj + 4);
            f32x4 ba = *(const LAS f32x4*)(ALB + sj), bb = *(const LAS f32x4*)(ALB + sj + 4), da = *(const LAS f32x4*)(XKD + sj), db = *(const LAS f32x4*)(XKD + sj + 4);
            f32x4 ra = *(const LAS f32x4*)(XR + sj), rb = *(const LAS f32x4*)(XR + sj + 4);
            float v = XV[rpart * 32 + srow];
#pragma unroll 8
            for (int t = 0; t < 32; ++t) {
                const int tn = (t < 31) ? t + 1 : 31;
                RW_LD(wn, WLW, tn); RW_LD(kn, KKN, tn); RW_LD(bn, ALB, tn); RW_LD(dn, XKD, tn); RW_LD(rn_, XR, tn);
                const float vn = XV[tn * 64 + rpart * 32 + srow];
                const f32x4 pa = Sa * ka + Sb * kb;
                float sa = (pa[0] + pa[1]) + (pa[2] + pa[3]);
                sa = -red8(sa);
                Sa = Sa * wa + sa * ba + v * da;
                Sb = Sb * wb + sa * bb + v * db;
                const f32x4 py = Sa * ra + Sb * rb;
                float y = (py[0] + py[1]) + (py[2] + py[3]);
                y = red8(y);
                if ((tid & 7) == 0) YO[t * 32 + srow] = y;
                wa = wna; wb = wnb; ka = kna; kb = knb; ba = bna; bb = bnb; da = dna; db = dnb; ra = rn_a; rb = rn_b; v = vn;
                if (t == 19 || t == 23) RW_BAR();
            }
            RW_BAR();
        }
    } else {
        const int ptid = tid - 256;
        const int cli = ptid & 15, cc4 = cli * 4;
        const f32x4 w0v = *(const f32x4*)(p.in[5] + (l * 2 + dir) * 256 + h * 64 + cc4);
        const f32x4 a0v = *(const f32x4*)(p.in[7] + (l * 2 + dir) * 256 + h * 64 + cc4);
        const f32x4 kkw = *(const f32x4*)(p.in[10] + l * 256 + h * 64 + cc4);
        const f32x4 kaw = *(const f32x4*)(p.in[11] + l * 256 + h * 64 + cc4);
        const f32x4 rkw = *(const f32x4*)(p.in[12] + l * 256 + h * 64 + cc4);
        u32x2 rc[10], rp_[10], rn[10];
        const bf16_t* bq[10];
        const long bstep = dir ? -(long)32 * NPROJ : (long)32 * NPROJ;
#define RW_BQ(i_) { const int pt = ptid; RW_DECODE(i_) const int pos = dir ? (len - 1 - t) : t; bq[i_] = proj + (size_t)(start + pos) * NPROJ + col; }
        RW_BQ(0) RW_BQ(1) RW_BQ(2) RW_BQ(3) RW_BQ(4) RW_BQ(5) RW_BQ(6) RW_BQ(7) RW_BQ(8) RW_BQ(9)
        f32x4 mureg[5];
        { const int c4 = (ptid & 15) * 4;
          mureg[0] = *(const f32x4*)(mu + C_R + h * 64 + c4); mureg[1] = *(const f32x4*)(mu + C_K + h * 64 + c4); mureg[2] = *(const f32x4*)(mu + C_V + h * 64 + c4);
          mureg[3] = *(const f32x4*)(mu + C_WD + dir * 64 + c4); mureg[4] = *(const f32x4*)(mu + C_AD + dir * 64 + c4); }
        { int pt = ptid; RW_ISSUE(0); }
        for (int ch = -1; ch < nch; ++ch) {
            int pt = ptid; asm volatile("" : "+v"(pt));
            if (ch >= 1) {
                const int pc = ch - 1;
                LAS float* YO = (LAS float*)(lds + RW_YO + (pc & 1) * 4096); LAS float* CD = (LAS float*)(lds + RW_CD + (pc & 1) * 128);
                const int t = ptid >> 3, c4 = (ptid & 7) * 4;
                const int n = pc * 32 + t; const int pos = dir ? (len - 1 - n) : n; const int tok = start + pos;
                const f32x4 yv = *(const LAS f32x4*)(YO + t * 32 + c4);
                u32x2 w; w.x = cvtpk(yv[0], yv[1]); w.y = cvtpk(yv[2], yv[3]);
                if (c4 < nrows) { if (dir) *(u32x2*)(yb + (size_t)tok * 256 + h * 64 + rpart * nrows + c4) = w; else *(u32x2*)(mix + (size_t)tok * DM + h * 64 + rpart * nrows + c4) = w; }
                if (rpart == 0 && ptid < 32) { const int n2 = pc * 32 + ptid; const int pos2 = dir ? (len - 1 - n2) : n2; cdot[((size_t)(start + pos2) * 4 + h) * 2 + dir] = CD[ptid]; }
            }
            const int nc = ch + 1;
            const bool build = nc < nch;
            LAS unsigned char* B = lds + (nc & 1) * RW_BUF;
            LAS float* XR = (LAS float*)(B + RW_XR); LAS float* XKD = (LAS float*)(B + RW_XKD); LAS float* XV = (LAS float*)(B + RW_XV);
            LAS float* WLW = (LAS float*)(B + RW_WLW); LAS float* ALB = (LAS float*)(B + RW_ALB); LAS float* KKN = (LAS float*)(B + RW_KKN);
            LAS float* CDn = (LAS float*)(lds + RW_CD + (nc & 1) * 128);
            if (build) {
                RW_CONV1(0) RW_CONV1(1) RW_CONV1(2) RW_CONV1(3) RW_CONV1(4) RW_CONV1(5) RW_CONV1(6) RW_CONV1(7) RW_CONV1(8) RW_CONV1(9)
                if (nc + 1 < nch - 1) RW_ISSUE_MID(); else if (nc + 1 < nch) RW_ISSUE(nc + 1);
            }
            RW_BAR();
            if (build) {
                const int mat = (wave - 4) >> 1, nb = (wave - 4) & 1;
                LAS bf16_t* Xs = mat ? XAD : XWD; LAS bf16_t* Ws = mat ? A2T : W2T;
                f32x16 acc = zero16();
#pragma unroll
                for (int ks = 0; ks < 4; ++ks) {
                    const bf16x8 a = *(const LAS bf16x8*)(Xs + r32 * 72 + ks * 16 + hh * 8);
                    const bf16x8 bb = *(const LAS bf16x8*)(Ws + (nb * 32 + r32) * 72 + ks * 16 + hh * 8);
                    acc = MFMA32(a, bb, acc);
                }
                LAS float* dst = mat ? ALB : WLW;
#pragma unroll
                for (int i = 0; i < 16; ++i) dst[crow(i, hh) * 64 + nb * 32 + r32] = acc[i];
            }
            RW_BAR();
            if (build) {
#pragma unroll
                for (int it = 0; it < 2; ++it) {
                    const int ct = (ptid >> 4) + 16 * it;
                    const f32x4 wl = *(const LAS f32x4*)(WLW + ct * 64 + cc4), al = *(const LAS f32x4*)(ALB + ct * 64 + cc4);
                    const f32x4 k4 = *(const LAS f32x4*)(XKD + ct * 64 + cc4), r4 = *(const LAS f32x4*)(XR + ct * 64 + cc4);
                    f32x4 w, a, kkr, kd;
                    float ssq = 0.f, cd = 0.f;
#pragma unroll
                    for (int j = 0; j < 4; ++j) {
                        const float sg = sigmoidf_(w0v[j] + wl[j]);
                        w[j] = __expf(-0.6065306597126334f * sg);
                        a[j] = sigmoidf_(a0v[j] + al[j]);
                        kkr[j] = k4[j] * kkw[j]; ssq += kkr[j] * kkr[j];
                        kd[j] = k4[j] * (1.f + (a[j] - 1.f) * kaw[j]);
                        cd += r4[j] * kd[j] * rkw[j];
                    }
                    ssq = red16(ssq); cd = red16(cd);
                    const float inv = __builtin_amdgcn_rsqf(fmaxf(ssq, 1e-24f));
                    f32x4 kkn, bv;
#pragma unroll
                    for (int j = 0; j < 4; ++j) { kkn[j] = kkr[j] * inv; bv[j] = kkn[j] * a[j]; }
                    *(LAS f32x4*)(WLW + ct * 64 + cc4) = w; *(LAS f32x4*)(ALB + ct * 64 + cc4) = bv; *(LAS f32x4*)(KKN + ct * 64 + cc4) = kkn; *(LAS f32x4*)(XKD + ct * 64 + cc4) = kd;
                    if (cli == 0) CDn[ct] = cd;
                }
            }
            RW_BAR();
        }
        {
            const int pc = nch - 1;
            LAS float* YO = (LAS float*)(lds + RW_YO + (pc & 1) * 4096); LAS float* CD = (LAS float*)(lds + RW_CD + (pc & 1) * 128);
            const int t = ptid >> 3, c4 = (ptid & 7) * 4;
            const int n = pc * 32 + t; const int pos = dir ? (len - 1 - n) : n; const int tok = start + pos;
            const f32x4 yv = *(const LAS f32x4*)(YO + t * 32 + c4);
            u32x2 w; w.x = cvtpk(yv[0], yv[1]); w.y = cvtpk(yv[2], yv[3]);
            if (c4 < nrows) { if (dir) *(u32x2*)(yb + (size_t)tok * 256 + h * 64 + rpart * nrows + c4) = w; else *(u32x2*)(mix + (size_t)tok * DM + h * 64 + rpart * nrows + c4) = w; }
            if (rpart == 0 && ptid < 32) { const int n2 = pc * 32 + ptid; const int pos2 = dir ? (len - 1 - n2) : n2; cdot[((size_t)(start + pos2) * 4 + h) * 2 + dir] = CD[ptid]; }
        }
    }
    __syncthreads();
}

constexpr int ML_QS = 0, ML_KS = 9216, ML_KT = 18432, ML_VT = 27648, ML_VWT = 36864, ML_PS = 46080, ML_CB = 55296, ML_WGT = 64512, ML_RR = 64768, ML_MROW = 65024,
              ML_SC = 65280, ML_EMT = 65536, ML_DENI = 65792, ML_NS = 66048, ML_A12 = 66304;
DI void mlstm_job(const KP& p, int l, int job, LAS unsigned char* lds, int tid) {
    int seq, hm, dir; seq_of_job(job, seq, hm, dir);
    int start, len; seq_info(seq, start, len);
    const bf16_t* proj = (const bf16_t*)(p.ws + WS_R);
    bf16_t* mix = (bf16_t*)(p.ws + WS_X1);
    bf16_t* hbp = (bf16_t*)(p.ws + WS_HBP);
    const float* cw = p.in[17] + l * 3 * 512;
    const float ibv = p.in[18][(l * 2 + dir) * 4 + hm], fbv = p.in[19][(l * 2 + dir) * 4 + hm];
    const int wave = tid >> 6, lane = tid & 63, r32 = lane & 31, hh = lane >> 5;
    LAS bf16_t* Qs = (LAS bf16_t*)(lds + ML_QS); LAS bf16_t* Ks = (LAS bf16_t*)(lds + ML_KS); LAS bf16_t* KT = (LAS bf16_t*)(lds + ML_KT);
    LAS bf16_t* VT = (LAS bf16_t*)(lds + ML_VT); LAS bf16_t* VWT = (LAS bf16_t*)(lds + ML_VWT); LAS bf16_t* Ps = (LAS bf16_t*)(lds + ML_PS); LAS bf16_t* CB = (LAS bf16_t*)(lds + ML_CB);
    LAS float* WGT = (LAS float*)(lds + ML_WGT); LAS float* RR = (LAS float*)(lds + ML_RR); LAS float* MROW = (LAS float*)(lds + ML_MROW); LAS float* SC = (LAS float*)(lds + ML_SC);
    LAS float* EMT = (LAS float*)(lds + ML_EMT); LAS float* DENI = (LAS float*)(lds + ML_DENI); LAS float* NS = (LAS float*)(lds + ML_NS); LAS float* A12 = (LAS float*)(lds + ML_A12);
    for (int i = tid; i < 64 * 72; i += NTHR) CB[i] = 0;
    if (tid < 64) NS[tid] = 0.f;
    f32x16 Creg = zero16();
    float Mst = 0.f;
    __syncthreads();
    const int nch = len >> 6;
    const int ll = tid >> 3, e8 = (tid & 7) * 8;
    for (int ch = 0; ch < nch; ++ch) {
        {
            const int n = ch * 64 + ll; const int pos = dir ? (len - 1 - n) : n; const int tok = start + pos;
#pragma unroll
            for (int which = 0; which < 2; ++which) {
                const int col = (which ? C_MK : C_MQ) + hm * 64 + e8; const int cwc = (which ? 256 : 0) + hm * 64 + e8;
                const bf16_t* bp = proj + (size_t)tok * NPROJ + col;
                const u32x4 cu = *(const u32x4*)bp; u32x4 pv = {0u, 0u, 0u, 0u}, nv = {0u, 0u, 0u, 0u};
                if (pos > 0) pv = *(const u32x4*)(bp - NPROJ);
                if (pos < len - 1) nv = *(const u32x4*)(bp + NPROJ);
                float o[8];
#pragma unroll
                for (int j = 0; j < 4; ++j) {
                    const f32x2 c0 = *(const f32x2*)(cw + cwc + 2 * j), c1 = *(const f32x2*)(cw + 512 + cwc + 2 * j), c2 = *(const f32x2*)(cw + 1024 + cwc + 2 * j);
                    const float v0 = c0.x * bflo(pv[j]) + c1.x * bflo(cu[j]) + c2.x * bflo(nv[j]);
                    const float v1 = c0.y * bfhi(pv[j]) + c1.y * bfhi(cu[j]) + c2.y * bfhi(nv[j]);
                    o[2 * j] = v0 * sigmoidf_(v0); o[2 * j + 1] = v1 * sigmoidf_(v1);
                }
                if (which) {
#pragma unroll
                    for (int j = 0; j < 8; ++j) o[j] *= 0.125f;
                }
                u32x4 w; w.x = cvtpk(o[0], o[1]); w.y = cvtpk(o[2], o[3]); w.z = cvtpk(o[4], o[5]); w.w = cvtpk(o[6], o[7]);
                if (!which) *(LAS u32x4*)(Qs + ll * 72 + e8) = w;
                else { *(LAS u32x4*)(Ks + ll * 72 + e8) = w;
#pragma unroll
                    for (int j = 0; j < 4; ++j) { KT[(e8 + 2 * j) * 72 + ll] = (bf16_t)(w[j] & 0xffffu); KT[(e8 + 2 * j + 1) * 72 + ll] = (bf16_t)(w[j] >> 16); } }
            }
        }
        if (wave == 0) {
            const int n = ch * 64 + lane; const int pos = dir ? (len - 1 - n) : n; const int tok = start + pos;
            const float igv = bf2f(proj[(size_t)tok * NPROJ + C_IG + dir * 4 + hm]) + ibv;
            const float fgv = bf2f(proj[(size_t)tok * NPROJ + C_FG + dir * 4 + hm]) + fbv;
            const float lf = (fgv > 0.f) ? -log1pf(__expf(-fgv)) : (fgv - log1pf(__expf(fgv)));
            float b = lf;
#pragma unroll
            for (int o = 1; o < 64; o <<= 1) { const float t2 = __shfl_up(b, o); if (lane >= o) b += t2; }
            const float bL = __shfl(b, 63);
            const float g = bL - b + igv;
            float mg = g;
#pragma unroll
            for (int o = 32; o >= 1; o >>= 1) mg = fmaxf(mg, __shfl_xor(mg, o));
            const float wgt = __expf(g - mg);
            const float r = igv - b;
            float cm = r;
#pragma unroll
            for (int o = 1; o < 64; o <<= 1) { const float t2 = __shfl_up(cm, o); if (lane >= o) cm = fmaxf(cm, t2); }
            const float mrow = fmaxf(cm, Mst);
            WGT[lane] = wgt; RR[lane] = r; MROW[lane] = mrow; SC[lane] = __expf(Mst - mrow); EMT[lane] = __expf(-(b + mrow));
            const float Mnew = fmaxf(bL + Mst, mg);
            if (lane == 0) { A12[0] = __expf(bL + Mst - Mnew); A12[1] = __expf(mg - Mnew); }
            Mst = Mnew;
        }
        __syncthreads();
        {
            const int n = ch * 64 + ll; const int pos = dir ? (len - 1 - n) : n; const int tok = start + pos;
            const u32x4 vv = *(const u32x4*)(proj + (size_t)tok * NPROJ + C_MV + hm * 64 + e8);
            const float wg = WGT[ll];
#pragma unroll
            for (int j = 0; j < 4; ++j) {
                VT[(e8 + 2 * j) * 72 + ll] = (bf16_t)(vv[j] & 0xffffu); VT[(e8 + 2 * j + 1) * 72 + ll] = (bf16_t)(vv[j] >> 16);
                const unsigned pw = cvtpk(bflo(vv[j]) * wg, bfhi(vv[j]) * wg);
                VWT[(e8 + 2 * j) * 72 + ll] = (bf16_t)(pw & 0xffffu); VWT[(e8 + 2 * j + 1) * 72 + ll] = (bf16_t)(pw >> 16);
            }
        }
        __syncthreads();
        if (wave < 4) {
            const int tb = wave >> 1, sb = wave & 1;
            f32x16 acc = zero16();
#pragma unroll
            for (int ks = 0; ks < 4; ++ks) {
                const bf16x8 a = *(const LAS bf16x8*)(Qs + (tb * 32 + r32) * 72 + ks * 16 + hh * 8);
                const bf16x8 b = *(const LAS bf16x8*)(Ks + (sb * 32 + r32) * 72 + ks * 16 + hh * 8);
                acc = MFMA32(a, b, acc);
            }
            const int s = sb * 32 + r32; const float rs_ = RR[s];
#pragma unroll
            for (int i = 0; i < 16; ++i) { const int t = tb * 32 + crow(i, hh); const float pvv = (s <= t) ? __expf(rs_ - MROW[t]) * acc[i] : 0.f; Ps[t * 72 + s] = f2bf(pvv); }
        } else {
            const int db = (wave - 4) >> 1, eb = (wave - 4) & 1;
            f32x16 kc = zero16();
#pragma unroll
            for (int ks = 0; ks < 4; ++ks) {
                const bf16x8 a = *(const LAS bf16x8*)(VWT + (db * 32 + r32) * 72 + ks * 16 + hh * 8);
                const bf16x8 b = *(const LAS bf16x8*)(KT + (eb * 32 + r32) * 72 + ks * 16 + hh * 8);
                kc = MFMA32(a, b, kc);
            }
            const float a1 = A12[0], a2 = A12[1];
#pragma unroll
            for (int i = 0; i < 16; ++i) Creg[i] = a1 * Creg[i] + a2 * kc[i];
        }
        __syncthreads();
        f32x16 acc = zero16();
        float ncv = 0.f;
        if (wave < 4) {
            const int tb = wave >> 1, db = wave & 1;
#pragma unroll
            for (int ks = 0; ks < 4; ++ks) {
                const bf16x8 a = *(const LAS bf16x8*)(Qs + (tb * 32 + r32) * 72 + ks * 16 + hh * 8);
                const bf16x8 b = *(const LAS bf16x8*)(CB + (db * 32 + r32) * 72 + ks * 16 + hh * 8);
                acc = MFMA32(a, b, acc);
            }
#pragma unroll
            for (int i = 0; i < 16; ++i) acc[i] *= SC[tb * 32 + crow(i, hh)];
#pragma unroll
            for (int ks = 0; ks < 4; ++ks) {
                const bf16x8 a = *(const LAS bf16x8*)(Ps + (tb * 32 + r32) * 72 + ks * 16 + hh * 8);
                const bf16x8 b = *(const LAS bf16x8*)(VT + (db * 32 + r32) * 72 + ks * 16 + hh * 8);
                acc = MFMA32(a, b, acc);
            }
        } else if (wave == 4) {
            float rsum = 0.f, qn = 0.f;
            for (int e = 0; e < 64; ++e) { rsum += bf2f(Ps[lane * 72 + e]); qn += bf2f(Qs[lane * 72 + e]) * NS[e]; }
            const float den = rsum + SC[lane] * qn;
            DENI[lane] = 1.f / fmaxf(fabsf(den), EMT[lane]);
        } else if (wave == 5) {
            for (int s = 0; s < 64; ++s) ncv += WGT[s] * bf2f(KT[lane * 72 + s]);
        }
        __syncthreads();
        if (wave < 4) {
            const int tb = wave >> 1, db = wave & 1;
#pragma unroll
            for (int i = 0; i < 16; ++i) {
                const int t = tb * 32 + crow(i, hh); const int n = ch * 64 + t; const int pos = dir ? (len - 1 - n) : n; const int tok = start + pos;
                const bf16_t o = f2bf(acc[i] * DENI[t]);
                if (dir) hbp[(size_t)tok * 256 + hm * 64 + db * 32 + r32] = o; else mix[(size_t)tok * DM + 768 + hm * 64 + db * 32 + r32] = o;
            }
        } else {
            const int db = (wave - 4) >> 1, eb = (wave - 4) & 1;
#pragma unroll
            for (int i = 0; i < 16; ++i) CB[(db * 32 + crow(i, hh)) * 72 + eb * 32 + r32] = f2bf(Creg[i]);
            if (wave == 5) NS[lane] = A12[0] * NS[lane] + A12[1] * ncv;
        }
        __syncthreads();
    }
}

DI void mixers_phase(const KP& p, int l, int cidx, LAS unsigned char* lds, int tid, int G, int bid) {
    unsigned* cnt = (unsigned*)(p.ws + WS_CNT) + cidx;
    LAS int* slot = (LAS int*)(lds + SLOT_OFF);
    for (;;) {
        if (tid == 0) *slot = (int)atomicAdd(cnt, 1u);
        __syncthreads();
        const int item = *slot;
        __syncthreads();
        if (item >= 240 + 1536) {
            if (l != 0 || item >= 240 + 1536 + 1344) break;
            const int t0 = 768 + (item - 1776) * 4;
            for (int q = 0; q < 4; ++q) convert_tile(p, t0 + q, (LAS float*)lds, tid);
            continue;
        }
        int kind, jb;
        if (item < 32) { kind = 0; jb = item; } else if (item < 48) { kind = 1; jb = item - 32; } else if (item < 176) { kind = 0; jb = item - 48 + 32; }
        else if (item < 240) { kind = 1; jb = item - 176 + 16; } else { kind = 2; jb = item - 240; }
        int t2 = tid; asm volatile("" : "+v"(t2));
#ifndef REP_R
#define REP_R 1
#endif
#ifndef REP_M
#define REP_M 1
#endif
#ifndef REP_T
#define REP_T 1
#endif
        if (kind == 0) { rwkv_job(p, l, jb, lds, t2); }
        else if (kind == 1) { for (int rep = 0; rep < REP_M; ++rep) { mlstm_job(p, l, jb, lds, t2); __syncthreads(); } }
        else { for (int rep = 0; rep < REP_T; ++rep) { attn_unit(p, l, jb, lds, t2); __syncthreads(); } }
        __syncthreads();
    }
}

constexpr int PO_G2T = 0, PO_AS = 69632, PO_GO = 87040;
DI void post_phase(const KP& p, int l, LAS unsigned char* lds, int tid, int G, int bid) {
    const bf16_t* proj = (const bf16_t*)(p.ws + WS_R);
    bf16_t* mix = (bf16_t*)(p.ws + WS_X1);
    const bf16_t* yb = (const bf16_t*)(p.ws + WS_YB);
    const bf16_t* hbp = (const bf16_t*)(p.ws + WS_HBP);
    const float* cdot = (const float*)(p.ws + WS_CDOT);
    const float* mu = p.in[4] + l * 1152;
    const float* lnw = p.in[13] + l * 256; const float* lnb = p.in[14] + l * 256; const float* nw = p.in[20] + l * 256;
    LAS bf16_t* G2T = (LAS bf16_t*)(lds + PO_G2T); LAS bf16_t* AS = (LAS bf16_t*)(lds + PO_AS); LAS bf16_t* GO = (LAS bf16_t*)(lds + PO_GO);
    const int wave = tid >> 6, lane = tid & 63, r32 = lane & 31, hh = lane >> 5;
    { const float* g2 = p.in[9] + (size_t)l * 128 * 256;
      for (int i = 0; i < 64; ++i) { const int idx = tid + NTHR * i; const int mm = idx >> 8, c = idx & 255; G2T[c * 136 + mm] = f2bf(g2[idx]); } }
    __syncthreads();
    for (int unit = bid; unit < T / 64; unit += G) {
        const int tok0 = unit * 64;
        int len; const int st = tok_seq_start(tok0, len);
#pragma unroll
        for (int i = 0; i < 4; ++i) {
            const int q = tid + NTHR * i; const int t = q >> 5, c4 = (q & 31) * 4; const int tok = tok0 + t; const int pos = tok - st;
            const bf16_t* bp = proj + (size_t)tok * NPROJ + C_GD + c4;
            const u32x2 cu = *(const u32x2*)bp; u32x2 pv = {0u, 0u}, nv = {0u, 0u};
            if (pos > 0) pv = *(const u32x2*)(bp - NPROJ);
            if (pos < len - 1) nv = *(const u32x2*)(bp + NPROJ);
            const f32x4 m4 = *(const f32x4*)(mu + C_GD + c4);
            float x[4] = {bflo(cu.x), bfhi(cu.x), bflo(cu.y), bfhi(cu.y)};
            const float pn[4] = {bflo(pv.x) + bflo(nv.x), bfhi(pv.x) + bfhi(nv.x), bflo(pv.y) + bflo(nv.y), bfhi(pv.y) + bfhi(nv.y)};
#pragma unroll
            for (int j = 0; j < 4; ++j) x[j] = sigmoidf_(x[j] + (0.5f * pn[j] - x[j]) * m4[j]);
            u32x2 w; w.x = cvtpk(x[0], x[1]); w.y = cvtpk(x[2], x[3]); *(LAS u32x2*)(AS + t * 136 + c4) = w;
        }
        __syncthreads();
        {
            const int hd = wave & 3, tb = wave >> 2;
            f32x16 a0 = zero16(), a1 = zero16();
#pragma unroll
            for (int ks = 0; ks < 8; ++ks) {
                const bf16x8 a = *(const LAS bf16x8*)(AS + (tb * 32 + r32) * 136 + ks * 16 + hh * 8);
                const bf16x8 b0 = *(const LAS bf16x8*)(G2T + (hd * 64 + r32) * 136 + ks * 16 + hh * 8);
                const bf16x8 b1 = *(const LAS bf16x8*)(G2T + (hd * 64 + 32 + r32) * 136 + ks * 16 + hh * 8);
                a0 = MFMA32(a, b0, a0); a1 = MFMA32(a, b1, a1);
            }
#pragma unroll
            for (int i = 0; i < 16; ++i) { const int t = tb * 32 + crow(i, hh); GO[t * 264 + hd * 64 + r32] = f2bf(a0[i]); GO[t * 264 + hd * 64 + 32 + r32] = f2bf(a1[i]); }
        }
        __syncthreads();
#pragma unroll 1
        for (int it = 0; it < 8; ++it) {
            const int task = tid + NTHR * it; const int grp = task >> 4, li = task & 15; const int t = grp >> 2, hd = grp & 3; const int c4 = li * 4;
            const int tok = tok0 + t; const int pos = tok - st;
            {
                const u32x2 yf = *(const u32x2*)(mix + (size_t)tok * DM + hd * 64 + c4), ybv = *(const u32x2*)(yb + (size_t)tok * 256 + hd * 64 + c4);
                float x[4] = {bflo(yf.x) + bflo(ybv.x), bfhi(yf.x) + bfhi(ybv.x), bflo(yf.y) + bflo(ybv.y), bfhi(yf.y) + bfhi(ybv.y)};
                const float mean = red16(x[0] + x[1] + x[2] + x[3]) * (1.f / 64.f);
                float vs = 0.f;
#pragma unroll
                for (int j = 0; j < 4; ++j) { x[j] -= mean; vs += x[j] * x[j]; }
                const float rstd = rsqrtf(red16(vs) * (1.f / 64.f) + 64e-5f);
                const bf16_t* bp = proj + (size_t)tok * NPROJ + C_V + hd * 64 + c4;
                const u32x2 cu = *(const u32x2*)bp; u32x2 pv = {0u, 0u}, nv = {0u, 0u};
                if (pos > 0) pv = *(const u32x2*)(bp - NPROJ);
                if (pos < len - 1) nv = *(const u32x2*)(bp + NPROJ);
                const f32x4 m4 = *(const f32x4*)(mu + C_V + hd * 64 + c4);
                float v[4] = {bflo(cu.x), bfhi(cu.x), bflo(cu.y), bfhi(cu.y)};
                const float pn[4] = {bflo(pv.x) + bflo(nv.x), bfhi(pv.x) + bfhi(nv.x), bflo(pv.y) + bflo(nv.y), bfhi(pv.y) + bfhi(nv.y)};
                const f32x2 cdv = *(const f32x2*)(cdot + ((size_t)tok * 4 + hd) * 2);
                const float cds = cdv.x + cdv.y;
                const f32x4 lw = *(const f32x4*)(lnw + hd * 64 + c4), lb = *(const f32x4*)(lnb + hd * 64 + c4);
                const u32x2 gv = *(const LAS u32x2*)(GO + t * 264 + hd * 64 + c4);
                const float g[4] = {bflo(gv.x), bfhi(gv.x), bflo(gv.y), bfhi(gv.y)};
                float o[4];
#pragma unroll
                for (int j = 0; j < 4; ++j) { const float vsft = v[j] + (0.5f * pn[j] - v[j]) * m4[j]; o[j] = (x[j] * rstd * lw[j] + lb[j] + cds * vsft) * g[j]; }
                u32x2 w; w.x = cvtpk(o[0], o[1]); w.y = cvtpk(o[2], o[3]); *(u32x2*)(mix + (size_t)tok * DM + hd * 64 + c4) = w;
            }
            {
                const u32x2 hf = *(const u32x2*)(mix + (size_t)tok * DM + 768 + hd * 64 + c4), hb = *(const u32x2*)(hbp + (size_t)tok * 256 + hd * 64 + c4);
                const float x[4] = {bflo(hf.x) + bflo(hb.x), bfhi(hf.x) + bfhi(hb.x), bflo(hf.y) + bflo(hb.y), bfhi(hf.y) + bfhi(hb.y)};
                const float ms = red16(x[0] * x[0] + x[1] * x[1] + x[2] * x[2] + x[3] * x[3]) * (1.f / 64.f);
                const float rinv = rsqrtf(ms + 1e-6f);
                const u32x2 ov = *(const u32x2*)(proj + (size_t)tok * NPROJ + C_MO + hd * 64 + c4);
                const float og[4] = {bflo(ov.x), bfhi(ov.x), bflo(ov.y), bfhi(ov.y)};
                const f32x4 nwv = *(const f32x4*)(nw + hd * 64 + c4);
                float o[4];
#pragma unroll
                for (int j = 0; j < 4; ++j) o[j] = sigmoidf_(og[j]) * x[j] * rinv * nwv[j];
                u32x2 w; w.x = cvtpk(o[0], o[1]); w.y = cvtpk(o[2], o[3]); *(u32x2*)(mix + (size_t)tok * DM + 768 + hd * 64 + c4) = w;
            }
        }
        __syncthreads();
    }
}

DI void final_phase(const KP& p, int tid, int G, int bid) {
    const float* ss = (const float*)(p.ws + WS_SS) + 4 * T;
    const float* g = p.in[25];
    const int wave = tid >> 6, lane = tid & 63;
    f32x4 gv[4];
#pragma unroll
    for (int j = 0; j < 4; ++j) gv[j] = *(const f32x4*)(g + (j * 64 + lane) * 4);
    for (int row = (bid * 8 + wave) * 4; row < T; row += G * 8 * 4) {
        f32x4 v[4][4]; float rs[4];
#pragma unroll
        for (int r = 0; r < 4; ++r) {
            rs[r] = rsqrtf(ss[row + r] * (1.f / 1024.f) + 1e-6f);
#pragma unroll
            for (int j = 0; j < 4; ++j) v[r][j] = *(const f32x4*)(p.out + (size_t)(row + r) * DM + (j * 64 + lane) * 4);
        }
#pragma unroll
        for (int r = 0; r < 4; ++r)
#pragma unroll
            for (int j = 0; j < 4; ++j) *(f32x4*)(p.out + (size_t)(row + r) * DM + (j * 64 + lane) * 4) = v[r][j] * rs[r] * gv[j];
    }
}

__global__ void __launch_bounds__(NTHR, 2) fwd_kernel(KP p) {
    extern __shared__ __attribute__((aligned(16))) unsigned char lds_raw[];
    LAS unsigned char* lds = (LAS unsigned char*)lds_raw;
    cg::grid_group grid = cg::this_grid();
    int tid = threadIdx.x; const int G = gridDim.x, bid = blockIdx.x;
#define LAUNDER() asm volatile("" : "+v"(tid))
    float* ss = (float*)(p.ws + WS_SS);
    bf16_t* X1 = (bf16_t*)(p.ws + WS_X1);
    bf16_t* PROJ = (bf16_t*)(p.ws + WS_R);
    bf16_t* HB = (bf16_t*)(p.ws + WS_R);
    bf16_t* HID = (bf16_t*)(p.ws + WS_HID);

        LAUNDER();
    volatile LAS unsigned* bst = (volatile LAS unsigned*)(lds + SLOT_OFF + 16);
    if (tid == 0) { bst[0] = 0u; bst[1] = 0u; }
    __syncthreads();
    const XcdBarrier xbar = xcd_barrier_post((unsigned*)(p.ws + WS_BAR), bst);
#define GSYNC() xcd_barrier(xbar)
    p0_phase(p, lds, tid, G, bid);
    grid.sync();
#ifdef PROBE_SYNC20
    for (int i = 0; i < 20; ++i) GSYNC();
#endif
#ifdef PROBE_P0X2
    LAUNDER(); p0_phase(p, lds, tid, G, bid);
    GSYNC();
#endif
#ifdef PROBE_SYNC10
    for (int i = 0; i < 10; ++i) GSYNC();
#endif
    for (int l = 0; l < 2; ++l) {
        {
            pg8::Gemm g{X1, (const bf16_t*)(p.ws + WS_WIN) + (size_t)l * NPROJ * 1024, T, NPROJ, 1024}; pg8::StaticOrder S; S.init(T, NPROJ, G, bid);
            EpiProj E{PROJ, ss + (2 * l) * T};
            pg8::gemm_phase<EpiProj, pg8::StaticOrder, true, true>(lds, g, S, E);
#ifdef PROBE_P1X2
            GSYNC();
            pg8::gemm_phase<EpiProj, pg8::StaticOrder, true, true>(lds, g, S, E);
#endif
        }
        GSYNC();
        LAUNDER();
        prep_phase(p, l, lds, tid, G, bid);
        GSYNC();
        LAUNDER();
        mixers_phase(p, l, l, lds, tid, G, bid);
#ifdef PROBE_MIX2
        GSYNC(); LAUNDER();
        mixers_phase(p, l, l + 2, lds, tid, G, bid);
#endif
        GSYNC();
        LAUNDER();
        post_phase(p, l, lds, tid, G, bid);
        GSYNC();
        {
            pg8::Gemm g{X1, (const bf16_t*)(p.ws + WS_WOUT) + (size_t)l * 1024 * 1024, T, DM, 1024}; pg8::StaticOrder S; S.init(T, DM, G, bid);
            if (l == 0) { EpiRes<true, true, true> E{p.out, HB, ss + (2 * l + 1) * T, p.in[0], p.in[1]}; pg8::gemm_phase<EpiRes<true, true, true>, pg8::StaticOrder, true, true>(lds, g, S, E); }
            else { EpiRes<true, true> E{p.out, HB, ss + (2 * l + 1) * T, nullptr, nullptr}; pg8::gemm_phase<EpiRes<true, true>, pg8::StaticOrder, true, true>(lds, g, S, E); }
        }
        GSYNC();
        for (int hf = 0; hf < 2; ++hf) {
            {
                pg8::Gemm g{HB, (const bf16_t*)(p.ws + WS_W1) + (size_t)l * 4096 * 1024 + (size_t)hf * HFF * 1024, T, HFF, 1024}; pg8::StaticOrder S; S.init(T, HFF, G, bid);
                EpiRelu2 E{HID, ss + (2 * l + 1) * T};
                pg8::gemm_phase<EpiRelu2, pg8::StaticOrder, true, true>(lds, g, S, E);
            }
            GSYNC();
            {
                pg8::Gemm g{HID, (const bf16_t*)(p.ws + WS_W2) + (size_t)l * 2 * 1024 * 2048 + (size_t)hf * 1024 * 2048, T, DM, HFF}; pg8::StaticOrder S; S.init(T, DM, G, bid);
                if (hf == 0) { EpiPart E{X1}; pg8::gemm_phase<EpiPart, pg8::StaticOrder, true, true>(lds, g, S, E); }
                else { EpiRes<true, true, false, true> E{p.out, X1, ss + (2 * l + 2) * T, nullptr, nullptr}; pg8::gemm_phase<EpiRes<true, true, false, true>, pg8::StaticOrder, true, true>(lds, g, S, E); }
            }
            GSYNC();
        }
    }
        LAUNDER();
    final_phase(p, tid, G, bid);
}

extern "C" void kernel_launch(void* const* d_in, const int* in_sizes, int n_in, void* d_out, int out_size, void* d_ws, size_t ws_size, hipStream_t stream) {
    static int grid_blocks = 0;
    if (grid_blocks == 0) {
        if (n_in != 26 || out_size != T * DM || ws_size < WS_END) { fprintf(stderr, "kernel_launch: unexpected shapes (n_in %d out %d ws %zu)\n", n_in, out_size, ws_size); grid_blocks = -1; return; }
        int dev = 0, cus = 0, per_cu = 0;
        hipGetDevice(&dev);
        hipDeviceGetAttribute(&cus, hipDeviceAttributeMultiprocessorCount, dev);
        hipFuncSetAttribute((const void*)fwd_kernel, hipFuncAttributeMaxDynamicSharedMemorySize, LDS_BYTES);
        hipOccupancyMaxActiveBlocksPerMultiprocessor(&per_cu, (const void*)fwd_kernel, NTHR, LDS_BYTES);
        if (per_cu < 1) per_cu = 1;
        grid_blocks = cus * per_cu;
        (void)hipGetLastError();
    }
    if (grid_blocks < 0) return;
    KP p{};
    for (int i = 0; i < 26; ++i) p.in[i] = (const float*)d_in[i];
    p.out = (float*)d_out; p.ws = (unsigned char*)d_ws;
    (void)hipMemsetAsync((char*)d_ws + WS_BAR, 0, 16384, stream);
    void* args[] = {&p};
    hipError_t e = hipLaunchCooperativeKernel((const void*)fwd_kernel, dim3(grid_blocks), dim3(NTHR), args, LDS_BYTES, stream);
    if (e != hipSuccess) fprintf(stderr, "cooperative launch failed: %s (grid %d)\n", hipGetErrorString(e), grid_blocks);
}
```

```cpp
#include <hip/hip_runtime.h>
#include <hip/hip_cooperative_groups.h>
#include <cstdio>
#include <cstdint>
namespace cg = cooperative_groups;
namespace pg8 {
#define PG8_LAS __attribute__((address_space(3)))
typedef unsigned short bf16_t;
typedef short bf16x8 __attribute__((ext_vector_type(8)));
typedef float f32x4 __attribute__((ext_vector_type(4)));
typedef unsigned u32x4 __attribute__((ext_vector_type(4)));
constexpr int BM = 256, BK = 64, HALF = 128, HTB = HALF * BK * 2  , STAGE_BYTES = 8 * HTB, NXCD = 8, WGM = 8;

__host__ __device__ __forceinline__ int lds_byte(int r, int c) { const int st = (r >> 4) * 2 + (c >> 5), rr = r & 15, cc = c & 31, ob = rr * 64 + cc * 2; return st * 1024 + (ob ^ (((ob >> 9) & 1) << 5)); }
__host__ __device__ __forceinline__ void stage_rc(int b, int& R, int& C) { const int st = b / 1024, sb = b % 1024, swz = sb ^ (((sb >> 9) & 1) << 5); R = (st >> 1) * 16 + swz / 64; C = (st & 1) * 32 + (swz % 64) / 2; }
__host__ __device__ __forceinline__ int perm32(int rho) { const int n = rho >> 4, i = rho & 15; return 8 * (i >> 2) + 4 * n + (i & 3); }

struct Unit { int pm, pn; };
struct Gemm { const bf16_t* A; const bf16_t* Bt; int M, N, K; };

struct StaticOrder {
    int nM, nN, nwg, G, c;
    __host__ __device__ void init(int M, int N, int G_, int c_) { nM = M / BM; nN = N / BM; nwg = nM * nN; G = G_; c = c_; }
    __host__ __device__ bool next(int i, Unit& u) const {
        const long L = (long)i * G + c; if (L >= nwg) return false;
        int wgid = (int)L; { const int q = nwg / NXCD, r = nwg % NXCD, xcd = wgid % NXCD, off = wgid / NXCD; wgid = (xcd < r ? xcd * (q + 1) : r * (q + 1) + (xcd - r) * q) + off; }
        const int nig = WGM * nN, gid = wgid / nig, fm = gid * WGM, gsz = (nM - fm) < WGM ? (nM - fm) : WGM;
        u.pm = fm + ((wgid % nig) % gsz); u.pn = (wgid % nig) / gsz; return true;
    }
    __device__ __forceinline__ void a_ready(const Unit&) const {}
    __device__ __forceinline__ void done(const Unit&) const {}
};

template <class Epi, class Sched, bool ALIGN_EPI = false, bool SP2 = false>
__device__ __forceinline__ void gemm_phase(PG8_LAS unsigned char* lds, const Gemm g, const Sched& S, const Epi& E) {
    int tid_l = threadIdx.x; asm volatile("" : "+v"(tid_l));
    const int tid = tid_l, wid = __builtin_amdgcn_readfirstlane(tid >> 6), lane = tid & 63, wr = wid >> 2, wc = wid & 3, fr = lane & 15, fq = lane >> 4;
    const int K = g.K, nt = K / BK;
    unsigned voffA[2], voffB[2];
#pragma unroll
    for (int i = 0; i < 2; ++i) { int R, C; stage_rc(tid * 16 + i * 8192, R, C); const int Rb = Epi::PERM ? ((R & ~31) + perm32(R & 31)) : R;
        voffA[i] = (unsigned)(R * K + C) * 2u; voffB[i] = (unsigned)(Rb * K + C) * 2u; }
    const size_t kstep = (size_t)(BK * 2);
    const size_t hstep = (size_t)HALF * K * 2;
    const size_t tstep = 2 * hstep;
    const unsigned ldsw = (unsigned)wid * 1024u;
    const int aoff = lds_byte(wr * 64 + fr, fq * 8), boff = lds_byte(wc * 32 + fr, fq * 8);
#define PG8_SA(b, h) (((b) * 2 + (h)) * HTB)
#define PG8_SB(b, h) ((4 + (b) * 2 + (h)) * HTB)
#define PG8_STAGE(bufoff, gbase, voff) do { _Pragma("unroll") for (int _i = 0; _i < 2; ++_i) \
        __builtin_amdgcn_global_load_lds((const unsigned*)((const char*)(gbase) + (voff)[_i]), (PG8_LAS unsigned*)(lds + (bufoff) + ldsw + _i * 8192), 16, 0, 0); } while (0)
#define PG8_LDA(dst, b, h) do { _Pragma("unroll") for (int m = 0; m < 4; ++m) _Pragma("unroll") for (int k = 0; k < 2; ++k) dst[m][k] = *(const PG8_LAS bf16x8*)(lds + PG8_SA(b, h) + aoff + m * 2048 + k * 1024); } while (0)
#define PG8_LDB(dst, b, h) do { _Pragma("unroll") for (int n = 0; n < 2; ++n) _Pragma("unroll") for (int k = 0; k < 2; ++k) dst[n][k] = *(const PG8_LAS bf16x8*)(lds + PG8_SB(b, h) + boff + n * 2048 + k * 1024); } while (0)
#define PG8_MMA(ai, bj, At, Bt) do { __builtin_amdgcn_s_setprio(1); _Pragma("unroll") for (int m = 0; m < 4; ++m) _Pragma("unroll") for (int n = 0; n < 2; ++n) _Pragma("unroll") for (int k = 0; k < 2; ++k) \
        acc[ai][bj][m][n] = __builtin_amdgcn_mfma_f32_16x16x32_bf16(Bt[n][k], At[m][k], acc[ai][bj][m][n], 0, 0, 0); __builtin_amdgcn_s_setprio(0); } while (0)
#define PG8_WAIT_V(n) asm volatile("s_waitcnt vmcnt(" #n ")" ::: "memory")
#define PG8_WAIT_L(n) asm volatile("s_waitcnt lgkmcnt(" #n ")" ::: "memory")
#define PG8_BAR __builtin_amdgcn_s_barrier()
#define PG8_SCHED __builtin_amdgcn_sched_barrier(0)
    Unit cur, nxt; int ui = 0;
    if (!S.next(0, cur)) return;
    f32x4 acc[2][2][4][2];
#pragma unroll
    for (int a = 0; a < 2; ++a)
#pragma unroll
        for (int b = 0; b < 2; ++b)
#pragma unroll
            for (int m = 0; m < 4; ++m)
#pragma unroll
                for (int n = 0; n < 2; ++n) acc[a][b][m][n] = (f32x4){0.f, 0.f, 0.f, 0.f};
    bf16x8 At[4][2], B0[2][2], B1[2][2];
    const char* cA = (const char*)g.A + (size_t)cur.pm * tstep; const char* cB = (const char*)g.Bt + (size_t)cur.pn * tstep;
    S.a_ready(cur);
    if constexpr (SP2) {
        PG8_STAGE(PG8_SB(0, 0), cB, voffB); PG8_STAGE(PG8_SB(0, 1), cB + hstep, voffB); PG8_STAGE(PG8_SA(0, 0), cA, voffA); PG8_STAGE(PG8_SA(0, 1), cA + hstep, voffA);
        if (wr == 1) PG8_BAR;
        PG8_WAIT_V(2); PG8_BAR;
        PG8_STAGE(PG8_SB(1, 0), cB + kstep, voffB); PG8_STAGE(PG8_SA(1, 0), cA + kstep, voffA); PG8_STAGE(PG8_SB(1, 1), cB + hstep + kstep, voffB);
        PG8_WAIT_V(6); PG8_BAR;
    } else {
        PG8_STAGE(PG8_SB(0, 0), cB, voffB); PG8_STAGE(PG8_SA(0, 0), cA, voffA); PG8_STAGE(PG8_SB(0, 1), cB + hstep, voffB); PG8_STAGE(PG8_SA(0, 1), cA + hstep, voffA);
        if (wr == 1) PG8_BAR;
        PG8_WAIT_V(4); PG8_BAR;
        PG8_STAGE(PG8_SB(1, 0), cB + kstep, voffB); PG8_STAGE(PG8_SA(1, 0), cA + kstep, voffA); PG8_STAGE(PG8_SB(1, 1), cB + hstep + kstep, voffB);
        PG8_WAIT_V(6); PG8_BAR;
    }
    for (;;) {
        const bool has_next = S.next(ui + 1, nxt);
        const char* nA = has_next ? (const char*)g.A + (size_t)nxt.pm * tstep : cA; const char* nB = has_next ? (const char*)g.Bt + (size_t)nxt.pn * tstep : cB;
        for (int t = 0; t < nt; t += 2) {
            const bool last = (t == nt - 2);
            const char* a1 = cA + (size_t)(t + 1) * kstep;
            const char* a2 = last ? nA : cA + (size_t)(t + 2) * kstep; const char* b2 = last ? nB : cB + (size_t)(t + 2) * kstep;
            const char* a3 = a2 + kstep; const char* b3 = b2 + kstep;
            if (last && has_next) S.a_ready(nxt);
            if constexpr (SP2) {
            PG8_LDB(B0, 0, 0); PG8_LDB(B1, 0, 1); PG8_SCHED; PG8_LDA(At, 0, 0); PG8_STAGE(PG8_SA(1, 1), a1 + hstep, voffA);
            PG8_WAIT_V(8); PG8_WAIT_L(0); PG8_BAR; PG8_MMA(0, 0, At, B0); PG8_MMA(0, 1, At, B1); PG8_BAR; PG8_SCHED;
            PG8_LDA(At, 0, 1); PG8_STAGE(PG8_SB(0, 0), b2, voffB); PG8_STAGE(PG8_SB(0, 1), b2 + hstep, voffB); PG8_STAGE(PG8_SA(0, 0), a2, voffA);
            PG8_WAIT_V(8); PG8_WAIT_L(0); PG8_BAR; PG8_MMA(1, 0, At, B0); PG8_MMA(1, 1, At, B1); PG8_BAR; PG8_SCHED;
            PG8_LDB(B0, 1, 0); PG8_LDB(B1, 1, 1); PG8_SCHED; PG8_LDA(At, 1, 0); PG8_STAGE(PG8_SA(0, 1), a2 + hstep, voffA);
            PG8_WAIT_V(8); PG8_WAIT_L(0); PG8_BAR; PG8_MMA(0, 0, At, B0); PG8_MMA(0, 1, At, B1); PG8_BAR; PG8_SCHED;
            PG8_LDA(At, 1, 1); PG8_STAGE(PG8_SB(1, 0), b3, voffB); PG8_STAGE(PG8_SB(1, 1), b3 + hstep, voffB); PG8_STAGE(PG8_SA(1, 0), a3, voffA);
            PG8_WAIT_V(8); PG8_WAIT_L(0); PG8_BAR; PG8_MMA(1, 0, At, B0); PG8_MMA(1, 1, At, B1); PG8_BAR; PG8_SCHED;
            } else {
            PG8_LDB(B0, 0, 0); PG8_SCHED; PG8_LDA(At, 0, 0); PG8_STAGE(PG8_SA(1, 1), a1 + hstep, voffA);
            PG8_WAIT_L(8); PG8_BAR; PG8_WAIT_L(0); PG8_MMA(0, 0, At, B0); PG8_BAR; PG8_SCHED;
            PG8_LDB(B1, 0, 1); PG8_STAGE(PG8_SB(0, 0), b2, voffB);
            PG8_BAR; PG8_WAIT_L(0); PG8_MMA(0, 1, At, B1); PG8_BAR;
            PG8_LDA(At, 0, 1); PG8_STAGE(PG8_SA(0, 0), a2, voffA);
            PG8_BAR; PG8_WAIT_L(0); PG8_MMA(1, 0, At, B0); PG8_BAR; PG8_SCHED;
            PG8_STAGE(PG8_SB(0, 1), b2 + hstep, voffB);
            PG8_WAIT_V(6); PG8_BAR; PG8_MMA(1, 1, At, B1); PG8_BAR;
            PG8_LDB(B0, 1, 0); PG8_SCHED; PG8_LDA(At, 1, 0); PG8_STAGE(PG8_SA(0, 1), a2 + hstep, voffA);
            PG8_WAIT_L(8); PG8_BAR; PG8_WAIT_L(0); PG8_MMA(0, 0, At, B0); PG8_BAR; PG8_SCHED;
            PG8_LDB(B1, 1, 1); PG8_STAGE(PG8_SB(1, 0), b3, voffB);
            PG8_BAR; PG8_WAIT_L(0); PG8_MMA(0, 1, At, B1); PG8_BAR;
            PG8_LDA(At, 1, 1); PG8_STAGE(PG8_SA(1, 0), a3, voffA);
            PG8_BAR; PG8_WAIT_L(0); PG8_MMA(1, 0, At, B0); PG8_BAR; PG8_SCHED;
            PG8_STAGE(PG8_SB(1, 1), b3 + hstep, voffB);
            PG8_WAIT_V(6); PG8_BAR; PG8_MMA(1, 1, At, B1); PG8_BAR;
            }
        }
        if constexpr (ALIGN_EPI) { if (wr == 0) PG8_BAR; }
        if constexpr (!Epi::AFTER_DRAIN) { E(acc, cur, wr, wc, fr, fq); S.done(cur); }
        if (!has_next) break;
#pragma unroll
        for (int a = 0; a < 2; ++a)
#pragma unroll
            for (int b = 0; b < 2; ++b)
#pragma unroll
                for (int m = 0; m < 4; ++m)
#pragma unroll
                    for (int n = 0; n < 2; ++n) acc[a][b][m][n] = (f32x4){0.f, 0.f, 0.f, 0.f};
        cur = nxt; cA = nA; cB = nB; ++ui;
        if constexpr (ALIGN_EPI) { if (wr == 1) PG8_BAR; }
    }
    PG8_WAIT_V(0);
    if constexpr (!ALIGN_EPI) { if (wr == 0) PG8_BAR; }
    PG8_BAR;
    if constexpr (Epi::AFTER_DRAIN) { E.fused(acc, cur, wr, wc, fr, fq, lds, wid, lane); S.done(cur); }
#undef PG8_SA
#undef PG8_SB
#undef PG8_STAGE
#undef PG8_LDA
#undef PG8_LDB
#undef PG8_MMA
#undef PG8_WAIT_V
#undef PG8_WAIT_L
#undef PG8_BAR
#undef PG8_SCHED
}
}

#define DI __device__ __forceinline__
#define LAS __attribute__((address_space(3)))
typedef unsigned short bf16_t;
typedef short bf16x8 __attribute__((ext_vector_type(8)));
typedef short s16x4 __attribute__((ext_vector_type(4)));
typedef float f32x4 __attribute__((ext_vector_type(4)));
typedef float f32x2 __attribute__((ext_vector_type(2)));
typedef float f32x16 __attribute__((ext_vector_type(16)));
typedef unsigned u32x4 __attribute__((ext_vector_type(4)));
typedef unsigned u32x2 __attribute__((ext_vector_type(2)));
typedef __bf16 bf16x2_t __attribute__((ext_vector_type(2)));
#define MFMA32(a, b, c) __builtin_amdgcn_mfma_f32_32x32x16_bf16((a), (b), (c), 0, 0, 0)

constexpr int T = 49152, DM = 1024, NPROJ = 3072, NIN = 2960, DFF = 4096, HFF = 2048;
constexpr int C_R = 0, C_K = 256, C_V = 512, C_WD = 768, C_AD = 896, C_GD = 1024;
constexpr int C_AQ = 1152, C_AK = 1664, C_AV = 1792;
constexpr int C_MQ = 1920, C_MK = 2176, C_MV = 2432, C_MO = 2688, C_IG = 2944, C_FG = 2952;
constexpr size_t MiB = 1u << 20;
constexpr size_t WS_SS = 0, WS_CNT = MiB - 4096, WS_CDOT = 1 * MiB, WS_TAB = 2 * MiB + 512 * 1024, WS_BAR = 2 * MiB + 768 * 1024, WS_WIN = 3 * MiB, WS_WOUT = 15 * MiB,
                 WS_W1 = 19 * MiB, WS_W2 = 35 * MiB, WS_VT = 51 * MiB, WS_YB = 63 * MiB, WS_HBP = 87 * MiB, WS_X1 = 111 * MiB, WS_R = 207 * MiB,
                 WS_HID = WS_R + 96 * MiB, WS_END = 495 * MiB;
constexpr int LDS_BYTES = 134400 + 256;
constexpr int NTHR = 512;

struct KP { const float* in[26]; float* out; unsigned char* ws; };

DI unsigned cvtpk(float lo, float hi) { f32x2 v = {lo, hi}; bf16x2_t b = __builtin_convertvector(v, bf16x2_t); return __builtin_bit_cast(unsigned, b); }
DI unsigned short f2bf(float f) { return (unsigned short)(cvtpk(f, 0.f) & 0xffffu); }
DI float bf2f(unsigned h) { return __builtin_bit_cast(float, h << 16); }
DI float bflo(unsigned w) { return __builtin_bit_cast(float, w << 16); }
DI float bfhi(unsigned w) { return __builtin_bit_cast(float, w & 0xffff0000u); }
DI int crow(int reg, int h) { return (reg & 3) + 8 * (reg >> 2) + 4 * h; }
template <int CTRL> DI float dppf(float v) { return __builtin_bit_cast(float, __builtin_amdgcn_update_dpp(0, __builtin_bit_cast(int, v), CTRL, 0xf, 0xf, true)); }
DI float red8(float v) { v += dppf<0xB1>(v); v += dppf<0x4E>(v); v += dppf<0x141>(v); return v; }
DI float red16(float v) { v = red8(v); v += dppf<0x128>(v); return v; }
DI float frcp(float x) { return __builtin_amdgcn_rcpf(x); }
DI float sigmoidf_(float x) { return frcp(1.f + __expf(-x)); }
DI f32x16 zero16() { f32x16 z; for (int i = 0; i < 16; ++i) z[i] = 0.f; return z; }
DI void seq_of_job(int j, int& seq, int& h, int& dir) { if (j < 16) { seq = 8 + (j >> 3); } else { j -= 16; seq = j >> 3; } h = (j >> 1) & 3; dir = j & 1; }
DI void seq_info(int s, int& start, int& len) { if (s < 8) { start = s * 4096; len = 4096; } else { start = 32768 + (s - 8) * 8192; len = 8192; } }
DI int tok_seq_start(int tok, int& len) { if (tok < 32768) { len = 4096; return tok & ~4095; } len = 8192; return 32768 + ((tok - 32768) & ~8191); }

#define XB_TMO      128
#define XB_XCNT(j)  (256  + 64 * (j))
#define XB_XSUB(j)  (1280 + 64 * (j))
#define XB_XGEN(j)  (2304 + 64 * (j))
#define XB_TOP      3328
#define XB_TOPGEN   3392
#define XCD_BAR_WORDS 3456
#define XB_SPIN_CAP (1u << 18)

__device__ __forceinline__ unsigned xb_ld(unsigned* p)              { return __hip_atomic_load(p, __ATOMIC_RELAXED, __HIP_MEMORY_SCOPE_AGENT); }
__device__ __forceinline__ unsigned xb_add(unsigned* p, unsigned v) { return __hip_atomic_fetch_add(p, v, __ATOMIC_RELAXED, __HIP_MEMORY_SCOPE_AGENT); }
__device__ __forceinline__ unsigned xb_xcc_id() { return (unsigned)__builtin_amdgcn_s_getreg((3 << 11) | 20) & 0xFu; }
#define XB_SPIN(cond, bar) do { unsigned _sp = 0; while (cond) { __builtin_amdgcn_s_sleep(1); \
    if ((++_sp & 255u) == 0u) { if (xb_ld(&(bar)[XB_TMO])) break; if (_sp > XB_SPIN_CAP) { atomicAdd(&(bar)[XB_TMO], 1u); break; } } } } while (0)

struct XcdBarrier {
    unsigned* bar; unsigned x;
    volatile LAS unsigned* st;
};

__device__ __forceinline__ XcdBarrier xcd_barrier_post(unsigned* bar, volatile LAS unsigned* st) {
    XcdBarrier b; b.bar = bar; b.x = xb_xcc_id(); b.st = st;
    if (threadIdx.x == 0) (void)xb_add(&bar[XB_XCNT(b.x)], 1u);
    return b;
}
__device__ __forceinline__ void xcd_barrier_complete(unsigned* bar, unsigned x, unsigned& nloc, unsigned& nx) {
    const unsigned G = gridDim.x * gridDim.y * gridDim.z;
    unsigned sum, cnt, mine, sp = 0u;
    for (;;) {
        sum = 0u; cnt = 0u; mine = 0u;
#pragma unroll
        for (unsigned j = 0; j < 16; ++j) { const unsigned c = xb_ld(&bar[XB_XCNT(j)]); sum += c; cnt += (c > 0u) ? 1u : 0u; mine = (j == x) ? c : mine; }
        if (sum == G) break;
        __builtin_amdgcn_s_sleep(1);
        if ((++sp & 255u) == 0u) { if (xb_ld(&bar[XB_TMO])) break; if (sp > XB_SPIN_CAP) { atomicAdd(&bar[XB_TMO], 1u); break; } }
    }
    nloc = mine > 0u ? mine : 1u; nx = cnt > 0u ? cnt : 1u;
}

__device__ __forceinline__ void xcd_barrier(const XcdBarrier& b) {
    asm volatile("s_waitcnt vmcnt(0)" ::: "memory");
    __syncthreads();
    if (threadIdx.x == 0) {
        unsigned* bar = b.bar;
        __builtin_amdgcn_s_waitcnt(0);
        unsigned nloc = b.st[0], nx = b.st[1];
        if (nloc == 0u) { xcd_barrier_complete(bar, b.x, nloc, nx); b.st[0] = nloc; b.st[1] = nx; }
        const unsigned old = xb_add(&bar[XB_XSUB(b.x)], 1u);
        const unsigned gen = old / nloc;
        if (old + 1u == (gen + 1u) * nloc) {
            __builtin_amdgcn_fence(__ATOMIC_RELEASE, "agent");
            asm volatile("s_waitcnt vmcnt(0)" ::: "memory");
            const unsigned og = xb_add(&bar[XB_TOP], 1u);
            const unsigned tg = og / nx;
            if (og + 1u == (tg + 1u) * nx) xb_add(&bar[XB_TOPGEN], 1u);
            else XB_SPIN(xb_ld(&bar[XB_TOPGEN]) == tg, bar);
            __builtin_amdgcn_fence(__ATOMIC_ACQUIRE, "agent");
            xb_add(&bar[XB_XGEN(b.x)], 1u);
            asm volatile("s_waitcnt vmcnt(0)" ::: "memory");
        } else {
            XB_SPIN(xb_ld(&bar[XB_XGEN(b.x)]) == gen, bar);
            __builtin_amdgcn_fence(__ATOMIC_ACQUIRE, "agent");
            asm volatile("s_waitcnt vmcnt(0)" ::: "memory");
        }
    }
    __syncthreads();
}

struct EpiProj {
    static constexpr bool PERM = true, AFTER_DRAIN = false;
    bf16_t* O; const float* ss;
    DI void operator()(const pg8::f32x4 (&acc)[2][2][4][2], const pg8::Unit& u, int wr, int wc, int fr, int fq) const {
        const int row0 = u.pm * 256 + wr * 64 + fr, col0 = u.pn * 256 + wc * 32 + 8 * fq;
#pragma unroll
        for (int ai = 0; ai < 2; ++ai)
#pragma unroll
            for (int m = 0; m < 4; ++m) {
                const int row = row0 + ai * 128 + m * 16;
                const float rs = rsqrtf(ss[row] * (1.f / 1024.f) + 1e-6f);
                bf16_t* rp = O + (size_t)row * NPROJ + col0;
#pragma unroll
                for (int bj = 0; bj < 2; ++bj) {
                    pg8::f32x4 v0 = acc[ai][bj][m][0] * rs, v1 = acc[ai][bj][m][1] * rs;
                    u32x4 w; w.x = cvtpk(v0[0], v0[1]); w.y = cvtpk(v0[2], v0[3]); w.z = cvtpk(v1[0], v1[1]); w.w = cvtpk(v1[2], v1[3]);
                    *(u32x4*)(rp + bj * 128) = w;
                }
            }
    }
};
struct EpiRelu2 {
    static constexpr bool PERM = true, AFTER_DRAIN = false;
    bf16_t* O; const float* ss;
    DI void operator()(const pg8::f32x4 (&acc)[2][2][4][2], const pg8::Unit& u, int wr, int wc, int fr, int fq) const {
        const int row0 = u.pm * 256 + wr * 64 + fr, col0 = u.pn * 256 + wc * 32 + 8 * fq;
#pragma unroll
        for (int ai = 0; ai < 2; ++ai)
#pragma unroll
            for (int m = 0; m < 4; ++m) {
                const int row = row0 + ai * 128 + m * 16;
                const float rs = rsqrtf(ss[row] * (1.f / 1024.f) + 1e-6f);
                bf16_t* rp = O + (size_t)row * HFF + col0;
#pragma unroll
                for (int bj = 0; bj < 2; ++bj) {
                    pg8::f32x4 v0 = acc[ai][bj][m][0] * rs, v1 = acc[ai][bj][m][1] * rs;
#pragma unroll
                    for (int j = 0; j < 4; ++j) { float a = fmaxf(v0[j], 0.f); v0[j] = a * a; float b = fmaxf(v1[j], 0.f); v1[j] = b * b; }
                    u32x4 w; w.x = cvtpk(v0[0], v0[1]); w.y = cvtpk(v0[2], v0[3]); w.z = cvtpk(v1[0], v1[1]); w.w = cvtpk(v1[2], v1[3]);
                    *(u32x4*)(rp + bj * 128) = w;
                }
            }
    }
};
struct EpiPart {
    static constexpr bool PERM = true, AFTER_DRAIN = false;
    bf16_t* O;
    DI void operator()(const pg8::f32x4 (&acc)[2][2][4][2], const pg8::Unit& u, int wr, int wc, int fr, int fq) const {
        const int row0 = u.pm * 256 + wr * 64 + fr, col0 = u.pn * 256 + wc * 32 + 8 * fq;
#pragma unroll
        for (int ai = 0; ai < 2; ++ai)
#pragma unroll
            for (int m = 0; m < 4; ++m) {
                bf16_t* rp = O + (size_t)(row0 + ai * 128 + m * 16) * DM + col0;
#pragma unroll
                for (int bj = 0; bj < 2; ++bj) {
                    const pg8::f32x4 v0 = acc[ai][bj][m][0], v1 = acc[ai][bj][m][1];
                    u32x4 w; w.x = cvtpk(v0[0], v0[1]); w.y = cvtpk(v0[2], v0[3]); w.z = cvtpk(v1[0], v1[1]); w.w = cvtpk(v1[2], v1[3]);
                    *(u32x4*)(rp + bj * 128) = w;
                }
            }
    }
};
template <bool WRITE_HB, bool DO_SS, bool FIRST = false, bool PART = false> struct EpiRes {
    static constexpr bool PERM = true, AFTER_DRAIN = false;
    float* X; bf16_t* HB; float* ss; const float* xin0; const float* xin1;
    DI void operator()(const pg8::f32x4 (&acc)[2][2][4][2], const pg8::Unit& u, int wr, int wc, int fr, int fq) const {
        const int row0 = u.pm * 256 + wr * 64 + fr, col0 = u.pn * 256 + wc * 32 + 8 * fq;
#pragma unroll
        for (int ai = 0; ai < 2; ++ai)
#pragma unroll
            for (int m = 0; m < 4; ++m) {
                const int row = row0 + ai * 128 + m * 16;
                float* xp = X + (size_t)row * DM + col0;
                const float* rp = FIRST ? ((row < 32768 ? xin0 + (size_t)row * DM : xin1 + (size_t)(row - 32768) * DM) + col0) : xp;
                float sq = 0.f;
#pragma unroll
                for (int bj = 0; bj < 2; ++bj) {
                    pg8::f32x4 a0 = *(const pg8::f32x4*)(rp + bj * 128), a1 = *(const pg8::f32x4*)(rp + bj * 128 + 4);
                    a0 += acc[ai][bj][m][0]; a1 += acc[ai][bj][m][1];
                    if (PART) { const u32x4 pw = *(const u32x4*)(HB + (size_t)row * DM + col0 + bj * 128);
                        a0[0] += bflo(pw.x); a0[1] += bfhi(pw.x); a0[2] += bflo(pw.y); a0[3] += bfhi(pw.y); a1[0] += bflo(pw.z); a1[1] += bfhi(pw.z); a1[2] += bflo(pw.w); a1[3] += bfhi(pw.w); }
                    *(pg8::f32x4*)(xp + bj * 128) = a0; *(pg8::f32x4*)(xp + bj * 128 + 4) = a1;
                    if (WRITE_HB) { u32x4 w; w.x = cvtpk(a0[0], a0[1]); w.y = cvtpk(a0[2], a0[3]); w.z = cvtpk(a1[0], a1[1]); w.w = cvtpk(a1[2], a1[3]);
                        *(u32x4*)(HB + (size_t)row * DM + col0 + bj * 128) = w; }
                    if (DO_SS) sq += a0[0] * a0[0] + a0[1] * a0[1] + a0[2] * a0[2] + a0[3] * a0[3] + a1[0] * a1[0] + a1[1] * a1[1] + a1[2] * a1[2] + a1[3] * a1[3];
                }
                if (DO_SS) { sq += __shfl_xor(sq, 16); sq += __shfl_xor(sq, 32); if (fq == 0) atomicAdd(ss + row, sq); }
            }
    }
};

DI void transpose_tile(const float* src, int N, int nvalid, const float* gain, bf16_t* dst, int K, int kt, int nt, LAS float* tile, int tid) {
    const int a = tid & 63, b8 = tid >> 6;
#pragma unroll
    for (int i = 0; i < 8; ++i) { const int k = b8 + 8 * i, n = nt * 64 + a; float v = (n < nvalid) ? src[(size_t)(kt * 64 + k) * N + n] : 0.f; if (gain) v *= gain[kt * 64 + k]; tile[k * 65 + a] = v; }
    __syncthreads();
#pragma unroll
    for (int i = 0; i < 8; ++i) { const int n = b8 + 8 * i; dst[(size_t)(nt * 64 + n) * K + kt * 64 + a] = f2bf(tile[a * 65 + n]); }
    __syncthreads();
}
DI void convert_tile(const KP& p, int it, LAS float* tile, int tid) {
    {
        const int l = it / 3072; int r = it % 3072;
        const float* src; const float* gain; bf16_t* dst; int N, nvalid, K, kt, nt;
        if (r < 768) { src = p.in[3] + (size_t)l * 1024 * NIN; N = NIN; nvalid = NIN; K = 1024; gain = p.in[2] + l * 1024; dst = (bf16_t*)(p.ws + WS_WIN) + (size_t)l * NPROJ * 1024; kt = r / 48; nt = r % 48; }
        else if (r < 1024) { r -= 768; src = p.in[21] + (size_t)l * 1024 * 1024; N = 1024; nvalid = 1024; K = 1024; gain = nullptr; dst = (bf16_t*)(p.ws + WS_WOUT) + (size_t)l * 1024 * 1024; kt = r / 16; nt = r % 16; }
        else if (r < 2048) { r -= 1024; src = p.in[23] + (size_t)l * 1024 * 4096; N = 4096; nvalid = 4096; K = 1024; gain = p.in[22] + l * 1024; dst = (bf16_t*)(p.ws + WS_W1) + (size_t)l * 4096 * 1024; kt = r / 64; nt = r % 64; }
        else { r -= 2048; const int h = r / 512; r %= 512; src = p.in[24] + (size_t)l * 4096 * 1024 + (size_t)h * 2048 * 1024; N = 1024; nvalid = 1024; K = 2048; gain = nullptr;
               dst = (bf16_t*)(p.ws + WS_W2) + (size_t)l * 2 * 1024 * 2048 + (size_t)h * 1024 * 2048; kt = r / 16; nt = r % 16; }
        transpose_tile(src, N, nvalid, gain, dst, K, kt, nt, tile, tid);
    }
}
DI void p0_phase(const KP& p, LAS unsigned char* lds, int tid, int G, int bid) {
    LAS float* tile = (LAS float*)lds;
    for (int it = bid; it < 768; it += G) convert_tile(p, it, tile, tid);
    const int wave = tid >> 6, lane = tid & 63;
    float* ss = (float*)(p.ws + WS_SS);
    bf16_t* xb = (bf16_t*)(p.ws + WS_X1);
    for (int row0 = (bid * 8 + wave) * 2; row0 < T; row0 += G * 8 * 2) {
        f32x4 v[2][4];
#pragma unroll
        for (int r = 0; r < 2; ++r) {
            const int row = row0 + r;
            const float* xs = (row < 32768) ? p.in[0] + (size_t)row * DM : p.in[1] + (size_t)(row - 32768) * DM;
#pragma unroll
            for (int j = 0; j < 4; ++j) v[r][j] = *(const f32x4*)(xs + (j * 64 + lane) * 4);
        }
#pragma unroll
        for (int r = 0; r < 2; ++r) {
            const int row = row0 + r;
            float sq = 0.f;
#pragma unroll
            for (int j = 0; j < 4; ++j) {
                const f32x4 x = v[r][j];
                u32x2 w; w.x = cvtpk(x[0], x[1]); w.y = cvtpk(x[2], x[3]);
                *(u32x2*)(xb + (size_t)row * DM + (j * 64 + lane) * 4) = w;
                sq += x[0] * x[0] + x[1] * x[1] + x[2] * x[2] + x[3] * x[3];
            }
#pragma unroll
            for (int o = 32; o >= 1; o >>= 1) sq += __shfl_xor(sq, o);
            if (lane == 0) ss[row] = sq;
        }
    }
    for (int i = bid * NTHR + tid; i < 4 * T; i += G * NTHR) ss[T + i] = 0.f;
    if (bid == 0) {
        if (tid < 64) ((unsigned*)(p.ws + WS_CNT))[tid] = 0u;
        float2* tab = (float2*)(p.ws + WS_TAB);
        for (int idx = tid; idx < 2048; idx += NTHR) { const int pos = idx >> 4, f = idx & 15; const float inv = powf(10000.f, -(float)f / 16.f); const float ang = (float)pos * inv; tab[idx] = make_float2(cosf(ang), sinf(ang)); }
    }
}

DI void prep_phase(const KP& p, int l, LAS unsigned char* lds, int tid, int G, int bid) {
    bf16_t* proj = (bf16_t*)(p.ws + WS_R);
    bf16_t* vT = (bf16_t*)(p.ws + WS_VT);
    const float2* tab = (const float2*)(p.ws + WS_TAB);
    const float* qn = p.in[15] + l * 64; const float* kn = p.in[16] + l * 64;
    const int wave = tid >> 6, lane = tid & 63, g = lane >> 4, li = lane & 15;
    LAS bf16_t* vts = (LAS bf16_t*)lds;
    for (int unit = bid; unit < T / 64; unit += G) {
        const int tok0 = unit * 64;
        u32x2 raw[8][3];
#pragma unroll
        for (int i = 0; i < 8; ++i) {
            const int tok = tok0 + wave * 8 + i;
#pragma unroll
            for (int it = 0; it < 3; ++it) {
                const int colbase = (it < 2) ? C_AQ + (it * 4 + g) * 64 : C_AK + (g & 1) * 64;
                raw[i][it] = *(const u32x2*)(proj + (size_t)tok * NPROJ + colbase + li * 4);
            }
        }
#pragma unroll
        for (int i = 0; i < 8; ++i) {
            const int tok = tok0 + wave * 8 + i; int len; const int st = tok_seq_start(tok, len); const int pos = tok - st; const int prow = pos >> 6, pcol = pos & 63;
#pragma unroll
            for (int it = 0; it < 3; ++it) {
                const bool act = (it < 2) || (g < 2);
                const int colbase = (it < 2) ? C_AQ + (it * 4 + g) * 64 : C_AK + (g & 1) * 64;
                const float* wn = (it < 2) ? qn : kn;
                bf16_t* ptr = proj + (size_t)tok * NPROJ + colbase + li * 4;
                const u32x2 rw = raw[i][it];
                float x[4] = {bflo(rw.x), bfhi(rw.x), bflo(rw.y), bfhi(rw.y)};
                float sq = x[0] * x[0] + x[1] * x[1] + x[2] * x[2] + x[3] * x[3];
                sq = red16(sq);
                const float rinv = rsqrtf(sq * (1.f / 64.f) + 1e-6f);
                const f32x4 w4 = *(const f32x4*)(wn + li * 4);
                const int idx = (li >> 3) ? pcol : prow; const bool second = (li >> 2) & 1;
                const float scale = (it < 2) ? 0.125f * 1.4426950408889634f : 1.f;
                float o[4];
#pragma unroll
                for (int j = 0; j < 4; ++j) {
                    const float y = x[j] * rinv * w4[j];
                    const float pr = __shfl_xor(y, 4);
                    const int f = (li * 4 + j) & 15;
                    const float2 cs = tab[idx * 16 + f];
                    o[j] = (second ? (y * cs.x + pr * cs.y) : (y * cs.x - pr * cs.y)) * scale;
                }
                if (act) { u32x2 w; w.x = cvtpk(o[0], o[1]); w.y = cvtpk(o[2], o[3]); *(u32x2*)ptr = w; }
            }
        }
#pragma unroll
        for (int i = 0; i < 2; ++i) { const int idx = tid + NTHR * i; const int tl = idx >> 4, c8 = (idx & 15) * 8;
            const u32x4 v = *(const u32x4*)(proj + (size_t)(tok0 + tl) * NPROJ + C_AV + c8); *(LAS u32x4*)(vts + tl * 136 + c8) = v; }
        __syncthreads();
        { const int c = tid >> 2, tq = tid & 3; unsigned w[8];
#pragma unroll
          for (int j = 0; j < 8; ++j) { const unsigned lo = vts[(tq * 16 + 2 * j) * 136 + c], hi = vts[(tq * 16 + 2 * j + 1) * 136 + c]; w[j] = lo | (hi << 16); }
          u32x4 a = {w[0], w[1], w[2], w[3]}, b = {w[4], w[5], w[6], w[7]};
          bf16_t* dp = vT + (size_t)c * T + tok0 + tq * 16; *(u32x4*)dp = a; *(u32x4*)(dp + 8) = b; }
        __syncthreads();
    }
}

DI void attn_unit(const KP& p, int l, int unit, LAS unsigned char* lds, int tid) {
    const float* qnw = p.in[15] + l * 64; const float* knw = p.in[16] + l * 64;
    const bf16_t* proj = (const bf16_t*)(p.ws + WS_R);
    const bf16_t* vT = (const bf16_t*)(p.ws + WS_VT);
    bf16_t* mix = (bf16_t*)(p.ws + WS_X1);
    int seq, kvh, qt;
    if (unit < 512) { seq = 8 + (unit >> 8); const int r = unit & 255; kvh = r >> 7; qt = r & 127; }
    else { const int u2 = unit - 512; seq = u2 >> 7; const int r = u2 & 127; kvh = r >> 6; qt = r & 63; }
    int start, len; seq_info(seq, start, len);
    const int nk = len >> 6;
    const int wave = tid >> 6, lane = tid & 63, r32 = lane & 31, hh = lane >> 5;
    const int head = kvh * 4 + (wave >> 1);
    const int q0 = start + qt * 64 + (wave & 1) * 32;
    bf16x8 qf[4];
    { const bf16_t* qp = proj + (size_t)(q0 + r32) * NPROJ + C_AQ + head * 64 + hh * 8;
#pragma unroll
      for (int ks = 0; ks < 4; ++ks) qf[ks] = *(const bf16x8*)(qp + ks * 16); }
    f32x16 o0 = zero16(), o1 = zero16();
    float lsum = 0.f;
    f32x16 sinit;
    { float mq = fabsf(qnw[lane]), mk = fabsf(knw[lane]);
#pragma unroll
      for (int o = 32; o >= 1; o >>= 1) { mq = fmaxf(mq, __shfl_xor(mq, o)); mk = fmaxf(mk, __shfl_xor(mk, o)); }
      const float bnd = 64.f * 0.125f * 1.4426950408889634f * 1.01f * mq * mk;
#pragma unroll
      for (int i = 0; i < 16; ++i) sinit[i] = -bnd; }
    const int lrow = tid >> 3, lseg = tid & 7;
    const bf16_t* kptr = proj + (size_t)(start + lrow) * NPROJ + C_AK + kvh * 64 + lseg * 8;
    const bf16_t* vptr = vT + (size_t)(kvh * 64 + lrow) * T + start + lseg * 8;
    const int lds_off = lrow * 144 + lseg * 16;
    u32x4 kreg = *(const u32x4*)kptr, vreg = *(const u32x4*)vptr;
    *(LAS u32x4*)(lds + lds_off) = kreg; *(LAS u32x4*)(lds + 9216 + lds_off) = vreg;
    kreg = *(const u32x4*)(kptr + (size_t)64 * NPROJ); vreg = *(const u32x4*)(vptr + 64);
    u32x4 kreg2 = kreg, vreg2 = vreg;
    __syncthreads();
    for (int j = 0; j < nk; ++j) {
        const bool more = (j + 1 < nk);
        if (j + 2 < nk) { kreg2 = *(const u32x4*)(kptr + (size_t)(j + 2) * 64 * NPROJ); vreg2 = *(const u32x4*)(vptr + (j + 2) * 64); }
        LAS unsigned char* Ks = lds + (j & 1) * 18432; LAS unsigned char* Vs = Ks + 9216;
        f32x16 s0 = sinit, s1 = sinit;
#pragma unroll
        for (int ks = 0; ks < 4; ++ks) {
            const bf16x8 a0 = *(const LAS bf16x8*)(Ks + r32 * 144 + (ks * 16 + hh * 8) * 2);
            const bf16x8 a1 = *(const LAS bf16x8*)(Ks + (32 + r32) * 144 + (ks * 16 + hh * 8) * 2);
            s0 = MFMA32(a0, qf[ks], s0); s1 = MFMA32(a1, qf[ks], s1);
        }
        float rs = 0.f;
#pragma unroll
        for (int i = 0; i < 16; ++i) { s0[i] = __builtin_amdgcn_exp2f(s0[i]); rs += s0[i]; }
#pragma unroll
        for (int i = 0; i < 16; ++i) { s1[i] = __builtin_amdgcn_exp2f(s1[i]); rs += s1[i]; }
        lsum += rs;
#pragma unroll
        for (int mb = 0; mb < 2; ++mb)
#pragma unroll
            for (int s = 0; s < 2; ++s) {
                u32x4 pk;
                if (mb == 0) { pk.x = cvtpk(s0[8 * s], s0[8 * s + 1]); pk.y = cvtpk(s0[8 * s + 2], s0[8 * s + 3]); pk.z = cvtpk(s0[8 * s + 4], s0[8 * s + 5]); pk.w = cvtpk(s0[8 * s + 6], s0[8 * s + 7]); }
                else         { pk.x = cvtpk(s1[8 * s], s1[8 * s + 1]); pk.y = cvtpk(s1[8 * s + 2], s1[8 * s + 3]); pk.z = cvtpk(s1[8 * s + 4], s1[8 * s + 5]); pk.w = cvtpk(s1[8 * s + 6], s1[8 * s + 7]); }
                const bf16x8 pb = __builtin_bit_cast(bf16x8, pk);
                const int keyoff = 32 * mb + 16 * s + 4 * hh;
                { const s16x4 lo = *(const LAS s16x4*)(Vs + r32 * 144 + keyoff * 2), hi = *(const LAS s16x4*)(Vs + r32 * 144 + (keyoff + 8) * 2);
                  const bf16x8 va = __builtin_shufflevector(lo, hi, 0, 1, 2, 3, 4, 5, 6, 7); o0 = MFMA32(va, pb, o0); }
                { const s16x4 lo = *(const LAS s16x4*)(Vs + (32 + r32) * 144 + keyoff * 2), hi = *(const LAS s16x4*)(Vs + (32 + r32) * 144 + (keyoff + 8) * 2);
                  const bf16x8 va = __builtin_shufflevector(lo, hi, 0, 1, 2, 3, 4, 5, 6, 7); o1 = MFMA32(va, pb, o1); }
            }
        if (more) { LAS unsigned char* Kn = lds + ((j + 1) & 1) * 18432; *(LAS u32x4*)(Kn + lds_off) = kreg; *(LAS u32x4*)(Kn + 9216 + lds_off) = vreg; }
        asm volatile("s_waitcnt lgkmcnt(0)\n\ts_barrier" ::: "memory");
        kreg = kreg2; vreg = vreg2;
    }
    lsum += __shfl_xor(lsum, 32);
    const float inv = 1.f / lsum;
    bf16_t* op = mix + (size_t)(q0 + r32) * DM + 256 + head * 64;
#pragma unroll
    for (int g4 = 0; g4 < 4; ++g4) {
        u32x2 w0; w0.x = cvtpk(o0[4 * g4] * inv, o0[4 * g4 + 1] * inv); w0.y = cvtpk(o0[4 * g4 + 2] * inv, o0[4 * g4 + 3] * inv);
        *(u32x2*)(op + 8 * g4 + 4 * hh) = w0;
        u32x2 w1; w1.x = cvtpk(o1[4 * g4] * inv, o1[4 * g4 + 1] * inv); w1.y = cvtpk(o1[4 * g4 + 2] * inv, o1[4 * g4 + 3] * inv);
        *(u32x2*)(op + 32 + 8 * g4 + 4 * hh) = w1;
    }
}

constexpr int RW_BUF = 49152, RW_XR = 0, RW_XKD = 8192, RW_XV = 16384, RW_WLW = 24576, RW_ALB = 32768, RW_KKN = 40960, RW_YO = 98304, RW_XWD = 106496, RW_XAD = 111104,
              RW_W2T = 115712, RW_A2T = 124928, RW_CD = 134144, SLOT_OFF = 134400;
#define RW_BAR() asm volatile("s_waitcnt lgkmcnt(0)\n\ts_barrier" ::: "memory")
#define RW_DECODE(i_) const int t = (pt >> 4) + 16 * ((i_) / 5), c4 = (pt & 15) * 4; constexpr int gi = (i_) % 5; \
            const int col = (gi == 0) ? C_R + h * 64 + c4 : (gi == 1) ? C_K + h * 64 + c4 : (gi == 2) ? C_V + h * 64 + c4 : (gi == 3) ? C_WD + dir * 64 + c4 : C_AD + dir * 64 + c4;
#define RW_ISSUE1(chx, i_) { const int t = (pt >> 4) + 16 * ((i_) / 5); \
            const int n = (chx) * 32 + t; const int pos = dir ? (len - 1 - n) : n; \
            const bf16_t* bp = bq[i_]; bq[i_] = bp + bstep; \
            rc[i_] = *(const u32x2*)bp; rp_[i_] = (u32x2){0u, 0u}; rn[i_] = (u32x2){0u, 0u}; \
            if (pos > 0) rp_[i_] = *(const u32x2*)(bp - NPROJ); \
            if (pos < len - 1) rn[i_] = *(const u32x2*)(bp + NPROJ); }
#define RW_ISSUE(chx) do { RW_ISSUE1(chx, 0) RW_ISSUE1(chx, 1) RW_ISSUE1(chx, 2) RW_ISSUE1(chx, 3) RW_ISSUE1(chx, 4) RW_ISSUE1(chx, 5) RW_ISSUE1(chx, 6) RW_ISSUE1(chx, 7) RW_ISSUE1(chx, 8) RW_ISSUE1(chx, 9) } while (0)
#define RW_ISSUEM1(i_) { const bf16_t* bp = bq[i_]; bq[i_] = bp + bstep; \
            rc[i_] = *(const u32x2*)bp; rp_[i_] = *(const u32x2*)(bp - NPROJ); rn[i_] = *(const u32x2*)(bp + NPROJ); }
#define RW_ISSUE_MID() do { RW_ISSUEM1(0) RW_ISSUEM1(1) RW_ISSUEM1(2) RW_ISSUEM1(3) RW_ISSUEM1(4) RW_ISSUEM1(5) RW_ISSUEM1(6) RW_ISSUEM1(7) RW_ISSUEM1(8) RW_ISSUEM1(9) } while (0)
#define RW_CONV1(i_) { RW_DECODE(i_) \
            const f32x4 m4 = mureg[gi]; \
            f32x4 x = {bflo(rc[i_].x), bfhi(rc[i_].x), bflo(rc[i_].y), bfhi(rc[i_].y)}; \
            const f32x4 pn = {bflo(rp_[i_].x) + bflo(rn[i_].x), bfhi(rp_[i_].x) + bfhi(rn[i_].x), bflo(rp_[i_].y) + bflo(rn[i_].y), bfhi(rp_[i_].y) + bfhi(rn[i_].y)}; \
            x = x + (0.5f * pn - x) * m4; \
            if (gi < 3) { LAS float* dst = (gi == 0) ? XR : (gi == 1) ? XKD : XV; *(LAS f32x4*)(dst + t * 64 + c4) = x; } \
            else if (gi == 3) { \
                _Pragma("unroll") for (int j = 0; j < 4; ++j) { const float e = __expf(2.f * x[j]); x[j] = 1.f - 2.f * frcp(e + 1.f); } \
                u32x2 w; w.x = cvtpk(x[0], x[1]); w.y = cvtpk(x[2], x[3]); *(LAS u32x2*)(XWD + t * 72 + c4) = w; } \
            else { u32x2 w; w.x = cvtpk(x[0], x[1]); w.y = cvtpk(x[2], x[3]); *(LAS u32x2*)(XAD + t * 72 + c4) = w; } }
DI void rwkv_job(const KP& p, int l, int job, LAS unsigned char* lds, int tid) {
    int seq, h, dir, rpart; constexpr int nrows = 32;
    { int j = job; if (j < 32) { seq = 8 + (j >> 4); } else { j -= 32; seq = j >> 4; } h = (j >> 2) & 3; dir = (j >> 1) & 1; rpart = j & 1; }
    int start, len; seq_info(seq, start, len);
    const bf16_t* proj = (const bf16_t*)(p.ws + WS_R);
    bf16_t* mix = (bf16_t*)(p.ws + WS_X1);
    bf16_t* yb = (bf16_t*)(p.ws + WS_YB);
    float* cdot = (float*)(p.ws + WS_CDOT);
    const float* mu = p.in[4] + l * 1152;
    const int wave = tid >> 6, lane = tid & 63, r32 = lane & 31, hh = lane >> 5;
    LAS bf16_t* XWD = (LAS bf16_t*)(lds + RW_XWD); LAS bf16_t* XAD = (LAS bf16_t*)(lds + RW_XAD);
    LAS bf16_t* W2T = (LAS bf16_t*)(lds + RW_W2T); LAS bf16_t* A2T = (LAS bf16_t*)(lds + RW_A2T);
    { const float* w2 = p.in[6] + (size_t)((l * 2 + dir) * 64) * 256 + h * 64; const float* a2 = p.in[8] + (size_t)((l * 2 + dir) * 64) * 256 + h * 64;
#pragma unroll
      for (int i = 0; i < 8; ++i) { const int idx = tid + NTHR * i; const int mm = idx >> 6, c = idx & 63; W2T[c * 72 + mm] = f2bf(w2[mm * 256 + c]); A2T[c * 72 + mm] = f2bf(a2[mm * 256 + c]); } }
    const int nch = len >> 5;
    __syncthreads();
    if (tid < 256) {
        const int srow = tid >> 3, sj = (tid & 7) * 8;
        f32x4 Sa = {0.f, 0.f, 0.f, 0.f}, Sb = {0.f, 0.f, 0.f, 0.f};
        RW_BAR(); RW_BAR(); RW_BAR();
#define RW_LD(dst, arr, tt) const f32x4 dst##a = *(const LAS f32x4*)((arr) + (tt) * 64 + sj), dst##b = *(const LAS f32x4*)((arr) + (tt) * 64 + sj + 4)
        for (int ch = 0; ch < nch; ++ch) {
            LAS unsigned char* B = lds + (ch & 1) * RW_BUF;
            LAS float* XR = (LAS float*)(B + RW_XR); LAS float* XKD = (LAS float*)(B + RW_XKD); LAS float* XV = (LAS float*)(B + RW_XV);
            LAS float* WLW = (LAS float*)(B + RW_WLW); LAS float* ALB = (LAS float*)(B + RW_ALB); LAS float* KKN = (LAS float*)(B + RW_KKN);
            LAS float* YO = (LAS float*)(lds + RW_YO + (ch & 1) * 4096);
            f32x4 wa = *(const LAS f32x4*)(WLW + sj), wb = *(const LAS f32x4*)(WLW + sj + 4), ka = *(const LAS f32x4*)(KKN + sj), kb = *(const LAS f32x4*)(KKN + sj + 4);
            f32x4 ba = *(const LAS f32x4*)(ALB + sj), bb = *(const LAS f32x4*)(ALB + sj + 4), da = *(const LAS f32x4*)(XKD + sj), db = *(const LAS f32x4*)(XKD + sj + 4);
            f32x4 ra = *(const LAS f32x4*)(XR + sj), rb = *(const LAS f32x4*)(XR + sj + 4);
            float v = XV[rpart * 32 + srow];
#pragma unroll 8
            for (int t = 0; t < 32; ++t) {
                const int tn = (t < 31) ? t + 1 : 31;
                RW_LD(wn, WLW, tn); RW_LD(kn, KKN, tn); RW_LD(bn, ALB, tn); RW_LD(dn, XKD, tn); RW_LD(rn_, XR, tn);
                const float vn = XV[tn * 64 + rpart * 32 + srow];
                const f32x4 pa = Sa * ka + Sb * kb;
                float sa = (pa[0] + pa[1]) + (pa[2] + pa[3]);
                sa = -red8(sa);
                Sa = Sa * wa + sa * ba + v * da;
                Sb = Sb * wb + sa * bb + v * db;
                const f32x4 py = Sa * ra + Sb * rb;
                float y = (py[0] + py[1]) + (py[2] + py[3]);
                y = red8(y);
                YO[t * 32 + srow] = y;
                wa = wna; wb = wnb; ka = kna; kb = knb; ba = bna; bb = bnb; da = dna; db = dnb; ra = rn_a; rb = rn_b; v = vn;
                if (t == 19 || t == 23) RW_BAR();
            }
            RW_BAR();
        }
    } else {
        const int ptid = tid - 256;
        const int cli = ptid & 15, cc4 = cli * 4;
        const f32x4 w0v = *(const f32x4*)(p.in[5] + (l * 2 + dir) * 256 + h * 64 + cc4);
        const f32x4 a0v = *(const f32x4*)(p.in[7] + (l * 2 + dir) * 256 + h * 64 + cc4);
        const f32x4 kkw = *(const f32x4*)(p.in[10] + l * 256 + h * 64 + cc4);
        const f32x4 kaw = *(const f32x4*)(p.in[11] + l * 256 + h * 64 + cc4);
        const f32x4 rkw = *(const f32x4*)(p.in[12] + l * 256 + h * 64 + cc4);
        u32x2 rc[10], rp_[10], rn[10];
        const bf16_t* bq[10];
        const long bstep = dir ? -(long)32 * NPROJ : (long)32 * NPROJ;
#define RW_BQ(i_) { const int pt = ptid; RW_DECODE(i_) const int pos = dir ? (len - 1 - t) : t; bq[i_] = proj + (size_t)(start + pos) * NPROJ + col; }
        RW_BQ(0) RW_BQ(1) RW_BQ(2) RW_BQ(3) RW_BQ(4) RW_BQ(5) RW_BQ(6) RW_BQ(7) RW_BQ(8) RW_BQ(9)
        f32x4 mureg[5];
        { const int c4 = (ptid & 15) * 4;
          mureg[0] = *(const f32x4*)(mu + C_R + h * 64 + c4); mureg[1] = *(const f32x4*)(mu + C_K + h * 64 + c4); mureg[2] = *(const f32x4*)(mu + C_V + h * 64 + c4);
          mureg[3] = *(const f32x4*)(mu + C_WD + dir * 64 + c4); mureg[4] = *(const f32x4*)(mu + C_AD + dir * 64 + c4); }
        { int pt = ptid; RW_ISSUE(0); }
        for (int ch = -1; ch < nch; ++ch) {
            int pt = ptid; asm volatile("" : "+v"(pt));
            if (ch >= 1) {
                const int pc = ch - 1;
                LAS float* YO = (LAS float*)(lds + RW_YO + (pc & 1) * 4096); LAS float* CD = (LAS float*)(lds + RW_CD + (pc & 1) * 128);
                const int t = ptid >> 3, c4 = (ptid & 7) * 4;
                const int n = pc * 32 + t; const int pos = dir ? (len - 1 - n) : n; const int tok = start + pos;
                const f32x4 yv = *(const LAS f32x4*)(YO + t * 32 + c4);
                u32x2 w; w.x = cvtpk(yv[0], yv[1]); w.y = cvtpk(yv[2], yv[3]);
                if (c4 < nrows) { if (dir) *(u32x2*)(yb + (size_t)tok * 256 + h * 64 + rpart * nrows + c4) = w; else *(u32x2*)(mix + (size_t)tok * DM + h * 64 + rpart * nrows + c4) = w; }
                if (rpart == 0 && ptid < 32) { const int n2 = pc * 32 + ptid; const int pos2 = dir ? (len - 1 - n2) : n2; cdot[((size_t)(start + pos2) * 4 + h) * 2 + dir] = CD[ptid]; }
            }
            const int nc = ch + 1;
            const bool build = nc < nch;
            LAS unsigned char* B = lds + (nc & 1) * RW_BUF;
            LAS float* XR = (LAS float*)(B + RW_XR); LAS float* XKD = (LAS float*)(B + RW_XKD); LAS float* XV = (LAS float*)(B + RW_XV);
            LAS float* WLW = (LAS float*)(B + RW_WLW); LAS float* ALB = (LAS float*)(B + RW_ALB); LAS float* KKN = (LAS float*)(B + RW_KKN);
            LAS float* CDn = (LAS float*)(lds + RW_CD + (nc & 1) * 128);
            if (build) {
                RW_CONV1(0) RW_CONV1(1) RW_CONV1(2) RW_CONV1(3) RW_CONV1(4) RW_CONV1(5) RW_CONV1(6) RW_CONV1(7) RW_CONV1(8) RW_CONV1(9)
                if (nc + 1 < nch - 1) RW_ISSUE_MID(); else if (nc + 1 < nch) RW_ISSUE(nc + 1);
            }
            RW_BAR();
            if (build) {
                const int mat = (wave - 4) >> 1, nb = (wave - 4) & 1;
                LAS bf16_t* Xs = mat ? XAD : XWD; LAS bf16_t* Ws = mat ? A2T : W2T;
                f32x16 acc = zero16();
#pragma unroll
                for (int ks = 0; ks < 4; ++ks) {
                    const bf16x8 a = *(const LAS bf16x8*)(Xs + r32 * 72 + ks * 16 + hh * 8);
                    const bf16x8 bb = *(const LAS bf16x8*)(Ws + (nb * 32 + r32) * 72 + ks * 16 + hh * 8);
                    acc = MFMA32(a, bb, acc);
                }
                LAS float* dst = mat ? ALB : WLW;
#pragma unroll
                for (int i = 0; i < 16; ++i) dst[crow(i, hh) * 64 + nb * 32 + r32] = acc[i];
            }
            RW_BAR();
            if (build) {
#pragma unroll
                for (int it = 0; it < 2; ++it) {
                    const int ct = (ptid >> 4) + 16 * it;
                    const f32x4 wl = *(const LAS f32x4*)(WLW + ct * 64 + cc4), al = *(const LAS f32x4*)(ALB + ct * 64 + cc4);
                    const f32x4 k4 = *(const LAS f32x4*)(XKD + ct * 64 + cc4), r4 = *(const LAS f32x4*)(XR + ct * 64 + cc4);
                    f32x4 w, a, kkr, kd;
                    float ssq = 0.f, cd = 0.f;
#pragma unroll
                    for (int j = 0; j < 4; ++j) {
                        const float sg = sigmoidf_(w0v[j] + wl[j]);
                        w[j] = __expf(-0.6065306597126334f * sg);
                        a[j] = sigmoidf_(a0v[j] + al[j]);
                        kkr[j] = k4[j] * kkw[j]; ssq += kkr[j] * kkr[j];
                        kd[j] = k4[j] * (1.f + (a[j] - 1.f) * kaw[j]);
                        cd += r4[j] * kd[j] * rkw[j];
                    }
                    ssq = red16(ssq); cd = red16(cd);
                    const float inv = __builtin_amdgcn_rsqf(fmaxf(ssq, 1e-24f));
                    f32x4 kkn, bv;
#pragma unroll
                    for (int j = 0; j < 4; ++j) { kkn[j] = kkr[j] * inv; bv[j] = kkn[j] * a[j]; }
                    *(LAS f32x4*)(WLW + ct * 64 + cc4) = w; *(LAS f32x4*)(ALB + ct * 64 + cc4) = bv; *(LAS f32x4*)(KKN + ct * 64 + cc4) = kkn; *(LAS f32x4*)(XKD + ct * 64 + cc4) = kd;
                    if (cli == 0) CDn[ct] = cd;
                }
            }
            RW_BAR();
        }
        {
            const int pc = nch - 1;
            LAS float* YO = (LAS float*)(lds + RW_YO + (pc & 1) * 4096); LAS float* CD = (LAS float*)(lds + RW_CD + (pc & 1) * 128);
            const int t = ptid >> 3, c4 = (ptid & 7) * 4;
            const int n = pc * 32 + t; const int pos = dir ? (len - 1 - n) : n; const int tok = start + pos;
            const f32x4 yv = *(const LAS f32x4*)(YO + t * 32 + c4);
            u32x2 w; w.x = cvtpk(yv[0], yv[1]); w.y = cvtpk(yv[2], yv[3]);
            if (c4 < nrows) { if (dir) *(u32x2*)(yb + (size_t)tok * 256 + h * 64 + rpart * nrows + c4) = w; else *(u32x2*)(mix + (size_t)tok * DM + h * 64 + rpart * nrows + c4) = w; }
            if (rpart == 0 && ptid < 32) { const int n2 = pc * 32 + ptid; const int pos2 = dir ? (len - 1 - n2) : n2; cdot[((size_t)(start + pos2) * 4 + h) * 2 + dir] = CD[ptid]; }
        }
    }
    __syncthreads();
}

constexpr int ML_QS = 0, ML_KS = 9216, ML_KT = 18432, ML_VT = 27648, ML_VWT = 36864, ML_PS = 46080, ML_CB = 55296, ML_WGT = 64512, ML_RR = 64768, ML_MROW = 65024,
              ML_SC = 65280, ML_EMT = 65536, ML_DENI = 65792, ML_NS = 66048, ML_A12 = 66304;
DI void mlstm_job(const KP& p, int l, int job, LAS unsigned char* lds, int tid) {
    int seq, hm, dir; seq_of_job(job, seq, hm, dir);
    int start, len; seq_info(seq, start, len);
    const bf16_t* proj = (const bf16_t*)(p.ws + WS_R);
    bf16_t* mix = (bf16_t*)(p.ws + WS_X1);
    bf16_t* hbp = (bf16_t*)(p.ws + WS_HBP);
    const float* cw = p.in[17] + l * 3 * 512;
    const float ibv = p.in[18][(l * 2 + dir) * 4 + hm], fbv = p.in[19][(l * 2 + dir) * 4 + hm];
    const int wave = tid >> 6, lane = tid & 63, r32 = lane & 31, hh = lane >> 5;
    LAS bf16_t* Qs = (LAS bf16_t*)(lds + ML_QS); LAS bf16_t* Ks = (LAS bf16_t*)(lds + ML_KS); LAS bf16_t* KT = (LAS bf16_t*)(lds + ML_KT);
    LAS bf16_t* VT = (LAS bf16_t*)(lds + ML_VT); LAS bf16_t* VWT = (LAS bf16_t*)(lds + ML_VWT); LAS bf16_t* Ps = (LAS bf16_t*)(lds + ML_PS); LAS bf16_t* CB = (LAS bf16_t*)(lds + ML_CB);
    LAS float* WGT = (LAS float*)(lds + ML_WGT); LAS float* RR = (LAS float*)(lds + ML_RR); LAS float* MROW = (LAS float*)(lds + ML_MROW); LAS float* SC = (LAS float*)(lds + ML_SC);
    LAS float* EMT = (LAS float*)(lds + ML_EMT); LAS float* DENI = (LAS float*)(lds + ML_DENI); LAS float* NS = (LAS float*)(lds + ML_NS); LAS float* A12 = (LAS float*)(lds + ML_A12);
    for (int i = tid; i < 64 * 72; i += NTHR) CB[i] = 0;
    if (tid < 64) NS[tid] = 0.f;
    f32x16 Creg = zero16();
    float Mst = 0.f;
    __syncthreads();
    const int nch = len >> 6;
    const int ll = tid >> 3, e8 = (tid & 7) * 8;
    for (int ch = 0; ch < nch; ++ch) {
        {
            const int n = ch * 64 + ll; const int pos = dir ? (len - 1 - n) : n; const int tok = start + pos;
#pragma unroll
            for (int which = 0; which < 2; ++which) {
                const int col = (which ? C_MK : C_MQ) + hm * 64 + e8; const int cwc = (which ? 256 : 0) + hm * 64 + e8;
                const bf16_t* bp = proj + (size_t)tok * NPROJ + col;
                const u32x4 cu = *(const u32x4*)bp; u32x4 pv = {0u, 0u, 0u, 0u}, nv = {0u, 0u, 0u, 0u};
                if (pos > 0) pv = *(const u32x4*)(bp - NPROJ);
                if (pos < len - 1) nv = *(const u32x4*)(bp + NPROJ);
                float o[8];
#pragma unroll
                for (int j = 0; j < 4; ++j) {
                    const f32x2 c0 = *(const f32x2*)(cw + cwc + 2 * j), c1 = *(const f32x2*)(cw + 512 + cwc + 2 * j), c2 = *(const f32x2*)(cw + 1024 + cwc + 2 * j);
                    const float v0 = c0.x * bflo(pv[j]) + c1.x * bflo(cu[j]) + c2.x * bflo(nv[j]);
                    const float v1 = c0.y * bfhi(pv[j]) + c1.y * bfhi(cu[j]) + c2.y * bfhi(nv[j]);
                    o[2 * j] = v0 * sigmoidf_(v0); o[2 * j + 1] = v1 * sigmoidf_(v1);
                }
                if (which) {
#pragma unroll
                    for (int j = 0; j < 8; ++j) o[j] *= 0.125f;
                }
                u32x4 w; w.x = cvtpk(o[0], o[1]); w.y = cvtpk(o[2], o[3]); w.z = cvtpk(o[4], o[5]); w.w = cvtpk(o[6], o[7]);
                if (!which) *(LAS u32x4*)(Qs + ll * 72 + e8) = w;
                else { *(LAS u32x4*)(Ks + ll * 72 + e8) = w;
#pragma unroll
                    for (int j = 0; j < 4; ++j) { KT[(e8 + 2 * j) * 72 + ll] = (bf16_t)(w[j] & 0xffffu); KT[(e8 + 2 * j + 1) * 72 + ll] = (bf16_t)(w[j] >> 16); } }
            }
        }
        if (wave == 0) {
            const int n = ch * 64 + lane; const int pos = dir ? (len - 1 - n) : n; const int tok = start + pos;
            const float igv = bf2f(proj[(size_t)tok * NPROJ + C_IG + dir * 4 + hm]) + ibv;
            const float fgv = bf2f(proj[(size_t)tok * NPROJ + C_FG + dir * 4 + hm]) + fbv;
            const float lf = (fgv > 0.f) ? -log1pf(__expf(-fgv)) : (fgv - log1pf(__expf(fgv)));
            float b = lf;
#pragma unroll
            for (int o = 1; o < 64; o <<= 1) { const float t2 = __shfl_up(b, o); if (lane >= o) b += t2; }
            const float bL = __shfl(b, 63);
            const float g = bL - b + igv;
            float mg = g;
#pragma unroll
            for (int o = 32; o >= 1; o >>= 1) mg = fmaxf(mg, __shfl_xor(mg, o));
            const float wgt = __expf(g - mg);
            const float r = igv - b;
            float cm = r;
#pragma unroll
            for (int o = 1; o < 64; o <<= 1) { const float t2 = __shfl_up(cm, o); if (lane >= o) cm = fmaxf(cm, t2); }
            const float mrow = fmaxf(cm, Mst);
            WGT[lane] = wgt; RR[lane] = r; MROW[lane] = mrow; SC[lane] = __expf(Mst - mrow); EMT[lane] = __expf(-(b + mrow));
            const float Mnew = fmaxf(bL + Mst, mg);
            if (lane == 0) { A12[0] = __expf(bL + Mst - Mnew); A12[1] = __expf(mg - Mnew); }
            Mst = Mnew;
        }
        __syncthreads();
        {
            const int n = ch * 64 + ll; const int pos = dir ? (len - 1 - n) : n; const int tok = start + pos;
            const u32x4 vv = *(const u32x4*)(proj + (size_t)tok * NPROJ + C_MV + hm * 64 + e8);
            const float wg = WGT[ll];
#pragma unroll
            for (int j = 0; j < 4; ++j) {
                VT[(e8 + 2 * j) * 72 + ll] = (bf16_t)(vv[j] & 0xffffu); VT[(e8 + 2 * j + 1) * 72 + ll] = (bf16_t)(vv[j] >> 16);
                const unsigned pw = cvtpk(bflo(vv[j]) * wg, bfhi(vv[j]) * wg);
                VWT[(e8 + 2 * j) * 72 + ll] = (bf16_t)(pw & 0xffffu); VWT[(e8 + 2 * j + 1) * 72 + ll] = (bf16_t)(pw >> 16);
            }
        }
        __syncthreads();
        if (wave < 4) {
            const int tb = wave >> 1, sb = wave & 1;
            f32x16 acc = zero16();
#pragma unroll
            for (int ks = 0; ks < 4; ++ks) {
                const bf16x8 a = *(const LAS bf16x8*)(Qs + (tb * 32 + r32) * 72 + ks * 16 + hh * 8);
                const bf16x8 b = *(const LAS bf16x8*)(Ks + (sb * 32 + r32) * 72 + ks * 16 + hh * 8);
                acc = MFMA32(a, b, acc);
            }
            const int s = sb * 32 + r32; const float rs_ = RR[s];
#pragma unroll
            for (int i = 0; i < 16; ++i) { const int t = tb * 32 + crow(i, hh); const float pvv = (s <= t) ? __expf(rs_ - MROW[t]) * acc[i] : 0.f; Ps[t * 72 + s] = f2bf(pvv); }
        } else {
            const int db = (wave - 4) >> 1, eb = (wave - 4) & 1;
            f32x16 kc = zero16();
#pragma unroll
            for (int ks = 0; ks < 4; ++ks) {
                const bf16x8 a = *(const LAS bf16x8*)(VWT + (db * 32 + r32) * 72 + ks * 16 + hh * 8);
                const bf16x8 b = *(const LAS bf16x8*)(KT + (eb * 32 + r32) * 72 + ks * 16 + hh * 8);
                kc = MFMA32(a, b, kc);
            }
            const float a1 = A12[0], a2 = A12[1];
#pragma unroll
            for (int i = 0; i < 16; ++i) Creg[i] = a1 * Creg[i] + a2 * kc[i];
        }
        __syncthreads();
        f32x16 acc = zero16();
        float ncv = 0.f;
        if (wave < 4) {
            const int tb = wave >> 1, db = wave & 1;
#pragma unroll
            for (int ks = 0; ks < 4; ++ks) {
                const bf16x8 a = *(const LAS bf16x8*)(Qs + (tb * 32 + r32) * 72 + ks * 16 + hh * 8);
                const bf16x8 b = *(const LAS bf16x8*)(CB + (db * 32 + r32) * 72 + ks * 16 + hh * 8);
                acc = MFMA32(a, b, acc);
            }
#pragma unroll
            for (int i = 0; i < 16; ++i) acc[i] *= SC[tb * 32 + crow(i, hh)];
#pragma unroll
            for (int ks = 0; ks < 4; ++ks) {
                const bf16x8 a = *(const LAS bf16x8*)(Ps + (tb * 32 + r32) * 72 + ks * 16 + hh * 8);
                const bf16x8 b = *(const LAS bf16x8*)(VT + (db * 32 + r32) * 72 + ks * 16 + hh * 8);
                acc = MFMA32(a, b, acc);
            }
        } else if (wave == 4) {
            float rsum = 0.f, qn = 0.f;
            for (int e = 0; e < 64; ++e) { rsum += bf2f(Ps[lane * 72 + e]); qn += bf2f(Qs[lane * 72 + e]) * NS[e]; }
            const float den = rsum + SC[lane] * qn;
            DENI[lane] = 1.f / fmaxf(fabsf(den), EMT[lane]);
        } else if (wave == 5) {
            for (int s = 0; s < 64; ++s) ncv += WGT[s] * bf2f(KT[lane * 72 + s]);
        }
        __syncthreads();
        if (wave < 4) {
            const int tb = wave >> 1, db = wave & 1;
#pragma unroll
            for (int i = 0; i < 16; ++i) {
                const int t = tb * 32 + crow(i, hh); const int n = ch * 64 + t; const int pos = dir ? (len - 1 - n) : n; const int tok = start + pos;
                const bf16_t o = f2bf(acc[i] * DENI[t]);
                if (dir) hbp[(size_t)tok * 256 + hm * 64 + db * 32 + r32] = o; else mix[(size_t)tok * DM + 768 + hm * 64 + db * 32 + r32] = o;
            }
        } else {
            const int db = (wave - 4) >> 1, eb = (wave - 4) & 1;
#pragma unroll
            for (int i = 0; i < 16; ++i) CB[(db * 32 + crow(i, hh)) * 72 + eb * 32 + r32] = f2bf(Creg[i]);
            if (wave == 5) NS[lane] = A12[0] * NS[lane] + A12[1] * ncv;
        }
        __syncthreads();
    }
}

DI void mixers_phase(const KP& p, int l, int cidx, LAS unsigned char* lds, int tid, int G, int bid) {
    unsigned* cnt = (unsigned*)(p.ws + WS_CNT) + cidx;
    LAS int* slot = (LAS int*)(lds + SLOT_OFF);
    for (;;) {
        if (tid == 0) *slot = (int)atomicAdd(cnt, 1u);
        __syncthreads();
        const int item = *slot;
        __syncthreads();
        if (item >= 240 + 1536) {
            if (l != 0 || item >= 240 + 1536 + 1344) break;
            const int t0 = 768 + (item - 1776) * 4;
            for (int q = 0; q < 4; ++q) convert_tile(p, t0 + q, (LAS float*)lds, tid);
            continue;
        }
        int kind, jb;
        if (item < 32) { kind = 0; jb = item; } else if (item < 48) { kind = 1; jb = item - 32; } else if (item < 176) { kind = 0; jb = item - 48 + 32; }
        else if (item < 240) { kind = 1; jb = item - 176 + 16; } else { kind = 2; jb = item - 240; }
        int t2 = tid; asm volatile("" : "+v"(t2));
#ifndef REP_R
#define REP_R 1
#endif
#ifndef REP_M
#define REP_M 1
#endif
#ifndef REP_T
#define REP_T 1
#endif
        if (kind == 0) { rwkv_job(p, l, jb, lds, t2); }
        else if (kind == 1) { for (int rep = 0; rep < REP_M; ++rep) { mlstm_job(p, l, jb, lds, t2); __syncthreads(); } }
        else { for (int rep = 0; rep < REP_T; ++rep) { attn_unit(p, l, jb, lds, t2); __syncthreads(); } }
        __syncthreads();
    }
}

constexpr int PO_G2T = 0, PO_AS = 69632, PO_GO = 87040;
DI void post_phase(const KP& p, int l, LAS unsigned char* lds, int tid, int G, int bid) {
    const bf16_t* proj = (const bf16_t*)(p.ws + WS_R);
    bf16_t* mix = (bf16_t*)(p.ws + WS_X1);
    const bf16_t* yb = (const bf16_t*)(p.ws + WS_YB);
    const bf16_t* hbp = (const bf16_t*)(p.ws + WS_HBP);
    const float* cdot = (const float*)(p.ws + WS_CDOT);
    const float* mu = p.in[4] + l * 1152;
    const float* lnw = p.in[13] + l * 256; const float* lnb = p.in[14] + l * 256; const float* nw = p.in[20] + l * 256;
    LAS bf16_t* G2T = (LAS bf16_t*)(lds + PO_G2T); LAS bf16_t* AS = (LAS bf16_t*)(lds + PO_AS); LAS bf16_t* GO = (LAS bf16_t*)(lds + PO_GO);
    const int wave = tid >> 6, lane = tid & 63, r32 = lane & 31, hh = lane >> 5;
    { const float* g2 = p.in[9] + (size_t)l * 128 * 256;
      for (int i = 0; i < 64; ++i) { const int idx = tid + NTHR * i; const int mm = idx >> 8, c = idx & 255; G2T[c * 136 + mm] = f2bf(g2[idx]); } }
    __syncthreads();
    for (int unit = bid; unit < T / 64; unit += G) {
        const int tok0 = unit * 64;
        int len; const int st = tok_seq_start(tok0, len);
#pragma unroll
        for (int i = 0; i < 4; ++i) {
            const int q = tid + NTHR * i; const int t = q >> 5, c4 = (q & 31) * 4; const int tok = tok0 + t; const int pos = tok - st;
            const bf16_t* bp = proj + (size_t)tok * NPROJ + C_GD + c4;
            const u32x2 cu = *(const u32x2*)bp; u32x2 pv = {0u, 0u}, nv = {0u, 0u};
            if (pos > 0) pv = *(const u32x2*)(bp - NPROJ);
            if (pos < len - 1) nv = *(const u32x2*)(bp + NPROJ);
            const f32x4 m4 = *(const f32x4*)(mu + C_GD + c4);
            float x[4] = {bflo(cu.x), bfhi(cu.x), bflo(cu.y), bfhi(cu.y)};
            const float pn[4] = {bflo(pv.x) + bflo(nv.x), bfhi(pv.x) + bfhi(nv.x), bflo(pv.y) + bflo(nv.y), bfhi(pv.y) + bfhi(nv.y)};
#pragma unroll
            for (int j = 0; j < 4; ++j) x[j] = sigmoidf_(x[j] + (0.5f * pn[j] - x[j]) * m4[j]);
            u32x2 w; w.x = cvtpk(x[0], x[1]); w.y = cvtpk(x[2], x[3]); *(LAS u32x2*)(AS + t * 136 + c4) = w;
        }
        __syncthreads();
        {
            const int hd = wave & 3, tb = wave >> 2;
            f32x16 a0 = zero16(), a1 = zero16();
#pragma unroll
            for (int ks = 0; ks < 8; ++ks) {
                const bf16x8 a = *(const LAS bf16x8*)(AS + (tb * 32 + r32) * 136 + ks * 16 + hh * 8);
                const bf16x8 b0 = *(const LAS bf16x8*)(G2T + (hd * 64 + r32) * 136 + ks * 16 + hh * 8);
                const bf16x8 b1 = *(const LAS bf16x8*)(G2T + (hd * 64 + 32 + r32) * 136 + ks * 16 + hh * 8);
                a0 = MFMA32(a, b0, a0); a1 = MFMA32(a, b1, a1);
            }
#pragma unroll
            for (int i = 0; i < 16; ++i) { const int t = tb * 32 + crow(i, hh); GO[t * 264 + hd * 64 + r32] = f2bf(a0[i]); GO[t * 264 + hd * 64 + 32 + r32] = f2bf(a1[i]); }
        }
        __syncthreads();
#pragma unroll 1
        for (int it = 0; it < 8; ++it) {
            const int task = tid + NTHR * it; const int grp = task >> 4, li = task & 15; const int t = grp >> 2, hd = grp & 3; const int c4 = li * 4;
            const int tok = tok0 + t; const int pos = tok - st;
            {
                const u32x2 yf = *(const u32x2*)(mix + (size_t)tok * DM + hd * 64 + c4), ybv = *(const u32x2*)(yb + (size_t)tok * 256 + hd * 64 + c4);
                float x[4] = {bflo(yf.x) + bflo(ybv.x), bfhi(yf.x) + bfhi(ybv.x), bflo(yf.y) + bflo(ybv.y), bfhi(yf.y) + bfhi(ybv.y)};
                const float mean = red16(x[0] + x[1] + x[2] + x[3]) * (1.f / 64.f);
                float vs = 0.f;
#pragma unroll
                for (int j = 0; j < 4; ++j) { x[j] -= mean; vs += x[j] * x[j]; }
                const float rstd = rsqrtf(red16(vs) * (1.f / 64.f) + 64e-5f);
                const bf16_t* bp = proj + (size_t)tok * NPROJ + C_V + hd * 64 + c4;
                const u32x2 cu = *(const u32x2*)bp; u32x2 pv = {0u, 0u}, nv = {0u, 0u};
                if (pos > 0) pv = *(const u32x2*)(bp - NPROJ);
                if (pos < len - 1) nv = *(const u32x2*)(bp + NPROJ);
                const f32x4 m4 = *(const f32x4*)(mu + C_V + hd * 64 + c4);
                float v[4] = {bflo(cu.x), bfhi(cu.x), bflo(cu.y), bfhi(cu.y)};
                const float pn[4] = {bflo(pv.x) + bflo(nv.x), bfhi(pv.x) + bfhi(nv.x), bflo(pv.y) + bflo(nv.y), bfhi(pv.y) + bfhi(nv.y)};
                const f32x2 cdv = *(const f32x2*)(cdot + ((size_t)tok * 4 + hd) * 2);
                const float cds = cdv.x + cdv.y;
                const f32x4 lw = *(const f32x4*)(lnw + hd * 64 + c4), lb = *(const f32x4*)(lnb + hd * 64 + c4);
                const u32x2 gv = *(const LAS u32x2*)(GO + t * 264 + hd * 64 + c4);
                const float g[4] = {bflo(gv.x), bfhi(gv.x), bflo(gv.y), bfhi(gv.y)};
                float o[4];
#pragma unroll
                for (int j = 0; j < 4; ++j) { const float vsft = v[j] + (0.5f * pn[j] - v[j]) * m4[j]; o[j] = (x[j] * rstd * lw[j] + lb[j] + cds * vsft) * g[j]; }
                u32x2 w; w.x = cvtpk(o[0], o[1]); w.y = cvtpk(o[2], o[3]); *(u32x2*)(mix + (size_t)tok * DM + hd * 64 + c4) = w;
            }
            {
                const u32x2 hf = *(const u32x2*)(mix + (size_t)tok * DM + 768 + hd * 64 + c4), hb = *(const u32x2*)(hbp + (size_t)tok * 256 + hd * 64 + c4);
                const float x[4] = {bflo(hf.x) + bflo(hb.x), bfhi(hf.x) + bfhi(hb.x), bflo(hf.y) + bflo(hb.y), bfhi(hf.y) + bfhi(hb.y)};
                const float ms = red16(x[0] * x[0] + x[1] * x[1] + x[2] * x[2] + x[3] * x[3]) * (1.f / 64.f);
                const float rinv = rsqrtf(ms + 1e-6f);
                const u32x2 ov = *(const u32x2*)(proj + (size_t)tok * NPROJ + C_MO + hd * 64 + c4);
                const float og[4] = {bflo(ov.x), bfhi(ov.x), bflo(ov.y), bfhi(ov.y)};
                const f32x4 nwv = *(const f32x4*)(nw + hd * 64 + c4);
                float o[4];
#pragma unroll
                for (int j = 0; j < 4; ++j) o[j] = sigmoidf_(og[j]) * x[j] * rinv * nwv[j];
                u32x2 w; w.x = cvtpk(o[0], o[1]); w.y = cvtpk(o[2], o[3]); *(u32x2*)(mix + (size_t)tok * DM + 768 + hd * 64 + c4) = w;
            }
        }
        __syncthreads();
    }
}

DI void final_phase(const KP& p, int tid, int G, int bid) {
    const float* ss = (const float*)(p.ws + WS_SS) + 4 * T;
    const float* g = p.in[25];
    const int wave = tid >> 6, lane = tid & 63;
    f32x4 gv[4];
#pragma unroll
    for (int j = 0; j < 4; ++j) gv[j] = *(const f32x4*)(g + (j * 64 + lane) * 4);
    for (int row = (bid * 8 + wave) * 4; row < T; row += G * 8 * 4) {
        f32x4 v[4][4]; float rs[4];
#pragma unroll
        for (int r = 0; r < 4; ++r) {
            rs[r] = rsqrtf(ss[row + r] * (1.f / 1024.f) + 1e-6f);
#pragma unroll
            for (int j = 0; j < 4; ++j) v[r][j] = *(const f32x4*)(p.out + (size_t)(row + r) * DM + (j * 64 + lane) * 4);
        }
#pragma unroll
        for (int r = 0; r < 4; ++r)
#pragma unroll
            for (int j = 0; j < 4; ++j) *(f32x4*)(p.out + (size_t)(row + r) * DM + (j * 64 + lane) * 4) = v[r][j] * rs[r] * gv[j];
    }
}

__global__ void __launch_bounds__(NTHR, 2) fwd_kernel(KP p) {
    extern __shared__ __attribute__((aligned(16))) unsigned char lds_raw[];
    LAS unsigned char* lds = (LAS unsigned char*)lds_raw;
    cg::grid_group grid = cg::this_grid();
    int tid = threadIdx.x; const int G = gridDim.x, bid = blockIdx.x;
#define LAUNDER() asm volatile("" : "+v"(tid))
    float* ss = (float*)(p.ws + WS_SS);
    bf16_t* X1 = (bf16_t*)(p.ws + WS_X1);
    bf16_t* PROJ = (bf16_t*)(p.ws + WS_R);
    bf16_t* HB = (bf16_t*)(p.ws + WS_R);
    bf16_t* HID = (bf16_t*)(p.ws + WS_HID);

        LAUNDER();
    volatile LAS unsigned* bst = (volatile LAS unsigned*)(lds + SLOT_OFF + 16);
    if (tid == 0) { bst[0] = 0u; bst[1] = 0u; }
    __syncthreads();
    const XcdBarrier xbar = xcd_barrier_post((unsigned*)(p.ws + WS_BAR), bst);
#define GSYNC() xcd_barrier(xbar)
    p0_phase(p, lds, tid, G, bid);
    grid.sync();
#ifdef PROBE_SYNC20
    for (int i = 0; i < 20; ++i) GSYNC();
#endif
#ifdef PROBE_P0X2
    LAUNDER(); p0_phase(p, lds, tid, G, bid);
    GSYNC();
#endif
#ifdef PROBE_SYNC10
    for (int i = 0; i < 10; ++i) GSYNC();
#endif
    for (int l = 0; l < 2; ++l) {
        {
            pg8::Gemm g{X1, (const bf16_t*)(p.ws + WS_WIN) + (size_t)l * NPROJ * 1024, T, NPROJ, 1024}; pg8::StaticOrder S; S.init(T, NPROJ, G, bid);
            EpiProj E{PROJ, ss + (2 * l) * T};
            pg8::gemm_phase<EpiProj, pg8::StaticOrder, true, true>(lds, g, S, E);
#ifdef PROBE_P1X2
            GSYNC();
            pg8::gemm_phase<EpiProj, pg8::StaticOrder, true, true>(lds, g, S, E);
#endif
        }
        GSYNC();
        LAUNDER();
        prep_phase(p, l, lds, tid, G, bid);
        GSYNC();
        LAUNDER();
        mixers_phase(p, l, l, lds, tid, G, bid);
#ifdef PROBE_MIX2
        GSYNC(); LAUNDER();
        mixers_phase(p, l, l + 2, lds, tid, G, bid);
#endif
        GSYNC();
        LAUNDER();
        post_phase(p, l, lds, tid, G, bid);
        GSYNC();
        {
            pg8::Gemm g{X1, (const bf16_t*)(p.ws + WS_WOUT) + (size_t)l * 1024 * 1024, T, DM, 1024}; pg8::StaticOrder S; S.init(T, DM, G, bid);
            if (l == 0) { EpiRes<true, true, true> E{p.out, HB, ss + (2 * l + 1) * T, p.in[0], p.in[1]}; pg8::gemm_phase<EpiRes<true, true, true>, pg8::StaticOrder, true, true>(lds, g, S, E); }
            else { EpiRes<true, true> E{p.out, HB, ss + (2 * l + 1) * T, nullptr, nullptr}; pg8::gemm_phase<EpiRes<true, true>, pg8::StaticOrder, true, true>(lds, g, S, E); }
        }
        GSYNC();
        for (int hf = 0; hf < 2; ++hf) {
            {
                pg8::Gemm g{HB, (const bf16_t*)(p.ws + WS_W1) + (size_t)l * 4096 * 1024 + (size_t)hf * HFF * 1024, T, HFF, 1024}; pg8::StaticOrder S; S.init(T, HFF, G, bid);
                EpiRelu2 E{HID, ss + (2 * l + 1) * T};
                pg8::gemm_phase<EpiRelu2, pg8::StaticOrder, true, true>(lds, g, S, E);
            }
            GSYNC();
            {
                pg8::Gemm g{HID, (const bf16_t*)(p.ws + WS_W2) + (size_t)l * 2 * 1024 * 2048 + (size_t)hf * 1024 * 2048, T, DM, HFF}; pg8::StaticOrder S; S.init(T, DM, G, bid);
                if (hf == 0) { EpiPart E{X1}; pg8::gemm_phase<EpiPart, pg8::StaticOrder, true, true>(lds, g, S, E); }
                else { EpiRes<true, true, false, true> E{p.out, X1, ss + (2 * l + 2) * T, nullptr, nullptr}; pg8::gemm_phase<EpiRes<true, true, false, true>, pg8::StaticOrder, true, true>(lds, g, S, E); }
            }
            GSYNC();
        }
    }
        LAUNDER();
    final_phase(p, tid, G, bid);
}

extern "C" void kernel_launch(void* const* d_in, const int* in_sizes, int n_in, void* d_out, int out_size, void* d_ws, size_t ws_size, hipStream_t stream) {
    static int grid_blocks = 0;
    if (grid_blocks == 0) {
        if (n_in != 26 || out_size != T * DM || ws_size < WS_END) { fprintf(stderr, "kernel_launch: unexpected shapes (n_in %d out %d ws %zu)\n", n_in, out_size, ws_size); grid_blocks = -1; return; }
        int dev = 0, cus = 0, per_cu = 0;
        hipGetDevice(&dev);
        hipDeviceGetAttribute(&cus, hipDeviceAttributeMultiprocessorCount, dev);
        hipFuncSetAttribute((const void*)fwd_kernel, hipFuncAttributeMaxDynamicSharedMemorySize, LDS_BYTES);
        hipOccupancyMaxActiveBlocksPerMultiprocessor(&per_cu, (const void*)fwd_kernel, NTHR, LDS_BYTES);
        if (per_cu < 1) per_cu = 1;
        grid_blocks = cus * per_cu;
        (void)hipGetLastError();
    }
    if (grid_blocks < 0) return;
    KP p{};
    for (int i = 0; i < 26; ++i) p.in[i] = (const float*)d_in[i];
    p.out = (float*)d_out; p.ws = (unsigned char*)d_ws;
    (void)hipMemsetAsync((char*)d_ws + WS_BAR, 0, 16384, stream);
    void* args[] = {&p};
    hipError_t e = hipLaunchCooperativeKernel((const void*)fwd_kernel, dim3(grid_blocks), dim3(NTHR), args, LDS_BYTES, stream);
    if (e != hipSuccess) fprintf(stderr, "cooperative launch failed: %s (grid %d)\n", hipGetErrorString(e), grid_blocks);
}
```

```cpp
#include <hip/hip_runtime.h>
#include <hip/hip_cooperative_groups.h>
#include <cstdio>
#include <cstdint>
namespace cg = cooperative_groups;
namespace pg8 {
#define PG8_LAS __attribute__((address_space(3)))
typedef unsigned short bf16_t;
typedef short bf16x8 __attribute__((ext_vector_type(8)));
typedef float f32x4 __attribute__((ext_vector_type(4)));
typedef unsigned u32x4 __attribute__((ext_vector_type(4)));
constexpr int BM = 256, BK = 64, HALF = 128, HTB = HALF * BK * 2  , STAGE_BYTES = 8 * HTB, NXCD = 8, WGM = 8;

__host__ __device__ __forceinline__ int lds_byte(int r, int c) { const int st = (r >> 4) * 2 + (c >> 5), rr = r & 15, cc = c & 31, ob = rr * 64 + cc * 2; return st * 1024 + (ob ^ (((ob >> 9) & 1) << 5)); }
__host__ __device__ __forceinline__ void stage_rc(int b, int& R, int& C) { const int st = b / 1024, sb = b % 1024, swz = sb ^ (((sb >> 9) & 1) << 5); R = (st >> 1) * 16 + swz / 64; C = (st & 1) * 32 + (swz % 64) / 2; }
__host__ __device__ __forceinline__ int perm32(int rho) { const int n = rho >> 4, i = rho & 15; return 8 * (i >> 2) + 4 * n + (i & 3); }

struct Unit { int pm, pn; };
struct Gemm { const bf16_t* A; const bf16_t* Bt; int M, N, K; };

struct StaticOrder {
    int nM, nN, nwg, G, c;
    __host__ __device__ void init(int M, int N, int G_, int c_) { nM = M / BM; nN = N / BM; nwg = nM * nN; G = G_; c = c_; }
    __host__ __device__ bool next(int i, Unit& u) const {
        const long L = (long)i * G + c; if (L >= nwg) return false;
        int wgid = (int)L; { const int q = nwg / NXCD, r = nwg % NXCD, xcd = wgid % NXCD, off = wgid / NXCD; wgid = (xcd < r ? xcd * (q + 1) : r * (q + 1) + (xcd - r) * q) + off; }
        const int nig = WGM * nN, gid = wgid / nig, fm = gid * WGM, gsz = (nM - fm) < WGM ? (nM - fm) : WGM;
        u.pm = fm + ((wgid % nig) % gsz); u.pn = (wgid % nig) / gsz; return true;
    }
    __device__ __forceinline__ void a_ready(const Unit&) const {}
    __device__ __forceinline__ void done(const Unit&) const {}
};

template <class Epi, class Sched, bool ALIGN_EPI = false, bool SP2 = false>
__device__ __forceinline__ void gemm_phase(PG8_LAS unsigned char* lds, const Gemm g, const Sched& S, const Epi& E) {
    int tid_l = threadIdx.x; asm volatile("" : "+v"(tid_l));
    const int tid = tid_l, wid = __builtin_amdgcn_readfirstlane(tid >> 6), lane = tid & 63, wr = wid >> 2, wc = wid & 3, fr = lane & 15, fq = lane >> 4;
    const int K = g.K, nt = K / BK;
    unsigned voffA[2], voffB[2];
#pragma unroll
    for (int i = 0; i < 2; ++i) { int R, C; stage_rc(tid * 16 + i * 8192, R, C); const int Rb = Epi::PERM ? ((R & ~31) + perm32(R & 31)) : R;
        voffA[i] = (unsigned)(R * K + C) * 2u; voffB[i] = (unsigned)(Rb * K + C) * 2u; }
    const size_t kstep = (size_t)(BK * 2);
    const size_t hstep = (size_t)HALF * K * 2;
    const size_t tstep = 2 * hstep;
    const unsigned ldsw = (unsigned)wid * 1024u;
    const int aoff = lds_byte(wr * 64 + fr, fq * 8), boff = lds_byte(wc * 32 + fr, fq * 8);
#define PG8_SA(b, h) (((b) * 2 + (h)) * HTB)
#define PG8_SB(b, h) ((4 + (b) * 2 + (h)) * HTB)
#define PG8_STAGE(bufoff, gbase, voff) do { _Pragma("unroll") for (int _i = 0; _i < 2; ++_i) \
        __builtin_amdgcn_global_load_lds((const unsigned*)((const char*)(gbase) + (voff)[_i]), (PG8_LAS unsigned*)(lds + (bufoff) + ldsw + _i * 8192), 16, 0, 0); } while (0)
#define PG8_LDA(dst, b, h) do { _Pragma("unroll") for (int m = 0; m < 4; ++m) _Pragma("unroll") for (int k = 0; k < 2; ++k) dst[m][k] = *(const PG8_LAS bf16x8*)(lds + PG8_SA(b, h) + aoff + m * 2048 + k * 1024); } while (0)
#define PG8_LDB(dst, b, h) do { _Pragma("unroll") for (int n = 0; n < 2; ++n) _Pragma("unroll") for (int k = 0; k < 2; ++k) dst[n][k] = *(const PG8_LAS bf16x8*)(lds + PG8_SB(b, h) + boff + n * 2048 + k * 1024); } while (0)
#define PG8_MMA(ai, bj, At, Bt) do { __builtin_amdgcn_s_setprio(1); _Pragma("unroll") for (int m = 0; m < 4; ++m) _Pragma("unroll") for (int n = 0; n < 2; ++n) _Pragma("unroll") for (int k = 0; k < 2; ++k) \
        acc[ai][bj][m][n] = __builtin_amdgcn_mfma_f32_16x16x32_bf16(Bt[n][k], At[m][k], acc[ai][bj][m][n], 0, 0, 0); __builtin_amdgcn_s_setprio(0); } while (0)
#define PG8_WAIT_V(n) asm volatile("s_waitcnt vmcnt(" #n ")" ::: "memory")
#define PG8_WAIT_L(n) asm volatile("s_waitcnt lgkmcnt(" #n ")" ::: "memory")
#define PG8_BAR __builtin_amdgcn_s_barrier()
#define PG8_SCHED __builtin_amdgcn_sched_barrier(0)
    Unit cur, nxt; int ui = 0;
    if (!S.next(0, cur)) return;
    f32x4 acc[2][2][4][2];
#pragma unroll
    for (int a = 0; a < 2; ++a)
#pragma unroll
        for (int b = 0; b < 2; ++b)
#pragma unroll
            for (int m = 0; m < 4; ++m)
#pragma unroll
                for (int n = 0; n < 2; ++n) acc[a][b][m][n] = (f32x4){0.f, 0.f, 0.f, 0.f};
    bf16x8 At[4][2], B0[2][2], B1[2][2];
    const char* cA = (const char*)g.A + (size_t)cur.pm * tstep; const char* cB = (const char*)g.Bt + (size_t)cur.pn * tstep;
    S.a_ready(cur);
    if constexpr (SP2) {
        PG8_STAGE(PG8_SB(0, 0), cB, voffB); PG8_STAGE(PG8_SB(0, 1), cB + hstep, voffB); PG8_STAGE(PG8_SA(0, 0), cA, voffA); PG8_STAGE(PG8_SA(0, 1), cA + hstep, voffA);
        if (wr == 1) PG8_BAR;
        PG8_WAIT_V(2); PG8_BAR;
        PG8_STAGE(PG8_SB(1, 0), cB + kstep, voffB); PG8_STAGE(PG8_SA(1, 0), cA + kstep, voffA); PG8_STAGE(PG8_SB(1, 1), cB + hstep + kstep, voffB);
        PG8_WAIT_V(6); PG8_BAR;
    } else {
        PG8_STAGE(PG8_SB(0, 0), cB, voffB); PG8_STAGE(PG8_SA(0, 0), cA, voffA); PG8_STAGE(PG8_SB(0, 1), cB + hstep, voffB); PG8_STAGE(PG8_SA(0, 1), cA + hstep, voffA);
        if (wr == 1) PG8_BAR;
        PG8_WAIT_V(4); PG8_BAR;
        PG8_STAGE(PG8_SB(1, 0), cB + kstep, voffB); PG8_STAGE(PG8_SA(1, 0), cA + kstep, voffA); PG8_STAGE(PG8_SB(1, 1), cB + hstep + kstep, voffB);
        PG8_WAIT_V(6); PG8_BAR;
    }
    for (;;) {
        const bool has_next = S.next(ui + 1, nxt);
        const char* nA = has_next ? (const char*)g.A + (size_t)nxt.pm * tstep : cA; const char* nB = has_next ? (const char*)g.Bt + (size_t)nxt.pn * tstep : cB;
        for (int t = 0; t < nt; t += 2) {
            const bool last = (t == nt - 2);
            const char* a1 = cA + (size_t)(t + 1) * kstep;
            const char* a2 = last ? nA : cA + (size_t)(t + 2) * kstep; const char* b2 = last ? nB : cB + (size_t)(t + 2) * kstep;
            const char* a3 = a2 + kstep; const char* b3 = b2 + kstep;
            if (last && has_next) S.a_ready(nxt);
            if constexpr (SP2) {
            PG8_LDB(B0, 0, 0); PG8_LDB(B1, 0, 1); PG8_SCHED; PG8_LDA(At, 0, 0); PG8_STAGE(PG8_SA(1, 1), a1 + hstep, voffA);
            PG8_WAIT_V(8); PG8_WAIT_L(0); PG8_BAR; PG8_MMA(0, 0, At, B0); PG8_MMA(0, 1, At, B1); PG8_BAR; PG8_SCHED;
            PG8_LDA(At, 0, 1); PG8_STAGE(PG8_SB(0, 0), b2, voffB); PG8_STAGE(PG8_SB(0, 1), b2 + hstep, voffB); PG8_STAGE(PG8_SA(0, 0), a2, voffA);
            PG8_WAIT_V(8); PG8_WAIT_L(0); PG8_BAR; PG8_MMA(1, 0, At, B0); PG8_MMA(1, 1, At, B1); PG8_BAR; PG8_SCHED;
            PG8_LDB(B0, 1, 0); PG8_LDB(B1, 1, 1); PG8_SCHED; PG8_LDA(At, 1, 0); PG8_STAGE(PG8_SA(0, 1), a2 + hstep, voffA);
            PG8_WAIT_V(8); PG8_WAIT_L(0); PG8_BAR; PG8_MMA(0, 0, At, B0); PG8_MMA(0, 1, At, B1); PG8_BAR; PG8_SCHED;
            PG8_LDA(At, 1, 1); PG8_STAGE(PG8_SB(1, 0), b3, voffB); PG8_STAGE(PG8_SB(1, 1), b3 + hstep, voffB); PG8_STAGE(PG8_SA(1, 0), a3, voffA);
            PG8_WAIT_V(8); PG8_WAIT_L(0); PG8_BAR; PG8_MMA(1, 0, At, B0); PG8_MMA(1, 1, At, B1); PG8_BAR; PG8_SCHED;
            } else {
            PG8_LDB(B0, 0, 0); PG8_SCHED; PG8_LDA(At, 0, 0); PG8_STAGE(PG8_SA(1, 1), a1 + hstep, voffA);
            PG8_WAIT_L(8); PG8_BAR; PG8_WAIT_L(0); PG8_MMA(0, 0, At, B0); PG8_BAR; PG8_SCHED;
            PG8_LDB(B1, 0, 1); PG8_STAGE(PG8_SB(0, 0), b2, voffB);
            PG8_BAR; PG8_WAIT_L(0); PG8_MMA(0, 1, At, B1); PG8_BAR;
            PG8_LDA(At, 0, 1); PG8_STAGE(PG8_SA(0, 0), a2, voffA);
            PG8_BAR; PG8_WAIT_L(0); PG8_MMA(1, 0, At, B0); PG8_BAR; PG8_SCHED;
            PG8_STAGE(PG8_SB(0, 1), b2 + hstep, voffB);
            PG8_WAIT_V(6); PG8_BAR; PG8_MMA(1, 1, At, B1); PG8_BAR;
            PG8_LDB(B0, 1, 0); PG8_SCHED; PG8_LDA(At, 1, 0); PG8_STAGE(PG8_SA(0, 1), a2 + hstep, voffA);
            PG8_WAIT_L(8); PG8_BAR; PG8_WAIT_L(0); PG8_MMA(0, 0, At, B0); PG8_BAR; PG8_SCHED;
            PG8_LDB(B1, 1, 1); PG8_STAGE(PG8_SB(1, 0), b3, voffB);
            PG8_BAR; PG8_WAIT_L(0); PG8_MMA(0, 1, At, B1); PG8_BAR;
            PG8_LDA(At, 1, 1); PG8_STAGE(PG8_SA(1, 0), a3, voffA);
            PG8_BAR; PG8_WAIT_L(0); PG8_MMA(1, 0, At, B0); PG8_BAR; PG8_SCHED;
            PG8_STAGE(PG8_SB(1, 1), b3 + hstep, voffB);
            PG8_WAIT_V(6); PG8_BAR; PG8_MMA(1, 1, At, B1); PG8_BAR;
            }
        }
        if constexpr (ALIGN_EPI) { if (wr == 0) PG8_BAR; }
        if constexpr (!Epi::AFTER_DRAIN) { E(acc, cur, wr, wc, fr, fq); S.done(cur); }
        if (!has_next) break;
#pragma unroll
        for (int a = 0; a < 2; ++a)
#pragma unroll
            for (int b = 0; b < 2; ++b)
#pragma unroll
                for (int m = 0; m < 4; ++m)
#pragma unroll
                    for (int n = 0; n < 2; ++n) acc[a][b][m][n] = (f32x4){0.f, 0.f, 0.f, 0.f};
        cur = nxt; cA = nA; cB = nB; ++ui;
        if constexpr (ALIGN_EPI) { if (wr == 1) PG8_BAR; }
    }
    PG8_WAIT_V(0);
    if constexpr (!ALIGN_EPI) { if (wr == 0) PG8_BAR; }
    PG8_BAR;
    if constexpr (Epi::AFTER_DRAIN) { E.fused(acc, cur, wr, wc, fr, fq, lds, wid, lane); S.done(cur); }
#undef PG8_SA
#undef PG8_SB
#undef PG8_STAGE
#undef PG8_LDA
#undef PG8_LDB
#undef PG8_MMA
#undef PG8_WAIT_V
#undef PG8_WAIT_L
#undef PG8_BAR
#undef PG8_SCHED
}
}

#define DI __device__ __forceinline__
#define LAS __attribute__((address_space(3)))
typedef unsigned short bf16_t;
typedef short bf16x8 __attribute__((ext_vector_type(8)));
typedef short s16x4 __attribute__((ext_vector_type(4)));
typedef float f32x4 __attribute__((ext_vector_type(4)));
typedef float f32x2 __attribute__((ext_vector_type(2)));
typedef float f32x16 __attribute__((ext_vector_type(16)));
typedef unsigned u32x4 __attribute__((ext_vector_type(4)));
typedef unsigned u32x2 __attribute__((ext_vector_type(2)));
typedef __bf16 bf16x2_t __attribute__((ext_vector_type(2)));
#define MFMA32(a, b, c) __builtin_amdgcn_mfma_f32_32x32x16_bf16((a), (b), (c), 0, 0, 0)

constexpr int T = 49152, DM = 1024, NPROJ = 3072, NIN = 2960, DFF = 4096, HFF = 2048;
constexpr int C_R = 0, C_K = 256, C_V = 512, C_WD = 768, C_AD = 896, C_GD = 1024;
constexpr int C_AQ = 1152, C_AK = 1664, C_AV = 1792;
constexpr int C_MQ = 1920, C_MK = 2176, C_MV = 2432, C_MO = 2688, C_IG = 2944, C_FG = 2952;
constexpr size_t MiB = 1u << 20;
constexpr size_t WS_SS = 0, WS_CNT = MiB - 4096, WS_CDOT = 1 * MiB, WS_TAB = 2 * MiB + 512 * 1024, WS_BAR = 2 * MiB + 768 * 1024, WS_WIN = 3 * MiB, WS_WOUT = 15 * MiB,
                 WS_W1 = 19 * MiB, WS_W2 = 35 * MiB, WS_VT = 51 * MiB, WS_YB = 63 * MiB, WS_HBP = 87 * MiB, WS_X1 = 111 * MiB, WS_R = 207 * MiB,
                 WS_HID = WS_R + 96 * MiB, WS_END = 495 * MiB;
constexpr int LDS_BYTES = 134400 + 256;
constexpr int NTHR = 512;

struct KP { const float* in[26]; float* out; unsigned char* ws; };

DI unsigned cvtpk(float lo, float hi) { f32x2 v = {lo, hi}; bf16x2_t b = __builtin_convertvector(v, bf16x2_t); return __builtin_bit_cast(unsigned, b); }
DI unsigned short f2bf(float f) { return (unsigned short)(cvtpk(f, 0.f) & 0xffffu); }
DI float bf2f(unsigned h) { return __builtin_bit_cast(float, h << 16); }
DI float bflo(unsigned w) { return __builtin_bit_cast(float, w << 16); }
DI float bfhi(unsigned w) { return __builtin_bit_cast(float, w & 0xffff0000u); }
DI int crow(int reg, int h) { return (reg & 3) + 8 * (reg >> 2) + 4 * h; }
template <int CTRL> DI float dppf(float v) { return __builtin_bit_cast(float, __builtin_amdgcn_update_dpp(0, __builtin_bit_cast(int, v), CTRL, 0xf, 0xf, true)); }
DI float red8(float v) { v += dppf<0xB1>(v); v += dppf<0x4E>(v); v += dppf<0x141>(v); return v; }
DI float red16(float v) { v = red8(v); v += dppf<0x128>(v); return v; }
DI float frcp(float x) { return __builtin_amdgcn_rcpf(x); }
DI float sigmoidf_(float x) { return frcp(1.f + __expf(-x)); }
DI f32x16 zero16() { f32x16 z; for (int i = 0; i < 16; ++i) z[i] = 0.f; return z; }
DI void seq_of_job(int j, int& seq, int& h, int& dir) { if (j < 16) { seq = 8 + (j >> 3); } else { j -= 16; seq = j >> 3; } h = (j >> 1) & 3; dir = j & 1; }
DI void seq_info(int s, int& start, int& len) { if (s < 8) { start = s * 4096; len = 4096; } else { start = 32768 + (s - 8) * 8192; len = 8192; } }
DI int tok_seq_start(int tok, int& len) { if (tok < 32768) { len = 4096; return tok & ~4095; } len = 8192; return 32768 + ((tok - 32768) & ~8191); }

#define XB_TMO      128
#define XB_XCNT(j)  (256  + 64 * (j))
#define XB_XSUB(j)  (1280 + 64 * (j))
#define XB_XGEN(j)  (2304 + 64 * (j))
#define XB_TOP      3328
#define XB_TOPGEN   3392
#define XCD_BAR_WORDS 3456
#define XB_SPIN_CAP (1u << 18)

__device__ __forceinline__ unsigned xb_ld(unsigned* p)              { return __hip_atomic_load(p, __ATOMIC_RELAXED, __HIP_MEMORY_SCOPE_AGENT); }
__device__ __forceinline__ unsigned xb_add(unsigned* p, unsigned v) { return __hip_atomic_fetch_add(p, v, __ATOMIC_RELAXED, __HIP_MEMORY_SCOPE_AGENT); }
__device__ __forceinline__ unsigned xb_xcc_id() { return (unsigned)__builtin_amdgcn_s_getreg((3 << 11) | 20) & 0xFu; }
#define XB_SPIN(cond, bar) do { unsigned _sp = 0; while (cond) { __builtin_amdgcn_s_sleep(1); \
    if ((++_sp & 255u) == 0u) { if (xb_ld(&(bar)[XB_TMO])) break; if (_sp > XB_SPIN_CAP) { atomicAdd(&(bar)[XB_TMO], 1u); break; } } } } while (0)

struct XcdBarrier {
    unsigned* bar; unsigned x;
    volatile LAS unsigned* st;
};

__device__ __forceinline__ XcdBarrier xcd_barrier_post(unsigned* bar, volatile LAS unsigned* st) {
    XcdBarrier b; b.bar = bar; b.x = xb_xcc_id(); b.st = st;
    if (threadIdx.x == 0) (void)xb_add(&bar[XB_XCNT(b.x)], 1u);
    return b;
}
__device__ __forceinline__ void xcd_barrier_complete(unsigned* bar, unsigned x, unsigned& nloc, unsigned& nx) {
    const unsigned G = gridDim.x * gridDim.y * gridDim.z;
    unsigned sum, cnt, mine, sp = 0u;
    for (;;) {
        sum = 0u; cnt = 0u; mine = 0u;
#pragma unroll
        for (unsigned j = 0; j < 16; ++j) { const unsigned c = xb_ld(&bar[XB_XCNT(j)]); sum += c; cnt += (c > 0u) ? 1u : 0u; mine = (j == x) ? c : mine; }
        if (sum == G) break;
        __builtin_amdgcn_s_sleep(1);
        if ((++sp & 255u) == 0u) { if (xb_ld(&bar[XB_TMO])) break; if (sp > XB_SPIN_CAP) { atomicAdd(&bar[XB_TMO], 1u); break; } }
    }
    nloc = mine > 0u ? mine : 1u; nx = cnt > 0u ? cnt : 1u;
}

__device__ __forceinline__ void xcd_barrier(const XcdBarrier& b) {
    asm volatile("s_waitcnt vmcnt(0)" ::: "memory");
    __syncthreads();
    if (threadIdx.x == 0) {
        unsigned* bar = b.bar;
        __builtin_amdgcn_s_waitcnt(0);
        unsigned nloc = b.st[0], nx = b.st[1];
        if (nloc == 0u) { xcd_barrier_complete(bar, b.x, nloc, nx); b.st[0] = nloc; b.st[1] = nx; }
        const unsigned old = xb_add(&bar[XB_XSUB(b.x)], 1u);
        const unsigned gen = old / nloc;
        if (old + 1u == (gen + 1u) * nloc) {
            __builtin_amdgcn_fence(__ATOMIC_RELEASE, "agent");
            asm volatile("s_waitcnt vmcnt(0)" ::: "memory");
            const unsigned og = xb_add(&bar[XB_TOP], 1u);
            const unsigned tg = og / nx;
            if (og + 1u == (tg + 1u) * nx) xb_add(&bar[XB_TOPGEN], 1u);
            else XB_SPIN(xb_ld(&bar[XB_TOPGEN]) == tg, bar);
            __builtin_amdgcn_fence(__ATOMIC_ACQUIRE, "agent");
            xb_add(&bar[XB_XGEN(b.x)], 1u);
            asm volatile("s_waitcnt vmcnt(0)" ::: "memory");
        } else {
            XB_SPIN(xb_ld(&bar[XB_XGEN(b.x)]) == gen, bar);
            __builtin_amdgcn_fence(__ATOMIC_ACQUIRE, "agent");
            asm volatile("s_waitcnt vmcnt(0)" ::: "memory");
        }
    }
    __syncthreads();
}

struct EpiProj {
    static constexpr bool PERM = true, AFTER_DRAIN = false;
    bf16_t* O; const float* ss;
    DI void operator()(const pg8::f32x4 (&acc)[2][2][4][2], const pg8::Unit& u, int wr, int wc, int fr, int fq) const {
        const int row0 = u.pm * 256 + wr * 64 + fr, col0 = u.pn * 256 + wc * 32 + 8 * fq;
#pragma unroll
        for (int ai = 0; ai < 2; ++ai)
#pragma unroll
            for (int m = 0; m < 4; ++m) {
                const int row = row0 + ai * 128 + m * 16;
                const float rs = rsqrtf(ss[row] * (1.f / 1024.f) + 1e-6f);
                bf16_t* rp = O + (size_t)row * NPROJ + col0;
#pragma unroll
                for (int bj = 0; bj < 2; ++bj) {
                    pg8::f32x4 v0 = acc[ai][bj][m][0] * rs, v1 = acc[ai][bj][m][1] * rs;
                    u32x4 w; w.x = cvtpk(v0[0], v0[1]); w.y = cvtpk(v0[2], v0[3]); w.z = cvtpk(v1[0], v1[1]); w.w = cvtpk(v1[2], v1[3]);
                    *(u32x4*)(rp + bj * 128) = w;
                }
            }
    }
};
struct EpiRelu2 {
    static constexpr bool PERM = true, AFTER_DRAIN = false;
    bf16_t* O; const float* ss;
    DI void operator()(const pg8::f32x4 (&acc)[2][2][4][2], const pg8::Unit& u, int wr, int wc, int fr, int fq) const {
        const int row0 = u.pm * 256 + wr * 64 + fr, col0 = u.pn * 256 + wc * 32 + 8 * fq;
#pragma unroll
        for (int ai = 0; ai < 2; ++ai)
#pragma unroll
            for (int m = 0; m < 4; ++m) {
                const int row = row0 + ai * 128 + m * 16;
                const float rs = rsqrtf(ss[row] * (1.f / 1024.f) + 1e-6f);
                bf16_t* rp = O + (size_t)row * HFF + col0;
#pragma unroll
                for (int bj = 0; bj < 2; ++bj) {
                    pg8::f32x4 v0 = acc[ai][bj][m][0] * rs, v1 = acc[ai][bj][m][1] * rs;
#pragma unroll
                    for (int j = 0; j < 4; ++j) { float a = fmaxf(v0[j], 0.f); v0[j] = a * a; float b = fmaxf(v1[j], 0.f); v1[j] = b * b; }
                    u32x4 w; w.x = cvtpk(v0[0], v0[1]); w.y = cvtpk(v0[2], v0[3]); w.z = cvtpk(v1[0], v1[1]); w.w = cvtpk(v1[2], v1[3]);
                    *(u32x4*)(rp + bj * 128) = w;
                }
            }
    }
};
struct EpiPart {
    static constexpr bool PERM = true, AFTER_DRAIN = false;
    bf16_t* O;
    DI void operator()(const pg8::f32x4 (&acc)[2][2][4][2], const pg8::Unit& u, int wr, int wc, int fr, int fq) const {
        const int row0 = u.pm * 256 + wr * 64 + fr, col0 = u.pn * 256 + wc * 32 + 8 * fq;
#pragma unroll
        for (int ai = 0; ai < 2; ++ai)
#pragma unroll
            for (int m = 0; m < 4; ++m) {
                bf16_t* rp = O + (size_t)(row0 + ai * 128 + m * 16) * DM + col0;
#pragma unroll
                for (int bj = 0; bj < 2; ++bj) {
                    const pg8::f32x4 v0 = acc[ai][bj][m][0], v1 = acc[ai][bj][m][1];
                    u32x4 w; w.x = cvtpk(v0[0], v0[1]); w.y = cvtpk(v0[2], v0[3]); w.z = cvtpk(v1[0], v1[1]); w.w = cvtpk(v1[2], v1[3]);
                    *(u32x4*)(rp + bj * 128) = w;
                }
            }
    }
};
template <bool WRITE_HB, bool DO_SS, bool FIRST = false, bool PART = false> struct EpiRes {
    static constexpr bool PERM = true, AFTER_DRAIN = false;
    float* X; bf16_t* HB; float* ss; const float* xin0; const float* xin1;
    DI void operator()(const pg8::f32x4 (&acc)[2][2][4][2], const pg8::Unit& u, int wr, int wc, int fr, int fq) const {
        const int row0 = u.pm * 256 + wr * 64 + fr, col0 = u.pn * 256 + wc * 32 + 8 * fq;
#pragma unroll
        for (int ai = 0; ai < 2; ++ai)
#pragma unroll
            for (int m = 0; m < 4; ++m) {
                const int row = row0 + ai * 128 + m * 16;
                float* xp = X + (size_t)row * DM + col0;
                const float* rp = FIRST ? ((row < 32768 ? xin0 + (size_t)row * DM : xin1 + (size_t)(row - 32768) * DM) + col0) : xp;
                float sq = 0.f;
#pragma unroll
                for (int bj = 0; bj < 2; ++bj) {
                    pg8::f32x4 a0 = *(const pg8::f32x4*)(rp + bj * 128), a1 = *(const pg8::f32x4*)(rp + bj * 128 + 4);
                    a0 += acc[ai][bj][m][0]; a1 += acc[ai][bj][m][1];
                    if (PART) { const u32x4 pw = *(const u32x4*)(HB + (size_t)row * DM + col0 + bj * 128);
                        a0[0] += bflo(pw.x); a0[1] += bfhi(pw.x); a0[2] += bflo(pw.y); a0[3] += bfhi(pw.y); a1[0] += bflo(pw.z); a1[1] += bfhi(pw.z); a1[2] += bflo(pw.w); a1[3] += bfhi(pw.w); }
                    *(pg8::f32x4*)(xp + bj * 128) = a0; *(pg8::f32x4*)(xp + bj * 128 + 4) = a1;
                    if (WRITE_HB) { u32x4 w; w.x = cvtpk(a0[0], a0[1]); w.y = cvtpk(a0[2], a0[3]); w.z = cvtpk(a1[0], a1[1]); w.w = cvtpk(a1[2], a1[3]);
                        *(u32x4*)(HB + (size_t)row * DM + col0 + bj * 128) = w; }
                    if (DO_SS) sq += a0[0] * a0[0] + a0[1] * a0[1] + a0[2] * a0[2] + a0[3] * a0[3] + a1[0] * a1[0] + a1[1] * a1[1] + a1[2] * a1[2] + a1[3] * a1[3];
                }
                if (DO_SS) { sq += __shfl_xor(sq, 16); sq += __shfl_xor(sq, 32); if (fq == 0) atomicAdd(ss + row, sq); }
            }
    }
};

DI void transpose_tile(const float* src, int N, int nvalid, const float* gain, bf16_t* dst, int K, int kt, int nt, LAS float* tile, int tid) {
    const int a = tid & 63, b8 = tid >> 6;
#pragma unroll
    for (int i = 0; i < 8; ++i) { const int k = b8 + 8 * i, n = nt * 64 + a; float v = (n < nvalid) ? src[(size_t)(kt * 64 + k) * N + n] : 0.f; if (gain) v *= gain[kt * 64 + k]; tile[k * 65 + a] = v; }
    __syncthreads();
#pragma unroll
    for (int i = 0; i < 8; ++i) { const int n = b8 + 8 * i; dst[(size_t)(nt * 64 + n) * K + kt * 64 + a] = f2bf(tile[a * 65 + n]); }
    __syncthreads();
}
DI void convert_tile(const KP& p, int it, LAS float* tile, int tid) {
    {
        const int l = it / 3072; int r = it % 3072;
        const float* src; const float* gain; bf16_t* dst; int N, nvalid, K, kt, nt;
        if (r < 768) { src = p.in[3] + (size_t)l * 1024 * NIN; N = NIN; nvalid = NIN; K = 1024; gain = p.in[2] + l * 1024; dst = (bf16_t*)(p.ws + WS_WIN) + (size_t)l * NPROJ * 1024; kt = r / 48; nt = r % 48; }
        else if (r < 1024) { r -= 768; src = p.in[21] + (size_t)l * 1024 * 1024; N = 1024; nvalid = 1024; K = 1024; gain = nullptr; dst = (bf16_t*)(p.ws + WS_WOUT) + (size_t)l * 1024 * 1024; kt = r / 16; nt = r % 16; }
        else if (r < 2048) { r -= 1024; src = p.in[23] + (size_t)l * 1024 * 4096; N = 4096; nvalid = 4096; K = 1024; gain = p.in[22] + l * 1024; dst = (bf16_t*)(p.ws + WS_W1) + (size_t)l * 4096 * 1024; kt = r / 64; nt = r % 64; }
        else { r -= 2048; const int h = r / 512; r %= 512; src = p.in[24] + (size_t)l * 4096 * 1024 + (size_t)h * 2048 * 1024; N = 1024; nvalid = 1024; K = 2048; gain = nullptr;
               dst = (bf16_t*)(p.ws + WS_W2) + (size_t)l * 2 * 1024 * 2048 + (size_t)h * 1024 * 2048; kt = r / 16; nt = r % 16; }
        transpose_tile(src, N, nvalid, gain, dst, K, kt, nt, tile, tid);
    }
}
DI void p0_phase(const KP& p, LAS unsigned char* lds, int tid, int G, int bid) {
    LAS float* tile = (LAS float*)lds;
    for (int it = bid; it < 768; it += G) convert_tile(p, it, tile, tid);
    const int wave = tid >> 6, lane = tid & 63;
    float* ss = (float*)(p.ws + WS_SS);
    bf16_t* xb = (bf16_t*)(p.ws + WS_X1);
    for (int row0 = (bid * 8 + wave) * 2; row0 < T; row0 += G * 8 * 2) {
        f32x4 v[2][4];
#pragma unroll
        for (int r = 0; r < 2; ++r) {
            const int row = row0 + r;
            const float* xs = (row < 32768) ? p.in[0] + (size_t)row * DM : p.in[1] + (size_t)(row - 32768) * DM;
#pragma unroll
            for (int j = 0; j < 4; ++j) v[r][j] = *(const f32x4*)(xs + (j * 64 + lane) * 4);
        }
#pragma unroll
        for (int r = 0; r < 2; ++r) {
            const int row = row0 + r;
            float sq = 0.f;
#pragma unroll
            for (int j = 0; j < 4; ++j) {
                const f32x4 x = v[r][j];
                u32x2 w; w.x = cvtpk(x[0], x[1]); w.y = cvtpk(x[2], x[3]);
                *(u32x2*)(xb + (size_t)row * DM + (j * 64 + lane) * 4) = w;
                sq += x[0] * x[0] + x[1] * x[1] + x[2] * x[2] + x[3] * x[3];
            }
#pragma unroll
            for (int o = 32; o >= 1; o >>= 1) sq += __shfl_xor(sq, o);
            if (lane == 0) ss[row] = sq;
        }
    }
    for (int i = bid * NTHR + tid; i < 4 * T; i += G * NTHR) ss[T + i] = 0.f;
    if (bid == 0) {
        if (tid < 64) ((unsigned*)(p.ws + WS_CNT))[tid] = 0u;
        float2* tab = (float2*)(p.ws + WS_TAB);
        for (int idx = tid; idx < 2048; idx += NTHR) { const int pos = idx >> 4, f = idx & 15; const float inv = powf(10000.f, -(float)f / 16.f); const float ang = (float)pos * inv; tab[idx] = make_float2(cosf(ang), sinf(ang)); }
    }
}

DI void prep_phase(const KP& p, int l, LAS unsigned char* lds, int tid, int G, int bid) {
    bf16_t* proj = (bf16_t*)(p.ws + WS_R);
    bf16_t* vT = (bf16_t*)(p.ws + WS_VT);
    const float2* tab = (const float2*)(p.ws + WS_TAB);
    const float* qn = p.in[15] + l * 64; const float* kn = p.in[16] + l * 64;
    const int wave = tid >> 6, lane = tid & 63, g = lane >> 4, li = lane & 15;
    LAS bf16_t* vts = (LAS bf16_t*)lds;
    for (int unit = bid; unit < T / 64; unit += G) {
        const int tok0 = unit * 64;
        u32x2 raw[8][3];
#pragma unroll
        for (int i = 0; i < 8; ++i) {
            const int tok = tok0 + wave * 8 + i;
#pragma unroll
            for (int it = 0; it < 3; ++it) {
                const int colbase = (it < 2) ? C_AQ + (it * 4 + g) * 64 : C_AK + (g & 1) * 64;
                raw[i][it] = *(const u32x2*)(proj + (size_t)tok * NPROJ + colbase + li * 4);
            }
        }
#pragma unroll
        for (int i = 0; i < 8; ++i) {
            const int tok = tok0 + wave * 8 + i; int len; const int st = tok_seq_start(tok, len); const int pos = tok - st; const int prow = pos >> 6, pcol = pos & 63;
#pragma unroll
            for (int it = 0; it < 3; ++it) {
                const bool act = (it < 2) || (g < 2);
                const int colbase = (it < 2) ? C_AQ + (it * 4 + g) * 64 : C_AK + (g & 1) * 64;
                const float* wn = (it < 2) ? qn : kn;
                bf16_t* ptr = proj + (size_t)tok * NPROJ + colbase + li * 4;
                const u32x2 rw = raw[i][it];
                float x[4] = {bflo(rw.x), bfhi(rw.x), bflo(rw.y), bfhi(rw.y)};
                float sq = x[0] * x[0] + x[1] * x[1] + x[2] * x[2] + x[3] * x[3];
                sq = red16(sq);
                const float rinv = rsqrtf(sq * (1.f / 64.f) + 1e-6f);
                const f32x4 w4 = *(const f32x4*)(wn + li * 4);
                const int idx = (li >> 3) ? pcol : prow; const bool second = (li >> 2) & 1;
                const float scale = (it < 2) ? 0.125f * 1.4426950408889634f : 1.f;
                float o[4];
#pragma unroll
                for (int j = 0; j < 4; ++j) {
                    const float y = x[j] * rinv * w4[j];
                    const float pr = __shfl_xor(y, 4);
                    const int f = (li * 4 + j) & 15;
                    const float2 cs = tab[idx * 16 + f];
                    o[j] = (second ? (y * cs.x + pr * cs.y) : (y * cs.x - pr * cs.y)) * scale;
                }
                if (act) { u32x2 w; w.x = cvtpk(o[0], o[1]); w.y = cvtpk(o[2], o[3]); *(u32x2*)ptr = w; }
            }
        }
#pragma unroll
        for (int i = 0; i < 2; ++i) { const int idx = tid + NTHR * i; const int tl = idx >> 4, c8 = (idx & 15) * 8;
            const u32x4 v = *(const u32x4*)(proj + (size_t)(tok0 + tl) * NPROJ + C_AV + c8); *(LAS u32x4*)(vts + tl * 136 + c8) = v; }
        __syncthreads();
        { const int c = tid >> 2, tq = tid & 3; unsigned w[8];
#pragma unroll
          for (int j = 0; j < 8; ++j) { const unsigned lo = vts[(tq * 16 + 2 * j) * 136 + c], hi = vts[(tq * 16 + 2 * j + 1) * 136 + c]; w[j] = lo | (hi << 16); }
          u32x4 a = {w[0], w[1], w[2], w[3]}, b = {w[4], w[5], w[6], w[7]};
          bf16_t* dp = vT + (size_t)c * T + tok0 + tq * 16; *(u32x4*)dp = a; *(u32x4*)(dp + 8) = b; }
        __syncthreads();
    }
}

DI void attn_unit(const KP& p, int l, int unit, LAS unsigned char* lds, int tid) {
    const float* qnw = p.in[15] + l * 64; const float* knw = p.in[16] + l * 64;
    const bf16_t* proj = (const bf16_t*)(p.ws + WS_R);
    const bf16_t* vT = (const bf16_t*)(p.ws + WS_VT);
    bf16_t* mix = (bf16_t*)(p.ws + WS_X1);
    int seq, kvh, qt;
    if (unit < 512) { seq = 8 + (unit >> 8); const int r = unit & 255; kvh = r >> 7; qt = r & 127; }
    else { const int u2 = unit - 512; seq = u2 >> 7; const int r = u2 & 127; kvh = r >> 6; qt = r & 63; }
    int start, len; seq_info(seq, start, len);
    const int nk = len >> 6;
    const int wave = tid >> 6, lane = tid & 63, r32 = lane & 31, hh = lane >> 5;
    const int head = kvh * 4 + (wave >> 1);
    const int q0 = start + qt * 64 + (wave & 1) * 32;
    bf16x8 qf[4];
    { const bf16_t* qp = proj + (size_t)(q0 + r32) * NPROJ + C_AQ + head * 64 + hh * 8;
#pragma unroll
      for (int ks = 0; ks < 4; ++ks) qf[ks] = *(const bf16x8*)(qp + ks * 16); }
    f32x16 o0 = zero16(), o1 = zero16();
    float lsum = 0.f;
    f32x16 sinit;
    { float mq = fabsf(qnw[lane]), mk = fabsf(knw[lane]);
#pragma unroll
      for (int o = 32; o >= 1; o >>= 1) { mq = fmaxf(mq, __shfl_xor(mq, o)); mk = fmaxf(mk, __shfl_xor(mk, o)); }
      const float bnd = 64.f * 0.125f * 1.4426950408889634f * 1.01f * mq * mk;
#pragma unroll
      for (int i = 0; i < 16; ++i) sinit[i] = -bnd; }
    const int lrow = tid >> 3, lseg = tid & 7;
    const bf16_t* kptr = proj + (size_t)(start + lrow) * NPROJ + C_AK + kvh * 64 + lseg * 8;
    const bf16_t* vptr = vT + (size_t)(kvh * 64 + lrow) * T + start + lseg * 8;
    const int lds_off = lrow * 144 + lseg * 16;
    u32x4 kreg = *(const u32x4*)kptr, vreg = *(const u32x4*)vptr;
    *(LAS u32x4*)(lds + lds_off) = kreg; *(LAS u32x4*)(lds + 9216 + lds_off) = vreg;
    kreg = *(const u32x4*)(kptr + (size_t)64 * NPROJ); vreg = *(const u32x4*)(vptr + 64);
    u32x4 kreg2 = kreg, vreg2 = vreg;
    __syncthreads();
    for (int j = 0; j < nk; ++j) {
        const bool more = (j + 1 < nk);
        if (j + 2 < nk) { kreg2 = *(const u32x4*)(kptr + (size_t)(j + 2) * 64 * NPROJ); vreg2 = *(const u32x4*)(vptr + (j + 2) * 64); }
        LAS unsigned char* Ks = lds + (j & 1) * 18432; LAS unsigned char* Vs = Ks + 9216;
        f32x16 s0 = sinit, s1 = sinit;
#pragma unroll
        for (int ks = 0; ks < 4; ++ks) {
            const bf16x8 a0 = *(const LAS bf16x8*)(Ks + r32 * 144 + (ks * 16 + hh * 8) * 2);
            const bf16x8 a1 = *(const LAS bf16x8*)(Ks + (32 + r32) * 144 + (ks * 16 + hh * 8) * 2);
            s0 = MFMA32(a0, qf[ks], s0); s1 = MFMA32(a1, qf[ks], s1);
        }
        float rs = 0.f;
#pragma unroll
        for (int i = 0; i < 16; ++i) { s0[i] = __builtin_amdgcn_exp2f(s0[i]); rs += s0[i]; }
#pragma unroll
        for (int i = 0; i < 16; ++i) { s1[i] = __builtin_amdgcn_exp2f(s1[i]); rs += s1[i]; }
        lsum += rs;
#pragma unroll
        for (int mb = 0; mb < 2; ++mb)
#pragma unroll
            for (int s = 0; s < 2; ++s) {
                u32x4 pk;
                if (mb == 0) { pk.x = cvtpk(s0[8 * s], s0[8 * s + 1]); pk.y = cvtpk(s0[8 * s + 2], s0[8 * s + 3]); pk.z = cvtpk(s0[8 * s + 4], s0[8 * s + 5]); pk.w = cvtpk(s0[8 * s + 6], s0[8 * s + 7]); }
                else         { pk.x = cvtpk(s1[8 * s], s1[8 * s + 1]); pk.y = cvtpk(s1[8 * s + 2], s1[8 * s + 3]); pk.z = cvtpk(s1[8 * s + 4], s1[8 * s + 5]); pk.w = cvtpk(s1[8 * s + 6], s1[8 * s + 7]); }
                const bf16x8 pb = __builtin_bit_cast(bf16x8, pk);
                const int keyoff = 32 * mb + 16 * s + 4 * hh;
                { const s16x4 lo = *(const LAS s16x4*)(Vs + r32 * 144 + keyoff * 2), hi = *(const LAS s16x4*)(Vs + r32 * 144 + (keyoff + 8) * 2);
                  const bf16x8 va = __builtin_shufflevector(lo, hi, 0, 1, 2, 3, 4, 5, 6, 7); o0 = MFMA32(va, pb, o0); }
                { const s16x4 lo = *(const LAS s16x4*)(Vs + (32 + r32) * 144 + keyoff * 2), hi = *(const LAS s16x4*)(Vs + (32 + r32) * 144 + (keyoff + 8) * 2);
                  const bf16x8 va = __builtin_shufflevector(lo, hi, 0, 1, 2, 3, 4, 5, 6, 7); o1 = MFMA32(va, pb, o1); }
            }
        if (more) { LAS unsigned char* Kn = lds + ((j + 1) & 1) * 18432; *(LAS u32x4*)(Kn + lds_off) = kreg; *(LAS u32x4*)(Kn + 9216 + lds_off) = vreg; }
        asm volatile("s_waitcnt lgkmcnt(0)\n\ts_barrier" ::: "memory");
        kreg = kreg2; vreg = vreg2;
    }
    lsum += __shfl_xor(lsum, 32);
    const float inv = 1.f / lsum;
    bf16_t* op = mix + (size_t)(q0 + r32) * DM + 256 + head * 64;
#pragma unroll
    for (int g4 = 0; g4 < 4; ++g4) {
        u32x2 w0; w0.x = cvtpk(o0[4 * g4] * inv, o0[4 * g4 + 1] * inv); w0.y = cvtpk(o0[4 * g4 + 2] * inv, o0[4 * g4 + 3] * inv);
        *(u32x2*)(op + 8 * g4 + 4 * hh) = w0;
        u32x2 w1; w1.x = cvtpk(o1[4 * g4] * inv, o1[4 * g4 + 1] * inv); w1.y = cvtpk(o1[4 * g4 + 2] * inv, o1[4 * g4 + 3] * inv);
        *(u32x2*)(op + 32 + 8 * g4 + 4 * hh) = w1;
    }
}

constexpr int RW_BUF = 49152, RW_XR = 0, RW_XKD = 8192, RW_XV = 16384, RW_WLW = 24576, RW_ALB = 32768, RW_KKN = 40960, RW_YO = 98304, RW_XWD = 106496, RW_XAD = 111104,
              RW_W2T = 115712, RW_A2T = 124928, RW_CD = 134144, SLOT_OFF = 134400;
#define RW_BAR() asm volatile("s_waitcnt lgkmcnt(0)\n\ts_barrier" ::: "memory")
#define RW_DECODE(i_) const int t = (pt >> 4) + 16 * ((i_) / 5), c4 = (pt & 15) * 4; constexpr int gi = (i_) % 5; \
            const int col = (gi == 0) ? C_R + h * 64 + c4 : (gi == 1) ? C_K + h * 64 + c4 : (gi == 2) ? C_V + h * 64 + c4 : (gi == 3) ? C_WD + dir * 64 + c4 : C_AD + dir * 64 + c4;
#define RW_ISSUE1(chx, i_) { const int t = (pt >> 4) + 16 * ((i_) / 5); \
            const int n = (chx) * 32 + t; const int pos = dir ? (len - 1 - n) : n; \
            const bf16_t* bp = bq[i_]; bq[i_] = bp + bstep; \
            rc[i_] = *(const u32x2*)bp; rp_[i_] = (u32x2){0u, 0u}; rn[i_] = (u32x2){0u, 0u}; \
            if (pos > 0) rp_[i_] = *(const u32x2*)(bp - NPROJ); \
            if (pos < len - 1) rn[i_] = *(const u32x2*)(bp + NPROJ); }
#define RW_ISSUE(chx) do { RW_ISSUE1(chx, 0) RW_ISSUE1(chx, 1) RW_ISSUE1(chx, 2) RW_ISSUE1(chx, 3) RW_ISSUE1(chx, 4) RW_ISSUE1(chx, 5) RW_ISSUE1(chx, 6) RW_ISSUE1(chx, 7) RW_ISSUE1(chx, 8) RW_ISSUE1(chx, 9) } while (0)
#define RW_ISSUEM1(i_) { const bf16_t* bp = bq[i_]; bq[i_] = bp + bstep; \
            rc[i_] = *(const u32x2*)bp; rp_[i_] = *(const u32x2*)(bp - NPROJ); rn[i_] = *(const u32x2*)(bp + NPROJ); }
#define RW_ISSUE_MID() do { RW_ISSUEM1(0) RW_ISSUEM1(1) RW_ISSUEM1(2) RW_ISSUEM1(3) RW_ISSUEM1(4) RW_ISSUEM1(5) RW_ISSUEM1(6) RW_ISSUEM1(7) RW_ISSUEM1(8) RW_ISSUEM1(9) } while (0)
#define RW_CONV1(i_) { RW_DECODE(i_) \
            const f32x4 m4 = mureg[gi]; \
            f32x4 x = {bflo(rc[i_].x), bfhi(rc[i_].x), bflo(rc[i_].y), bfhi(rc[i_].y)}; \
            const f32x4 pn = {bflo(rp_[i_].x) + bflo(rn[i_].x), bfhi(rp_[i_].x) + bfhi(rn[i_].x), bflo(rp_[i_].y) + bflo(rn[i_].y), bfhi(rp_[i_].y) + bfhi(rn[i_].y)}; \
            x = x + (0.5f * pn - x) * m4; \
            if (gi < 3) { LAS float* dst = (gi == 0) ? XR : (gi == 1) ? XKD : XV; *(LAS f32x4*)(dst + t * 64 + c4) = x; } \
            else if (gi == 3) { \
                _Pragma("unroll") for (int j = 0; j < 4; ++j) { const float e = __expf(2.f * x[j]); x[j] = 1.f - 2.f * frcp(e + 1.f); } \
                u32x2 w; w.x = cvtpk(x[0], x[1]); w.y = cvtpk(x[2], x[3]); *(LAS u32x2*)(XWD + t * 72 + c4) = w; } \
            else { u32x2 w; w.x = cvtpk(x[0], x[1]); w.y = cvtpk(x[2], x[3]); *(LAS u32x2*)(XAD + t * 72 + c4) = w; } }
DI void rwkv_job(const KP& p, int l, int job, LAS unsigned char* lds, int tid) {
    int seq, h, dir, rpart; constexpr int nrows = 32;
    { int j = job; if (j < 32) { seq = 8 + (j >> 4); } else { j -= 32; seq = j >> 4; } h = (j >> 2) & 3; dir = (j >> 1) & 1; rpart = j & 1; }
    int start, len; seq_info(seq, start, len);
    const bf16_t* proj = (const bf16_t*)(p.ws + WS_R);
    bf16_t* mix = (bf16_t*)(p.ws + WS_X1);
    bf16_t* yb = (bf16_t*)(p.ws + WS_YB);
    float* cdot = (float*)(p.ws + WS_CDOT);
    const float* mu = p.in[4] + l * 1152;
    const int wave = tid >> 6, lane = tid & 63, r32 = lane & 31, hh = lane >> 5;
    LAS bf16_t* XWD = (LAS bf16_t*)(lds + RW_XWD); LAS bf16_t* XAD = (LAS bf16_t*)(lds + RW_XAD);
    LAS bf16_t* W2T = (LAS bf16_t*)(lds + RW_W2T); LAS bf16_t* A2T = (LAS bf16_t*)(lds + RW_A2T);
    { const float* w2 = p.in[6] + (size_t)((l * 2 + dir) * 64) * 256 + h * 64; const float* a2 = p.in[8] + (size_t)((l * 2 + dir) * 64) * 256 + h * 64;
#pragma unroll
      for (int i = 0; i < 8; ++i) { const int idx = tid + NTHR * i; const int mm = idx >> 6, c = idx & 63; W2T[c * 72 + mm] = f2bf(w2[mm * 256 + c]); A2T[c * 72 + mm] = f2bf(a2[mm * 256 + c]); } }
    const int nch = len >> 5;
    __syncthreads();
    if (tid < 256) {
        const int srow = tid >> 3, sj = (tid & 7) * 8;
        f32x4 Sa = {0.f, 0.f, 0.f, 0.f}, Sb = {0.f, 0.f, 0.f, 0.f};
        RW_BAR(); RW_BAR(); RW_BAR();
#define RW_LD(dst, arr, tt) const f32x4 dst##a = *(const LAS f32x4*)((arr) + (tt) * 64 + sj), dst##b = *(const LAS f32x4*)((arr) + (tt) * 64 + sj + 4)
        for (int ch = 0; ch < nch; ++ch) {
            LAS unsigned char* B = lds + (ch & 1) * RW_BUF;
            LAS float* XR = (LAS float*)(B + RW_XR); LAS float* XKD = (LAS float*)(B + RW_XKD); LAS float* XV = (LAS float*)(B + RW_XV);
            LAS float* WLW = (LAS float*)(B + RW_WLW); LAS float* ALB = (LAS float*)(B + RW_ALB); LAS float* KKN = (LAS float*)(B + RW_KKN);
            LAS float* YO = (LAS float*)(lds + RW_YO + (ch & 1) * 4096);
            f32x4 wa = *(const LAS f32x4*)(WLW + sj), wb = *(const LAS f32x4*)(WLW + sj + 4), ka = *(const LAS f32x4*)(KKN + sj), kb = *(const LAS f32x4*)(KKN + sj + 4);
            f32x4 ba = *(const LAS f32x4*)(ALB + sj), bb = *(const LAS f32x4*)(ALB + sj + 4), da = *(const LAS f32x4*)(XKD + sj), db = *(const LAS f32x4*)(XKD + sj + 4);
            f32x4 ra = *(const LAS f32x4*)(XR + sj), rb = *(const LAS f32x4*)(XR + sj + 4);
            float v = XV[rpart * 32 + srow];
#pragma unroll 8
            for (int t = 0; t < 32; ++t) {
                const int tn = (t < 31) ? t + 1 : 31;
                RW_LD(wn, WLW, tn); RW_LD(kn, KKN, tn); RW_LD(bn, ALB, tn); RW_LD(dn, XKD, tn); RW_LD(rn_, XR, tn);
                const float vn = XV[tn * 64 + rpart * 32 + srow];
                const f32x4 pa = Sa * ka + Sb * kb;
                float sa = (pa[0] + pa[1]) + (pa[2] + pa[3]);
                sa = -red8(sa);
                Sa = Sa * wa + sa * ba + v * da;
                Sb = Sb * wb + sa * bb + v * db;
                const f32x4 py = Sa * ra + Sb * rb;
                float y = (py[0] + py[1]) + (py[2] + py[3]);
                y = red8(y);
                YO[t * 32 + srow] = y;
                wa = wna; wb = wnb; ka = kna; kb = knb; ba = bna; bb = bnb; da = dna; db = dnb; ra = rn_a; rb = rn_b; v = vn;
                if (t == 19 || t == 23) RW_BAR();
            }
            RW_BAR();
        }
    } else {
        const int ptid = tid - 256;
        const int cli = ptid & 15, cc4 = cli * 4;
        const f32x4 w0v = *(const f32x4*)(p.in[5] + (l * 2 + dir) * 256 + h * 64 + cc4);
        const f32x4 a0v = *(const f32x4*)(p.in[7] + (l * 2 + dir) * 256 + h * 64 + cc4);
        const f32x4 kkw = *(const f32x4*)(p.in[10] + l * 256 + h * 64 + cc4);
        const f32x4 kaw = *(const f32x4*)(p.in[11] + l * 256 + h * 64 + cc4);
        const f32x4 rkw = *(const f32x4*)(p.in[12] + l * 256 + h * 64 + cc4);
        u32x2 rc[10], rp_[10], rn[10];
        const bf16_t* bq[10];
        const long bstep = dir ? -(long)32 * NPROJ : (long)32 * NPROJ;
#define RW_BQ(i_) { const int pt = ptid; RW_DECODE(i_) const int pos = dir ? (len - 1 - t) : t; bq[i_] = proj + (size_t)(start + pos) * NPROJ + col; }
        RW_BQ(0) RW_BQ(1) RW_BQ(2) RW_BQ(3) RW_BQ(4) RW_BQ(5) RW_BQ(6) RW_BQ(7) RW_BQ(8) RW_BQ(9)
        f32x4 mureg[5];
        { const int c4 = (ptid & 15) * 4;
          mureg[0] = *(const f32x4*)(mu + C_R + h * 64 + c4); mureg[1] = *(const f32x4*)(mu + C_K + h * 64 + c4); mureg[2] = *(const f32x4*)(mu + C_V + h * 64 + c4);
          mureg[3] = *(const f32x4*)(mu + C_WD + dir * 64 + c4); mureg[4] = *(const f32x4*)(mu + C_AD + dir * 64 + c4); }
        { int pt = ptid; RW_ISSUE(0); }
        for (int ch = -1; ch < nch; ++ch) {
            int pt = ptid; asm volatile("" : "+v"(pt));
            if (ch >= 1) {
                const int pc = ch - 1;
                LAS float* YO = (LAS float*)(lds + RW_YO + (pc & 1) * 4096); LAS float* CD = (LAS float*)(lds + RW_CD + (pc & 1) * 128);
                const int t = ptid >> 3, c4 = (ptid & 7) * 4;
                const int n = pc * 32 + t; const int pos = dir ? (len - 1 - n) : n; const int tok = start + pos;
                const f32x4 yv = *(const LAS f32x4*)(YO + t * 32 + c4);
                u32x2 w; w.x = cvtpk(yv[0], yv[1]); w.y = cvtpk(yv[2], yv[3]);
                if (c4 < nrows) { if (dir) *(u32x2*)(yb + (size_t)tok * 256 + h * 64 + rpart * nrows + c4) = w; else *(u32x2*)(mix + (size_t)tok * DM + h * 64 + rpart * nrows + c4) = w; }
                if (rpart == 0 && ptid < 32) { const int n2 = pc * 32 + ptid; const int pos2 = dir ? (len - 1 - n2) : n2; cdot[((size_t)(start + pos2) * 4 + h) * 2 + dir] = CD[ptid]; }
            }
            const int nc = ch + 1;
            const bool build = nc < nch;
            LAS unsigned char* B = lds + (nc & 1) * RW_BUF;
            LAS float* XR = (LAS float*)(B + RW_XR); LAS float* XKD = (LAS float*)(B + RW_XKD); LAS float* XV = (LAS float*)(B + RW_XV);
            LAS float* WLW = (LAS float*)(B + RW_WLW); LAS float* ALB = (LAS float*)(B + RW_ALB); LAS float* KKN = (LAS float*)(B + RW_KKN);
            LAS float* CDn = (LAS float*)(lds + RW_CD + (nc & 1) * 128);
            if (build) {
                RW_CONV1(0) RW_CONV1(1) RW_CONV1(2) RW_CONV1(3) RW_CONV1(4) RW_CONV1(5) RW_CONV1(6) RW_CONV1(7) RW_CONV1(8) RW_CONV1(9)
                if (nc + 1 < nch - 1) RW_ISSUE_MID(); else if (nc + 1 < nch) RW_ISSUE(nc + 1);
            }
            RW_BAR();
            if (build) {
                const int mat = (wave - 4) >> 1, nb = (wave - 4) & 1;
                LAS bf16_t* Xs = mat ? XAD : XWD; LAS bf16_t* Ws = mat ? A2T : W2T;
                f32x16 acc = zero16();
#pragma unroll
                for (int ks = 0; ks < 4; ++ks) {
                    const bf16x8 a = *(const LAS bf16x8*)(Xs + r32 * 72 + ks * 16 + hh * 8);
                    const bf16x8 bb = *(const LAS bf16x8*)(Ws + (nb * 32 + r32) * 72 + ks * 16 + hh * 8);
                    acc = MFMA32(a, bb, acc);
                }
                LAS float* dst = mat ? ALB : WLW;
#pragma unroll
                for (int i = 0; i < 16; ++i) dst[crow(i, hh) * 64 + nb * 32 + r32] = acc[i];
            }
            RW_BAR();
            if (build) {
#pragma unroll
                for (int it = 0; it < 2; ++it) {
                    const int ct = (ptid >> 4) + 16 * it;
                    const f32x4 wl = *(const LAS f32x4*)(WLW + ct * 64 + cc4), al = *(const LAS f32x4*)(ALB + ct * 64 + cc4);
                    const f32x4 k4 = *(const LAS f32x4*)(XKD + ct * 64 + cc4), r4 = *(const LAS f32x4*)(XR + ct * 64 + cc4);
                    f32x4 w, a, kkr, kd;
                    float ssq = 0.f, cd = 0.f;
#pragma unroll
                    for (int j = 0; j < 4; ++j) {
                        const float sg = sigmoidf_(w0v[j] + wl[j]);
                        w[j] = __expf(-0.6065306597126334f * sg);
                        a[j] = sigmoidf_(a0v[j] + al[j]);
                        kkr[j] = k4[j] * kkw[j]; ssq += kkr[j] * kkr[j];
                        kd[j] = k4[j] * (1.f + (a[j] - 1.f) * kaw[j]);
                        cd += r4[j] * kd[j] * rkw[j];
                    }
                    ssq = red16(ssq); cd = red16(cd);
                    const float inv = __builtin_amdgcn_rsqf(fmaxf(ssq, 1e-24f));
                    f32x4 kkn, bv;
#pragma unroll
                    for (int j = 0; j < 4; ++j) { kkn[j] = kkr[j] * inv; bv[j] = kkn[j] * a[j]; }
                    *(LAS f32x4*)(WLW + ct * 64 + cc4) = w; *(LAS f32x4*)(ALB + ct * 64 + cc4) = bv; *(LAS f32x4*)(KKN + ct * 64 + cc4) = kkn; *(LAS f32x4*)(XKD + ct * 64 + cc4) = kd;
                    if (cli == 0) CDn[ct] = cd;
                }
            }
            RW_BAR();
        }
        {
            const int pc = nch - 1;
            LAS float* YO = (LAS float*)(lds + RW_YO + (pc & 1) * 4096); LAS float* CD = (LAS float*)(lds + RW_CD + (pc & 1) * 128);
            const int t = ptid >> 3, c4 = (ptid & 7) * 4;
            const int n = pc * 32 + t; const int pos = dir ? (len - 1 - n) : n; const int tok = start + pos;
            const f32x4 yv = *(const LAS f32x4*)(YO + t * 32 + c4);
            u32x2 w; w.x = cvtpk(yv[0], yv[1]); w.y = cvtpk(yv[2], yv[3]);
            if (c4 < nrows) { if (dir) *(u32x2*)(yb + (size_t)tok * 256 + h * 64 + rpart * nrows + c4) = w; else *(u32x2*)(mix + (size_t)tok * DM + h * 64 + rpart * nrows + c4) = w; }
            if (rpart == 0 && ptid < 32) { const int n2 = pc * 32 + ptid; const int pos2 = dir ? (len - 1 - n2) : n2; cdot[((size_t)(start + pos2) * 4 + h) * 2 + dir] = CD[ptid]; }
        }
    }
    __syncthreads();
}

constexpr int PJ_XR = 0, PJ_XK = 8192, PJ_XV = 16384, PJ_WL = 24576, PJ_AL = 32768, PJ_KK = 40960, PJ_XWD = 49152, PJ_XAD = 53760, PJ_W2T = 58368, PJ_A2T = 67584, PJ_YO = 76800, PJ_CD = 84992;
#define PJ_DECODE(i_) const int t = tid >> 4, c4 = (tid & 15) * 4; constexpr int gi = (i_); \
            const int col = (gi == 0) ? C_R + h * 64 + c4 : (gi == 1) ? C_K + h * 64 + c4 : (gi == 2) ? C_V + h * 64 + c4 : (gi == 3) ? C_WD + dir * 64 + c4 : C_AD + dir * 64 + c4;
#define PJ_ISSUE1(chx, i_) { const int t = tid >> 4; \
            const int n = (chx) * 32 + t; const int pos = dir ? (len - 1 - n) : n; \
            const bf16_t* bp = bq[i_]; bq[i_] = bp + bstep; \
            rc[i_] = *(const u32x2*)bp; rp_[i_] = (u32x2){0u, 0u}; rn[i_] = (u32x2){0u, 0u}; \
            if (pos > 0) rp_[i_] = *(const u32x2*)(bp - NPROJ); \
            if (pos < len - 1) rn[i_] = *(const u32x2*)(bp + NPROJ); }
#define PJ_ISSUE(chx) do { PJ_ISSUE1(chx, 0) PJ_ISSUE1(chx, 1) PJ_ISSUE1(chx, 2) PJ_ISSUE1(chx, 3) PJ_ISSUE1(chx, 4) } while (0)
#define PJ_ISSUEM1(i_) { const bf16_t* bp = bq[i_]; bq[i_] = bp + bstep; rc[i_] = *(const u32x2*)bp; rp_[i_] = *(const u32x2*)(bp - NPROJ); rn[i_] = *(const u32x2*)(bp + NPROJ); }
#define PJ_ISSUE_MID() do { PJ_ISSUEM1(0) PJ_ISSUEM1(1) PJ_ISSUEM1(2) PJ_ISSUEM1(3) PJ_ISSUEM1(4) } while (0)
#define PJ_BQ(i_) { PJ_DECODE(i_) const int pos = dir ? (len - 1 - t) : t; bq[i_] = proj + (size_t)(start + pos) * NPROJ + col; }
#define PJ_CONV1(i_) { PJ_DECODE(i_) \
            const f32x4 m4 = *(const f32x4*)(mu + col); \
            f32x4 x = {bflo(rc[i_].x), bfhi(rc[i_].x), bflo(rc[i_].y), bfhi(rc[i_].y)}; \
            const f32x4 pn = {bflo(rp_[i_].x) + bflo(rn[i_].x), bfhi(rp_[i_].x) + bfhi(rn[i_].x), bflo(rp_[i_].y) + bflo(rn[i_].y), bfhi(rp_[i_].y) + bfhi(rn[i_].y)}; \
            x = x + (0.5f * pn - x) * m4; \
            if (gi < 3) { LAS float* dst = (gi == 0) ? XR : (gi == 1) ? XK : XV; *(LAS f32x4*)(dst + t * 64 + c4) = x; } \
            else if (gi == 3) { \
                _Pragma("unroll") for (int j = 0; j < 4; ++j) { const float e = __expf(2.f * x[j]); x[j] = 1.f - 2.f * frcp(e + 1.f); } \
                u32x2 w; w.x = cvtpk(x[0], x[1]); w.y = cvtpk(x[2], x[3]); *(LAS u32x2*)(XWD + t * 72 + c4) = w; } \
            else { u32x2 w; w.x = cvtpk(x[0], x[1]); w.y = cvtpk(x[2], x[3]); *(LAS u32x2*)(XAD + t * 72 + c4) = w; } }
DI void rwkv_job_p(const KP& p, int l, int job, LAS unsigned char* lds, int tid) {
    const int seq = job >> 3, h = (job >> 1) & 3, dir = job & 1;
    int start, len; seq_info(seq, start, len);
    const bf16_t* proj = (const bf16_t*)(p.ws + WS_R);
    bf16_t* mix = (bf16_t*)(p.ws + WS_X1);
    bf16_t* yb = (bf16_t*)(p.ws + WS_YB);
    float* cdot = (float*)(p.ws + WS_CDOT);
    const float* mu = p.in[4] + l * 1152;
    const int wave = tid >> 6, lane = tid & 63, r32 = lane & 31, hh = lane >> 5;
    LAS float* XR = (LAS float*)(lds + PJ_XR); LAS float* XK = (LAS float*)(lds + PJ_XK); LAS float* XV = (LAS float*)(lds + PJ_XV);
    LAS float* WL = (LAS float*)(lds + PJ_WL); LAS float* AL = (LAS float*)(lds + PJ_AL); LAS float* KK = (LAS float*)(lds + PJ_KK);
    LAS bf16_t* XWD = (LAS bf16_t*)(lds + PJ_XWD); LAS bf16_t* XAD = (LAS bf16_t*)(lds + PJ_XAD); LAS bf16_t* W2T = (LAS bf16_t*)(lds + PJ_W2T); LAS bf16_t* A2T = (LAS bf16_t*)(lds + PJ_A2T);
    LAS float* CD = (LAS float*)(lds + PJ_CD); LAS float* YO = (LAS float*)(lds + PJ_YO);
    { const float* w2 = p.in[6] + (size_t)((l * 2 + dir) * 64) * 256 + h * 64; const float* a2 = p.in[8] + (size_t)((l * 2 + dir) * 64) * 256 + h * 64;
#pragma unroll
      for (int i = 0; i < 8; ++i) { const int idx = tid + NTHR * i; const int mm = idx >> 6, c = idx & 63; W2T[c * 72 + mm] = f2bf(w2[mm * 256 + c]); A2T[c * 72 + mm] = f2bf(a2[mm * 256 + c]); } }
    const int ct = tid >> 4, cli = tid & 15, cc4 = cli * 4;
    const f32x4 w0v = *(const f32x4*)(p.in[5] + (l * 2 + dir) * 256 + h * 64 + cc4);
    const f32x4 a0v = *(const f32x4*)(p.in[7] + (l * 2 + dir) * 256 + h * 64 + cc4);
    const f32x4 kkw = *(const f32x4*)(p.in[10] + l * 256 + h * 64 + cc4);
    const f32x4 kaw = *(const f32x4*)(p.in[11] + l * 256 + h * 64 + cc4);
    const f32x4 rkw = *(const f32x4*)(p.in[12] + l * 256 + h * 64 + cc4);
    const int srow = tid >> 3, sj = (tid & 7) * 8;
    f32x4 Sa = {0.f, 0.f, 0.f, 0.f}, Sb = {0.f, 0.f, 0.f, 0.f};
    u32x2 rc[5], rp_[5], rn[5];
    const bf16_t* bq[5];
    const long bstep = dir ? -(long)32 * NPROJ : (long)32 * NPROJ;
    PJ_BQ(0) PJ_BQ(1) PJ_BQ(2) PJ_BQ(3) PJ_BQ(4)
    const int nch = len >> 5;
    PJ_ISSUE(0);
    __syncthreads();
    for (int ch = 0; ch < nch; ++ch) {
        PJ_CONV1(0) PJ_CONV1(1) PJ_CONV1(2) PJ_CONV1(3) PJ_CONV1(4)
        if (ch + 1 < nch - 1) PJ_ISSUE_MID(); else if (ch + 1 < nch) PJ_ISSUE(ch + 1);
        RW_BAR();
        if (wave < 4) {
            const int mat = wave >> 1, nb = wave & 1;
            LAS bf16_t* Xs = mat ? XAD : XWD; LAS bf16_t* Ws = mat ? A2T : W2T;
            f32x16 acc = zero16();
#pragma unroll
            for (int ks = 0; ks < 4; ++ks) {
                const bf16x8 a = *(const LAS bf16x8*)(Xs + r32 * 72 + ks * 16 + hh * 8);
                const bf16x8 b = *(const LAS bf16x8*)(Ws + (nb * 32 + r32) * 72 + ks * 16 + hh * 8);
                acc = MFMA32(a, b, acc);
            }
            LAS float* dst = mat ? AL : WL;
#pragma unroll
            for (int i = 0; i < 16; ++i) dst[crow(i, hh) * 64 + nb * 32 + r32] = acc[i];
        }
        RW_BAR();
        {
            const f32x4 wl = *(const LAS f32x4*)(WL + ct * 64 + cc4), al = *(const LAS f32x4*)(AL + ct * 64 + cc4);
            const f32x4 k4 = *(const LAS f32x4*)(XK + ct * 64 + cc4), r4 = *(const LAS f32x4*)(XR + ct * 64 + cc4);
            f32x4 lw, a, kkr, kd;
            float ssq = 0.f, cd = 0.f;
#pragma unroll
            for (int j = 0; j < 4; ++j) {
                lw[j] = __expf(-0.6065306597126334f * sigmoidf_(w0v[j] + wl[j]));
                a[j] = sigmoidf_(a0v[j] + al[j]);
                kkr[j] = k4[j] * kkw[j]; ssq += kkr[j] * kkr[j];
                kd[j] = k4[j] * (1.f + (a[j] - 1.f) * kaw[j]);
                cd += r4[j] * kd[j] * rkw[j];
            }
            ssq = red16(ssq); cd = red16(cd);
            const float inv = __builtin_amdgcn_rsqf(fmaxf(ssq, 1e-24f));
            f32x4 kkn, b;
#pragma unroll
            for (int j = 0; j < 4; ++j) { kkn[j] = kkr[j] * inv; b[j] = kkn[j] * a[j]; }
            *(LAS f32x4*)(WL + ct * 64 + cc4) = lw; *(LAS f32x4*)(AL + ct * 64 + cc4) = b; *(LAS f32x4*)(KK + ct * 64 + cc4) = kkn; *(LAS f32x4*)(XK + ct * 64 + cc4) = kd;
            if (cli == 0) CD[ct] = cd;
        }
        RW_BAR();
        {
            f32x4 wa = *(const LAS f32x4*)(WL + sj), wb = *(const LAS f32x4*)(WL + sj + 4), ka = *(const LAS f32x4*)(KK + sj), kb = *(const LAS f32x4*)(KK + sj + 4);
            f32x4 ba = *(const LAS f32x4*)(AL + sj), bb = *(const LAS f32x4*)(AL + sj + 4), da = *(const LAS f32x4*)(XK + sj), db = *(const LAS f32x4*)(XK + sj + 4);
            f32x4 ra = *(const LAS f32x4*)(XR + sj), rb = *(const LAS f32x4*)(XR + sj + 4);
            float v = XV[srow];
#pragma unroll 8
            for (int t = 0; t < 32; ++t) {
                const int tn = (t < 31) ? t + 1 : 31;
                RW_LD(wn, WL, tn); RW_LD(kn, KK, tn); RW_LD(bn, AL, tn); RW_LD(dn, XK, tn); RW_LD(rn_, XR, tn);
                const float vn = XV[tn * 64 + srow];
                const f32x4 pa = Sa * ka + Sb * kb;
                float sa = (pa[0] + pa[1]) + (pa[2] + pa[3]);
                sa = -red8(sa);
                Sa = Sa * wa + sa * ba + v * da;
                Sb = Sb * wb + sa * bb + v * db;
                const f32x4 py = Sa * ra + Sb * rb;
                float y = (py[0] + py[1]) + (py[2] + py[3]);
                y = red8(y);
                YO[t * 64 + srow] = y;
                wa = wna; wb = wnb; ka = kna; kb = knb; ba = bna; bb = bnb; da = dna; db = dnb; ra = rn_a; rb = rn_b; v = vn;
            }
        }
        RW_BAR();
        {
            const int n = ch * 32 + ct; const int pos = dir ? (len - 1 - n) : n; const int tok = start + pos;
            const f32x4 yv = *(const LAS f32x4*)(YO + ct * 64 + cc4);
            u32x2 w; w.x = cvtpk(yv[0], yv[1]); w.y = cvtpk(yv[2], yv[3]);
            if (dir) *(u32x2*)(yb + (size_t)tok * 256 + h * 64 + cc4) = w; else *(u32x2*)(mix + (size_t)tok * DM + h * 64 + cc4) = w;
            if (tid < 32) { const int n2 = ch * 32 + tid; const int pos2 = dir ? (len - 1 - n2) : n2; cdot[((size_t)(start + pos2) * 4 + h) * 2 + dir] = CD[tid]; }
        }
    }
    __syncthreads();
}

constexpr int ML_QS = 0, ML_KS = 9216, ML_KT = 18432, ML_VT = 27648, ML_VWT = 36864, ML_PS = 46080, ML_CB = 55296, ML_WGT = 64512, ML_RR = 64768, ML_MROW = 65024,
              ML_SC = 65280, ML_EMT = 65536, ML_DENI = 65792, ML_NS = 66048, ML_A12 = 66304;
DI void mlstm_job(const KP& p, int l, int job, LAS unsigned char* lds, int tid) {
    int seq, hm, dir; seq_of_job(job, seq, hm, dir);
    int start, len; seq_info(seq, start, len);
    const bf16_t* proj = (const bf16_t*)(p.ws + WS_R);
    bf16_t* mix = (bf16_t*)(p.ws + WS_X1);
    bf16_t* hbp = (bf16_t*)(p.ws + WS_HBP);
    const float* cw = p.in[17] + l * 3 * 512;
    const float ibv = p.in[18][(l * 2 + dir) * 4 + hm], fbv = p.in[19][(l * 2 + dir) * 4 + hm];
    const int wave = tid >> 6, lane = tid & 63, r32 = lane & 31, hh = lane >> 5;
    LAS bf16_t* Qs = (LAS bf16_t*)(lds + ML_QS); LAS bf16_t* Ks = (LAS bf16_t*)(lds + ML_KS); LAS bf16_t* KT = (LAS bf16_t*)(lds + ML_KT);
    LAS bf16_t* VT = (LAS bf16_t*)(lds + ML_VT); LAS bf16_t* VWT = (LAS bf16_t*)(lds + ML_VWT); LAS bf16_t* Ps = (LAS bf16_t*)(lds + ML_PS); LAS bf16_t* CB = (LAS bf16_t*)(lds + ML_CB);
    LAS float* WGT = (LAS float*)(lds + ML_WGT); LAS float* RR = (LAS float*)(lds + ML_RR); LAS float* MROW = (LAS float*)(lds + ML_MROW); LAS float* SC = (LAS float*)(lds + ML_SC);
    LAS float* EMT = (LAS float*)(lds + ML_EMT); LAS float* DENI = (LAS float*)(lds + ML_DENI); LAS float* NS = (LAS float*)(lds + ML_NS); LAS float* A12 = (LAS float*)(lds + ML_A12);
    for (int i = tid; i < 64 * 72; i += NTHR) CB[i] = 0;
    if (tid < 64) NS[tid] = 0.f;
    f32x16 Creg = zero16();
    float Mst = 0.f;
    __syncthreads();
    const int nch = len >> 6;
    const int ll = tid >> 3, e8 = (tid & 7) * 8;
    for (int ch = 0; ch < nch; ++ch) {
        {
            const int n = ch * 64 + ll; const int pos = dir ? (len - 1 - n) : n; const int tok = start + pos;
#pragma unroll
            for (int which = 0; which < 2; ++which) {
                const int col = (which ? C_MK : C_MQ) + hm * 64 + e8; const int cwc = (which ? 256 : 0) + hm * 64 + e8;
                const bf16_t* bp = proj + (size_t)tok * NPROJ + col;
                const u32x4 cu = *(const u32x4*)bp; u32x4 pv = {0u, 0u, 0u, 0u}, nv = {0u, 0u, 0u, 0u};
                if (pos > 0) pv = *(const u32x4*)(bp - NPROJ);
                if (pos < len - 1) nv = *(const u32x4*)(bp + NPROJ);
                float o[8];
#pragma unroll
                for (int j = 0; j < 4; ++j) {
                    const f32x2 c0 = *(const f32x2*)(cw + cwc + 2 * j), c1 = *(const f32x2*)(cw + 512 + cwc + 2 * j), c2 = *(const f32x2*)(cw + 1024 + cwc + 2 * j);
                    const float v0 = c0.x * bflo(pv[j]) + c1.x * bflo(cu[j]) + c2.x * bflo(nv[j]);
                    const float v1 = c0.y * bfhi(pv[j]) + c1.y * bfhi(cu[j]) + c2.y * bfhi(nv[j]);
                    o[2 * j] = v0 * sigmoidf_(v0); o[2 * j + 1] = v1 * sigmoidf_(v1);
                }
                if (which) {
#pragma unroll
                    for (int j = 0; j < 8; ++j) o[j] *= 0.125f;
                }
                u32x4 w; w.x = cvtpk(o[0], o[1]); w.y = cvtpk(o[2], o[3]); w.z = cvtpk(o[4], o[5]); w.w = cvtpk(o[6], o[7]);
                if (!which) *(LAS u32x4*)(Qs + ll * 72 + e8) = w;
                else { *(LAS u32x4*)(Ks + ll * 72 + e8) = w;
#pragma unroll
                    for (int j = 0; j < 4; ++j) { KT[(e8 + 2 * j) * 72 + ll] = (bf16_t)(w[j] & 0xffffu); KT[(e8 + 2 * j + 1) * 72 + ll] = (bf16_t)(w[j] >> 16); } }
            }
        }
        if (wave == 0) {
            const int n = ch * 64 + lane; const int pos = dir ? (len - 1 - n) : n; const int tok = start + pos;
            const float igv = bf2f(proj[(size_t)tok * NPROJ + C_IG + dir * 4 + hm]) + ibv;
            const float fgv = bf2f(proj[(size_t)tok * NPROJ + C_FG + dir * 4 + hm]) + fbv;
            const float lf = (fgv > 0.f) ? -log1pf(__expf(-fgv)) : (fgv - log1pf(__expf(fgv)));
            float b = lf;
#pragma unroll
            for (int o = 1; o < 64; o <<= 1) { const float t2 = __shfl_up(b, o); if (lane >= o) b += t2; }
            const float bL = __shfl(b, 63);
            const float g = bL - b + igv;
            float mg = g;
#pragma unroll
            for (int o = 32; o >= 1; o >>= 1) mg = fmaxf(mg, __shfl_xor(mg, o));
            const float wgt = __expf(g - mg);
            const float r = igv - b;
            float cm = r;
#pragma unroll
            for (int o = 1; o < 64; o <<= 1) { const float t2 = __shfl_up(cm, o); if (lane >= o) cm = fmaxf(cm, t2); }
            const float mrow = fmaxf(cm, Mst);
            WGT[lane] = wgt; RR[lane] = r; MROW[lane] = mrow; SC[lane] = __expf(Mst - mrow); EMT[lane] = __expf(-(b + mrow));
            const float Mnew = fmaxf(bL + Mst, mg);
            if (lane == 0) { A12[0] = __expf(bL + Mst - Mnew); A12[1] = __expf(mg - Mnew); }
            Mst = Mnew;
        }
        __syncthreads();
        {
            const int n = ch * 64 + ll; const int pos = dir ? (len - 1 - n) : n; const int tok = start + pos;
            const u32x4 vv = *(const u32x4*)(proj + (size_t)tok * NPROJ + C_MV + hm * 64 + e8);
            const float wg = WGT[ll];
#pragma unroll
            for (int j = 0; j < 4; ++j) {
                VT[(e8 + 2 * j) * 72 + ll] = (bf16_t)(vv[j] & 0xffffu); VT[(e8 + 2 * j + 1) * 72 + ll] = (bf16_t)(vv[j] >> 16);
                const unsigned pw = cvtpk(bflo(vv[j]) * wg, bfhi(vv[j]) * wg);
                VWT[(e8 + 2 * j) * 72 + ll] = (bf16_t)(pw & 0xffffu); VWT[(e8 + 2 * j + 1) * 72 + ll] = (bf16_t)(pw >> 16);
            }
        }
        __syncthreads();
        if (wave < 4) {
            const int tb = wave >> 1, sb = wave & 1;
            f32x16 acc = zero16();
#pragma unroll
            for (int ks = 0; ks < 4; ++ks) {
                const bf16x8 a = *(const LAS bf16x8*)(Qs + (tb * 32 + r32) * 72 + ks * 16 + hh * 8);
                const bf16x8 b = *(const LAS bf16x8*)(Ks + (sb * 32 + r32) * 72 + ks * 16 + hh * 8);
                acc = MFMA32(a, b, acc);
            }
            const int s = sb * 32 + r32; const float rs_ = RR[s];
#pragma unroll
            for (int i = 0; i < 16; ++i) { const int t = tb * 32 + crow(i, hh); const float pvv = (s <= t) ? __expf(rs_ - MROW[t]) * acc[i] : 0.f; Ps[t * 72 + s] = f2bf(pvv); }
        } else {
            const int db = (wave - 4) >> 1, eb = (wave - 4) & 1;
            f32x16 kc = zero16();
#pragma unroll
            for (int ks = 0; ks < 4; ++ks) {
                const bf16x8 a = *(const LAS bf16x8*)(VWT + (db * 32 + r32) * 72 + ks * 16 + hh * 8);
                const bf16x8 b = *(const LAS bf16x8*)(KT + (eb * 32 + r32) * 72 + ks * 16 + hh * 8);
                kc = MFMA32(a, b, kc);
            }
            const float a1 = A12[0], a2 = A12[1];
#pragma unroll
            for (int i = 0; i < 16; ++i) Creg[i] = a1 * Creg[i] + a2 * kc[i];
        }
        __syncthreads();
        f32x16 acc = zero16();
        float ncv = 0.f;
        if (wave < 4) {
            const int tb = wave >> 1, db = wave & 1;
#pragma unroll
            for (int ks = 0; ks < 4; ++ks) {
                const bf16x8 a = *(const LAS bf16x8*)(Qs + (tb * 32 + r32) * 72 + ks * 16 + hh * 8);
                const bf16x8 b = *(const LAS bf16x8*)(CB + (db * 32 + r32) * 72 + ks * 16 + hh * 8);
                acc = MFMA32(a, b, acc);
            }
#pragma unroll
            for (int i = 0; i < 16; ++i) acc[i] *= SC[tb * 32 + crow(i, hh)];
#pragma unroll
            for (int ks = 0; ks < 4; ++ks) {
                const bf16x8 a = *(const LAS bf16x8*)(Ps + (tb * 32 + r32) * 72 + ks * 16 + hh * 8);
                const bf16x8 b = *(const LAS bf16x8*)(VT + (db * 32 + r32) * 72 + ks * 16 + hh * 8);
                acc = MFMA32(a, b, acc);
            }
        } else if (wave == 4) {
            float rsum = 0.f, qn = 0.f;
            for (int e = 0; e < 64; ++e) { rsum += bf2f(Ps[lane * 72 + e]); qn += bf2f(Qs[lane * 72 + e]) * NS[e]; }
            const float den = rsum + SC[lane] * qn;
            DENI[lane] = 1.f / fmaxf(fabsf(den), EMT[lane]);
        } else if (wave == 5) {
            for (int s = 0; s < 64; ++s) ncv += WGT[s] * bf2f(KT[lane * 72 + s]);
        }
        __syncthreads();
        if (wave < 4) {
            const int tb = wave >> 1, db = wave & 1;
#pragma unroll
            for (int i = 0; i < 16; ++i) {
                const int t = tb * 32 + crow(i, hh); const int n = ch * 64 + t; const int pos = dir ? (len - 1 - n) : n; const int tok = start + pos;
                const bf16_t o = f2bf(acc[i] * DENI[t]);
                if (dir) hbp[(size_t)tok * 256 + hm * 64 + db * 32 + r32] = o; else mix[(size_t)tok * DM + 768 + hm * 64 + db * 32 + r32] = o;
            }
        } else {
            const int db = (wave - 4) >> 1, eb = (wave - 4) & 1;
#pragma unroll
            for (int i = 0; i < 16; ++i) CB[(db * 32 + crow(i, hh)) * 72 + eb * 32 + r32] = f2bf(Creg[i]);
            if (wave == 5) NS[lane] = A12[0] * NS[lane] + A12[1] * ncv;
        }
        __syncthreads();
    }
}

DI void mixers_phase(const KP& p, int l, int cidx, LAS unsigned char* lds, int tid, int G, int bid) {
    unsigned* cnt = (unsigned*)(p.ws + WS_CNT) + cidx;
    LAS int* slot = (LAS int*)(lds + SLOT_OFF);
    for (;;) {
        if (tid == 0) *slot = (int)atomicAdd(cnt, 1u);
        __syncthreads();
        const int item = *slot;
        __syncthreads();
        if (item >= 176 + 1536) {
            if (l != 0 || item >= 176 + 1536 + 1344) break;
            const int t0 = 768 + (item - 1712) * 4;
            for (int q = 0; q < 4; ++q) convert_tile(p, t0 + q, (LAS float*)lds, tid);
            continue;
        }
        int kind, jb;
        if (item < 32) { kind = 0; jb = item; } else if (item < 48) { kind = 1; jb = item - 32; } else if (item < 112) { kind = 3; jb = item - 48; }
        else if (item < 176) { kind = 1; jb = item - 112 + 16; } else { kind = 2; jb = item - 176; }
        int t2 = tid; asm volatile("" : "+v"(t2));
#ifndef REP_R
#define REP_R 1
#endif
#ifndef REP_M
#define REP_M 1
#endif
#ifndef REP_T
#define REP_T 1
#endif
        if (kind == 0) { rwkv_job(p, l, jb, lds, t2); }
        else if (kind == 3) { rwkv_job_p(p, l, jb, lds, t2); }
        else if (kind == 1) { for (int rep = 0; rep < REP_M; ++rep) { mlstm_job(p, l, jb, lds, t2); __syncthreads(); } }
        else { for (int rep = 0; rep < REP_T; ++rep) { attn_unit(p, l, jb, lds, t2); __syncthreads(); } }
        __syncthreads();
    }
}

constexpr int PO_G2T = 0, PO_AS = 69632, PO_GO = 87040;
DI void post_phase(const KP& p, int l, LAS unsigned char* lds, int tid, int G, int bid) {
    const bf16_t* proj = (const bf16_t*)(p.ws + WS_R);
    bf16_t* mix = (bf16_t*)(p.ws + WS_X1);
    const bf16_t* yb = (const bf16_t*)(p.ws + WS_YB);
    const bf16_t* hbp = (const bf16_t*)(p.ws + WS_HBP);
    const float* cdot = (const float*)(p.ws + WS_CDOT);
    const float* mu = p.in[4] + l * 1152;
    const float* lnw = p.in[13] + l * 256; const float* lnb = p.in[14] + l * 256; const float* nw = p.in[20] + l * 256;
    LAS bf16_t* G2T = (LAS bf16_t*)(lds + PO_G2T); LAS bf16_t* AS = (LAS bf16_t*)(lds + PO_AS); LAS bf16_t* GO = (LAS bf16_t*)(lds + PO_GO);
    const int wave = tid >> 6, lane = tid & 63, r32 = lane & 31, hh = lane >> 5;
    { const float* g2 = p.in[9] + (size_t)l * 128 * 256;
      for (int i = 0; i < 64; ++i) { const int idx = tid + NTHR * i; const int mm = idx >> 8, c = idx & 255; G2T[c * 136 + mm] = f2bf(g2[idx]); } }
    __syncthreads();
    for (int unit = bid; unit < T / 64; unit += G) {
        const int tok0 = unit * 64;
        int len; const int st = tok_seq_start(tok0, len);
#pragma unroll
        for (int i = 0; i < 4; ++i) {
            const int q = tid + NTHR * i; const int t = q >> 5, c4 = (q & 31) * 4; const int tok = tok0 + t; const int pos = tok - st;
            const bf16_t* bp = proj + (size_t)tok * NPROJ + C_GD + c4;
            const u32x2 cu = *(const u32x2*)bp; u32x2 pv = {0u, 0u}, nv = {0u, 0u};
            if (pos > 0) pv = *(const u32x2*)(bp - NPROJ);
            if (pos < len - 1) nv = *(const u32x2*)(bp + NPROJ);
            const f32x4 m4 = *(const f32x4*)(mu + C_GD + c4);
            float x[4] = {bflo(cu.x), bfhi(cu.x), bflo(cu.y), bfhi(cu.y)};
            const float pn[4] = {bflo(pv.x) + bflo(nv.x), bfhi(pv.x) + bfhi(nv.x), bflo(pv.y) + bflo(nv.y), bfhi(pv.y) + bfhi(nv.y)};
#pragma unroll
            for (int j = 0; j < 4; ++j) x[j] = sigmoidf_(x[j] + (0.5f * pn[j] - x[j]) * m4[j]);
            u32x2 w; w.x = cvtpk(x[0], x[1]); w.y = cvtpk(x[2], x[3]); *(LAS u32x2*)(AS + t * 136 + c4) = w;
        }
        __syncthreads();
        {
            const int hd = wave & 3, tb = wave >> 2;
            f32x16 a0 = zero16(), a1 = zero16();
#pragma unroll
            for (int ks = 0; ks < 8; ++ks) {
                const bf16x8 a = *(const LAS bf16x8*)(AS + (tb * 32 + r32) * 136 + ks * 16 + hh * 8);
                const bf16x8 b0 = *(const LAS bf16x8*)(G2T + (hd * 64 + r32) * 136 + ks * 16 + hh * 8);
                const bf16x8 b1 = *(const LAS bf16x8*)(G2T + (hd * 64 + 32 + r32) * 136 + ks * 16 + hh * 8);
                a0 = MFMA32(a, b0, a0); a1 = MFMA32(a, b1, a1);
            }
#pragma unroll
            for (int i = 0; i < 16; ++i) { const int t = tb * 32 + crow(i, hh); GO[t * 264 + hd * 64 + r32] = f2bf(a0[i]); GO[t * 264 + hd * 64 + 32 + r32] = f2bf(a1[i]); }
        }
        __syncthreads();
#pragma unroll 1
        for (int it = 0; it < 8; ++it) {
            const int task = tid + NTHR * it; const int grp = task >> 4, li = task & 15; const int t = grp >> 2, hd = grp & 3; const int c4 = li * 4;
            const int tok = tok0 + t; const int pos = tok - st;
            {
                const u32x2 yf = *(const u32x2*)(mix + (size_t)tok * DM + hd * 64 + c4), ybv = *(const u32x2*)(yb + (size_t)tok * 256 + hd * 64 + c4);
                float x[4] = {bflo(yf.x) + bflo(ybv.x), bfhi(yf.x) + bfhi(ybv.x), bflo(yf.y) + bflo(ybv.y), bfhi(yf.y) + bfhi(ybv.y)};
                const float mean = red16(x[0] + x[1] + x[2] + x[3]) * (1.f / 64.f);
                float vs = 0.f;
#pragma unroll
                for (int j = 0; j < 4; ++j) { x[j] -= mean; vs += x[j] * x[j]; }
                const float rstd = rsqrtf(red16(vs) * (1.f / 64.f) + 64e-5f);
                const bf16_t* bp = proj + (size_t)tok * NPROJ + C_V + hd * 64 + c4;
                const u32x2 cu = *(const u32x2*)bp; u32x2 pv = {0u, 0u}, nv = {0u, 0u};
                if (pos > 0) pv = *(const u32x2*)(bp - NPROJ);
                if (pos < len - 1) nv = *(const u32x2*)(bp + NPROJ);
                const f32x4 m4 = *(const f32x4*)(mu + C_V + hd * 64 + c4);
                float v[4] = {bflo(cu.x), bfhi(cu.x), bflo(cu.y), bfhi(cu.y)};
                const float pn[4] = {bflo(pv.x) + bflo(nv.x), bfhi(pv.x) + bfhi(nv.x), bflo(pv.y) + bflo(nv.y), bfhi(pv.y) + bfhi(nv.y)};
                const f32x2 cdv = *(const f32x2*)(cdot + ((size_t)tok * 4 + hd) * 2);
                const float cds = cdv.x + cdv.y;
                const f32x4 lw = *(const f32x4*)(lnw + hd * 64 + c4), lb = *(const f32x4*)(lnb + hd * 64 + c4);
                const u32x2 gv = *(const LAS u32x2*)(GO + t * 264 + hd * 64 + c4);
                const float g[4] = {bflo(gv.x), bfhi(gv.x), bflo(gv.y), bfhi(gv.y)};
                float o[4];
#pragma unroll
                for (int j = 0; j < 4; ++j) { const float vsft = v[j] + (0.5f * pn[j] - v[j]) * m4[j]; o[j] = (x[j] * rstd * lw[j] + lb[j] + cds * vsft) * g[j]; }
                u32x2 w; w.x = cvtpk(o[0], o[1]); w.y = cvtpk(o[2], o[3]); *(u32x2*)(mix + (size_t)tok * DM + hd * 64 + c4) = w;
            }
            {
                const u32x2 hf = *(const u32x2*)(mix + (size_t)tok * DM + 768 + hd * 64 + c4), hb = *(const u32x2*)(hbp + (size_t)tok * 256 + hd * 64 + c4);
                const float x[4] = {bflo(hf.x) + bflo(hb.x), bfhi(hf.x) + bfhi(hb.x), bflo(hf.y) + bflo(hb.y), bfhi(hf.y) + bfhi(hb.y)};
                const float ms = red16(x[0] * x[0] + x[1] * x[1] + x[2] * x[2] + x[3] * x[3]) * (1.f / 64.f);
                const float rinv = rsqrtf(ms + 1e-6f);
                const u32x2 ov = *(const u32x2*)(proj + (size_t)tok * NPROJ + C_MO + hd * 64 + c4);
                const float og[4] = {bflo(ov.x), bfhi(ov.x), bflo(ov.y), bfhi(ov.y)};
                const f32x4 nwv = *(const f32x4*)(nw + hd * 64 + c4);
                float o[4];
#pragma unroll
                for (int j = 0; j < 4; ++j) o[j] = sigmoidf_(og[j]) * x[j] * rinv * nwv[j];
                u32x2 w; w.x = cvtpk(o[0], o[1]); w.y = cvtpk(o[2], o[3]); *(u32x2*)(mix + (size_t)tok * DM + 768 + hd * 64 + c4) = w;
            }
        }
        __syncthreads();
    }
}

DI void final_phase(const KP& p, int tid, int G, int bid) {
    const float* ss = (const float*)(p.ws + WS_SS) + 4 * T;
    const float* g = p.in[25];
    const int wave = tid >> 6, lane = tid & 63;
    f32x4 gv[4];
#pragma unroll
    for (int j = 0; j < 4; ++j) gv[j] = *(const f32x4*)(g + (j * 64 + lane) * 4);
    for (int row = (bid * 8 + wave) * 4; row < T; row += G * 8 * 4) {
        f32x4 v[4][4]; float rs[4];
#pragma unroll
        for (int r = 0; r < 4; ++r) {
            rs[r] = rsqrtf(ss[row + r] * (1.f / 1024.f) + 1e-6f);
#pragma unroll
            for (int j = 0; j < 4; ++j) v[r][j] = *(const f32x4*)(p.out + (size_t)(row + r) * DM + (j * 64 + lane) * 4);
        }
#pragma unroll
        for (int r = 0; r < 4; ++r)
#pragma unroll
            for (int j = 0; j < 4; ++j) *(f32x4*)(p.out + (size_t)(row + r) * DM + (j * 64 + lane) * 4) = v[r][j] * rs[r] * gv[j];
    }
}

__global__ void __launch_bounds__(NTHR, 2) fwd_kernel(KP p) {
    extern __shared__ __attribute__((aligned(16))) unsigned char lds_raw[];
    LAS unsigned char* lds = (LAS unsigned char*)lds_raw;
    cg::grid_group grid = cg::this_grid();
    int tid = threadIdx.x; const int G = gridDim.x, bid = blockIdx.x;
#define LAUNDER() asm volatile("" : "+v"(tid))
    float* ss = (float*)(p.ws + WS_SS);
    bf16_t* X1 = (bf16_t*)(p.ws + WS_X1);
    bf16_t* PROJ = (bf16_t*)(p.ws + WS_R);
    bf16_t* HB = (bf16_t*)(p.ws + WS_R);
    bf16_t* HID = (bf16_t*)(p.ws + WS_HID);

        LAUNDER();
    volatile LAS unsigned* bst = (volatile LAS unsigned*)(lds + SLOT_OFF + 16);
    if (tid == 0) { bst[0] = 0u; bst[1] = 0u; }
    __syncthreads();
    const XcdBarrier xbar = xcd_barrier_post((unsigned*)(p.ws + WS_BAR), bst);
#define GSYNC() xcd_barrier(xbar)
    p0_phase(p, lds, tid, G, bid);
    grid.sync();
#ifdef PROBE_SYNC20
    for (int i = 0; i < 20; ++i) GSYNC();
#endif
#ifdef PROBE_P0X2
    LAUNDER(); p0_phase(p, lds, tid, G, bid);
    GSYNC();
#endif
#ifdef PROBE_SYNC10
    for (int i = 0; i < 10; ++i) GSYNC();
#endif
    for (int l = 0; l < 2; ++l) {
        {
            pg8::Gemm g{X1, (const bf16_t*)(p.ws + WS_WIN) + (size_t)l * NPROJ * 1024, T, NPROJ, 1024}; pg8::StaticOrder S; S.init(T, NPROJ, G, bid);
            EpiProj E{PROJ, ss + (2 * l) * T};
            pg8::gemm_phase<EpiProj, pg8::StaticOrder, true, true>(lds, g, S, E);
#ifdef PROBE_P1X2
            GSYNC();
            pg8::gemm_phase<EpiProj, pg8::StaticOrder, true, true>(lds, g, S, E);
#endif
        }
        GSYNC();
        LAUNDER();
        prep_phase(p, l, lds, tid, G, bid);
        GSYNC();
        LAUNDER();
        mixers_phase(p, l, l, lds, tid, G, bid);
#ifdef PROBE_MIX2
        GSYNC(); LAUNDER();
        mixers_phase(p, l, l + 2, lds, tid, G, bid);
#endif
        GSYNC();
        LAUNDER();
        post_phase(p, l, lds, tid, G, bid);
        GSYNC();
        {
            pg8::Gemm g{X1, (const bf16_t*)(p.ws + WS_WOUT) + (size_t)l * 1024 * 1024, T, DM, 1024}; pg8::StaticOrder S; S.init(T, DM, G, bid);
            if (l == 0) { EpiRes<true, true, true> E{p.out, HB, ss + (2 * l + 1) * T, p.in[0], p.in[1]}; pg8::gemm_phase<EpiRes<true, true, true>, pg8::StaticOrder, true, true>(lds, g, S, E); }
            else { EpiRes<true, true> E{p.out, HB, ss + (2 * l + 1) * T, nullptr, nullptr}; pg8::gemm_phase<EpiRes<true, true>, pg8::StaticOrder, true, true>(lds, g, S, E); }
        }
        GSYNC();
        for (int hf = 0; hf < 2; ++hf) {
            {
                pg8::Gemm g{HB, (const bf16_t*)(p.ws + WS_W1) + (size_t)l * 4096 * 1024 + (size_t)hf * HFF * 1024, T, HFF, 1024}; pg8::StaticOrder S; S.init(T, HFF, G, bid);
                EpiRelu2 E{HID, ss + (2 * l + 1) * T};
                pg8::gemm_phase<EpiRelu2, pg8::StaticOrder, true, true>(lds, g, S, E);
            }
            GSYNC();
            {
                pg8::Gemm g{HID, (const bf16_t*)(p.ws + WS_W2) + (size_t)l * 2 * 1024 * 2048 + (size_t)hf * 1024 * 2048, T, DM, HFF}; pg8::StaticOrder S; S.init(T, DM, G, bid);
                if (hf == 0) { EpiPart E{X1}; pg8::gemm_phase<EpiPart, pg8::StaticOrder, true, true>(lds, g, S, E); }
                else { EpiRes<true, true, false, true> E{p.out, X1, ss + (2 * l + 2) * T, nullptr, nullptr}; pg8::gemm_phase<EpiRes<true, true, false, true>, pg8::StaticOrder, true, true>(lds, g, S, E); }
            }
            GSYNC();
        }
    }
        LAUNDER();
    final_phase(p, tid, G, bid);
}

extern "C" void kernel_launch(void* const* d_in, const int* in_sizes, int n_in, void* d_out, int out_size, void* d_ws, size_t ws_size, hipStream_t stream) {
    static int grid_blocks = 0;
    if (grid_blocks == 0) {
        if (n_in != 26 || out_size != T * DM || ws_size < WS_END) { fprintf(stderr, "kernel_launch: unexpected shapes (n_in %d out %d ws %zu)\n", n_in, out_size, ws_size); grid_blocks = -1; return; }
        int dev = 0, cus = 0, per_cu = 0;
        hipGetDevice(&dev);
        hipDeviceGetAttribute(&cus, hipDeviceAttributeMultiprocessorCount, dev);
        hipFuncSetAttribute((const void*)fwd_kernel, hipFuncAttributeMaxDynamicSharedMemorySize, LDS_BYTES);
        hipOccupancyMaxActiveBlocksPerMultiprocessor(&per_cu, (const void*)fwd_kernel, NTHR, LDS_BYTES);
        if (per_cu < 1) per_cu = 1;
        grid_blocks = cus * per_cu;
        (void)hipGetLastError();
    }
    if (grid_blocks < 0) return;
    KP p{};
    for (int i = 0; i < 26; ++i) p.in[i] = (const float*)d_in[i];
    p.out = (float*)d_out; p.ws = (unsigned char*)d_ws;
    (void)hipMemsetAsync((char*)d_ws + WS_BAR, 0, 16384, stream);
    void* args[] = {&p};
    hipError_t e = hipLaunchCooperativeKernel((const void*)fwd_kernel, dim3(grid_blocks), dim3(NTHR), args, LDS_BYTES, stream);
    if (e != hipSuccess) fprintf(stderr, "cooperative launch failed: %s (grid %d)\n", hipGetErrorString(e), grid_blocks);
}
```
